# Optimizing an MI355X kernel written in HIP

```python
import jax
import jax.numpy as jnp
from jax import lax
import numpy as np

D_MODEL = 1024
BATCH = 2
SEQ = 8192
DEPTH = 2

MIX_WIDTH = D_MODEL // 2
N_BRANCH = 3
NORM_EPS = 1e-6

SGU_GROUPS = 4
SGU_CHUNK = 128
SGU_WIDTH = MIX_WIDTH
SGU_GROUP_DIM = SGU_WIDTH // SGU_GROUPS

SWA_HEADS = 8
SWA_KV_HEADS = 2
SWA_HEAD_DIM = MIX_WIDTH // SWA_HEADS
SWA_GROUP = SWA_HEADS // SWA_KV_HEADS
WINDOW = 128
ROPE_THETA = 500000.0
ROPE_DIM = SWA_HEAD_DIM // 4

DN_HEADS = 4
DN_HEAD_DIM = MIX_WIDTH // DN_HEADS
DN_CONV = 4
DN_CHUNK = 64

D_FF = ((8 * D_MODEL // 3 + 255) // 256) * 256

IN_WIDTHS = (SGU_WIDTH, SGU_WIDTH,
             SWA_HEADS * SWA_HEAD_DIM, SWA_KV_HEADS * SWA_HEAD_DIM, SWA_KV_HEADS * SWA_HEAD_DIM,
             3 * MIX_WIDTH, MIX_WIDTH, DN_HEADS, DN_HEADS,
             N_BRANCH * D_MODEL)
IN_COLS = sum(IN_WIDTHS)

kernel_name = 'hybrid_gated_parallel_mixers'


def rmsnorm(x, g):
    xf = x.astype(jnp.float32)
    y = xf * lax.rsqrt(jnp.mean(xf * xf, axis=-1, keepdims=True) + NORM_EPS)
    return (y * g.astype(jnp.float32)).astype(x.dtype)


def layernorm(x, g, b):
    xf = x.astype(jnp.float32)
    xc = xf - jnp.mean(xf, axis=-1, keepdims=True)
    y = xc * lax.rsqrt(jnp.mean(xc * xc, axis=-1, keepdims=True) + NORM_EPS)
    return (y * g.astype(jnp.float32) + b.astype(jnp.float32)).astype(x.dtype)


def l2norm(x):
    return x * lax.rsqrt(jnp.sum(x * x, axis=-1, keepdims=True) + NORM_EPS)


def split_columns(t):
    parts, start = [], 0
    for w in IN_WIDTHS:
        parts.append(t[..., start:start + w])
        start += w
    return parts


def rotary_tables(positions):
    inv_freq = ROPE_THETA ** (-jnp.arange(0, ROPE_DIM, 2, dtype=jnp.float32) / ROPE_DIM)
    ang = positions.astype(jnp.float32)[..., None] * inv_freq
    return jnp.cos(ang)[:, :, None, :], jnp.sin(ang)[:, :, None, :]


def apply_partial_rope(x, cos, sin):
    half = ROPE_DIM // 2
    x1, x2, rest = x[..., :half], x[..., half:ROPE_DIM], x[..., ROPE_DIM:]
    c, s = cos.astype(x.dtype), sin.astype(x.dtype)
    return jnp.concatenate([x1 * c - x2 * s, x2 * c + x1 * s, rest], axis=-1)


def spatial_gating(u, v, ln_g, ln_b, w_s, b_s):
    B_, S_ = u.shape[:2]
    nc = S_ // SGU_CHUNK
    vn = layernorm(v, ln_g, ln_b).reshape(B_, nc, SGU_CHUNK, SGU_GROUPS, SGU_GROUP_DIM)
    causal = jnp.tril(jnp.ones((SGU_CHUNK, SGU_CHUNK), dtype=bool))
    w_causal = jnp.where(causal, w_s, 0.0).astype(vn.dtype)
    mixed = jnp.einsum('gts,bnsgc->bntgc', w_causal, vn) + b_s.T.astype(vn.dtype)[None, None, :, :, None]
    return u * mixed.reshape(B_, S_, SGU_WIDTH)


def sliding_window_attention(q, k, v, sinks, cos, sin):
    B_, S_ = q.shape[:2]
    nc = S_ // WINDOW
    q = apply_partial_rope(q, cos, sin) * (SWA_HEAD_DIM ** -0.5)
    k = apply_partial_rope(k, cos, sin)
    qb = q.reshape(B_, nc, WINDOW, SWA_KV_HEADS, SWA_GROUP, SWA_HEAD_DIM)

    def band(t):
        cur = t.reshape(B_, nc, WINDOW, SWA_KV_HEADS, SWA_HEAD_DIM)
        prev = jnp.concatenate([jnp.zeros_like(cur[:, :1]), cur[:, :-1]], axis=1)
        return jnp.concatenate([prev, cur], axis=2)

    kb, vb = band(k), band(v)
    logits = jnp.einsum('bnqkgd,bnskd->bnkgqs', qb, kb).astype(jnp.float32)
    qi = jnp.arange(WINDOW)[:, None]
    sj = jnp.arange(2 * WINDOW)[None, :]
    diff = qi + WINDOW - sj
    in_band = (diff >= 0) & (diff < WINDOW)
    valid = (jnp.arange(nc) > 0)[:, None, None] | (sj >= WINDOW)[None]
    mask = in_band[None] & valid
    logits = jnp.where(mask[None, :, None, None], logits, -jnp.inf)
    sink = jnp.broadcast_to(sinks.astype(jnp.float32).reshape(1, 1, SWA_KV_HEADS, SWA_GROUP, 1, 1),
                            logits.shape[:-1] + (1,))
    probs = jax.nn.softmax(jnp.concatenate([logits, sink], axis=-1), axis=-1)[..., :-1]
    out = jnp.einsum('bnkgqs,bnskd->bnqkgd', probs.astype(vb.dtype), vb)
    return out.reshape(B_, S_, SWA_HEADS * SWA_HEAD_DIM)


def causal_short_conv(x, w):
    S_ = x.shape[1]
    xp = jnp.pad(x, ((0, 0), (DN_CONV - 1, 0), (0, 0)))
    out = xp[:, 0:S_] * w[0]
    for i in range(1, DN_CONV):
        out = out + xp[:, i:i + S_] * w[i]
    return jax.nn.silu(out)


def gated_deltanet(qkv, z, beta_logit, a_logit, conv_w, a_log, dt_bias, norm_g):
    B_, S_ = qkv.shape[:2]
    in_dtype = qkv.dtype
    nt = S_ // DN_CHUNK
    H, hd, C = DN_HEADS, DN_HEAD_DIM, DN_CHUNK
    qkv = causal_short_conv(qkv, conv_w).astype(jnp.float32)
    q = l2norm(qkv[..., :MIX_WIDTH].reshape(B_, S_, H, hd)) * (hd ** -0.5)
    k = l2norm(qkv[..., MIX_WIDTH:2 * MIX_WIDTH].reshape(B_, S_, H, hd))
    v = qkv[..., 2 * MIX_WIDTH:].reshape(B_, S_, H, hd)
    beta = jax.nn.sigmoid(beta_logit.astype(jnp.float32))
    g = -jnp.exp(a_log.astype(jnp.float32)) * jax.nn.softplus(a_logit.astype(jnp.float32) + dt_bias.astype(jnp.float32))

    def to_chunks(t):
        t = t.reshape((B_, nt, C) + t.shape[2:])
        return jnp.swapaxes(jnp.swapaxes(t, 0, 1), 2, 3)

    q, k, v, beta, g = to_chunks(q), to_chunks(k), to_chunks(v), to_chunks(beta), to_chunks(g)
    gc = jnp.cumsum(g, axis=-1)
    tril = jnp.tril(jnp.ones((C, C), dtype=bool))
    strict = jnp.tril(jnp.ones((C, C), dtype=bool), -1)
    decay = jnp.exp(jnp.where(tril, gc[..., :, None] - gc[..., None, :], -jnp.inf))
    k_beta = k * beta[..., None]
    lower = jnp.where(strict, jnp.einsum('nbhid,nbhjd->nbhij', k_beta, k) * decay, 0.0)
    a_mat = lower + jnp.eye(C, dtype=jnp.float32)
    rhs = jnp.concatenate([v * beta[..., None], k_beta * jnp.exp(gc)[..., None]], axis=-1)
    sol = lax.linalg.triangular_solve(a_mat, rhs, left_side=True, lower=True, unit_diagonal=True)
    u_c, w_c = sol[..., :hd], sol[..., hd:]
    attn = jnp.einsum('nbhid,nbhjd->nbhij', q, k) * decay
    q_dec = q * jnp.exp(gc)[..., None]
    k_dec = k * jnp.exp(gc[..., -1:] - gc)[..., None]
    c_dec = jnp.exp(gc[..., -1])

    def step(state, xs):
        qd, wc, uc, at, kd, cd = xs
        v_new = uc - jnp.einsum('bhcd,bhde->bhce', wc, state)
        o_c = jnp.einsum('bhcd,bhde->bhce', qd, state) + jnp.einsum('bhij,bhje->bhie', at, v_new)
        state = state * cd[..., None, None] + jnp.einsum('bhcd,bhce->bhde', kd, v_new)
        return state, o_c

    state0 = jnp.zeros((B_, H, hd, hd), dtype=jnp.float32)
    _, o = lax.scan(step, state0, (q_dec, w_c, u_c, attn, k_dec, c_dec))
    o = jnp.swapaxes(jnp.swapaxes(o, 0, 1), 2, 3).reshape(B_, S_, H, hd)
    o = rmsnorm(o, norm_g) * jax.nn.silu(z.astype(jnp.float32).reshape(B_, S_, H, hd))
    return o.reshape(B_, S_, MIX_WIDTH).astype(in_dtype)


def setup_inputs(seed: int = 0) -> dict:
    key = jax.random.key(seed)
    ks = jax.random.split(key, 20)
    f32 = jnp.float32

    def nrm(k, shape, scale):
        return jax.random.normal(k, shape, dtype=f32) * scale

    dt = jnp.exp(jax.random.uniform(ks[11], (DEPTH, DN_HEADS), dtype=f32,
                                    minval=np.log(1e-3), maxval=np.log(1e-1)))
    return {
        'x': nrm(ks[0], (BATCH, SEQ, D_MODEL), 1.0),
        'positions': jnp.broadcast_to(jnp.arange(SEQ, dtype=jnp.int32), (BATCH, SEQ)),
        'attn_norm': 1.0 + nrm(ks[1], (DEPTH, D_MODEL), 0.02),
        'w_in': nrm(ks[2], (DEPTH, D_MODEL, IN_COLS), D_MODEL ** -0.5),
        'sgu_ln_g': 1.0 + nrm(ks[3], (DEPTH, SGU_WIDTH), 0.02),
        'sgu_ln_b': nrm(ks[4], (DEPTH, SGU_WIDTH), 0.02),
        'sgu_w': nrm(ks[5], (DEPTH, SGU_GROUPS, SGU_CHUNK, SGU_CHUNK), SGU_CHUNK ** -0.5),
        'sgu_b': 1.0 + nrm(ks[6], (DEPTH, SGU_GROUPS, SGU_CHUNK), 0.02),
        'attn_sinks': nrm(ks[7], (DEPTH, SWA_HEADS), 0.5),
        'dn_conv_w': nrm(ks[8], (DEPTH, DN_CONV, 3 * MIX_WIDTH), DN_CONV ** -0.5),
        'dn_a_log': jnp.log(jax.random.uniform(ks[9], (DEPTH, DN_HEADS), dtype=f32, minval=1.0, maxval=16.0)),
        'dn_dt_bias': dt + jnp.log(-jnp.expm1(-dt)),
        'dn_norm': 1.0 + nrm(ks[10], (DEPTH, DN_HEAD_DIM), 0.02),
        'w_branch': nrm(ks[12], (DEPTH, N_BRANCH, MIX_WIDTH, D_MODEL), MIX_WIDTH ** -0.5),
        'w_out': nrm(ks[13], (DEPTH, D_MODEL, D_MODEL), D_MODEL ** -0.5),
        'ffn_norm': 1.0 + nrm(ks[14], (DEPTH, D_MODEL), 0.02),
        'w_gate_up': nrm(ks[15], (DEPTH, D_MODEL, 2 * D_FF), D_MODEL ** -0.5),
        'w_down': nrm(ks[16], (DEPTH, D_FF, D_MODEL), D_FF ** -0.5),
        'final_norm': 1.0 + nrm(ks[17], (D_MODEL,), 0.02),
    }


def reference(x, positions, attn_norm, w_in, sgu_ln_g, sgu_ln_b, sgu_w, sgu_b, attn_sinks,
              dn_conv_w, dn_a_log, dn_dt_bias, dn_norm, w_branch, w_out, ffn_norm,
              w_gate_up, w_down, final_norm):
    B_, S_ = x.shape[:2]
    cos, sin = rotary_tables(positions)
    for layer in range(DEPTH):
        h = rmsnorm(x, attn_norm[layer])
        proj = jnp.einsum('bsd,dc->bsc', h, w_in[layer])
        u_a, v_a, q_b, k_b, v_b, qkv_c, z_c, beta_c, a_c, gate_pre = split_columns(proj)
        out_a = spatial_gating(jax.nn.gelu(u_a), jax.nn.gelu(v_a), sgu_ln_g[layer], sgu_ln_b[layer],
                               sgu_w[layer], sgu_b[layer])
        out_b = sliding_window_attention(q_b.reshape(B_, S_, SWA_HEADS, SWA_HEAD_DIM),
                                         k_b.reshape(B_, S_, SWA_KV_HEADS, SWA_HEAD_DIM),
                                         v_b.reshape(B_, S_, SWA_KV_HEADS, SWA_HEAD_DIM),
                                         attn_sinks[layer], cos, sin)
        out_c = gated_deltanet(qkv_c, z_c, beta_c, a_c, dn_conv_w[layer], dn_a_log[layer],
                               dn_dt_bias[layer], dn_norm[layer])
        branches = jnp.stack([out_a, out_b, out_c], axis=0)
        branch_d = jnp.einsum('nbsc,ncd->nbsd', branches, w_branch[layer])
        gates = jax.nn.sigmoid(gate_pre.reshape(B_, S_, N_BRANCH, D_MODEL))
        merged = jnp.einsum('bsnd,nbsd->bsd', gates, branch_d)
        x = x + jnp.einsum('bsd,de->bse', merged, w_out[layer])
        h2 = rmsnorm(x, ffn_norm[layer])
        gu = jnp.einsum('bsd,df->bsf', h2, w_gate_up[layer])
        x = x + jnp.einsum('bsf,fd->bsd', jax.nn.silu(gu[..., :D_FF]) * gu[..., D_FF:], w_down[layer])
    return rmsnorm(x, final_norm)
```

```cpp
#include <hip/hip_runtime.h>
#include <hip/hip_cooperative_groups.h>
#include <cstdio>
#include <cstdint>
namespace cg = cooperative_groups;
namespace pg8 {
#define PG8_LAS __attribute__((address_space(3)))
typedef unsigned short bf16_t;
typedef short bf16x8 __attribute__((ext_vector_type(8)));
typedef float f32x4 __attribute__((ext_vector_type(4)));
typedef unsigned u32x4 __attribute__((ext_vector_type(4)));
constexpr int BM = 256, BK = 64, HALF = 128, HTB = HALF * BK * 2  , STAGE_BYTES = 8 * HTB, NXCD = 8, WGM = 8;

__host__ __device__ __forceinline__ int lds_byte(int r, int c) { const int st = (r >> 4) * 2 + (c >> 5), rr = r & 15, cc = c & 31, ob = rr * 64 + cc * 2; return st * 1024 + (ob ^ (((ob >> 9) & 1) << 5)); }
__host__ __device__ __forceinline__ void stage_rc(int b, int& R, int& C) { const int st = b / 1024, sb = b % 1024, swz = sb ^ (((sb >> 9) & 1) << 5); R = (st >> 1) * 16 + swz / 64; C = (st & 1) * 32 + (swz % 64) / 2; }
__host__ __device__ __forceinline__ int perm32(int rho) { const int n = rho >> 4, i = rho & 15; return 8 * (i >> 2) + 4 * n + (i & 3); }

struct Unit { int pm, pn, idx; };
struct Gemm { const bf16_t* A; const bf16_t* Bt; int M, N, K; };

struct StaticOrder {
    int nM, nN, nwg, G, c;
    __host__ __device__ void init(int M, int N, int G_, int c_) { nM = M / BM; nN = N / BM; nwg = nM * nN; G = G_; c = c_; }
    __host__ __device__ bool next(int i, Unit& u) const {
        const long L = (long)i * G + c; if (L >= nwg) return false;
        int wgid = (int)L; { const int q = nwg / NXCD, r = nwg % NXCD, xcd = wgid % NXCD, off = wgid / NXCD; wgid = (xcd < r ? xcd * (q + 1) : r * (q + 1) + (xcd - r) * q) + off; }
        const int nig = WGM * nN, gid = wgid / nig, fm = gid * WGM, gsz = (nM - fm) < WGM ? (nM - fm) : WGM;
        u.pm = fm + ((wgid % nig) % gsz); u.pn = (wgid % nig) / gsz; u.idx = i; return true;
    }
    __device__ __forceinline__ void a_ready(const Unit&) const {}
    __device__ __forceinline__ void done(const Unit&) const {}
};

typedef float f32x2 __attribute__((ext_vector_type(2)));
typedef __bf16 bf16v2 __attribute__((ext_vector_type(2)));
typedef unsigned u32x2 __attribute__((ext_vector_type(2)));
__device__ __forceinline__ unsigned pk2(float lo, float hi) { f32x2 v = {lo, hi}; bf16v2 r = __builtin_convertvector(v, bf16v2); return __builtin_bit_cast(unsigned, r); }
__device__ __forceinline__ float bflo(unsigned w) { return __uint_as_float(w << 16); }
__device__ __forceinline__ float bfhi(unsigned w) { return __uint_as_float(w & 0xffff0000u); }
__device__ __forceinline__ float fast_sigmoid(float x) { return __builtin_amdgcn_rcpf(1.0f + __expf(-x)); }
__device__ __forceinline__ float gelu_tanh(float x) { const float u = 1.5957691216f * (x + 0.044715f * x * x * x); return x * fast_sigmoid(u); }
constexpr float NORM_EPS = 1e-6f;
__device__ __forceinline__ float row_rstd(const float* rowsq, int row) {
    const f32x4* p = (const f32x4*)(rowsq + (size_t)row * 16); const f32x4 a = p[0], b = p[1], c = p[2], d = p[3];
    const float s = ((a.x + a.y) + (a.z + a.w)) + ((b.x + b.y) + (b.z + b.w)) + ((c.x + c.y) + (c.z + c.w)) + ((d.x + d.y) + (d.z + d.w));
    return __builtin_amdgcn_rsqf(s * (1.0f / 1024.0f) + NORM_EPS);
}
constexpr int LRS_OFF = STAGE_BYTES, LRS_MAX_UNITS = 8;
template <class Sched> __device__ __forceinline__ void prep_rstd(PG8_LAS unsigned char* lds, const Sched& S, const float* rowsq) {
    PG8_LAS float* t = (PG8_LAS float*)(lds + LRS_OFF); Unit u;
#pragma unroll 1
    for (int i = 0; i < LRS_MAX_UNITS; ++i) { if (!S.next(i, u)) break; if (threadIdx.x < 256) t[i * 256 + threadIdx.x] = row_rstd(rowsq, u.pm * BM + threadIdx.x); asm volatile("" ::: "memory"); }
    __syncthreads();
}
struct EpiProj {
    static constexpr bool PERM = true, AFTER_DRAIN = false;
    bf16_t *uv, *qkvb, *qkvc, *z; const PG8_LAS float* lrs;
    __device__ __forceinline__ void operator()(const f32x4 (&acc)[2][2][4][2], const Unit& u, int wr, int wc, int fr, int fq) const {
        const int pn = u.pn; bf16_t* base; int ldc, colt; bool act = false;
        if (pn < 4) { base = uv; ldc = 1024; colt = pn * 256; act = true; }
        else if (pn < 7) { base = qkvb; ldc = 768; colt = (pn - 4) * 256; }
        else if (pn < 13) { base = qkvc; ldc = 1536; colt = (pn - 7) * 256; }
        else { base = z; ldc = 512; colt = (pn - 13) * 256; }
        const int row0 = u.pm * BM + wr * 64 + fr, col0 = colt + wc * 32 + 8 * fq;
#pragma unroll
        for (int ai = 0; ai < 2; ++ai)
#pragma unroll
            for (int m = 0; m < 4; ++m) { const int row = row0 + ai * HALF + m * 16; const float rs = lrs[u.idx * 256 + (row - u.pm * BM)]; bf16_t* rowp = base + (size_t)row * ldc + col0;
#pragma unroll
                for (int bj = 0; bj < 2; ++bj) { f32x4 v0 = acc[ai][bj][m][0] * rs, v1 = acc[ai][bj][m][1] * rs;
                    if (act) {
#pragma unroll
                        for (int j = 0; j < 4; ++j) { v0[j] = gelu_tanh(v0[j]); v1[j] = gelu_tanh(v1[j]); } }
                    u32x4 w; w.x = pk2(v0[0], v0[1]); w.y = pk2(v0[2], v0[3]); w.z = pk2(v1[0], v1[1]); w.w = pk2(v1[2], v1[3]);
                    *(u32x4*)(rowp + bj * HALF) = w; } }
    }
};
struct EpiSig {
    static constexpr bool PERM = true, AFTER_DRAIN = false;
    bf16_t* sig; const PG8_LAS float* lrs;
    __device__ __forceinline__ void operator()(const f32x4 (&acc)[2][2][4][2], const Unit& u, int wr, int wc, int fr, int fq) const {
        const int row0 = u.pm * BM + wr * 64 + fr, col0 = u.pn * BM + wc * 32 + 8 * fq;
#pragma unroll
        for (int ai = 0; ai < 2; ++ai)
#pragma unroll
            for (int m = 0; m < 4; ++m) { const int row = row0 + ai * HALF + m * 16; const float rs = lrs[u.idx * 256 + (row - u.pm * BM)]; bf16_t* rowp = sig + (size_t)row * 1024 + col0;
#pragma unroll
                for (int bj = 0; bj < 2; ++bj) { f32x4 v0 = acc[ai][bj][m][0] * rs, v1 = acc[ai][bj][m][1] * rs;
#pragma unroll
                    for (int j = 0; j < 4; ++j) { v0[j] = fast_sigmoid(v0[j]); v1[j] = fast_sigmoid(v1[j]); }
                    u32x4 w; w.x = pk2(v0[0], v0[1]); w.y = pk2(v0[2], v0[3]); w.z = pk2(v1[0], v1[1]); w.w = pk2(v1[2], v1[3]);
                    *(u32x4*)(rowp + bj * HALF) = w; } }
    }
};
template <int MODE> struct EpiMerge {
    static constexpr bool PERM = true, AFTER_DRAIN = false;
    bf16_t* sig; float* mf;
    __device__ __forceinline__ void operator()(const f32x4 (&acc)[2][2][4][2], const Unit& u, int wr, int wc, int fr, int fq) const {
        const int row0 = u.pm * BM + wr * 64 + fr, col0 = u.pn * BM + wc * 32 + 8 * fq;
#pragma unroll
        for (int ai = 0; ai < 2; ++ai)
#pragma unroll
            for (int m = 0; m < 4; ++m) { const size_t off = (size_t)(row0 + ai * HALF + m * 16) * 1024 + col0;
#pragma unroll
                for (int bj = 0; bj < 2; ++bj) { const u32x4 s = *(const u32x4*)(sig + off + bj * HALF);
                    f32x4 v0 = acc[ai][bj][m][0], v1 = acc[ai][bj][m][1];
                    v0[0] *= bflo(s.x); v0[1] *= bfhi(s.x); v0[2] *= bflo(s.y); v0[3] *= bfhi(s.y); v1[0] *= bflo(s.z); v1[1] *= bfhi(s.z); v1[2] *= bflo(s.w); v1[3] *= bfhi(s.w);
                    float* mp = mf + off + bj * HALF;
                    if (MODE >= 1) { v0 += *(const f32x4*)mp; v1 += *(const f32x4*)(mp + 4); }
                    if (MODE <= 1) { *(f32x4*)mp = v0; *(f32x4*)(mp + 4) = v1; }
                    else { u32x4 w; w.x = pk2(v0[0], v0[1]); w.y = pk2(v0[2], v0[3]); w.z = pk2(v1[0], v1[1]); w.w = pk2(v1[2], v1[3]); *(u32x4*)(sig + off + bj * HALF) = w; } } }
    }
};
struct EpiResid {
    static constexpr bool PERM = false, AFTER_DRAIN = false;
    const float* xin; float* xout; bf16_t* xb; float* rowsq;
    __device__ __forceinline__ void operator()(const f32x4 (&acc)[2][2][4][2], const Unit& u, int wr, int wc, int fr, int fq) const {
        const int row0 = u.pm * BM + wr * 64 + fr, col0 = u.pn * BM + wc * 32 + 4 * fq;
#pragma unroll
        for (int ai = 0; ai < 2; ++ai)
#pragma unroll
            for (int m = 0; m < 4; ++m) { const int row = row0 + ai * HALF + m * 16; const size_t off = (size_t)row * 1024 + col0; float ss = 0.f;
#pragma unroll
                for (int bj = 0; bj < 2; ++bj)
#pragma unroll
                    for (int n = 0; n < 2; ++n) { const size_t o = off + bj * HALF + n * 16; const f32x4 v = *(const f32x4*)(xin + o) + acc[ai][bj][m][n];
                        *(f32x4*)(xout + o) = v; u32x2 w; w.x = pk2(v[0], v[1]); w.y = pk2(v[2], v[3]); *(u32x2*)(xb + o) = w;
                        ss += (v[0] * v[0] + v[1] * v[1]) + (v[2] * v[2] + v[3] * v[3]); }
                ss += __shfl_xor(ss, 16); ss += __shfl_xor(ss, 32);
                if (fq == 0) rowsq[(size_t)row * 16 + u.pn * 4 + wc] = ss; }
    }
};
struct EpiGU {
    static constexpr bool PERM = true, AFTER_DRAIN = false;
    bf16_t* hid; const PG8_LAS float* lrs;
    __device__ __forceinline__ void operator()(const f32x4 (&acc)[2][2][4][2], const Unit& u, int wr, int wc, int fr, int fq) const {
        const int row0 = u.pm * BM + wr * 64 + fr, col0 = u.pn * HALF + wc * 32 + 8 * fq;
#pragma unroll
        for (int ai = 0; ai < 2; ++ai)
#pragma unroll
            for (int m = 0; m < 4; ++m) { const int row = row0 + ai * HALF + m * 16; const float rs = lrs[u.idx * 256 + (row - u.pm * BM)];
                float o[8];
#pragma unroll
                for (int n = 0; n < 2; ++n)
#pragma unroll
                    for (int j = 0; j < 4; ++j) { const float g = acc[ai][0][m][n][j] * rs, up = acc[ai][1][m][n][j] * rs; o[n * 4 + j] = g * fast_sigmoid(g) * up; }
                u32x4 w; w.x = pk2(o[0], o[1]); w.y = pk2(o[2], o[3]); w.z = pk2(o[4], o[5]); w.w = pk2(o[6], o[7]);
                *(u32x4*)(hid + (size_t)row * 2816 + col0) = w; }
    }
};

template <class Epi, class Sched, bool ALIGN_EPI = false, bool SP2 = false>
__device__ __forceinline__ void gemm_phase(PG8_LAS unsigned char* lds, const Gemm g, const Sched& S, const Epi& E) {
    int tid_ = threadIdx.x; asm volatile("" : "+v"(tid_));
    const int tid = tid_, wid = __builtin_amdgcn_readfirstlane(tid >> 6), lane = tid & 63, wr = wid >> 2, wc = wid & 3, fr = lane & 15, fq = lane >> 4;
    const int K = g.K, nt = K / BK;
    unsigned voffA[2], voffB[2];
#pragma unroll
    for (int i = 0; i < 2; ++i) { int R, C; stage_rc(tid * 16 + i * 8192, R, C); const int Rb = Epi::PERM ? ((R & ~31) + perm32(R & 31)) : R;
        voffA[i] = (unsigned)(R * K + C) * 2u; voffB[i] = (unsigned)(Rb * K + C) * 2u; }
    const size_t kstep = (size_t)(BK * 2);
    const size_t hstep = (size_t)HALF * K * 2;
    const size_t tstep = 2 * hstep;
    const unsigned ldsw = (unsigned)wid * 1024u;
    const int aoff = lds_byte(wr * 64 + fr, fq * 8), boff = lds_byte(wc * 32 + fr, fq * 8);
#define PG8_SA(b, h) (((b) * 2 + (h)) * HTB)
#define PG8_SB(b, h) ((4 + (b) * 2 + (h)) * HTB)
#define PG8_STAGE(bufoff, gbase, voff) do { _Pragma("unroll") for (int _i = 0; _i < 2; ++_i) \
        __builtin_amdgcn_global_load_lds((const unsigned*)((const char*)(gbase) + (voff)[_i]), (PG8_LAS unsigned*)(lds + (bufoff) + ldsw + _i * 8192), 16, 0, 0); } while (0)
#define PG8_LDA(dst, b, h) do { _Pragma("unroll") for (int m = 0; m < 4; ++m) _Pragma("unroll") for (int k = 0; k < 2; ++k) dst[m][k] = *(const PG8_LAS bf16x8*)(lds + PG8_SA(b, h) + aoff + m * 2048 + k * 1024); } while (0)
#define PG8_LDB(dst, b, h) do { _Pragma("unroll") for (int n = 0; n < 2; ++n) _Pragma("unroll") for (int k = 0; k < 2; ++k) dst[n][k] = *(const PG8_LAS bf16x8*)(lds + PG8_SB(b, h) + boff + n * 2048 + k * 1024); } while (0)
#define PG8_MMA(ai, bj, At, Bt) do { __builtin_amdgcn_s_setprio(1); _Pragma("unroll") for (int m = 0; m < 4; ++m) _Pragma("unroll") for (int n = 0; n < 2; ++n) _Pragma("unroll") for (int k = 0; k < 2; ++k) \
        acc[ai][bj][m][n] = __builtin_amdgcn_mfma_f32_16x16x32_bf16(Bt[n][k], At[m][k], acc[ai][bj][m][n], 0, 0, 0); __builtin_amdgcn_s_setprio(0); } while (0)
#define PG8_WAIT_V(n) asm volatile("s_waitcnt vmcnt(" #n ")" ::: "memory")
#define PG8_WAIT_L(n) asm volatile("s_waitcnt lgkmcnt(" #n ")" ::: "memory")
#define PG8_BAR __builtin_amdgcn_s_barrier()
#define PG8_SCHED __builtin_amdgcn_sched_barrier(0)
    Unit cur, nxt; int ui = 0;
    if (!S.next(0, cur)) return;
    f32x4 acc[2][2][4][2];
#pragma unroll
    for (int a = 0; a < 2; ++a)
#pragma unroll
        for (int b = 0; b < 2; ++b)
#pragma unroll
            for (int m = 0; m < 4; ++m)
#pragma unroll
                for (int n = 0; n < 2; ++n) acc[a][b][m][n] = (f32x4){0.f, 0.f, 0.f, 0.f};
    bf16x8 At[4][2], B0[2][2], B1[2][2];
    const char* cA = (const char*)g.A + (size_t)cur.pm * tstep; const char* cB = (const char*)g.Bt + (size_t)cur.pn * tstep;
    S.a_ready(cur);
    if constexpr (SP2) {
        PG8_STAGE(PG8_SB(0, 0), cB, voffB); PG8_STAGE(PG8_SB(0, 1), cB + hstep, voffB); PG8_STAGE(PG8_SA(0, 0), cA, voffA); PG8_STAGE(PG8_SA(0, 1), cA + hstep, voffA);
        if (wr == 1) PG8_BAR;
        PG8_WAIT_V(2); PG8_BAR;
        PG8_STAGE(PG8_SB(1, 0), cB + kstep, voffB); PG8_STAGE(PG8_SA(1, 0), cA + kstep, voffA); PG8_STAGE(PG8_SB(1, 1), cB + hstep + kstep, voffB);
        PG8_WAIT_V(6); PG8_BAR;
    } else {
        PG8_STAGE(PG8_SB(0, 0), cB, voffB); PG8_STAGE(PG8_SA(0, 0), cA, voffA); PG8_STAGE(PG8_SB(0, 1), cB + hstep, voffB); PG8_STAGE(PG8_SA(0, 1), cA + hstep, voffA);
        if (wr == 1) PG8_BAR;
        PG8_WAIT_V(4); PG8_BAR;
        PG8_STAGE(PG8_SB(1, 0), cB + kstep, voffB); PG8_STAGE(PG8_SA(1, 0), cA + kstep, voffA); PG8_STAGE(PG8_SB(1, 1), cB + hstep + kstep, voffB);
        PG8_WAIT_V(6); PG8_BAR;
    }
    for (;;) {
        const bool has_next = S.next(ui + 1, nxt);
        const char* nA = has_next ? (const char*)g.A + (size_t)nxt.pm * tstep : cA; const char* nB = has_next ? (const char*)g.Bt + (size_t)nxt.pn * tstep : cB;
        for (int t = 0; t < nt; t += 2) {
            const bool last = (t == nt - 2);
            const char* a1 = cA + (size_t)(t + 1) * kstep;
            const char* a2 = last ? nA : cA + (size_t)(t + 2) * kstep; const char* b2 = last ? nB : cB + (size_t)(t + 2) * kstep;
            const char* a3 = a2 + kstep; const char* b3 = b2 + kstep;
            if (last && has_next) S.a_ready(nxt);
            if constexpr (SP2) {
            PG8_LDB(B0, 0, 0); PG8_LDB(B1, 0, 1); PG8_SCHED; PG8_LDA(At, 0, 0); PG8_STAGE(PG8_SA(1, 1), a1 + hstep, voffA);
            PG8_WAIT_V(8); PG8_WAIT_L(0); PG8_BAR; PG8_MMA(0, 0, At, B0); PG8_MMA(0, 1, At, B1); PG8_BAR; PG8_SCHED;
            PG8_LDA(At, 0, 1); PG8_STAGE(PG8_SB(0, 0), b2, voffB); PG8_STAGE(PG8_SB(0, 1), b2 + hstep, voffB); PG8_STAGE(PG8_SA(0, 0), a2, voffA);
            PG8_WAIT_V(8); PG8_WAIT_L(0); PG8_BAR; PG8_MMA(1, 0, At, B0); PG8_MMA(1, 1, At, B1); PG8_BAR; PG8_SCHED;
            PG8_LDB(B0, 1, 0); PG8_LDB(B1, 1, 1); PG8_SCHED; PG8_LDA(At, 1, 0); PG8_STAGE(PG8_SA(0, 1), a2 + hstep, voffA);
            PG8_WAIT_V(8); PG8_WAIT_L(0); PG8_BAR; PG8_MMA(0, 0, At, B0); PG8_MMA(0, 1, At, B1); PG8_BAR; PG8_SCHED;
            PG8_LDA(At, 1, 1); PG8_STAGE(PG8_SB(1, 0), b3, voffB); PG8_STAGE(PG8_SB(1, 1), b3 + hstep, voffB); PG8_STAGE(PG8_SA(1, 0), a3, voffA);
            PG8_WAIT_V(8); PG8_WAIT_L(0); PG8_BAR; PG8_MMA(1, 0, At, B0); PG8_MMA(1, 1, At, B1); PG8_BAR; PG8_SCHED;
            } else {
            PG8_LDB(B0, 0, 0); PG8_SCHED; PG8_LDA(At, 0, 0); PG8_STAGE(PG8_SA(1, 1), a1 + hstep, voffA);
            PG8_WAIT_L(8); PG8_BAR; PG8_WAIT_L(0); PG8_MMA(0, 0, At, B0); PG8_BAR; PG8_SCHED;
            PG8_LDB(B1, 0, 1); PG8_STAGE(PG8_SB(0, 0), b2, voffB);
            PG8_BAR; PG8_WAIT_L(0); PG8_MMA(0, 1, At, B1); PG8_BAR;
            PG8_LDA(At, 0, 1); PG8_STAGE(PG8_SA(0, 0), a2, voffA);
            PG8_BAR; PG8_WAIT_L(0); PG8_MMA(1, 0, At, B0); PG8_BAR; PG8_SCHED;
            PG8_STAGE(PG8_SB(0, 1), b2 + hstep, voffB);
            PG8_WAIT_V(6); PG8_BAR; PG8_MMA(1, 1, At, B1); PG8_BAR;
            PG8_LDB(B0, 1, 0); PG8_SCHED; PG8_LDA(At, 1, 0); PG8_STAGE(PG8_SA(0, 1), a2 + hstep, voffA);
            PG8_WAIT_L(8); PG8_BAR; PG8_WAIT_L(0); PG8_MMA(0, 0, At, B0); PG8_BAR; PG8_SCHED;
            PG8_LDB(B1, 1, 1); PG8_STAGE(PG8_SB(1, 0), b3, voffB);
            PG8_BAR; PG8_WAIT_L(0); PG8_MMA(0, 1, At, B1); PG8_BAR;
            PG8_LDA(At, 1, 1); PG8_STAGE(PG8_SA(1, 0), a3, voffA);
            PG8_BAR; PG8_WAIT_L(0); PG8_MMA(1, 0, At, B0); PG8_BAR; PG8_SCHED;
            PG8_STAGE(PG8_SB(1, 1), b3 + hstep, voffB);
            PG8_WAIT_V(6); PG8_BAR; PG8_MMA(1, 1, At, B1); PG8_BAR;
            }
        }
        if constexpr (ALIGN_EPI) { if (wr == 0) PG8_BAR; }
        if constexpr (!Epi::AFTER_DRAIN) { E(acc, cur, wr, wc, fr, fq); S.done(cur); }
        if (!has_next) break;
#pragma unroll
        for (int a = 0; a < 2; ++a)
#pragma unroll
            for (int b = 0; b < 2; ++b)
#pragma unroll
                for (int m = 0; m < 4; ++m)
#pragma unroll
                    for (int n = 0; n < 2; ++n) acc[a][b][m][n] = (f32x4){0.f, 0.f, 0.f, 0.f};
        cur = nxt; cA = nA; cB = nB; ++ui;
        if constexpr (ALIGN_EPI) { if (wr == 1) PG8_BAR; }
    }
    PG8_WAIT_V(0);
    if constexpr (!ALIGN_EPI) { if (wr == 0) PG8_BAR; }
    PG8_BAR;
    if constexpr (Epi::AFTER_DRAIN) { E.fused(acc, cur, wr, wc, fr, fq, lds, wid, lane); S.done(cur); }
#undef PG8_SA
#undef PG8_SB
#undef PG8_STAGE
#undef PG8_LDA
#undef PG8_LDB
#undef PG8_MMA
#undef PG8_WAIT_V
#undef PG8_WAIT_L
#undef PG8_BAR
#undef PG8_SCHED
}
}

constexpr int NWAVES = 8, NTHR = 512;
constexpr int TT = 16384, SEQ = 8192, DM = 1024, DEPTH = 2, INC = 6920, DFF = 2816;
constexpr int C_QKVC = 1792, C_BETA = 3840, C_GATE = 3848;
constexpr int NMIX = 3840;
constexpr size_t MiB = 1u << 20, KiB = 1u << 10;
constexpr size_t WS_CTL = 0, CTL_ZERO_BYTES = 64 * KiB;
constexpr size_t WS_ROWSQ = 1 * MiB;
constexpr size_t WS_BA = 2 * MiB;
constexpr size_t WS_CD = 2 * MiB + 512 * KiB;
constexpr size_t WS_WBA = WS_CD + 64 * KiB;
constexpr size_t WS_SGUW = 2 * MiB + 768 * KiB;
constexpr size_t WS_WIN = 3 * MiB;
constexpr size_t WS_WG = WS_WIN + 3840 * 1024 * 2;
constexpr size_t WS_WBR = WS_WG + 3072 * 1024 * 2;
constexpr size_t WS_WOUT = WS_WBR + 3 * 1024 * 512 * 2;
constexpr size_t WS_XB = 22 * MiB;
constexpr size_t WS_UV = 54 * MiB;
constexpr size_t WS_QKVB = 86 * MiB;
constexpr size_t WS_WGU = WS_QKVB;
constexpr size_t WS_WDN = WS_QKVB + 5632 * 1024 * 2;
constexpr size_t WS_QKVC = 110 * MiB;
constexpr size_t WS_BR = WS_QKVC;
constexpr size_t WS_Z = 158 * MiB;
constexpr size_t WS_DN = 174 * MiB;
constexpr size_t WS_HID = 110 * MiB;
constexpr size_t WS_END = 246 * MiB;
static_assert(WS_WOUT + 1024 * 1024 * 2 <= WS_XB && WS_WDN + 1024 * 2816 * 2 <= WS_QKVC && WS_HID + (size_t)TT * DFF * 2 <= WS_END && WS_DN + 1024 * 72 * KiB <= WS_END, "ws map");
constexpr int DN_TASK_BYTES = 73728, DN_OFF_W = 0, DN_OFF_QD = 16384, DN_OFF_AT = 32768, DN_OFF_KD = 40960, DN_OFF_U = 57344;
constexpr int LDS_BYTES = 163840, MISC_OFF = LDS_BYTES - 256;

#define LAS __attribute__((address_space(3)))
typedef unsigned short bf16;
typedef float f32x4 __attribute__((ext_vector_type(4)));
typedef float f32x16 __attribute__((ext_vector_type(16)));
typedef short bf16x8 __attribute__((ext_vector_type(8)));
typedef unsigned u32x4 __attribute__((ext_vector_type(4)));
typedef unsigned u32x2 __attribute__((ext_vector_type(2)));
using pg8::pk2; using pg8::bflo; using pg8::bfhi; using pg8::fast_sigmoid; using pg8::NORM_EPS;
#define MFMA32(a, b, c) __builtin_amdgcn_mfma_f32_32x32x16_bf16((a), (b), (c), 0, 0, 0)
__device__ __forceinline__ int crow(int reg, int h) { return (reg & 3) + 8 * (reg >> 2) + 4 * h; }
__device__ __forceinline__ bf16x8 pack_step(const f32x16& x, int s) {
    u32x4 p; p.x = pk2(x[8 * s], x[8 * s + 1]); p.y = pk2(x[8 * s + 2], x[8 * s + 3]); p.z = pk2(x[8 * s + 4], x[8 * s + 5]); p.w = pk2(x[8 * s + 6], x[8 * s + 7]);
    return __builtin_bit_cast(bf16x8, p);
}
__device__ __forceinline__ float wave_sum(float v) {
#pragma unroll
    for (int o = 1; o < 64; o <<= 1) v += __shfl_xor(v, o);
    return v;
}
__device__ __forceinline__ f32x16 zero16() { f32x16 z; for (int i = 0; i < 16; ++i) z[i] = 0.f; return z; }

struct Params {
    const float* x; const int* pos; const float* attn_norm; const float* w_in; const float* sgu_ln_g; const float* sgu_ln_b; const float* sgu_w; const float* sgu_b;
    const float* sinks; const float* conv_w; const float* a_log; const float* dt_bias; const float* dn_norm; const float* w_branch; const float* w_out; const float* ffn_norm;
    const float* w_gate_up; const float* w_down; const float* final_norm;
    float* out; unsigned char* ws; int ph_lo, ph_hi;
};
struct Frame { LAS unsigned char* lds; int tid, lane, wave, vb, G; };

template <int MAP> __device__ __forceinline__ void transpose_item(const float* W, int ldw, int ncol0, int K, int N, const float* kscale, bf16* WT, LAS float* scr, int item, int lane) {
    const int nblk = N / 32, kb = item / nblk, nb = item % nblk, k0 = 64 * kb, n0 = 32 * nb;
#pragma unroll 8
    for (int i = 0; i < 32; ++i) { const int kk = 2 * i + (lane >> 5); float v = W[(size_t)(k0 + kk) * ldw + ncol0 + n0 + (lane & 31)]; if (kscale) v *= kscale[k0 + kk]; scr[kk * 33 + (lane & 31)] = v; }
    asm volatile("s_waitcnt lgkmcnt(0)" ::: "memory");
    const int c = lane & 7;
#pragma unroll
    for (int j = 0; j < 4; ++j) { const int n = (lane >> 3) + 8 * j; const LAS float* s = scr + (8 * c) * 33 + n;
        u32x4 o; o.x = pk2(s[0 * 33], s[1 * 33]); o.y = pk2(s[2 * 33], s[3 * 33]); o.z = pk2(s[4 * 33], s[5 * 33]); o.w = pk2(s[6 * 33], s[7 * 33]);
        const int nn = n0 + n; int dr = nn;
        if (MAP == 1) { const int f = nn < DFF ? nn : nn - DFF; dr = (f >> 7) * 256 + (nn < DFF ? 0 : 128) + (f & 127); }
        *(u32x4*)(WT + (size_t)dr * K + k0 + 8 * c) = o; }
    asm volatile("s_waitcnt lgkmcnt(0)" ::: "memory");
}
__device__ __forceinline__ void p0_attn_weights(const Frame& F, const Params& P, int l) {
    LAS float* scr = (LAS float*)(F.lds + F.wave * 8448);
    const int gw = F.vb * NWAVES + F.wave, NGW = F.G * NWAVES;
    const float* win = P.w_in + (size_t)l * DM * INC; const float* an = P.attn_norm + l * DM;
    constexpr int I_MIX = 16 * (NMIX / 32), I_G = 16 * (3072 / 32), I_BR = 8 * 32, I_O = 16 * 32, NIT = I_MIX + I_G + 3 * I_BR + I_O;
    for (int it = gw; it < NIT; it += NGW) {
        int r = it;
        if (r < I_MIX) { transpose_item<0>(win, INC, 0, DM, NMIX, an, (bf16*)(P.ws + WS_WIN), scr, r, F.lane); continue; } r -= I_MIX;
        if (r < I_G) { transpose_item<0>(win, INC, C_GATE, DM, 3072, an, (bf16*)(P.ws + WS_WG), scr, r, F.lane); continue; } r -= I_G;
        if (r < 3 * I_BR) { const int n = r / I_BR; transpose_item<0>(P.w_branch + ((size_t)l * 3 + n) * 512 * 1024, 1024, 0, 512, 1024, nullptr, (bf16*)(P.ws + WS_WBR) + (size_t)n * 1024 * 512, scr, r % I_BR, F.lane); continue; } r -= 3 * I_BR;
        transpose_item<0>(P.w_out + (size_t)l * DM * DM, DM, 0, DM, DM, nullptr, (bf16*)(P.ws + WS_WOUT), scr, r, F.lane);
    }
    const int gt = F.vb * NTHR + F.tid, NGT = F.G * NTHR;
    float* wba = (float*)(P.ws + WS_WBA);
    for (int i = gt; i < 8 * DM; i += NGT) { const int c = i >> 10, k = i & 1023; wba[i] = win[(size_t)k * INC + C_BETA + c] * an[k]; }
    bf16* sw = (bf16*)(P.ws + WS_SGUW); const float* sgw = P.sgu_w + (size_t)l * 4 * 128 * 128;
    for (int i = gt; i < 4 * 128 * 128 / 2; i += NGT) { const int e = 2 * i, s = e & 127, t = (e >> 7) & 127; const float a = s <= t ? sgw[e] : 0.f, b = (s + 1) <= t ? sgw[e + 1] : 0.f; ((unsigned*)sw)[i] = pk2(a, b); }
}
__device__ __forceinline__ void p0_ffn_weights(const Frame& F, const Params& P, int l) {
    LAS float* scr = (LAS float*)(F.lds + F.wave * 8448);
    const int gw = F.vb * NWAVES + F.wave, NGW = F.G * NWAVES;
    constexpr int I_GU = 16 * (2 * DFF / 32), I_DN = (DFF / 64) * 32, NIT = I_GU + I_DN;
    for (int it = gw; it < NIT; it += NGW) {
        if (it < I_GU) transpose_item<1>(P.w_gate_up + (size_t)l * DM * 2 * DFF, 2 * DFF, 0, DM, 2 * DFF, P.ffn_norm + l * DM, (bf16*)(P.ws + WS_WGU), scr, it, F.lane);
        else transpose_item<0>(P.w_down + (size_t)l * DFF * DM, DM, 0, DFF, DM, nullptr, (bf16*)(P.ws + WS_WDN), scr, it - I_GU, F.lane);
    }
}
__device__ __forceinline__ void p0_input(const Frame& F, const Params& P) {
    const int gw = F.vb * NWAVES + F.wave, NGW = F.G * NWAVES;
    bf16* xb = (bf16*)(P.ws + WS_XB); float* rowsq = (float*)(P.ws + WS_ROWSQ);
    for (int m = gw; m < TT; m += NGW) {
        const f32x4* xr = (const f32x4*)(P.x + (size_t)m * DM) + F.lane; float s = 0.f;
        unsigned long long* o8 = (unsigned long long*)(xb + (size_t)m * DM) + F.lane;
#pragma unroll
        for (int j = 0; j < 4; ++j) { const f32x4 v = xr[64 * j]; s += (v.x * v.x + v.y * v.y) + (v.z * v.z + v.w * v.w); o8[64 * j] = (unsigned long long)pk2(v.x, v.y) | ((unsigned long long)pk2(v.z, v.w) << 32); }
        s = wave_sum(s);
        if (F.lane < 16) rowsq[(size_t)m * 16 + F.lane] = F.lane == 0 ? s : 0.f;
    }
}
__device__ __forceinline__ void p1_ba(const Frame& F, const Params& P) {
    const int gw = F.vb * NWAVES + F.wave, NGW = F.G * NWAVES;
    const float* wba = (const float*)(P.ws + WS_WBA); const bf16* xb = (const bf16*)(P.ws + WS_XB); const float* rowsq = (const float*)(P.ws + WS_ROWSQ); float* ba = (float*)(P.ws + WS_BA);
    f32x4 wb[8][4];
#pragma unroll
    for (int c = 0; c < 8; ++c)
#pragma unroll
        for (int j = 0; j < 2; ++j) { const f32x4* p = (const f32x4*)(wba + c * DM + F.lane * 8 + 512 * j); wb[c][2 * j] = p[0]; wb[c][2 * j + 1] = p[1]; }
    for (int m = gw; m < TT; m += NGW) {
        float xv[16];
#pragma unroll
        for (int j = 0; j < 2; ++j) { const u32x4 w = *(const u32x4*)(xb + (size_t)m * DM + F.lane * 8 + 512 * j);
            xv[8 * j + 0] = bflo(w.x); xv[8 * j + 1] = bfhi(w.x); xv[8 * j + 2] = bflo(w.y); xv[8 * j + 3] = bfhi(w.y); xv[8 * j + 4] = bflo(w.z); xv[8 * j + 5] = bfhi(w.z); xv[8 * j + 6] = bflo(w.w); xv[8 * j + 7] = bfhi(w.w); }
        float sq = F.lane < 16 ? rowsq[(size_t)m * 16 + F.lane] : 0.f; sq = wave_sum(sq);
        const float rs = __builtin_amdgcn_rsqf(sq * (1.0f / 1024.0f) + NORM_EPS);
        float mine = 0.f;
#pragma unroll
        for (int c = 0; c < 8; ++c) { float d = 0.f;
#pragma unroll
            for (int q = 0; q < 4; ++q) d += (xv[4 * q] * wb[c][q].x + xv[4 * q + 1] * wb[c][q].y) + (xv[4 * q + 2] * wb[c][q].z + xv[4 * q + 3] * wb[c][q].w);
            d = wave_sum(d); if (F.lane == c) mine = d; }
        if (F.lane < 8) ba[(size_t)m * 8 + F.lane] = mine * rs;
    }
}

__device__ __forceinline__ void sgu_task(const Frame& F, const Params& P, int l, int task) {
    const int g = task & 3, cb = task >> 2, m0 = cb * 128;
    const bf16* uv = (const bf16*)(P.ws + WS_UV); bf16* bra = (bf16*)(P.ws + WS_BR);
    LAS bf16* vnT = (LAS bf16*)F.lds;
    const int r = F.tid >> 2, qq = F.tid & 3;
    { const bf16* vrow = uv + (size_t)(m0 + r) * 1024 + 512 + qq * 128; float s = 0.f, s2 = 0.f;
#pragma unroll
      for (int j = 0; j < 16; ++j) { const u32x4 w = *(const u32x4*)(vrow + 8 * j); const float a0 = bflo(w.x), a1 = bfhi(w.x), a2 = bflo(w.y), a3 = bfhi(w.y), a4 = bflo(w.z), a5 = bfhi(w.z), a6 = bflo(w.w), a7 = bfhi(w.w);
          s += ((a0 + a1) + (a2 + a3)) + ((a4 + a5) + (a6 + a7)); s2 += ((a0 * a0 + a1 * a1) + (a2 * a2 + a3 * a3)) + ((a4 * a4 + a5 * a5) + (a6 * a6 + a7 * a7)); }
      s += __shfl_xor(s, 1); s += __shfl_xor(s, 2); s2 += __shfl_xor(s2, 1); s2 += __shfl_xor(s2, 2);
      const float mean = s * (1.f / 512.f); float var = s2 * (1.f / 512.f) - mean * mean; var = var > 0.f ? var : 0.f; const float rstd = __builtin_amdgcn_rsqf(var + NORM_EPS);
      const bf16* vg = uv + (size_t)(m0 + r) * 1024 + 512 + g * 128 + qq * 32; const float* lg = P.sgu_ln_g + l * 512 + g * 128 + qq * 32; const float* lb = P.sgu_ln_b + l * 512 + g * 128 + qq * 32;
#pragma unroll
      for (int j = 0; j < 4; ++j) { const u32x4 w = *(const u32x4*)(vg + 8 * j); const float a[8] = {bflo(w.x), bfhi(w.x), bflo(w.y), bfhi(w.y), bflo(w.z), bfhi(w.z), bflo(w.w), bfhi(w.w)};
#pragma unroll
          for (int i = 0; i < 8; ++i) { const int c = qq * 32 + 8 * j + i; const float y = (a[i] - mean) * rstd * lg[8 * j + i] + lb[8 * j + i]; vnT[c * 136 + r] = (bf16)(pk2(y, 0.f) & 0xffffu); } }
    }
    __syncthreads();
    const int lr = F.lane & 31, h = F.lane >> 5, ct = F.wave >> 1;
    const bf16* sw = (const bf16*)(P.ws + WS_SGUW) + (size_t)g * 128 * 128;
#pragma unroll
    for (int t2 = 0; t2 < 2; ++t2) { const int tt = 2 * (F.wave & 1) + t2; f32x16 acc = zero16();
        for (int ks = 0; ks < 2 * (tt + 1); ++ks) {
            const bf16x8 a = *(const LAS bf16x8*)(vnT + (32 * ct + lr) * 136 + 16 * ks + 8 * h);
            const bf16x8 b = *(const bf16x8*)(sw + (size_t)(32 * tt + lr) * 128 + 16 * ks + 8 * h);
            acc = MFMA32(a, b, acc); }
        const int t = 32 * tt + lr; const float bias = P.sgu_b[l * 512 + g * 128 + t];
#pragma unroll
        for (int gq = 0; gq < 4; ++gq) { const int c0 = 32 * ct + 8 * gq + 4 * h; const u32x2 uu = *(const u32x2*)(uv + (size_t)(m0 + t) * 1024 + g * 128 + c0);
            u32x2 o; o.x = pk2(bflo(uu.x) * (acc[4 * gq] + bias), bfhi(uu.x) * (acc[4 * gq + 1] + bias)); o.y = pk2(bflo(uu.y) * (acc[4 * gq + 2] + bias), bfhi(uu.y) * (acc[4 * gq + 3] + bias));
            *(u32x2*)(bra + (size_t)(m0 + t) * 512 + g * 128 + c0) = o; } }
    __syncthreads();
}

__device__ __forceinline__ void swa_task(const Frame& F, const Params& P, int l, int task) {
    const int kvh = task & 1, cb = task >> 1, nq = cb & 63, m0 = cb * 128;
    const bf16* qkvb = (const bf16*)(P.ws + WS_QKVB); bf16* brb = (bf16*)(P.ws + WS_BR) + (size_t)TT * 512;
    LAS bf16* Qs = (LAS bf16*)F.lds;
    LAS bf16* Ks = (LAS bf16*)(F.lds + 73728);
    LAS bf16* VT = (LAS bf16*)(F.lds + 110592);
    for (int i = F.tid; i < 4096; i += NTHR) { const int g = i >> 10, r = (i >> 3) & 127, c8 = i & 7; if (c8 < 2) continue;
        const u32x4 w = *(const u32x4*)(qkvb + (size_t)(m0 + r) * 768 + (kvh * 4 + g) * 64 + c8 * 8);
        u32x4 o; o.x = pk2(bflo(w.x) * 0.125f, bfhi(w.x) * 0.125f); o.y = pk2(bflo(w.y) * 0.125f, bfhi(w.y) * 0.125f); o.z = pk2(bflo(w.z) * 0.125f, bfhi(w.z) * 0.125f); o.w = pk2(bflo(w.w) * 0.125f, bfhi(w.w) * 0.125f);
        *(LAS u32x4*)(Qs + (g * 128 + r) * 72 + c8 * 8) = o; }
    const float invf[8] = {1.0f, 0.19392274474868576f, 0.03760603093086393f, 0.007292664737217109f, 0.001414213562373095f, 0.0002742481756762073f, 5.318295896944988e-05f, 1.031338537721246e-05f};
    { const int g = F.tid >> 7, r = F.tid & 127; const float pos = (float)P.pos[m0 + r];
      const bf16* src = qkvb + (size_t)(m0 + r) * 768 + (kvh * 4 + g) * 64; const u32x4 w1 = *(const u32x4*)src, w2 = *(const u32x4*)(src + 8);
      const float x1[8] = {bflo(w1.x), bfhi(w1.x), bflo(w1.y), bfhi(w1.y), bflo(w1.z), bfhi(w1.z), bflo(w1.w), bfhi(w1.w)}, x2[8] = {bflo(w2.x), bfhi(w2.x), bflo(w2.y), bfhi(w2.y), bflo(w2.z), bfhi(w2.z), bflo(w2.w), bfhi(w2.w)};
      float o1[8], o2[8];
#pragma unroll
      for (int i = 0; i < 8; ++i) { float sn, cs; sincosf(pos * invf[i], &sn, &cs); o1[i] = (x1[i] * cs - x2[i] * sn) * 0.125f; o2[i] = (x2[i] * cs + x1[i] * sn) * 0.125f; }
      u32x4 a, b; a.x = pk2(o1[0], o1[1]); a.y = pk2(o1[2], o1[3]); a.z = pk2(o1[4], o1[5]); a.w = pk2(o1[6], o1[7]); b.x = pk2(o2[0], o2[1]); b.y = pk2(o2[2], o2[3]); b.z = pk2(o2[4], o2[5]); b.w = pk2(o2[6], o2[7]);
      *(LAS u32x4*)(Qs + (g * 128 + r) * 72) = a; *(LAS u32x4*)(Qs + (g * 128 + r) * 72 + 8) = b; }
    for (int i = F.tid; i < 2048; i += NTHR) { const int s = i >> 3, c8 = i & 7; const bool ok = nq > 0 || s >= 128; const size_t row = (size_t)(m0 - 128 + s);
        u32x4 kw = {0u, 0u, 0u, 0u}, vw = {0u, 0u, 0u, 0u};
        if (ok) { if (c8 >= 2) kw = *(const u32x4*)(qkvb + row * 768 + 512 + kvh * 64 + c8 * 8); vw = *(const u32x4*)(qkvb + row * 768 + 640 + kvh * 64 + c8 * 8); }
        if (c8 >= 2) *(LAS u32x4*)(Ks + s * 72 + c8 * 8) = kw;
        const int p = (s & ~12) | ((s & 4) << 1) | ((s & 8) >> 1); const unsigned vv[4] = {vw.x, vw.y, vw.z, vw.w};
#pragma unroll
        for (int j = 0; j < 4; ++j) { VT[(c8 * 8 + 2 * j) * 264 + p] = (bf16)(vv[j] & 0xffffu); VT[(c8 * 8 + 2 * j + 1) * 264 + p] = (bf16)(vv[j] >> 16); } }
    if (F.tid < 256) { const int s = F.tid; const bool ok = nq > 0 || s >= 128; u32x4 a = {0u, 0u, 0u, 0u}, b = {0u, 0u, 0u, 0u};
        if (ok) { const size_t row = (size_t)(m0 - 128 + s); const float pos = (float)P.pos[row]; const bf16* src = qkvb + row * 768 + 512 + kvh * 64; const u32x4 w1 = *(const u32x4*)src, w2 = *(const u32x4*)(src + 8);
            const float x1[8] = {bflo(w1.x), bfhi(w1.x), bflo(w1.y), bfhi(w1.y), bflo(w1.z), bfhi(w1.z), bflo(w1.w), bfhi(w1.w)}, x2[8] = {bflo(w2.x), bfhi(w2.x), bflo(w2.y), bfhi(w2.y), bflo(w2.z), bfhi(w2.z), bflo(w2.w), bfhi(w2.w)};
            float o1[8], o2[8];
#pragma unroll
            for (int i = 0; i < 8; ++i) { float sn, cs; sincosf(pos * invf[i], &sn, &cs); o1[i] = x1[i] * cs - x2[i] * sn; o2[i] = x2[i] * cs + x1[i] * sn; }
            a.x = pk2(o1[0], o1[1]); a.y = pk2(o1[2], o1[3]); a.z = pk2(o1[4], o1[5]); a.w = pk2(o1[6], o1[7]); b.x = pk2(o2[0], o2[1]); b.y = pk2(o2[2], o2[3]); b.z = pk2(o2[4], o2[5]); b.w = pk2(o2[6], o2[7]); }
        *(LAS u32x4*)(Ks + s * 72) = a; *(LAS u32x4*)(Ks + s * 72 + 8) = b; }
    __syncthreads();
    const int lr = F.lane & 31, h = F.lane >> 5, g = F.wave >> 1, qh = F.wave & 1;
    const float sink = P.sinks[l * 8 + kvh * 4 + g];
#pragma unroll 1
    for (int q2 = 0; q2 < 2; ++q2) { const int qt = 2 * qh + q2, q0 = 32 * qt, qi = q0 + lr;
        bf16x8 bq[4];
#pragma unroll
        for (int ks = 0; ks < 4; ++ks) bq[ks] = *(const LAS bf16x8*)(Qs + (g * 128 + q0 + lr) * 72 + 16 * ks + 8 * h);
        f32x16 sc[5];
#pragma unroll
        for (int k5 = 0; k5 < 5; ++k5) { sc[k5] = zero16();
#pragma unroll
            for (int ks = 0; ks < 4; ++ks) { const bf16x8 a = *(const LAS bf16x8*)(Ks + (32 * (qt + k5) + lr) * 72 + 16 * ks + 8 * h); sc[k5] = MFMA32(a, bq[ks], sc[k5]); } }
        float mx = sink;
#pragma unroll
        for (int k5 = 0; k5 < 5; ++k5)
#pragma unroll
            for (int rg = 0; rg < 16; ++rg) { const int sj = 32 * (qt + k5) + crow(rg, h); const bool ok = sj >= qi + 1 && sj <= qi + 128 && (nq > 0 || sj >= 128);
                const float v = ok ? sc[k5][rg] : -INFINITY; sc[k5][rg] = v; mx = fmaxf(mx, v); }
        mx = fmaxf(mx, __shfl_xor(mx, 32));
        float sum = 0.f;
#pragma unroll
        for (int k5 = 0; k5 < 5; ++k5)
#pragma unroll
            for (int rg = 0; rg < 16; ++rg) { const float p = __expf(sc[k5][rg] - mx); sc[k5][rg] = p; sum += p; }
        sum += __shfl_xor(sum, 32); sum += __expf(sink - mx);
        const float inv = 1.0f / sum;
        f32x16 o[2] = {zero16(), zero16()};
#pragma unroll
        for (int k5 = 0; k5 < 5; ++k5)
#pragma unroll
            for (int s2 = 0; s2 < 2; ++s2) { const bf16x8 pb = pack_step(sc[k5], s2);
#pragma unroll
                for (int dt = 0; dt < 2; ++dt) { const bf16x8 a = *(const LAS bf16x8*)(VT + (32 * dt + lr) * 264 + 32 * (qt + k5) + 16 * s2 + 8 * h); o[dt] = MFMA32(a, pb, o[dt]); } }
        bf16* orow = brb + (size_t)(m0 + qi) * 512 + (kvh * 4 + g) * 64;
#pragma unroll
        for (int dt = 0; dt < 2; ++dt)
#pragma unroll
            for (int gq = 0; gq < 4; ++gq) { u32x2 w; w.x = pk2(o[dt][4 * gq] * inv, o[dt][4 * gq + 1] * inv); w.y = pk2(o[dt][4 * gq + 2] * inv, o[dt][4 * gq + 3] * inv);
                *(u32x2*)(orow + 32 * dt + 8 * gq + 4 * h) = w; }
    }
    __syncthreads();
}

__device__ __forceinline__ void dn_pre_task(const Frame& F, const Params& P, int l, int task) {
    const int hd = task & 3, cbn = task >> 2, b = cbn >> 7, n = cbn & 127, m0 = cbn * 64;
    const bf16* qkvc = (const bf16*)(P.ws + WS_QKVC); const float* ba = (const float*)(P.ws + WS_BA);
    unsigned char* outb = P.ws + WS_DN + (size_t)task * DN_TASK_BYTES;
    LAS bf16* qs = (LAS bf16*)F.lds;
    LAS bf16* ks = (LAS bf16*)(F.lds + 17408);
    LAS bf16* kT = (LAS bf16*)(F.lds + 34816);
    LAS bf16* vT = (LAS bf16*)(F.lds + 53248);
    LAS float* Lm = (LAS float*)(F.lds + 71680);
    LAS bf16* Tm = (LAS bf16*)(F.lds + 89088);
    LAS float* tg = (LAS float*)(F.lds + 98304);
    LAS float *tgc = tg + 64, *tbeta = tg + 128, *teg = tg + 192, *ted = tg + 256, *tsb = tg + 320;
    const int lr = F.lane & 31, h = F.lane >> 5;
    { const int t = F.tid >> 3, seg = F.tid & 7, c0 = seg * 16; const int row = m0 + t;
      const float beta = fast_sigmoid(ba[(size_t)row * 8 + hd]); const float xa = ba[(size_t)row * 8 + 4 + hd] + P.dt_bias[l * 4 + hd];
      const float sp = xa > 20.f ? xa : log1pf(__expf(xa)); const float gt = -__expf(P.a_log[l * 4 + hd]) * sp;
      if (seg == 0) { tg[t] = gt; tbeta[t] = beta; }
#pragma unroll
      for (int part = 0; part < 3; ++part) { const int col0 = part * 512 + hd * 128 + c0; float acc[16];
#pragma unroll
          for (int i = 0; i < 16; ++i) acc[i] = 0.f;
#pragma unroll
          for (int tap = 0; tap < 4; ++tap) { const int sr = n * 64 + t - 3 + tap; if (sr >= 0) {
              const bf16* src = qkvc + (size_t)(b * SEQ + sr) * 1536 + col0; const u32x4 w1 = *(const u32x4*)src, w2 = *(const u32x4*)(src + 8);
              const float xv[16] = {bflo(w1.x), bfhi(w1.x), bflo(w1.y), bfhi(w1.y), bflo(w1.z), bfhi(w1.z), bflo(w1.w), bfhi(w1.w), bflo(w2.x), bfhi(w2.x), bflo(w2.y), bfhi(w2.y), bflo(w2.z), bfhi(w2.z), bflo(w2.w), bfhi(w2.w)};
              const f32x4* cw = (const f32x4*)(P.conv_w + ((size_t)l * 4 + tap) * 1536 + col0);
#pragma unroll
              for (int q = 0; q < 4; ++q) { const f32x4 w = cw[q]; acc[4 * q] += xv[4 * q] * w.x; acc[4 * q + 1] += xv[4 * q + 1] * w.y; acc[4 * q + 2] += xv[4 * q + 2] * w.z; acc[4 * q + 3] += xv[4 * q + 3] * w.w; } } }
          float ss = 0.f;
#pragma unroll
          for (int i = 0; i < 16; ++i) { acc[i] = acc[i] * fast_sigmoid(acc[i]); ss += acc[i] * acc[i]; }
          if (part < 2) { ss += __shfl_xor(ss, 1); ss += __shfl_xor(ss, 2); ss += __shfl_xor(ss, 4); const float rn = __builtin_amdgcn_rsqf(ss + NORM_EPS) * (part == 0 ? 0.08838834764831845f : 1.0f);
#pragma unroll
              for (int i = 0; i < 16; ++i) acc[i] *= rn; }
          else {
#pragma unroll
              for (int i = 0; i < 16; ++i) acc[i] *= beta; }
          unsigned pk[8];
#pragma unroll
          for (int i = 0; i < 8; ++i) pk[i] = pk2(acc[2 * i], acc[2 * i + 1]);
          if (part < 2) { LAS bf16* dst = (part == 0 ? qs : ks) + t * 136 + c0; *(LAS u32x4*)dst = (u32x4){pk[0], pk[1], pk[2], pk[3]}; *(LAS u32x4*)(dst + 8) = (u32x4){pk[4], pk[5], pk[6], pk[7]}; }
          if (part >= 1) { LAS bf16* dT = part == 1 ? kT : vT;
#pragma unroll
              for (int i = 0; i < 8; ++i) { dT[(c0 + 2 * i) * 72 + t] = (bf16)(pk[i] & 0xffffu); dT[(c0 + 2 * i + 1) * 72 + t] = (bf16)(pk[i] >> 16); } }
      }
    }
    __syncthreads();
    if (F.wave == 0) { float x = tg[F.lane];
#pragma unroll
        for (int o = 1; o < 64; o <<= 1) { const float y = __shfl_up(x, o); if (F.lane >= o) x += y; }
        const float gl = __shfl(x, 63); tgc[F.lane] = x; const float e = __expf(x); teg[F.lane] = e; ted[F.lane] = __expf(gl - x); tsb[F.lane] = tbeta[F.lane] * e;
        if (F.lane == 0) ((float*)(P.ws + WS_CD))[task] = __expf(gl); }
    __syncthreads();
    if (F.wave < 4) { const int it = F.wave >> 1, jt = F.wave & 1; f32x16 acc = zero16();
        if (jt <= it) {
#pragma unroll
            for (int s = 0; s < 8; ++s) { const bf16x8 a = *(const LAS bf16x8*)(ks + (32 * it + lr) * 136 + 16 * s + 8 * h), bb = *(const LAS bf16x8*)(ks + (32 * jt + lr) * 136 + 16 * s + 8 * h); acc = MFMA32(a, bb, acc); } }
        const int j = 32 * jt + lr; const float gj = tgc[j];
#pragma unroll
        for (int rg = 0; rg < 16; ++rg) { const int i = 32 * it + crow(rg, h); const float v = i > j ? tbeta[i] * acc[rg] * __expf(tgc[i] - gj) : 0.f; Lm[i * 68 + j] = v; } }
    else { const int w4 = F.wave - 4, jt = w4 >> 1, ct = w4 & 1; f32x16 acc = zero16();
        if (jt <= ct) {
#pragma unroll
            for (int s = 0; s < 8; ++s) { const bf16x8 a = *(const LAS bf16x8*)(ks + (32 * jt + lr) * 136 + 16 * s + 8 * h), bb = *(const LAS bf16x8*)(qs + (32 * ct + lr) * 136 + 16 * s + 8 * h); acc = MFMA32(a, bb, acc); } }
        const int c = 32 * ct + lr; const float gcc = tgc[c];
#pragma unroll
        for (int rg = 0; rg < 16; ++rg) { const int jp = 32 * jt + crow(rg, h); acc[rg] = jp <= c ? acc[rg] * __expf(gcc - tgc[jp]) : 0.f; }
#pragma unroll
        for (int s = 0; s < 2; ++s) *(bf16x8*)(outb + DN_OFF_AT + ((ct * 4 + 2 * jt + s) * 64 + F.lane) * 16) = pack_step(acc, s); }
    __syncthreads();
    if (F.wave == 0) { LAS float* Tf = (LAS float*)(F.lds + 99840);
#pragma unroll 1
        for (int bi = 0; bi < 4; ++bi) { float rr[16];
#pragma unroll
            for (int ii = 0; ii < 16; ++ii) rr[ii] = (F.lane == 16 * bi + ii) ? 1.f : 0.f;
#pragma unroll 1
            for (int j = 0; j < 16 * bi; j += 4) { const float t0 = Tf[j * 64 + F.lane], t1 = Tf[(j + 1) * 64 + F.lane], t2 = Tf[(j + 2) * 64 + F.lane], t3 = Tf[(j + 3) * 64 + F.lane];
#pragma unroll
                for (int ii = 0; ii < 16; ++ii) { const f32x4 lv = *(const LAS f32x4*)(Lm + (16 * bi + ii) * 68 + j); rr[ii] -= (lv.x * t0 + lv.y * t1) + (lv.z * t2 + lv.w * t3); } }
#pragma unroll
            for (int ii = 0; ii < 16; ++ii) {
#pragma unroll
                for (int j4 = 0; j4 < ii; j4 += 4) { const f32x4 lv = *(const LAS f32x4*)(Lm + (16 * bi + ii) * 68 + 16 * bi + j4);
                    rr[ii] -= lv.x * rr[j4]; if (j4 + 1 < ii) rr[ii] -= lv.y * rr[j4 + 1]; if (j4 + 2 < ii) rr[ii] -= lv.z * rr[j4 + 2]; if (j4 + 3 < ii) rr[ii] -= lv.w * rr[j4 + 3]; }
                Tf[(16 * bi + ii) * 64 + F.lane] = rr[ii]; Tm[(16 * bi + ii) * 72 + F.lane] = (bf16)(pk2(rr[ii], 0.f) & 0xffffu); } } }
    else { for (int f = F.wave - 1; f < 32; f += 7) {
            if (f < 16) { const int mt = f >> 3, s = f & 7, c = 32 * mt + lr; const float e = teg[c];
                const u32x2 lo = *(const LAS u32x2*)(qs + c * 136 + 16 * s + 4 * h), hi = *(const LAS u32x2*)(qs + c * 136 + 16 * s + 8 + 4 * h);
                u32x4 o; o.x = pk2(bflo(lo.x) * e, bfhi(lo.x) * e); o.y = pk2(bflo(lo.y) * e, bfhi(lo.y) * e); o.z = pk2(bflo(hi.x) * e, bfhi(hi.x) * e); o.w = pk2(bflo(hi.y) * e, bfhi(hi.y) * e);
                *(u32x4*)(outb + DN_OFF_QD + ((mt * 8 + s) * 64 + F.lane) * 16) = o; }
            else { const int f2 = f - 16, dt = f2 >> 2, s = f2 & 3, d = 32 * dt + lr;
                const u32x2 lo = *(const LAS u32x2*)(kT + d * 72 + 16 * s + 4 * h), hi = *(const LAS u32x2*)(kT + d * 72 + 16 * s + 8 + 4 * h);
                const f32x4 e0 = *(const LAS f32x4*)(ted + 16 * s + 4 * h), e1 = *(const LAS f32x4*)(ted + 16 * s + 8 + 4 * h);
                u32x4 o; o.x = pk2(bflo(lo.x) * e0.x, bfhi(lo.x) * e0.y); o.y = pk2(bflo(lo.y) * e0.z, bfhi(lo.y) * e0.w); o.z = pk2(bflo(hi.x) * e1.x, bfhi(hi.x) * e1.y); o.w = pk2(bflo(hi.y) * e1.z, bfhi(hi.y) * e1.w);
                *(u32x4*)(outb + DN_OFF_KD + ((dt * 4 + s) * 64 + F.lane) * 16) = o; } } }
    __syncthreads();
    { const int it = F.wave >> 2, et = F.wave & 3; f32x16 acc = zero16();
#pragma unroll
      for (int s = 0; s < 4; ++s) { const bf16x8 a = *(const LAS bf16x8*)(Tm + (32 * it + lr) * 72 + 16 * s + 8 * h), bb = *(const LAS bf16x8*)(vT + (32 * et + lr) * 72 + 16 * s + 8 * h); acc = MFMA32(a, bb, acc); }
      u32x4 o0, o1; o0.x = pk2(acc[0], acc[1]); o0.y = pk2(acc[2], acc[3]); o0.z = pk2(acc[4], acc[5]); o0.w = pk2(acc[6], acc[7]); o1.x = pk2(acc[8], acc[9]); o1.y = pk2(acc[10], acc[11]); o1.z = pk2(acc[12], acc[13]); o1.w = pk2(acc[14], acc[15]);
      unsigned char* up = outb + DN_OFF_U + ((et * 2 + it) * 64 + F.lane) * 32; *(u32x4*)up = o0; *(u32x4*)(up + 16) = o1; }
    { const int dt = F.wave >> 1, it = F.wave & 1; f32x16 acc = zero16();
#pragma unroll
      for (int s = 0; s < 4; ++s) { const u32x4 kw = *(const LAS u32x4*)(kT + (32 * dt + lr) * 72 + 16 * s + 8 * h); const f32x4 e0 = *(const LAS f32x4*)(tsb + 16 * s + 8 * h), e1 = *(const LAS f32x4*)(tsb + 16 * s + 8 * h + 4);
          u32x4 aw; aw.x = pk2(bflo(kw.x) * e0.x, bfhi(kw.x) * e0.y); aw.y = pk2(bflo(kw.y) * e0.z, bfhi(kw.y) * e0.w); aw.z = pk2(bflo(kw.z) * e1.x, bfhi(kw.z) * e1.y); aw.w = pk2(bflo(kw.w) * e1.z, bfhi(kw.w) * e1.w);
          const bf16x8 bb = *(const LAS bf16x8*)(Tm + (32 * it + lr) * 72 + 16 * s + 8 * h); acc = MFMA32(__builtin_bit_cast(bf16x8, aw), bb, acc); }
#pragma unroll
      for (int s = 0; s < 2; ++s) *(bf16x8*)(outb + DN_OFF_W + ((it * 8 + 2 * dt + s) * 64 + F.lane) * 16) = pack_step(acc, s); }
    __syncthreads();
}
__device__ __forceinline__ void dn_scan(const Frame& F, const Params& P, int bh) {
    const int b = bh >> 2, hd = bh & 3; const int lr = F.lane & 31, h = F.lane >> 5, es = F.wave;
    const unsigned char* dn = P.ws + WS_DN; const float* cdv = (const float*)(P.ws + WS_CD);
    bf16* brc = (bf16*)(P.ws + WS_BR) + (size_t)2 * TT * 512;
#define task_of(n_) ((((b) * 128 + (n_)) << 2) | (hd))
    { const u32x4* src = (const u32x4*)(dn + (size_t)task_of(0) * DN_TASK_BYTES); LAS u32x4* dst = (LAS u32x4*)F.lds;
#pragma unroll
      for (int i = 0; i < 9; ++i) dst[F.tid + 512 * i] = src[F.tid + 512 * i]; }
    __syncthreads();
    f32x16 S[4] = {zero16(), zero16(), zero16(), zero16()};
    for (int n = 0; n < 128; ++n) {
        if (F.wave >= 4) { if (n + 1 < 128) { const u32x4* src = (const u32x4*)(dn + (size_t)task_of(n + 1) * DN_TASK_BYTES); LAS u32x4* dst = (LAS u32x4*)(F.lds + ((n + 1) & 1) * DN_TASK_BYTES); const int t4 = F.tid - 256;
#pragma unroll
                for (int i = 0; i < 18; ++i) dst[t4 + 256 * i] = src[t4 + 256 * i]; } }
        else { const LAS unsigned char* cur = F.lds + (n & 1) * DN_TASK_BYTES; const float cd = cdv[task_of(n)];
            bf16x8 Sb[8];
#pragma unroll
            for (int dt = 0; dt < 4; ++dt) { Sb[2 * dt] = pack_step(S[dt], 0); Sb[2 * dt + 1] = pack_step(S[dt], 1); }
            f32x16 Pw[2] = {zero16(), zero16()}, O[2] = {zero16(), zero16()};
#pragma unroll
            for (int ct = 0; ct < 2; ++ct)
#pragma unroll
                for (int s = 0; s < 8; ++s) { const bf16x8 a = *(const LAS bf16x8*)(cur + DN_OFF_W + ((ct * 8 + s) * 64 + F.lane) * 16); Pw[ct] = MFMA32(a, Sb[s], Pw[ct]); }
#pragma unroll
            for (int ct = 0; ct < 2; ++ct)
#pragma unroll
                for (int s = 0; s < 8; ++s) { const bf16x8 a = *(const LAS bf16x8*)(cur + DN_OFF_QD + ((ct * 8 + s) * 64 + F.lane) * 16); O[ct] = MFMA32(a, Sb[s], O[ct]); }
            bf16x8 Vb[4];
#pragma unroll
            for (int ct = 0; ct < 2; ++ct) { const LAS u32x4* up = (const LAS u32x4*)(cur + DN_OFF_U + ((es * 2 + ct) * 64 + F.lane) * 32); const u32x4 u0 = up[0], u1 = up[1];
                const unsigned uw[8] = {u0.x, u0.y, u0.z, u0.w, u1.x, u1.y, u1.z, u1.w}; f32x16 v;
#pragma unroll
                for (int p = 0; p < 8; ++p) { v[2 * p] = bflo(uw[p]) - Pw[ct][2 * p]; v[2 * p + 1] = bfhi(uw[p]) - Pw[ct][2 * p + 1]; }
                Vb[2 * ct] = pack_step(v, 0); Vb[2 * ct + 1] = pack_step(v, 1); }
#pragma unroll
            for (int ct = 0; ct < 2; ++ct)
#pragma unroll
                for (int s = 0; s < 4; ++s) { const bf16x8 a = *(const LAS bf16x8*)(cur + DN_OFF_AT + ((ct * 4 + s) * 64 + F.lane) * 16); O[ct] = MFMA32(a, Vb[s], O[ct]); }
            bf16* orow = brc + (size_t)((b * 128 + n) * 64) * 512 + hd * 128 + es * 32 + lr;
#pragma unroll
            for (int ct = 0; ct < 2; ++ct)
#pragma unroll
                for (int rg = 0; rg < 16; ++rg) orow[(size_t)(32 * ct + crow(rg, h)) * 512] = (bf16)(pk2(O[ct][rg], 0.f) & 0xffffu);
#pragma unroll
            for (int dt = 0; dt < 4; ++dt) { S[dt] = S[dt] * cd;
#pragma unroll
                for (int s = 0; s < 4; ++s) { const bf16x8 a = *(const LAS bf16x8*)(cur + DN_OFF_KD + ((dt * 4 + s) * 64 + F.lane) * 16); S[dt] = MFMA32(a, Vb[s], S[dt]); } }
        }
        __syncthreads();
    }
}
__device__ __forceinline__ void dn_post(const Frame& F, const Params& P, int l) {
    const int gw = F.vb * NWAVES + F.wave, NGW = F.G * NWAVES; bf16* brc = (bf16*)(P.ws + WS_BR) + (size_t)2 * TT * 512; const bf16* z = (const bf16*)(P.ws + WS_Z);
    const f32x4* gp = (const f32x4*)(P.dn_norm + l * 128 + (F.lane & 15) * 8); const f32x4 g0 = gp[0], g1 = gp[1]; const float gn[8] = {g0.x, g0.y, g0.z, g0.w, g1.x, g1.y, g1.z, g1.w};
    for (int m = gw; m < TT; m += NGW) { u32x4* op = (u32x4*)(brc + (size_t)m * 512 + F.lane * 8); const u32x4 ow = *op, zw = *(const u32x4*)(z + (size_t)m * 512 + F.lane * 8);
        float o[8] = {bflo(ow.x), bfhi(ow.x), bflo(ow.y), bfhi(ow.y), bflo(ow.z), bfhi(ow.z), bflo(ow.w), bfhi(ow.w)}; const float zz[8] = {bflo(zw.x), bfhi(zw.x), bflo(zw.y), bfhi(zw.y), bflo(zw.z), bfhi(zw.z), bflo(zw.w), bfhi(zw.w)};
        float ss = 0.f;
#pragma unroll
        for (int i = 0; i < 8; ++i) ss += o[i] * o[i];
        ss += __shfl_xor(ss, 1); ss += __shfl_xor(ss, 2); ss += __shfl_xor(ss, 4); ss += __shfl_xor(ss, 8);
        const float rs = __builtin_amdgcn_rsqf(ss * (1.f / 128.f) + NORM_EPS);
#pragma unroll
        for (int i = 0; i < 8; ++i) o[i] = o[i] * rs * gn[i] * (zz[i] * fast_sigmoid(zz[i]));
        u32x4 w; w.x = pk2(o[0], o[1]); w.y = pk2(o[2], o[3]); w.z = pk2(o[4], o[5]); w.w = pk2(o[6], o[7]); *op = w; }
}
__device__ __forceinline__ void final_norm(const Frame& F, const Params& P) {
    const int gw = F.vb * NWAVES + F.wave, NGW = F.G * NWAVES; const float* rowsq = (const float*)(P.ws + WS_ROWSQ);
    f32x4 gn[4];
#pragma unroll
    for (int j = 0; j < 4; ++j) gn[j] = ((const f32x4*)P.final_norm)[F.lane + 64 * j];
    for (int m = gw; m < TT; m += NGW) { float sq = F.lane < 16 ? rowsq[(size_t)m * 16 + F.lane] : 0.f; sq = wave_sum(sq); const float rs = __builtin_amdgcn_rsqf(sq * (1.f / 1024.f) + NORM_EPS);
        f32x4* xr = (f32x4*)(P.out + (size_t)m * DM) + F.lane;
#pragma unroll
        for (int j = 0; j < 4; ++j) xr[64 * j] = xr[64 * j] * rs * gn[j]; }
}

constexpr int PH_PER_LAYER = 9, N_PHASES = DEPTH * PH_PER_LAYER + 1;
__device__ __forceinline__ void run_phase(const Frame& F0, const Params& P0, int ph) {
    Frame F = F0; Params P = P0; asm volatile("" : "+v"(F.tid)); F.lane = F.tid & 63; F.wave = __builtin_amdgcn_readfirstlane(F.tid >> 6); asm volatile("" : "+s"(P.ws));
    const int l = ph / PH_PER_LAYER, k = ph % PH_PER_LAYER;
    unsigned char* ws = P.ws; const float* rowsq = (const float*)(ws + WS_ROWSQ); const LAS float* lrs = (const LAS float*)(F.lds + pg8::LRS_OFF);
    if (ph == N_PHASES - 1) { final_norm(F, P); return; }
#ifdef ONLY_K
    if (k != ONLY_K) return;
#endif
    switch (k) {
    case 0: p0_attn_weights(F, P, l); if (l == 0) p0_input(F, P); break;
    case 1: { p1_ba(F, P); __syncthreads();
        pg8::Gemm g{(const pg8::bf16_t*)(ws + WS_XB), (const pg8::bf16_t*)(ws + WS_WIN), TT, NMIX, DM}; pg8::StaticOrder S; S.init(TT, NMIX, F.G, (int)blockIdx.x);
        pg8::EpiProj E{(pg8::bf16_t*)(ws + WS_UV), (pg8::bf16_t*)(ws + WS_QKVB), (pg8::bf16_t*)(ws + WS_QKVC), (pg8::bf16_t*)(ws + WS_Z), lrs};
        pg8::prep_rstd(F.lds, S, rowsq);
        pg8::gemm_phase<pg8::EpiProj, pg8::StaticOrder, true, true>(F.lds, g, S, E); } break;
    case 2: for (int t = F.vb; t < 1024; t += F.G) dn_pre_task(F, P, l, t); break;
    case 3: { const int sb = (int)blockIdx.x; if (sb < 8) dn_scan(F, P, sb);
              else { const int nb = F.G - 8; for (int t = sb - 8; t < 768; t += nb) { if (t < 256) swa_task(F, P, l, t); else sgu_task(F, P, l, t - 256); } } } break;
    case 4: dn_post(F, P, l); p0_ffn_weights(F, P, l); break;
    case 5: {
#pragma unroll 1
        for (int n = 0; n < 3; ++n) {
            { pg8::Gemm g{(const pg8::bf16_t*)(ws + WS_XB), (const pg8::bf16_t*)(ws + WS_WG) + (size_t)n * 1024 * 1024, TT, DM, DM}; pg8::StaticOrder S; S.init(TT, DM, F.G, (int)blockIdx.x);
              pg8::EpiSig E{(pg8::bf16_t*)(ws + WS_UV), lrs}; if (n == 0) pg8::prep_rstd(F.lds, S, rowsq); pg8::gemm_phase<pg8::EpiSig, pg8::StaticOrder, true, true>(F.lds, g, S, E); }
            __syncthreads();
            { pg8::Gemm g{(const pg8::bf16_t*)(ws + WS_BR) + (size_t)n * TT * 512, (const pg8::bf16_t*)(ws + WS_WBR) + (size_t)n * 1024 * 512, TT, DM, 512}; pg8::StaticOrder S; S.init(TT, DM, F.G, (int)blockIdx.x);
              if (n == 0) { pg8::EpiMerge<0> E{(pg8::bf16_t*)(ws + WS_UV), (float*)(ws + WS_DN)}; pg8::gemm_phase<pg8::EpiMerge<0>, pg8::StaticOrder, true, true>(F.lds, g, S, E); }
              else if (n == 1) { pg8::EpiMerge<1> E{(pg8::bf16_t*)(ws + WS_UV), (float*)(ws + WS_DN)}; pg8::gemm_phase<pg8::EpiMerge<1>, pg8::StaticOrder, true, true>(F.lds, g, S, E); }
              else { pg8::EpiMerge<2> E{(pg8::bf16_t*)(ws + WS_UV), (float*)(ws + WS_DN)}; pg8::gemm_phase<pg8::EpiMerge<2>, pg8::StaticOrder, true, true>(F.lds, g, S, E); } }
            __syncthreads();
        } } break;
    case 6: { pg8::Gemm g{(const pg8::bf16_t*)(ws + WS_UV), (const pg8::bf16_t*)(ws + WS_WOUT), TT, DM, DM}; pg8::StaticOrder S; S.init(TT, DM, F.G, (int)blockIdx.x);
        pg8::EpiResid E{l == 0 ? P.x : P.out, P.out, (pg8::bf16_t*)(ws + WS_XB), (float*)(ws + WS_ROWSQ)}; pg8::gemm_phase<pg8::EpiResid, pg8::StaticOrder, true, true>(F.lds, g, S, E); } break;
    case 7: { pg8::Gemm g{(const pg8::bf16_t*)(ws + WS_XB), (const pg8::bf16_t*)(ws + WS_WGU), TT, 2 * DFF, DM}; pg8::StaticOrder S; S.init(TT, 2 * DFF, F.G, (int)blockIdx.x);
        pg8::EpiGU E{(pg8::bf16_t*)(ws + WS_HID), lrs}; pg8::prep_rstd(F.lds, S, rowsq); pg8::gemm_phase<pg8::EpiGU, pg8::StaticOrder, true, true>(F.lds, g, S, E); } break;
    case 8: { pg8::Gemm g{(const pg8::bf16_t*)(ws + WS_HID), (const pg8::bf16_t*)(ws + WS_WDN), TT, DM, DFF}; pg8::StaticOrder S; S.init(TT, DM, F.G, (int)blockIdx.x);
        pg8::EpiResid E{P.out, P.out, (pg8::bf16_t*)(ws + WS_XB), (float*)(ws + WS_ROWSQ)}; pg8::gemm_phase<pg8::EpiResid, pg8::StaticOrder, true, true>(F.lds, g, S, E); } break;
    }
}

__global__ void __launch_bounds__(NTHR, 2) hgpm_fwd(Params P) {
    extern __shared__ __attribute__((aligned(16))) unsigned char lds_raw[];
    Frame F; F.lds = (LAS unsigned char*)lds_raw; F.tid = threadIdx.x; F.lane = F.tid & 63; F.wave = __builtin_amdgcn_readfirstlane(F.tid >> 6);
    F.G = gridDim.x; { const int bx = blockIdx.x; F.vb = (F.G % 8 == 0) ? (bx % 8) * (F.G / 8) + bx / 8 : bx; }
    cg::grid_group grid = cg::this_grid();
    for (int ph = P.ph_lo; ph < P.ph_hi; ++ph) {
        run_phase(F, P, ph);
        if (ph + 1 < P.ph_hi) grid.sync();
    }
}

#ifndef N_LAUNCH_MODE
#define N_LAUNCH_MODE 0
#endif
extern "C" void kernel_launch(void* const* d_in, const int* in_sizes, int n_in, void* d_out, int out_size, void* d_ws, size_t ws_size, hipStream_t stream) {
    static int grid = 0;
    if (grid == 0) {
        if (n_in != 19 || in_sizes[0] != TT * DM || out_size != TT * DM || ws_size < WS_END) { fprintf(stderr, "kernel_launch: unexpected shapes (n_in %d, in0 %d, out %d, ws %zu)\n", n_in, n_in > 0 ? in_sizes[0] : -1, out_size, ws_size); grid = -1; return; }
        int dev = 0, cus = 0, per_cu = 0;
        if (hipGetDevice(&dev) != hipSuccess || hipDeviceGetAttribute(&cus, hipDeviceAttributeMultiprocessorCount, dev) != hipSuccess) { grid = -1; return; }
        if (hipFuncSetAttribute((const void*)hgpm_fwd, hipFuncAttributeMaxDynamicSharedMemorySize, LDS_BYTES) != hipSuccess) { fprintf(stderr, "kernel_launch: hipFuncSetAttribute failed\n"); grid = -1; return; }
        if (hipOccupancyMaxActiveBlocksPerMultiprocessor(&per_cu, (const void*)hgpm_fwd, NTHR, LDS_BYTES) != hipSuccess || per_cu < 1) { fprintf(stderr, "kernel_launch: occupancy query says %d blocks per CU\n", per_cu); per_cu = 1; }
        (void)hipGetLastError();
        grid = cus;
    }
    if (grid < 0) return;
    Params p{};
    p.x = (const float*)d_in[0]; p.pos = (const int*)d_in[1]; p.attn_norm = (const float*)d_in[2]; p.w_in = (const float*)d_in[3]; p.sgu_ln_g = (const float*)d_in[4]; p.sgu_ln_b = (const float*)d_in[5];
    p.sgu_w = (const float*)d_in[6]; p.sgu_b = (const float*)d_in[7]; p.sinks = (const float*)d_in[8]; p.conv_w = (const float*)d_in[9]; p.a_log = (const float*)d_in[10]; p.dt_bias = (const float*)d_in[11];
    p.dn_norm = (const float*)d_in[12]; p.w_branch = (const float*)d_in[13]; p.w_out = (const float*)d_in[14]; p.ffn_norm = (const float*)d_in[15]; p.w_gate_up = (const float*)d_in[16]; p.w_down = (const float*)d_in[17];
    p.final_norm = (const float*)d_in[18]; p.out = (float*)d_out; p.ws = (unsigned char*)d_ws;
#if N_LAUNCH_MODE == 0
    p.ph_lo = 0; p.ph_hi = N_PHASES;
    void* args[] = {&p};
    hipError_t e = hipLaunchCooperativeKernel((const void*)hgpm_fwd, dim3(grid), dim3(NTHR), args, LDS_BYTES, stream);
    if (e != hipSuccess) fprintf(stderr, "kernel_launch: cooperative launch failed: %s (grid %d)\n", hipGetErrorString(e), grid);
#else
    for (int ph = 0; ph < N_PHASES; ++ph) { p.ph_lo = ph; p.ph_hi = ph + 1; hipLaunchKernelGGL(hgpm_fwd, dim3(grid), dim3(NTHR), LDS_BYTES, stream, p); }
#endif
}
```

```cpp
#include <hip/hip_runtime.h>
#include <hip/hip_cooperative_groups.h>
#include <cstdio>
#include <cstdint>
namespace cg = cooperative_groups;
namespace pg8 {
#define PG8_LAS __attribute__((address_space(3)))
typedef unsigned short bf16_t;
typedef short bf16x8 __attribute__((ext_vector_type(8)));
typedef float f32x4 __attribute__((ext_vector_type(4)));
typedef unsigned u32x4 __attribute__((ext_vector_type(4)));
constexpr int BM = 256, BK = 64, HALF = 128, HTB = HALF * BK * 2  , STAGE_BYTES = 8 * HTB, NXCD = 8, WGM = 8;

__host__ __device__ __forceinline__ int lds_byte(int r, int c) { const int st = (r >> 4) * 2 + (c >> 5), rr = r & 15, cc = c & 31, ob = rr * 64 + cc * 2; return st * 1024 + (ob ^ (((ob >> 9) & 1) << 5)); }
__host__ __device__ __forceinline__ void stage_rc(int b, int& R, int& C) { const int st = b / 1024, sb = b % 1024, swz = sb ^ (((sb >> 9) & 1) << 5); R = (st >> 1) * 16 + swz / 64; C = (st & 1) * 32 + (swz % 64) / 2; }
__host__ __device__ __forceinline__ int perm32(int rho) { const int n = rho >> 4, i = rho & 15; return 8 * (i >> 2) + 4 * n + (i & 3); }

struct Unit { int pm, pn, idx; };
struct Gemm { const bf16_t* A; const bf16_t* Bt; int M, N, K; };

struct StaticOrder {
    int nM, nN, nwg, G, c;
    __host__ __device__ void init(int M, int N, int G_, int c_) { nM = M / BM; nN = N / BM; nwg = nM * nN; G = G_; c = c_; }
    __host__ __device__ bool next(int i, Unit& u) const {
        const long L = (long)i * G + c; if (L >= nwg) return false;
        int wgid = (int)L; { const int q = nwg / NXCD, r = nwg % NXCD, xcd = wgid % NXCD, off = wgid / NXCD; wgid = (xcd < r ? xcd * (q + 1) : r * (q + 1) + (xcd - r) * q) + off; }
        const int nig = WGM * nN, gid = wgid / nig, fm = gid * WGM, gsz = (nM - fm) < WGM ? (nM - fm) : WGM;
        u.pm = fm + ((wgid % nig) % gsz); u.pn = (wgid % nig) / gsz; u.idx = i; return true;
    }
    __device__ __forceinline__ void a_ready(const Unit&) const {}
    __device__ __forceinline__ void done(const Unit&) const {}
};

typedef float f32x2 __attribute__((ext_vector_type(2)));
typedef __bf16 bf16v2 __attribute__((ext_vector_type(2)));
typedef unsigned u32x2 __attribute__((ext_vector_type(2)));
__device__ __forceinline__ unsigned pk2(float lo, float hi) { f32x2 v = {lo, hi}; bf16v2 r = __builtin_convertvector(v, bf16v2); return __builtin_bit_cast(unsigned, r); }
__device__ __forceinline__ float bflo(unsigned w) { return __uint_as_float(w << 16); }
__device__ __forceinline__ float bfhi(unsigned w) { return __uint_as_float(w & 0xffff0000u); }
__device__ __forceinline__ float fast_sigmoid(float x) { return __builtin_amdgcn_rcpf(1.0f + __expf(-x)); }
__device__ __forceinline__ float gelu_tanh(float x) { const float u = 1.5957691216f * (x + 0.044715f * x * x * x); return x * fast_sigmoid(u); }
constexpr float NORM_EPS = 1e-6f;
__device__ __forceinline__ float row_rstd(const float* rowsq, int row) {
    const f32x4* p = (const f32x4*)(rowsq + (size_t)row * 16); const f32x4 a = p[0], b = p[1], c = p[2], d = p[3];
    const float s = ((a.x + a.y) + (a.z + a.w)) + ((b.x + b.y) + (b.z + b.w)) + ((c.x + c.y) + (c.z + c.w)) + ((d.x + d.y) + (d.z + d.w));
    return __builtin_amdgcn_rsqf(s * (1.0f / 1024.0f) + NORM_EPS);
}
constexpr int LRS_OFF = STAGE_BYTES, LRS_MAX_UNITS = 8;
template <class Sched> __device__ __forceinline__ void prep_rstd(PG8_LAS unsigned char* lds, const Sched& S, const float* rowsq) {
    PG8_LAS float* t = (PG8_LAS float*)(lds + LRS_OFF); Unit u;
#pragma unroll 1
    for (int i = 0; i < LRS_MAX_UNITS; ++i) { if (!S.next(i, u)) break; if (threadIdx.x < 256) t[i * 256 + threadIdx.x] = row_rstd(rowsq, u.pm * BM + threadIdx.x); asm volatile("" ::: "memory"); }
    __syncthreads();
}
struct EpiProj {
    static constexpr bool PERM = true, AFTER_DRAIN = false;
    bf16_t *uv, *qkvb, *qkvc, *z; const PG8_LAS float* lrs;
    __device__ __forceinline__ void operator()(const f32x4 (&acc)[2][2][4][2], const Unit& u, int wr, int wc, int fr, int fq) const {
        const int pn = u.pn; bf16_t* base; int ldc, colt; bool act = false;
        if (pn < 4) { base = uv; ldc = 1024; colt = pn * 256; act = true; }
        else if (pn < 7) { base = qkvb; ldc = 768; colt = (pn - 4) * 256; }
        else if (pn < 13) { base = qkvc; ldc = 1536; colt = (pn - 7) * 256; }
        else { base = z; ldc = 512; colt = (pn - 13) * 256; }
        const int row0 = u.pm * BM + wr * 64 + fr, col0 = colt + wc * 32 + 8 * fq;
#pragma unroll
        for (int ai = 0; ai < 2; ++ai)
#pragma unroll
            for (int m = 0; m < 4; ++m) { const int row = row0 + ai * HALF + m * 16; const float rs = lrs[u.idx * 256 + (row - u.pm * BM)]; bf16_t* rowp = base + (size_t)row * ldc + col0;
#pragma unroll
                for (int bj = 0; bj < 2; ++bj) { f32x4 v0 = acc[ai][bj][m][0] * rs, v1 = acc[ai][bj][m][1] * rs;
                    if (act) {
#pragma unroll
                        for (int j = 0; j < 4; ++j) { v0[j] = gelu_tanh(v0[j]); v1[j] = gelu_tanh(v1[j]); } }
                    u32x4 w; w.x = pk2(v0[0], v0[1]); w.y = pk2(v0[2], v0[3]); w.z = pk2(v1[0], v1[1]); w.w = pk2(v1[2], v1[3]);
                    *(u32x4*)(rowp + bj * HALF) = w; } }
    }
};
struct EpiSig {
    static constexpr bool PERM = true, AFTER_DRAIN = false;
    bf16_t* sig; const PG8_LAS float* lrs;
    __device__ __forceinline__ void operator()(const f32x4 (&acc)[2][2][4][2], const Unit& u, int wr, int wc, int fr, int fq) const {
        const int row0 = u.pm * BM + wr * 64 + fr, col0 = u.pn * BM + wc * 32 + 8 * fq;
#pragma unroll
        for (int ai = 0; ai < 2; ++ai)
#pragma unroll
            for (int m = 0; m < 4; ++m) { const int row = row0 + ai * HALF + m * 16; const float rs = lrs[u.idx * 256 + (row - u.pm * BM)]; bf16_t* rowp = sig + (size_t)row * 1024 + col0;
#pragma unroll
                for (int bj = 0; bj < 2; ++bj) { f32x4 v0 = acc[ai][bj][m][0] * rs, v1 = acc[ai][bj][m][1] * rs;
#pragma unroll
                    for (int j = 0; j < 4; ++j) { v0[j] = fast_sigmoid(v0[j]); v1[j] = fast_sigmoid(v1[j]); }
                    u32x4 w; w.x = pk2(v0[0], v0[1]); w.y = pk2(v0[2], v0[3]); w.z = pk2(v1[0], v1[1]); w.w = pk2(v1[2], v1[3]);
                    *(u32x4*)(rowp + bj * HALF) = w; } }
    }
};
template <int MODE> struct EpiMerge {
    static constexpr bool PERM = true, AFTER_DRAIN = false;
    bf16_t* sig; float* mf;
    __device__ __forceinline__ void operator()(const f32x4 (&acc)[2][2][4][2], const Unit& u, int wr, int wc, int fr, int fq) const {
        const int row0 = u.pm * BM + wr * 64 + fr, col0 = u.pn * BM + wc * 32 + 8 * fq;
#pragma unroll
        for (int ai = 0; ai < 2; ++ai)
#pragma unroll
            for (int m = 0; m < 4; ++m) { const size_t off = (size_t)(row0 + ai * HALF + m * 16) * 1024 + col0;
#pragma unroll
                for (int bj = 0; bj < 2; ++bj) { const u32x4 s = *(const u32x4*)(sig + off + bj * HALF);
                    f32x4 v0 = acc[ai][bj][m][0], v1 = acc[ai][bj][m][1];
                    v0[0] *= bflo(s.x); v0[1] *= bfhi(s.x); v0[2] *= bflo(s.y); v0[3] *= bfhi(s.y); v1[0] *= bflo(s.z); v1[1] *= bfhi(s.z); v1[2] *= bflo(s.w); v1[3] *= bfhi(s.w);
                    float* mp = mf + off + bj * HALF;
                    if (MODE >= 1) { v0 += *(const f32x4*)mp; v1 += *(const f32x4*)(mp + 4); }
                    if (MODE <= 1) { *(f32x4*)mp = v0; *(f32x4*)(mp + 4) = v1; }
                    else { u32x4 w; w.x = pk2(v0[0], v0[1]); w.y = pk2(v0[2], v0[3]); w.z = pk2(v1[0], v1[1]); w.w = pk2(v1[2], v1[3]); *(u32x4*)(sig + off + bj * HALF) = w; } } }
    }
};
struct EpiResid {
    static constexpr bool PERM = false, AFTER_DRAIN = false;
    const float* xin; float* xout; bf16_t* xb; float* rowsq;
    __device__ __forceinline__ void operator()(const f32x4 (&acc)[2][2][4][2], const Unit& u, int wr, int wc, int fr, int fq) const {
        const int row0 = u.pm * BM + wr * 64 + fr, col0 = u.pn * BM + wc * 32 + 4 * fq;
#pragma unroll
        for (int ai = 0; ai < 2; ++ai)
#pragma unroll
            for (int m = 0; m < 4; ++m) { const int row = row0 + ai * HALF + m * 16; const size_t off = (size_t)row * 1024 + col0; float ss = 0.f;
#pragma unroll
                for (int bj = 0; bj < 2; ++bj)
#pragma unroll
                    for (int n = 0; n < 2; ++n) { const size_t o = off + bj * HALF + n * 16; const f32x4 v = *(const f32x4*)(xin + o) + acc[ai][bj][m][n];
                        *(f32x4*)(xout + o) = v; u32x2 w; w.x = pk2(v[0], v[1]); w.y = pk2(v[2], v[3]); *(u32x2*)(xb + o) = w;
                        ss += (v[0] * v[0] + v[1] * v[1]) + (v[2] * v[2] + v[3] * v[3]); }
                ss += __shfl_xor(ss, 16); ss += __shfl_xor(ss, 32);
                if (fq == 0) rowsq[(size_t)row * 16 + u.pn * 4 + wc] = ss; }
    }
};
struct EpiGU {
    static constexpr bool PERM = true, AFTER_DRAIN = false;
    bf16_t* hid; const PG8_LAS float* lrs;
    __device__ __forceinline__ void operator()(const f32x4 (&acc)[2][2][4][2], const Unit& u, int wr, int wc, int fr, int fq) const {
        const int row0 = u.pm * BM + wr * 64 + fr, col0 = u.pn * HALF + wc * 32 + 8 * fq;
#pragma unroll
        for (int ai = 0; ai < 2; ++ai)
#pragma unroll
            for (int m = 0; m < 4; ++m) { const int row = row0 + ai * HALF + m * 16; const float rs = lrs[u.idx * 256 + (row - u.pm * BM)];
                float o[8];
#pragma unroll
                for (int n = 0; n < 2; ++n)
#pragma unroll
                    for (int j = 0; j < 4; ++j) { const float g = acc[ai][0][m][n][j] * rs, up = acc[ai][1][m][n][j] * rs; o[n * 4 + j] = g * fast_sigmoid(g) * up; }
                u32x4 w; w.x = pk2(o[0], o[1]); w.y = pk2(o[2], o[3]); w.z = pk2(o[4], o[5]); w.w = pk2(o[6], o[7]);
                *(u32x4*)(hid + (size_t)row * 2816 + col0) = w; }
    }
};

template <class Epi, class Sched, bool ALIGN_EPI = false, bool SP2 = false>
__device__ __forceinline__ void gemm_phase(PG8_LAS unsigned char* lds, const Gemm g, const Sched& S, const Epi& E) {
    int tid_ = threadIdx.x; asm volatile("" : "+v"(tid_));
    const int tid = tid_, wid = __builtin_amdgcn_readfirstlane(tid >> 6), lane = tid & 63, wr = wid >> 2, wc = wid & 3, fr = lane & 15, fq = lane >> 4;
    const int K = g.K, nt = K / BK;
    unsigned voffA[2], voffB[2];
#pragma unroll
    for (int i = 0; i < 2; ++i) { int R, C; stage_rc(tid * 16 + i * 8192, R, C); const int Rb = Epi::PERM ? ((R & ~31) + perm32(R & 31)) : R;
        voffA[i] = (unsigned)(R * K + C) * 2u; voffB[i] = (unsigned)(Rb * K + C) * 2u; }
    const size_t kstep = (size_t)(BK * 2);
    const size_t hstep = (size_t)HALF * K * 2;
    const size_t tstep = 2 * hstep;
    const unsigned ldsw = (unsigned)wid * 1024u;
    const int aoff = lds_byte(wr * 64 + fr, fq * 8), boff = lds_byte(wc * 32 + fr, fq * 8);
#define PG8_SA(b, h) (((b) * 2 + (h)) * HTB)
#define PG8_SB(b, h) ((4 + (b) * 2 + (h)) * HTB)
#define PG8_STAGE(bufoff, gbase, voff) do { _Pragma("unroll") for (int _i = 0; _i < 2; ++_i) \
        __builtin_amdgcn_global_load_lds((const unsigned*)((const char*)(gbase) + (voff)[_i]), (PG8_LAS unsigned*)(lds + (bufoff) + ldsw + _i * 8192), 16, 0, 0); } while (0)
#define PG8_LDA(dst, b, h) do { _Pragma("unroll") for (int m = 0; m < 4; ++m) _Pragma("unroll") for (int k = 0; k < 2; ++k) dst[m][k] = *(const PG8_LAS bf16x8*)(lds + PG8_SA(b, h) + aoff + m * 2048 + k * 1024); } while (0)
#define PG8_LDB(dst, b, h) do { _Pragma("unroll") for (int n = 0; n < 2; ++n) _Pragma("unroll") for (int k = 0; k < 2; ++k) dst[n][k] = *(const PG8_LAS bf16x8*)(lds + PG8_SB(b, h) + boff + n * 2048 + k * 1024); } while (0)
#define PG8_MMA(ai, bj, At, Bt) do { __builtin_amdgcn_s_setprio(1); _Pragma("unroll") for (int m = 0; m < 4; ++m) _Pragma("unroll") for (int n = 0; n < 2; ++n) _Pragma("unroll") for (int k = 0; k < 2; ++k) \
        acc[ai][bj][m][n] = __builtin_amdgcn_mfma_f32_16x16x32_bf16(Bt[n][k], At[m][k], acc[ai][bj][m][n], 0, 0, 0); __builtin_amdgcn_s_setprio(0); } while (0)
#define PG8_WAIT_V(n) asm volatile("s_waitcnt vmcnt(" #n ")" ::: "memory")
#define PG8_WAIT_L(n) asm volatile("s_waitcnt lgkmcnt(" #n ")" ::: "memory")
#define PG8_BAR __builtin_amdgcn_s_barrier()
#define PG8_SCHED __builtin_amdgcn_sched_barrier(0)
    Unit cur, nxt; int ui = 0;
    if (!S.next(0, cur)) return;
    f32x4 acc[2][2][4][2];
#pragma unroll
    for (int a = 0; a < 2; ++a)
#pragma unroll
        for (int b = 0; b < 2; ++b)
#pragma unroll
            for (int m = 0; m < 4; ++m)
#pragma unroll
                for (int n = 0; n < 2; ++n) acc[a][b][m][n] = (f32x4){0.f, 0.f, 0.f, 0.f};
    bf16x8 At[4][2], B0[2][2], B1[2][2];
    const char* cA = (const char*)g.A + (size_t)cur.pm * tstep; const char* cB = (const char*)g.Bt + (size_t)cur.pn * tstep;
    S.a_ready(cur);
    if constexpr (SP2) {
        PG8_STAGE(PG8_SB(0, 0), cB, voffB); PG8_STAGE(PG8_SB(0, 1), cB + hstep, voffB); PG8_STAGE(PG8_SA(0, 0), cA, voffA); PG8_STAGE(PG8_SA(0, 1), cA + hstep, voffA);
        if (wr == 1) PG8_BAR;
        PG8_WAIT_V(2); PG8_BAR;
        PG8_STAGE(PG8_SB(1, 0), cB + kstep, voffB); PG8_STAGE(PG8_SA(1, 0), cA + kstep, voffA); PG8_STAGE(PG8_SB(1, 1), cB + hstep + kstep, voffB);
        PG8_WAIT_V(6); PG8_BAR;
    } else {
        PG8_STAGE(PG8_SB(0, 0), cB, voffB); PG8_STAGE(PG8_SA(0, 0), cA, voffA); PG8_STAGE(PG8_SB(0, 1), cB + hstep, voffB); PG8_STAGE(PG8_SA(0, 1), cA + hstep, voffA);
        if (wr == 1) PG8_BAR;
        PG8_WAIT_V(4); PG8_BAR;
        PG8_STAGE(PG8_SB(1, 0), cB + kstep, voffB); PG8_STAGE(PG8_SA(1, 0), cA + kstep, voffA); PG8_STAGE(PG8_SB(1, 1), cB + hstep + kstep, voffB);
        PG8_WAIT_V(6); PG8_BAR;
    }
    for (;;) {
        const bool has_next = S.next(ui + 1, nxt);
        const char* nA = has_next ? (const char*)g.A + (size_t)nxt.pm * tstep : cA; const char* nB = has_next ? (const char*)g.Bt + (size_t)nxt.pn * tstep : cB;
        for (int t = 0; t < nt; t += 2) {
            const bool last = (t == nt - 2);
            const char* a1 = cA + (size_t)(t + 1) * kstep;
            const char* a2 = last ? nA : cA + (size_t)(t + 2) * kstep; const char* b2 = last ? nB : cB + (size_t)(t + 2) * kstep;
            const char* a3 = a2 + kstep; const char* b3 = b2 + kstep;
            if (last && has_next) S.a_ready(nxt);
            if constexpr (SP2) {
            PG8_LDB(B0, 0, 0); PG8_LDB(B1, 0, 1); PG8_SCHED; PG8_LDA(At, 0, 0); PG8_STAGE(PG8_SA(1, 1), a1 + hstep, voffA);
            PG8_WAIT_V(8); PG8_WAIT_L(0); PG8_BAR; PG8_MMA(0, 0, At, B0); PG8_MMA(0, 1, At, B1); PG8_BAR; PG8_SCHED;
            PG8_LDA(At, 0, 1); PG8_STAGE(PG8_SB(0, 0), b2, voffB); PG8_STAGE(PG8_SB(0, 1), b2 + hstep, voffB); PG8_STAGE(PG8_SA(0, 0), a2, voffA);
            PG8_WAIT_V(8); PG8_WAIT_L(0); PG8_BAR; PG8_MMA(1, 0, At, B0); PG8_MMA(1, 1, At, B1); PG8_BAR; PG8_SCHED;
            PG8_LDB(B0, 1, 0); PG8_LDB(B1, 1, 1); PG8_SCHED; PG8_LDA(At, 1, 0); PG8_STAGE(PG8_SA(0, 1), a2 + hstep, voffA);
            PG8_WAIT_V(8); PG8_WAIT_L(0); PG8_BAR; PG8_MMA(0, 0, At, B0); PG8_MMA(0, 1, At, B1); PG8_BAR; PG8_SCHED;
            PG8_LDA(At, 1, 1); PG8_STAGE(PG8_SB(1, 0), b3, voffB); PG8_STAGE(PG8_SB(1, 1), b3 + hstep, voffB); PG8_STAGE(PG8_SA(1, 0), a3, voffA);
            PG8_WAIT_V(8); PG8_WAIT_L(0); PG8_BAR; PG8_MMA(1, 0, At, B0); PG8_MMA(1, 1, At, B1); PG8_BAR; PG8_SCHED;
            } else {
            PG8_LDB(B0, 0, 0); PG8_SCHED; PG8_LDA(At, 0, 0); PG8_STAGE(PG8_SA(1, 1), a1 + hstep, voffA);
            PG8_WAIT_L(8); PG8_BAR; PG8_WAIT_L(0); PG8_MMA(0, 0, At, B0); PG8_BAR; PG8_SCHED;
            PG8_LDB(B1, 0, 1); PG8_STAGE(PG8_SB(0, 0), b2, voffB);
            PG8_BAR; PG8_WAIT_L(0); PG8_MMA(0, 1, At, B1); PG8_BAR;
            PG8_LDA(At, 0, 1); PG8_STAGE(PG8_SA(0, 0), a2, voffA);
            PG8_BAR; PG8_WAIT_L(0); PG8_MMA(1, 0, At, B0); PG8_BAR; PG8_SCHED;
            PG8_STAGE(PG8_SB(0, 1), b2 + hstep, voffB);
            PG8_WAIT_V(6); PG8_BAR; PG8_MMA(1, 1, At, B1); PG8_BAR;
            PG8_LDB(B0, 1, 0); PG8_SCHED; PG8_LDA(At, 1, 0); PG8_STAGE(PG8_SA(0, 1), a2 + hstep, voffA);
            PG8_WAIT_L(8); PG8_BAR; PG8_WAIT_L(0); PG8_MMA(0, 0, At, B0); PG8_BAR; PG8_SCHED;
            PG8_LDB(B1, 1, 1); PG8_STAGE(PG8_SB(1, 0), b3, voffB);
            PG8_BAR; PG8_WAIT_L(0); PG8_MMA(0, 1, At, B1); PG8_BAR;
            PG8_LDA(At, 1, 1); PG8_STAGE(PG8_SA(1, 0), a3, voffA);
            PG8_BAR; PG8_WAIT_L(0); PG8_MMA(1, 0, At, B0); PG8_BAR; PG8_SCHED;
            PG8_STAGE(PG8_SB(1, 1), b3 + hstep, voffB);
            PG8_WAIT_V(6); PG8_BAR; PG8_MMA(1, 1, At, B1); PG8_BAR;
            }
        }
        if constexpr (ALIGN_EPI) { if (wr == 0) PG8_BAR; }
        if constexpr (!Epi::AFTER_DRAIN) { E(acc, cur, wr, wc, fr, fq); S.done(cur); }
        if (!has_next) break;
#pragma unroll
        for (int a = 0; a < 2; ++a)
#pragma unroll
            for (int b = 0; b < 2; ++b)
#pragma unroll
                for (int m = 0; m < 4; ++m)
#pragma unroll
                    for (int n = 0; n < 2; ++n) acc[a][b][m][n] = (f32x4){0.f, 0.f, 0.f, 0.f};
        cur = nxt; cA = nA; cB = nB; ++ui;
        if constexpr (ALIGN_EPI) { if (wr == 1) PG8_BAR; }
    }
    PG8_WAIT_V(0);
    if constexpr (!ALIGN_EPI) { if (wr == 0) PG8_BAR; }
    PG8_BAR;
    if constexpr (Epi::AFTER_DRAIN) { E.fused(acc, cur, wr, wc, fr, fq, lds, wid, lane); S.done(cur); }
#undef PG8_SA
#undef PG8_SB
#undef PG8_STAGE
#undef PG8_LDA
#undef PG8_LDB
#undef PG8_MMA
#undef PG8_WAIT_V
#undef PG8_WAIT_L
#undef PG8_BAR
#undef PG8_SCHED
}
}

#ifndef USE_CG_SYNC
#define USE_CG_SYNC 0
#endif
constexpr int NWAVES = 8, NTHR = 512;
constexpr int TT = 16384, SEQ = 8192, DM = 1024, DEPTH = 2, INC = 6920, DFF = 2816;
constexpr int C_QKVC = 1792, C_BETA = 3840, C_GATE = 3848;
constexpr int NMIX = 3840;
constexpr size_t MiB = 1u << 20, KiB = 1u << 10;
constexpr size_t WS_CTL = 0, CTL_ZERO_BYTES = 64 * KiB;
constexpr size_t WS_ROWSQ = 1 * MiB;
constexpr size_t WS_BA = 2 * MiB;
constexpr size_t WS_CD = 2 * MiB + 512 * KiB;
constexpr size_t WS_WBA = WS_CD + 64 * KiB;
constexpr size_t WS_SGUW = 2 * MiB + 768 * KiB;
constexpr size_t WS_WIN = 3 * MiB;
constexpr size_t WS_WG = WS_WIN + 3840 * 1024 * 2;
constexpr size_t WS_WBR = WS_WG + 3072 * 1024 * 2;
constexpr size_t WS_WOUT = WS_WBR + 3 * 1024 * 512 * 2;
constexpr size_t WS_XB = 22 * MiB;
constexpr size_t WS_UV = 54 * MiB;
constexpr size_t WS_QKVB = 86 * MiB;
constexpr size_t WS_WGU = WS_QKVB;
constexpr size_t WS_WDN = WS_QKVB + 5632 * 1024 * 2;
constexpr size_t WS_QKVC = 110 * MiB;
constexpr size_t WS_BR = WS_QKVC;
constexpr size_t WS_Z = 158 * MiB;
constexpr size_t WS_DN = 174 * MiB;
constexpr size_t WS_HID = 110 * MiB;
constexpr size_t WS_END = 246 * MiB;
static_assert(WS_WOUT + 1024 * 1024 * 2 <= WS_XB && WS_WDN + 1024 * 2816 * 2 <= WS_QKVC && WS_HID + (size_t)TT * DFF * 2 <= WS_END && WS_DN + 1024 * 72 * KiB <= WS_END, "ws map");
constexpr int DN_TASK_BYTES = 73728, DN_OFF_W = 0, DN_OFF_QD = 16384, DN_OFF_AT = 32768, DN_OFF_KD = 40960, DN_OFF_U = 57344;
constexpr int LDS_BYTES = 163840, MISC_OFF = LDS_BYTES - 256;

#define LAS __attribute__((address_space(3)))
typedef unsigned short bf16;
typedef float f32x4 __attribute__((ext_vector_type(4)));
typedef float f32x16 __attribute__((ext_vector_type(16)));
typedef short bf16x8 __attribute__((ext_vector_type(8)));
typedef unsigned u32x4 __attribute__((ext_vector_type(4)));
typedef unsigned u32x2 __attribute__((ext_vector_type(2)));
using pg8::pk2; using pg8::bflo; using pg8::bfhi; using pg8::fast_sigmoid; using pg8::NORM_EPS;
#define MFMA32(a, b, c) __builtin_amdgcn_mfma_f32_32x32x16_bf16((a), (b), (c), 0, 0, 0)
__device__ __forceinline__ int crow(int reg, int h) { return (reg & 3) + 8 * (reg >> 2) + 4 * h; }
__device__ __forceinline__ bf16x8 pack_step(const f32x16& x, int s) {
    u32x4 p; p.x = pk2(x[8 * s], x[8 * s + 1]); p.y = pk2(x[8 * s + 2], x[8 * s + 3]); p.z = pk2(x[8 * s + 4], x[8 * s + 5]); p.w = pk2(x[8 * s + 6], x[8 * s + 7]);
    return __builtin_bit_cast(bf16x8, p);
}
__device__ __forceinline__ float wave_sum(float v) {
#pragma unroll
    for (int o = 1; o < 64; o <<= 1) v += __shfl_xor(v, o);
    return v;
}
__device__ __forceinline__ f32x16 zero16() { f32x16 z; for (int i = 0; i < 16; ++i) z[i] = 0.f; return z; }

struct Params {
    const float* x; const int* pos; const float* attn_norm; const float* w_in; const float* sgu_ln_g; const float* sgu_ln_b; const float* sgu_w; const float* sgu_b;
    const float* sinks; const float* conv_w; const float* a_log; const float* dt_bias; const float* dn_norm; const float* w_branch; const float* w_out; const float* ffn_norm;
    const float* w_gate_up; const float* w_down; const float* final_norm;
    float* out; unsigned char* ws; int ph_lo, ph_hi;
};
struct Frame { LAS unsigned char* lds; int tid, lane, wave, vb, G; };

template <int MAP> __device__ __forceinline__ void transpose_item(const float* W, int ldw, int ncol0, int K, int N, const float* kscale, bf16* WT, LAS float* scr, int item, int lane) {
    const int nblk = N / 32, kb = item / nblk, nb = item % nblk, k0 = 64 * kb, n0 = 32 * nb;
#pragma unroll 8
    for (int i = 0; i < 32; ++i) { const int kk = 2 * i + (lane >> 5); float v = W[(size_t)(k0 + kk) * ldw + ncol0 + n0 + (lane & 31)]; if (kscale) v *= kscale[k0 + kk]; scr[kk * 33 + (lane & 31)] = v; }
    asm volatile("s_waitcnt lgkmcnt(0)" ::: "memory");
    const int c = lane & 7;
#pragma unroll
    for (int j = 0; j < 4; ++j) { const int n = (lane >> 3) + 8 * j; const LAS float* s = scr + (8 * c) * 33 + n;
        u32x4 o; o.x = pk2(s[0 * 33], s[1 * 33]); o.y = pk2(s[2 * 33], s[3 * 33]); o.z = pk2(s[4 * 33], s[5 * 33]); o.w = pk2(s[6 * 33], s[7 * 33]);
        const int nn = n0 + n; int dr = nn;
        if (MAP == 1) { const int f = nn < DFF ? nn : nn - DFF; dr = (f >> 7) * 256 + (nn < DFF ? 0 : 128) + (f & 127); }
        *(u32x4*)(WT + (size_t)dr * K + k0 + 8 * c) = o; }
    asm volatile("s_waitcnt lgkmcnt(0)" ::: "memory");
}
__device__ __forceinline__ void p0_attn_weights(const Frame& F, const Params& P, int l) {
    LAS float* scr = (LAS float*)(F.lds + F.wave * 8448);
    const int gw = F.vb * NWAVES + F.wave, NGW = F.G * NWAVES;
    const float* win = P.w_in + (size_t)l * DM * INC; const float* an = P.attn_norm + l * DM;
    constexpr int I_MIX = 16 * (NMIX / 32), I_G = 16 * (3072 / 32), I_BR = 8 * 32, I_O = 16 * 32, NIT = I_MIX + I_G + 3 * I_BR + I_O;
    for (int it = gw; it < NIT; it += NGW) {
        int r = it;
        if (r < I_MIX) { transpose_item<0>(win, INC, 0, DM, NMIX, an, (bf16*)(P.ws + WS_WIN), scr, r, F.lane); continue; } r -= I_MIX;
        if (r < I_G) { transpose_item<0>(win, INC, C_GATE, DM, 3072, an, (bf16*)(P.ws + WS_WG), scr, r, F.lane); continue; } r -= I_G;
        if (r < 3 * I_BR) { const int n = r / I_BR; transpose_item<0>(P.w_branch + ((size_t)l * 3 + n) * 512 * 1024, 1024, 0, 512, 1024, nullptr, (bf16*)(P.ws + WS_WBR) + (size_t)n * 1024 * 512, scr, r % I_BR, F.lane); continue; } r -= 3 * I_BR;
        transpose_item<0>(P.w_out + (size_t)l * DM * DM, DM, 0, DM, DM, nullptr, (bf16*)(P.ws + WS_WOUT), scr, r, F.lane);
    }
    const int gt = F.vb * NTHR + F.tid, NGT = F.G * NTHR;
    float* wba = (float*)(P.ws + WS_WBA);
    for (int i = gt; i < 8 * DM; i += NGT) { const int c = i >> 10, k = i & 1023; wba[i] = win[(size_t)k * INC + C_BETA + c] * an[k]; }
    bf16* sw = (bf16*)(P.ws + WS_SGUW); const float* sgw = P.sgu_w + (size_t)l * 4 * 128 * 128;
    for (int i = gt; i < 4 * 128 * 128 / 2; i += NGT) { const int e = 2 * i, s = e & 127, t = (e >> 7) & 127; const float a = s <= t ? sgw[e] : 0.f, b = (s + 1) <= t ? sgw[e + 1] : 0.f; ((unsigned*)sw)[i] = pk2(a, b); }
}
__device__ __forceinline__ void p0_ffn_weights(const Frame& F, const Params& P, int l) {
    LAS float* scr = (LAS float*)(F.lds + F.wave * 8448);
    const int gw = F.vb * NWAVES + F.wave, NGW = F.G * NWAVES;
    constexpr int I_GU = 16 * (2 * DFF / 32), I_DN = (DFF / 64) * 32, NIT = I_GU + I_DN;
    for (int it = gw; it < NIT; it += NGW) {
        if (it < I_GU) transpose_item<1>(P.w_gate_up + (size_t)l * DM * 2 * DFF, 2 * DFF, 0, DM, 2 * DFF, P.ffn_norm + l * DM, (bf16*)(P.ws + WS_WGU), scr, it, F.lane);
        else transpose_item<0>(P.w_down + (size_t)l * DFF * DM, DM, 0, DFF, DM, nullptr, (bf16*)(P.ws + WS_WDN), scr, it - I_GU, F.lane);
    }
}
__device__ __forceinline__ void p0_input(const Frame& F, const Params& P) {
    const int gw = F.vb * NWAVES + F.wave, NGW = F.G * NWAVES;
    bf16* xb = (bf16*)(P.ws + WS_XB); float* rowsq = (float*)(P.ws + WS_ROWSQ);
    for (int m = gw; m < TT; m += NGW) {
        const f32x4* xr = (const f32x4*)(P.x + (size_t)m * DM) + F.lane; float s = 0.f;
        unsigned long long* o8 = (unsigned long long*)(xb + (size_t)m * DM) + F.lane;
#pragma unroll
        for (int j = 0; j < 4; ++j) { const f32x4 v = xr[64 * j]; s += (v.x * v.x + v.y * v.y) + (v.z * v.z + v.w * v.w); o8[64 * j] = (unsigned long long)pk2(v.x, v.y) | ((unsigned long long)pk2(v.z, v.w) << 32); }
        s = wave_sum(s);
        if (F.lane < 16) rowsq[(size_t)m * 16 + F.lane] = F.lane == 0 ? s : 0.f;
    }
}
__device__ __forceinline__ void p1_ba(const Frame& F, const Params& P) {
    const int gw = F.vb * NWAVES + F.wave, NGW = F.G * NWAVES;
    const float* wba = (const float*)(P.ws + WS_WBA); const bf16* xb = (const bf16*)(P.ws + WS_XB); const float* rowsq = (const float*)(P.ws + WS_ROWSQ); float* ba = (float*)(P.ws + WS_BA);
    f32x4 wb[8][4];
#pragma unroll
    for (int c = 0; c < 8; ++c)
#pragma unroll
        for (int j = 0; j < 2; ++j) { const f32x4* p = (const f32x4*)(wba + c * DM + F.lane * 8 + 512 * j); wb[c][2 * j] = p[0]; wb[c][2 * j + 1] = p[1]; }
    for (int m = gw; m < TT; m += NGW) {
        float xv[16];
#pragma unroll
        for (int j = 0; j < 2; ++j) { const u32x4 w = *(const u32x4*)(xb + (size_t)m * DM + F.lane * 8 + 512 * j);
            xv[8 * j + 0] = bflo(w.x); xv[8 * j + 1] = bfhi(w.x); xv[8 * j + 2] = bflo(w.y); xv[8 * j + 3] = bfhi(w.y); xv[8 * j + 4] = bflo(w.z); xv[8 * j + 5] = bfhi(w.z); xv[8 * j + 6] = bflo(w.w); xv[8 * j + 7] = bfhi(w.w); }
        float sq = F.lane < 16 ? rowsq[(size_t)m * 16 + F.lane] : 0.f; sq = wave_sum(sq);
        const float rs = __builtin_amdgcn_rsqf(sq * (1.0f / 1024.0f) + NORM_EPS);
        float mine = 0.f;
#pragma unroll
        for (int c = 0; c < 8; ++c) { float d = 0.f;
#pragma unroll
            for (int q = 0; q < 4; ++q) d += (xv[4 * q] * wb[c][q].x + xv[4 * q + 1] * wb[c][q].y) + (xv[4 * q + 2] * wb[c][q].z + xv[4 * q + 3] * wb[c][q].w);
            d = wave_sum(d); if (F.lane == c) mine = d; }
        if (F.lane < 8) ba[(size_t)m * 8 + F.lane] = mine * rs;
    }
}

__device__ __forceinline__ void sgu_task(const Frame& F, const Params& P, int l, int task) {
    const int g = task & 3, cb = task >> 2, m0 = cb * 128;
    const bf16* uv = (const bf16*)(P.ws + WS_UV); bf16* bra = (bf16*)(P.ws + WS_BR);
    LAS bf16* vnT = (LAS bf16*)F.lds;
    const int r = F.tid >> 2, qq = F.tid & 3;
    { const bf16* vrow = uv + (size_t)(m0 + r) * 1024 + 512 + qq * 128; float s = 0.f, s2 = 0.f;
#pragma unroll
      for (int j = 0; j < 16; ++j) { const u32x4 w = *(const u32x4*)(vrow + 8 * j); const float a0 = bflo(w.x), a1 = bfhi(w.x), a2 = bflo(w.y), a3 = bfhi(w.y), a4 = bflo(w.z), a5 = bfhi(w.z), a6 = bflo(w.w), a7 = bfhi(w.w);
          s += ((a0 + a1) + (a2 + a3)) + ((a4 + a5) + (a6 + a7)); s2 += ((a0 * a0 + a1 * a1) + (a2 * a2 + a3 * a3)) + ((a4 * a4 + a5 * a5) + (a6 * a6 + a7 * a7)); }
      s += __shfl_xor(s, 1); s += __shfl_xor(s, 2); s2 += __shfl_xor(s2, 1); s2 += __shfl_xor(s2, 2);
      const float mean = s * (1.f / 512.f); float var = s2 * (1.f / 512.f) - mean * mean; var = var > 0.f ? var : 0.f; const float rstd = __builtin_amdgcn_rsqf(var + NORM_EPS);
      const bf16* vg = uv + (size_t)(m0 + r) * 1024 + 512 + g * 128 + qq * 32; const float* lg = P.sgu_ln_g + l * 512 + g * 128 + qq * 32; const float* lb = P.sgu_ln_b + l * 512 + g * 128 + qq * 32;
#pragma unroll
      for (int j = 0; j < 4; ++j) { const u32x4 w = *(const u32x4*)(vg + 8 * j); const float a[8] = {bflo(w.x), bfhi(w.x), bflo(w.y), bfhi(w.y), bflo(w.z), bfhi(w.z), bflo(w.w), bfhi(w.w)};
#pragma unroll
          for (int i = 0; i < 8; ++i) { const int c = qq * 32 + 8 * j + i; const float y = (a[i] - mean) * rstd * lg[8 * j + i] + lb[8 * j + i]; vnT[c * 136 + r] = (bf16)(pk2(y, 0.f) & 0xffffu); } }
    }
    __syncthreads();
    const int lr = F.lane & 31, h = F.lane >> 5, ct = F.wave >> 1;
    const bf16* sw = (const bf16*)(P.ws + WS_SGUW) + (size_t)g * 128 * 128;
#pragma unroll
    for (int t2 = 0; t2 < 2; ++t2) { const int tt = 2 * (F.wave & 1) + t2; f32x16 acc = zero16();
        for (int ks = 0; ks < 2 * (tt + 1); ++ks) {
            const bf16x8 a = *(const LAS bf16x8*)(vnT + (32 * ct + lr) * 136 + 16 * ks + 8 * h);
            const bf16x8 b = *(const bf16x8*)(sw + (size_t)(32 * tt + lr) * 128 + 16 * ks + 8 * h);
            acc = MFMA32(a, b, acc); }
        const int t = 32 * tt + lr; const float bias = P.sgu_b[l * 512 + g * 128 + t];
#pragma unroll
        for (int gq = 0; gq < 4; ++gq) { const int c0 = 32 * ct + 8 * gq + 4 * h; const u32x2 uu = *(const u32x2*)(uv + (size_t)(m0 + t) * 1024 + g * 128 + c0);
            u32x2 o; o.x = pk2(bflo(uu.x) * (acc[4 * gq] + bias), bfhi(uu.x) * (acc[4 * gq + 1] + bias)); o.y = pk2(bflo(uu.y) * (acc[4 * gq + 2] + bias), bfhi(uu.y) * (acc[4 * gq + 3] + bias));
            *(u32x2*)(bra + (size_t)(m0 + t) * 512 + g * 128 + c0) = o; } }
    __syncthreads();
}

__device__ __forceinline__ void swa_task(const Frame& F, const Params& P, int l, int task) {
    const int kvh = task & 1, cb = task >> 1, nq = cb & 63, m0 = cb * 128;
    const bf16* qkvb = (const bf16*)(P.ws + WS_QKVB); bf16* brb = (bf16*)(P.ws + WS_BR) + (size_t)TT * 512;
    LAS bf16* Qs = (LAS bf16*)F.lds;
    LAS bf16* Ks = (LAS bf16*)(F.lds + 73728);
    LAS bf16* VT = (LAS bf16*)(F.lds + 110592);
    for (int i = F.tid; i < 4096; i += NTHR) { const int g = i >> 10, r = (i >> 3) & 127, c8 = i & 7; if (c8 < 2) continue;
        const u32x4 w = *(const u32x4*)(qkvb + (size_t)(m0 + r) * 768 + (kvh * 4 + g) * 64 + c8 * 8);
        u32x4 o; o.x = pk2(bflo(w.x) * 0.125f, bfhi(w.x) * 0.125f); o.y = pk2(bflo(w.y) * 0.125f, bfhi(w.y) * 0.125f); o.z = pk2(bflo(w.z) * 0.125f, bfhi(w.z) * 0.125f); o.w = pk2(bflo(w.w) * 0.125f, bfhi(w.w) * 0.125f);
        *(LAS u32x4*)(Qs + (g * 128 + r) * 72 + c8 * 8) = o; }
    const float invf[8] = {1.0f, 0.19392274474868576f, 0.03760603093086393f, 0.007292664737217109f, 0.001414213562373095f, 0.0002742481756762073f, 5.318295896944988e-05f, 1.031338537721246e-05f};
    { const int g = F.tid >> 7, r = F.tid & 127; const float pos = (float)P.pos[m0 + r];
      const bf16* src = qkvb + (size_t)(m0 + r) * 768 + (kvh * 4 + g) * 64; const u32x4 w1 = *(const u32x4*)src, w2 = *(const u32x4*)(src + 8);
      const float x1[8] = {bflo(w1.x), bfhi(w1.x), bflo(w1.y), bfhi(w1.y), bflo(w1.z), bfhi(w1.z), bflo(w1.w), bfhi(w1.w)}, x2[8] = {bflo(w2.x), bfhi(w2.x), bflo(w2.y), bfhi(w2.y), bflo(w2.z), bfhi(w2.z), bflo(w2.w), bfhi(w2.w)};
      float o1[8], o2[8];
#pragma unroll
      for (int i = 0; i < 8; ++i) { float sn, cs; sincosf(pos * invf[i], &sn, &cs); o1[i] = (x1[i] * cs - x2[i] * sn) * 0.125f; o2[i] = (x2[i] * cs + x1[i] * sn) * 0.125f; }
      u32x4 a, b; a.x = pk2(o1[0], o1[1]); a.y = pk2(o1[2], o1[3]); a.z = pk2(o1[4], o1[5]); a.w = pk2(o1[6], o1[7]); b.x = pk2(o2[0], o2[1]); b.y = pk2(o2[2], o2[3]); b.z = pk2(o2[4], o2[5]); b.w = pk2(o2[6], o2[7]);
      *(LAS u32x4*)(Qs + (g * 128 + r) * 72) = a; *(LAS u32x4*)(Qs + (g * 128 + r) * 72 + 8) = b; }
    for (int i = F.tid; i < 2048; i += NTHR) { const int s = i >> 3, c8 = i & 7; const bool ok = nq > 0 || s >= 128; const size_t row = (size_t)(m0 - 128 + s);
        u32x4 kw = {0u, 0u, 0u, 0u}, vw = {0u, 0u, 0u, 0u};
        if (ok) { if (c8 >= 2) kw = *(const u32x4*)(qkvb + row * 768 + 512 + kvh * 64 + c8 * 8); vw = *(const u32x4*)(qkvb + row * 768 + 640 + kvh * 64 + c8 * 8); }
        if (c8 >= 2) *(LAS u32x4*)(Ks + s * 72 + c8 * 8) = kw;
        const int p = (s & ~12) | ((s & 4) << 1) | ((s & 8) >> 1); const unsigned vv[4] = {vw.x, vw.y, vw.z, vw.w};
#pragma unroll
        for (int j = 0; j < 4; ++j) { VT[(c8 * 8 + 2 * j) * 264 + p] = (bf16)(vv[j] & 0xffffu); VT[(c8 * 8 + 2 * j + 1) * 264 + p] = (bf16)(vv[j] >> 16); } }
    if (F.tid < 256) { const int s = F.tid; const bool ok = nq > 0 || s >= 128; u32x4 a = {0u, 0u, 0u, 0u}, b = {0u, 0u, 0u, 0u};
        if (ok) { const size_t row = (size_t)(m0 - 128 + s); const float pos = (float)P.pos[row]; const bf16* src = qkvb + row * 768 + 512 + kvh * 64; const u32x4 w1 = *(const u32x4*)src, w2 = *(const u32x4*)(src + 8);
            const float x1[8] = {bflo(w1.x), bfhi(w1.x), bflo(w1.y), bfhi(w1.y), bflo(w1.z), bfhi(w1.z), bflo(w1.w), bfhi(w1.w)}, x2[8] = {bflo(w2.x), bfhi(w2.x), bflo(w2.y), bfhi(w2.y), bflo(w2.z), bfhi(w2.z), bflo(w2.w), bfhi(w2.w)};
            float o1[8], o2[8];
#pragma unroll
            for (int i = 0; i < 8; ++i) { float sn, cs; sincosf(pos * invf[i], &sn, &cs); o1[i] = x1[i] * cs - x2[i] * sn; o2[i] = x2[i] * cs + x1[i] * sn; }
            a.x = pk2(o1[0], o1[1]); a.y = pk2(o1[2], o1[3]); a.z = pk2(o1[4], o1[5]); a.w = pk2(o1[6], o1[7]); b.x = pk2(o2[0], o2[1]); b.y = pk2(o2[2], o2[3]); b.z = pk2(o2[4], o2[5]); b.w = pk2(o2[6], o2[7]); }
        *(LAS u32x4*)(Ks + s * 72) = a; *(LAS u32x4*)(Ks + s * 72 + 8) = b; }
    __syncthreads();
    const int lr = F.lane & 31, h = F.lane >> 5, g = F.wave >> 1, qh = F.wave & 1;
    const float sink = P.sinks[l * 8 + kvh * 4 + g];
#pragma unroll 1
    for (int q2 = 0; q2 < 2; ++q2) { const int qt = 2 * qh + q2, q0 = 32 * qt, qi = q0 + lr;
        bf16x8 bq[4];
#pragma unroll
        for (int ks = 0; ks < 4; ++ks) bq[ks] = *(const LAS bf16x8*)(Qs + (g * 128 + q0 + lr) * 72 + 16 * ks + 8 * h);
        f32x16 sc[5];
#pragma unroll
        for (int k5 = 0; k5 < 5; ++k5) { sc[k5] = zero16();
#pragma unroll
            for (int ks = 0; ks < 4; ++ks) { const bf16x8 a = *(const LAS bf16x8*)(Ks + (32 * (qt + k5) + lr) * 72 + 16 * ks + 8 * h); sc[k5] = MFMA32(a, bq[ks], sc[k5]); } }
        float mx = sink;
#pragma unroll
        for (int k5 = 0; k5 < 5; ++k5)
#pragma unroll
            for (int rg = 0; rg < 16; ++rg) { const int sj = 32 * (qt + k5) + crow(rg, h); const bool ok = sj >= qi + 1 && sj <= qi + 128 && (nq > 0 || sj >= 128);
                const float v = ok ? sc[k5][rg] : -INFINITY; sc[k5][rg] = v; mx = fmaxf(mx, v); }
        mx = fmaxf(mx, __shfl_xor(mx, 32));
        float sum = 0.f;
#pragma unroll
        for (int k5 = 0; k5 < 5; ++k5)
#pragma unroll
            for (int rg = 0; rg < 16; ++rg) { const float p = __expf(sc[k5][rg] - mx); sc[k5][rg] = p; sum += p; }
        sum += __shfl_xor(sum, 32); sum += __expf(sink - mx);
        const float inv = 1.0f / sum;
        f32x16 o[2] = {zero16(), zero16()};
#pragma unroll
        for (int k5 = 0; k5 < 5; ++k5)
#pragma unroll
            for (int s2 = 0; s2 < 2; ++s2) { const bf16x8 pb = pack_step(sc[k5], s2);
#pragma unroll
                for (int dt = 0; dt < 2; ++dt) { const bf16x8 a = *(const LAS bf16x8*)(VT + (32 * dt + lr) * 264 + 32 * (qt + k5) + 16 * s2 + 8 * h); o[dt] = MFMA32(a, pb, o[dt]); } }
        bf16* orow = brb + (size_t)(m0 + qi) * 512 + (kvh * 4 + g) * 64;
#pragma unroll
        for (int dt = 0; dt < 2; ++dt)
#pragma unroll
            for (int gq = 0; gq < 4; ++gq) { u32x2 w; w.x = pk2(o[dt][4 * gq] * inv, o[dt][4 * gq + 1] * inv); w.y = pk2(o[dt][4 * gq + 2] * inv, o[dt][4 * gq + 3] * inv);
                *(u32x2*)(orow + 32 * dt + 8 * gq + 4 * h) = w; }
    }
    __syncthreads();
}

__device__ __forceinline__ void dn_pre_task(const Frame& F, const Params& P, int l, int task) {
    const int hd = task & 3, cbn = task >> 2, b = cbn >> 7, n = cbn & 127, m0 = cbn * 64;
    const bf16* qkvc = (const bf16*)(P.ws + WS_QKVC); const float* ba = (const float*)(P.ws + WS_BA);
    unsigned char* outb = P.ws + WS_DN + (size_t)task * DN_TASK_BYTES;
    LAS bf16* qs = (LAS bf16*)F.lds;
    LAS bf16* ks = (LAS bf16*)(F.lds + 17408);
    LAS bf16* kT = (LAS bf16*)(F.lds + 34816);
    LAS bf16* vT = (LAS bf16*)(F.lds + 53248);
    LAS float* Lm = (LAS float*)(F.lds + 71680);
    LAS bf16* Tm = (LAS bf16*)(F.lds + 89088);
    LAS float* tg = (LAS float*)(F.lds + 98304);
    LAS float *tgc = tg + 64, *tbeta = tg + 128, *teg = tg + 192, *ted = tg + 256, *tsb = tg + 320;
    const int lr = F.lane & 31, h = F.lane >> 5;
    { const int t = F.tid >> 3, seg = F.tid & 7, c0 = seg * 16; const int row = m0 + t;
      const float beta = fast_sigmoid(ba[(size_t)row * 8 + hd]); const float xa = ba[(size_t)row * 8 + 4 + hd] + P.dt_bias[l * 4 + hd];
      const float sp = xa > 20.f ? xa : log1pf(__expf(xa)); const float gt = -__expf(P.a_log[l * 4 + hd]) * sp;
      if (seg == 0) { tg[t] = gt; tbeta[t] = beta; }
#pragma unroll
      for (int part = 0; part < 3; ++part) { const int col0 = part * 512 + hd * 128 + c0; float acc[16];
#pragma unroll
          for (int i = 0; i < 16; ++i) acc[i] = 0.f;
#pragma unroll
          for (int tap = 0; tap < 4; ++tap) { const int sr = n * 64 + t - 3 + tap; if (sr >= 0) {
              const bf16* src = qkvc + (size_t)(b * SEQ + sr) * 1536 + col0; const u32x4 w1 = *(const u32x4*)src, w2 = *(const u32x4*)(src + 8);
              const float xv[16] = {bflo(w1.x), bfhi(w1.x), bflo(w1.y), bfhi(w1.y), bflo(w1.z), bfhi(w1.z), bflo(w1.w), bfhi(w1.w), bflo(w2.x), bfhi(w2.x), bflo(w2.y), bfhi(w2.y), bflo(w2.z), bfhi(w2.z), bflo(w2.w), bfhi(w2.w)};
              const f32x4* cw = (const f32x4*)(P.conv_w + ((size_t)l * 4 + tap) * 1536 + col0);
#pragma unroll
              for (int q = 0; q < 4; ++q) { const f32x4 w = cw[q]; acc[4 * q] += xv[4 * q] * w.x; acc[4 * q + 1] += xv[4 * q + 1] * w.y; acc[4 * q + 2] += xv[4 * q + 2] * w.z; acc[4 * q + 3] += xv[4 * q + 3] * w.w; } } }
          float ss = 0.f;
#pragma unroll
          for (int i = 0; i < 16; ++i) { acc[i] = acc[i] * fast_sigmoid(acc[i]); ss += acc[i] * acc[i]; }
          if (part < 2) { ss += __shfl_xor(ss, 1); ss += __shfl_xor(ss, 2); ss += __shfl_xor(ss, 4); const float rn = __builtin_amdgcn_rsqf(ss + NORM_EPS) * (part == 0 ? 0.08838834764831845f : 1.0f);
#pragma unroll
              for (int i = 0; i < 16; ++i) acc[i] *= rn; }
          else {
#pragma unroll
              for (int i = 0; i < 16; ++i) acc[i] *= beta; }
          unsigned pk[8];
#pragma unroll
          for (int i = 0; i < 8; ++i) pk[i] = pk2(acc[2 * i], acc[2 * i + 1]);
          if (part < 2) { LAS bf16* dst = (part == 0 ? qs : ks) + t * 136 + c0; *(LAS u32x4*)dst = (u32x4){pk[0], pk[1], pk[2], pk[3]}; *(LAS u32x4*)(dst + 8) = (u32x4){pk[4], pk[5], pk[6], pk[7]}; }
          if (part >= 1) { LAS bf16* dT = part == 1 ? kT : vT;
#pragma unroll
              for (int i = 0; i < 8; ++i) { dT[(c0 + 2 * i) * 72 + t] = (bf16)(pk[i] & 0xffffu); dT[(c0 + 2 * i + 1) * 72 + t] = (bf16)(pk[i] >> 16); } }
      }
    }
    __syncthreads();
    if (F.wave == 0) { float x = tg[F.lane];
#pragma unroll
        for (int o = 1; o < 64; o <<= 1) { const float y = __shfl_up(x, o); if (F.lane >= o) x += y; }
        const float gl = __shfl(x, 63); tgc[F.lane] = x; const float e = __expf(x); teg[F.lane] = e; ted[F.lane] = __expf(gl - x); tsb[F.lane] = tbeta[F.lane] * e;
        if (F.lane == 0) ((float*)(P.ws + WS_CD))[task] = __expf(gl); }
    __syncthreads();
    if (F.wave < 4) { const int it = F.wave >> 1, jt = F.wave & 1; f32x16 acc = zero16();
        if (jt <= it) {
#pragma unroll
            for (int s = 0; s < 8; ++s) { const bf16x8 a = *(const LAS bf16x8*)(ks + (32 * it + lr) * 136 + 16 * s + 8 * h), bb = *(const LAS bf16x8*)(ks + (32 * jt + lr) * 136 + 16 * s + 8 * h); acc = MFMA32(a, bb, acc); } }
        const int j = 32 * jt + lr; const float gj = tgc[j];
#pragma unroll
        for (int rg = 0; rg < 16; ++rg) { const int i = 32 * it + crow(rg, h); const float v = i > j ? tbeta[i] * acc[rg] * __expf(tgc[i] - gj) : 0.f; Lm[i * 68 + j] = v; } }
    else { const int w4 = F.wave - 4, jt = w4 >> 1, ct = w4 & 1; f32x16 acc = zero16();
        if (jt <= ct) {
#pragma unroll
            for (int s = 0; s < 8; ++s) { const bf16x8 a = *(const LAS bf16x8*)(ks + (32 * jt + lr) * 136 + 16 * s + 8 * h), bb = *(const LAS bf16x8*)(qs + (32 * ct + lr) * 136 + 16 * s + 8 * h); acc = MFMA32(a, bb, acc); } }
        const int c = 32 * ct + lr; const float gcc = tgc[c];
#pragma unroll
        for (int rg = 0; rg < 16; ++rg) { const int jp = 32 * jt + crow(rg, h); acc[rg] = jp <= c ? acc[rg] * __expf(gcc - tgc[jp]) : 0.f; }
#pragma unroll
        for (int s = 0; s < 2; ++s) *(bf16x8*)(outb + DN_OFF_AT + ((ct * 4 + 2 * jt + s) * 64 + F.lane) * 16) = pack_step(acc, s); }
    __syncthreads();
    if (F.wave == 0) { LAS float* Tf = (LAS float*)(F.lds + 99840);
#pragma unroll 1
        for (int bi = 0; bi < 4; ++bi) { float rr[16];
#pragma unroll
            for (int ii = 0; ii < 16; ++ii) rr[ii] = (F.lane == 16 * bi + ii) ? 1.f : 0.f;
#pragma unroll 1
            for (int j = 0; j < 16 * bi; j += 4) { const float t0 = Tf[j * 64 + F.lane], t1 = Tf[(j + 1) * 64 + F.lane], t2 = Tf[(j + 2) * 64 + F.lane], t3 = Tf[(j + 3) * 64 + F.lane];
#pragma unroll
                for (int ii = 0; ii < 16; ++ii) { const f32x4 lv = *(const LAS f32x4*)(Lm + (16 * bi + ii) * 68 + j); rr[ii] -= (lv.x * t0 + lv.y * t1) + (lv.z * t2 + lv.w * t3); } }
#pragma unroll
            for (int ii = 0; ii < 16; ++ii) {
#pragma unroll
                for (int j4 = 0; j4 < ii; j4 += 4) { const f32x4 lv = *(const LAS f32x4*)(Lm + (16 * bi + ii) * 68 + 16 * bi + j4);
                    rr[ii] -= lv.x * rr[j4]; if (j4 + 1 < ii) rr[ii] -= lv.y * rr[j4 + 1]; if (j4 + 2 < ii) rr[ii] -= lv.z * rr[j4 + 2]; if (j4 + 3 < ii) rr[ii] -= lv.w * rr[j4 + 3]; }
                Tf[(16 * bi + ii) * 64 + F.lane] = rr[ii]; Tm[(16 * bi + ii) * 72 + F.lane] = (bf16)(pk2(rr[ii], 0.f) & 0xffffu); } } }
    else { for (int f = F.wave - 1; f < 32; f += 7) {
            if (f < 16) { const int mt = f >> 3, s = f & 7, c = 32 * mt + lr; const float e = teg[c];
                const u32x2 lo = *(const LAS u32x2*)(qs + c * 136 + 16 * s + 4 * h), hi = *(const LAS u32x2*)(qs + c * 136 + 16 * s + 8 + 4 * h);
                u32x4 o; o.x = pk2(bflo(lo.x) * e, bfhi(lo.x) * e); o.y = pk2(bflo(lo.y) * e, bfhi(lo.y) * e); o.z = pk2(bflo(hi.x) * e, bfhi(hi.x) * e); o.w = pk2(bflo(hi.y) * e, bfhi(hi.y) * e);
                *(u32x4*)(outb + DN_OFF_QD + ((mt * 8 + s) * 64 + F.lane) * 16) = o; }
            else { const int f2 = f - 16, dt = f2 >> 2, s = f2 & 3, d = 32 * dt + lr;
                const u32x2 lo = *(const LAS u32x2*)(kT + d * 72 + 16 * s + 4 * h), hi = *(const LAS u32x2*)(kT + d * 72 + 16 * s + 8 + 4 * h);
                const f32x4 e0 = *(const LAS f32x4*)(ted + 16 * s + 4 * h), e1 = *(const LAS f32x4*)(ted + 16 * s + 8 + 4 * h);
                u32x4 o; o.x = pk2(bflo(lo.x) * e0.x, bfhi(lo.x) * e0.y); o.y = pk2(bflo(lo.y) * e0.z, bfhi(lo.y) * e0.w); o.z = pk2(bflo(hi.x) * e1.x, bfhi(hi.x) * e1.y); o.w = pk2(bflo(hi.y) * e1.z, bfhi(hi.y) * e1.w);
                *(u32x4*)(outb + DN_OFF_KD + ((dt * 4 + s) * 64 + F.lane) * 16) = o; } } }
    __syncthreads();
    { const int it = F.wave >> 2, et = F.wave & 3; f32x16 acc = zero16();
#pragma unroll
      for (int s = 0; s < 4; ++s) { const bf16x8 a = *(const LAS bf16x8*)(Tm + (32 * it + lr) * 72 + 16 * s + 8 * h), bb = *(const LAS bf16x8*)(vT + (32 * et + lr) * 72 + 16 * s + 8 * h); acc = MFMA32(a, bb, acc); }
      u32x4 o0, o1; o0.x = pk2(acc[0], acc[1]); o0.y = pk2(acc[2], acc[3]); o0.z = pk2(acc[4], acc[5]); o0.w = pk2(acc[6], acc[7]); o1.x = pk2(acc[8], acc[9]); o1.y = pk2(acc[10], acc[11]); o1.z = pk2(acc[12], acc[13]); o1.w = pk2(acc[14], acc[15]);
      unsigned char* up = outb + DN_OFF_U + ((et * 2 + it) * 64 + F.lane) * 32; *(u32x4*)up = o0; *(u32x4*)(up + 16) = o1; }
    { const int dt = F.wave >> 1, it = F.wave & 1; f32x16 acc = zero16();
#pragma unroll
      for (int s = 0; s < 4; ++s) { const u32x4 kw = *(const LAS u32x4*)(kT + (32 * dt + lr) * 72 + 16 * s + 8 * h); const f32x4 e0 = *(const LAS f32x4*)(tsb + 16 * s + 8 * h), e1 = *(const LAS f32x4*)(tsb + 16 * s + 8 * h + 4);
          u32x4 aw; aw.x = pk2(bflo(kw.x) * e0.x, bfhi(kw.x) * e0.y); aw.y = pk2(bflo(kw.y) * e0.z, bfhi(kw.y) * e0.w); aw.z = pk2(bflo(kw.z) * e1.x, bfhi(kw.z) * e1.y); aw.w = pk2(bflo(kw.w) * e1.z, bfhi(kw.w) * e1.w);
          const bf16x8 bb = *(const LAS bf16x8*)(Tm + (32 * it + lr) * 72 + 16 * s + 8 * h); acc = MFMA32(__builtin_bit_cast(bf16x8, aw), bb, acc); }
#pragma unroll
      for (int s = 0; s < 2; ++s) *(bf16x8*)(outb + DN_OFF_W + ((it * 8 + 2 * dt + s) * 64 + F.lane) * 16) = pack_step(acc, s); }
    __syncthreads();
}
__device__ __forceinline__ void dn_scan(const Frame& F, const Params& P, int bh) {
    const int b = bh >> 2, hd = bh & 3; const int lr = F.lane & 31, h = F.lane >> 5, es = F.wave;
    const unsigned char* dn = P.ws + WS_DN; const float* cdv = (const float*)(P.ws + WS_CD);
    bf16* brc = (bf16*)(P.ws + WS_BR) + (size_t)2 * TT * 512;
#define task_of(n_) ((((b) * 128 + (n_)) << 2) | (hd))
    { const u32x4* src = (const u32x4*)(dn + (size_t)task_of(0) * DN_TASK_BYTES); LAS u32x4* dst = (LAS u32x4*)F.lds;
#pragma unroll
      for (int i = 0; i < 9; ++i) dst[F.tid + 512 * i] = src[F.tid + 512 * i]; }
    __syncthreads();
    f32x16 S[4] = {zero16(), zero16(), zero16(), zero16()};
    for (int n = 0; n < 128; ++n) {
        if (F.wave >= 4) { if (n + 1 < 128) { const u32x4* src = (const u32x4*)(dn + (size_t)task_of(n + 1) * DN_TASK_BYTES); LAS u32x4* dst = (LAS u32x4*)(F.lds + ((n + 1) & 1) * DN_TASK_BYTES); const int t4 = F.tid - 256;
#pragma unroll
                for (int i = 0; i < 18; ++i) dst[t4 + 256 * i] = src[t4 + 256 * i]; } }
        else { const LAS unsigned char* cur = F.lds + (n & 1) * DN_TASK_BYTES; const float cd = cdv[task_of(n)];
            bf16x8 Sb[8];
#pragma unroll
            for (int dt = 0; dt < 4; ++dt) { Sb[2 * dt] = pack_step(S[dt], 0); Sb[2 * dt + 1] = pack_step(S[dt], 1); }
            f32x16 Pw[2] = {zero16(), zero16()}, O[2] = {zero16(), zero16()};
#pragma unroll
            for (int ct = 0; ct < 2; ++ct)
#pragma unroll
                for (int s = 0; s < 8; ++s) { const bf16x8 a = *(const LAS bf16x8*)(cur + DN_OFF_W + ((ct * 8 + s) * 64 + F.lane) * 16); Pw[ct] = MFMA32(a, Sb[s], Pw[ct]); }
#pragma unroll
            for (int ct = 0; ct < 2; ++ct)
#pragma unroll
                for (int s = 0; s < 8; ++s) { const bf16x8 a = *(const LAS bf16x8*)(cur + DN_OFF_QD + ((ct * 8 + s) * 64 + F.lane) * 16); O[ct] = MFMA32(a, Sb[s], O[ct]); }
            bf16x8 Vb[4];
#pragma unroll
            for (int ct = 0; ct < 2; ++ct) { const LAS u32x4* up = (const LAS u32x4*)(cur + DN_OFF_U + ((es * 2 + ct) * 64 + F.lane) * 32); const u32x4 u0 = up[0], u1 = up[1];
                const unsigned uw[8] = {u0.x, u0.y, u0.z, u0.w, u1.x, u1.y, u1.z, u1.w}; f32x16 v;
#pragma unroll
                for (int p = 0; p < 8; ++p) { v[2 * p] = bflo(uw[p]) - Pw[ct][2 * p]; v[2 * p + 1] = bfhi(uw[p]) - Pw[ct][2 * p + 1]; }
                Vb[2 * ct] = pack_step(v, 0); Vb[2 * ct + 1] = pack_step(v, 1); }
#pragma unroll
            for (int ct = 0; ct < 2; ++ct)
#pragma unroll
                for (int s = 0; s < 4; ++s) { const bf16x8 a = *(const LAS bf16x8*)(cur + DN_OFF_AT + ((ct * 4 + s) * 64 + F.lane) * 16); O[ct] = MFMA32(a, Vb[s], O[ct]); }
            bf16* orow = brc + (size_t)((b * 128 + n) * 64) * 512 + hd * 128 + es * 32 + lr;
#pragma unroll
            for (int ct = 0; ct < 2; ++ct)
#pragma unroll
                for (int rg = 0; rg < 16; ++rg) orow[(size_t)(32 * ct + crow(rg, h)) * 512] = (bf16)(pk2(O[ct][rg], 0.f) & 0xffffu);
#pragma unroll
            for (int dt = 0; dt < 4; ++dt) { S[dt] = S[dt] * cd;
#pragma unroll
                for (int s = 0; s < 4; ++s) { const bf16x8 a = *(const LAS bf16x8*)(cur + DN_OFF_KD + ((dt * 4 + s) * 64 + F.lane) * 16); S[dt] = MFMA32(a, Vb[s], S[dt]); } }
        }
        __syncthreads();
    }
}
__device__ __forceinline__ void dn_post(const Frame& F, const Params& P, int l) {
    const int gw = F.vb * NWAVES + F.wave, NGW = F.G * NWAVES; bf16* brc = (bf16*)(P.ws + WS_BR) + (size_t)2 * TT * 512; const bf16* z = (const bf16*)(P.ws + WS_Z);
    const f32x4* gp = (const f32x4*)(P.dn_norm + l * 128 + (F.lane & 15) * 8); const f32x4 g0 = gp[0], g1 = gp[1]; const float gn[8] = {g0.x, g0.y, g0.z, g0.w, g1.x, g1.y, g1.z, g1.w};
    for (int m = gw; m < TT; m += NGW) { u32x4* op = (u32x4*)(brc + (size_t)m * 512 + F.lane * 8); const u32x4 ow = *op, zw = *(const u32x4*)(z + (size_t)m * 512 + F.lane * 8);
        float o[8] = {bflo(ow.x), bfhi(ow.x), bflo(ow.y), bfhi(ow.y), bflo(ow.z), bfhi(ow.z), bflo(ow.w), bfhi(ow.w)}; const float zz[8] = {bflo(zw.x), bfhi(zw.x), bflo(zw.y), bfhi(zw.y), bflo(zw.z), bfhi(zw.z), bflo(zw.w), bfhi(zw.w)};
        float ss = 0.f;
#pragma unroll
        for (int i = 0; i < 8; ++i) ss += o[i] * o[i];
        ss += __shfl_xor(ss, 1); ss += __shfl_xor(ss, 2); ss += __shfl_xor(ss, 4); ss += __shfl_xor(ss, 8);
        const float rs = __builtin_amdgcn_rsqf(ss * (1.f / 128.f) + NORM_EPS);
#pragma unroll
        for (int i = 0; i < 8; ++i) o[i] = o[i] * rs * gn[i] * (zz[i] * fast_sigmoid(zz[i]));
        u32x4 w; w.x = pk2(o[0], o[1]); w.y = pk2(o[2], o[3]); w.z = pk2(o[4], o[5]); w.w = pk2(o[6], o[7]); *op = w; }
}
__device__ __forceinline__ void final_norm(const Frame& F, const Params& P) {
    const int gw = F.vb * NWAVES + F.wave, NGW = F.G * NWAVES; const float* rowsq = (const float*)(P.ws + WS_ROWSQ);
    f32x4 gn[4];
#pragma unroll
    for (int j = 0; j < 4; ++j) gn[j] = ((const f32x4*)P.final_norm)[F.lane + 64 * j];
    for (int m = gw; m < TT; m += NGW) { float sq = F.lane < 16 ? rowsq[(size_t)m * 16 + F.lane] : 0.f; sq = wave_sum(sq); const float rs = __builtin_amdgcn_rsqf(sq * (1.f / 1024.f) + NORM_EPS);
        f32x4* xr = (f32x4*)(P.out + (size_t)m * DM) + F.lane;
#pragma unroll
        for (int j = 0; j < 4; ++j) xr[64 * j] = xr[64 * j] * rs * gn[j]; }
}

#define RLX_AGENT __ATOMIC_RELAXED, __HIP_MEMORY_SCOPE_AGENT
#define XB_TMO      128
#define XB_XCNT(j)  (256  + 64 * (j))
#define XB_XSUB(j)  (1280 + 64 * (j))
#define XB_XGEN(j)  (2304 + 64 * (j))
#define XB_TOP      3328
#define XB_TOPGEN   3392
#define XCD_BAR_WORDS 3456
#define XB_SPIN_CAP (1u << 18)

__device__ __forceinline__ unsigned xb_ld(unsigned* p)              { return __hip_atomic_load(p, __ATOMIC_RELAXED, __HIP_MEMORY_SCOPE_AGENT); }
__device__ __forceinline__ unsigned xb_add(unsigned* p, unsigned v) { return __hip_atomic_fetch_add(p, v, __ATOMIC_RELAXED, __HIP_MEMORY_SCOPE_AGENT); }
__device__ __forceinline__ unsigned xb_xcc_id() { return (unsigned)__builtin_amdgcn_s_getreg((3 << 11) | 20) & 0xFu; }
#define XB_SPIN(cond, bar) do { unsigned _sp = 0; while (cond) { __builtin_amdgcn_s_sleep(1); \
    if ((++_sp & 255u) == 0u) { if (xb_ld(&(bar)[XB_TMO])) break; if (_sp > XB_SPIN_CAP) { atomicAdd(&(bar)[XB_TMO], 1u); break; } } } } while (0)

struct XcdBarrier {
    unsigned* bar; unsigned x;
    volatile LAS unsigned* st;
};

__device__ __forceinline__ XcdBarrier xcd_barrier_post(unsigned* bar, volatile LAS unsigned* st) {
    XcdBarrier b; b.bar = bar; b.x = xb_xcc_id(); b.st = st;
    if (threadIdx.x == 0) (void)xb_add(&bar[XB_XCNT(b.x)], 1u);
    return b;
}
__device__ __forceinline__ void xcd_barrier_complete(unsigned* bar, unsigned x, unsigned& nloc, unsigned& nx) {
    const unsigned G = gridDim.x * gridDim.y * gridDim.z;
    unsigned sum, cnt, mine, sp = 0u;
    for (;;) {
        sum = 0u; cnt = 0u; mine = 0u;
#pragma unroll
        for (unsigned j = 0; j < 16; ++j) { const unsigned c = xb_ld(&bar[XB_XCNT(j)]); sum += c; cnt += (c > 0u) ? 1u : 0u; mine = (j == x) ? c : mine; }
        if (sum == G) break;
        __builtin_amdgcn_s_sleep(1);
        if ((++sp & 255u) == 0u) { if (xb_ld(&bar[XB_TMO])) break; if (sp > XB_SPIN_CAP) { atomicAdd(&bar[XB_TMO], 1u); break; } }
    }
    nloc = mine > 0u ? mine : 1u; nx = cnt > 0u ? cnt : 1u;
}

__device__ __forceinline__ void xcd_barrier(const XcdBarrier& b) {
    asm volatile("s_waitcnt vmcnt(0)" ::: "memory");
    __syncthreads();
    if (threadIdx.x == 0) {
        unsigned* bar = b.bar;
        __builtin_amdgcn_s_waitcnt(0);
        unsigned nloc = b.st[0], nx = b.st[1];
        if (nloc == 0u) { xcd_barrier_complete(bar, b.x, nloc, nx); b.st[0] = nloc; b.st[1] = nx; }
        const unsigned old = xb_add(&bar[XB_XSUB(b.x)], 1u);
        const unsigned gen = old / nloc;
        if (old + 1u == (gen + 1u) * nloc) {
            __builtin_amdgcn_fence(__ATOMIC_RELEASE, "agent");
            asm volatile("s_waitcnt vmcnt(0)" ::: "memory");
            const unsigned og = xb_add(&bar[XB_TOP], 1u);
            const unsigned tg = og / nx;
            if (og + 1u == (tg + 1u) * nx) xb_add(&bar[XB_TOPGEN], 1u);
            else XB_SPIN(xb_ld(&bar[XB_TOPGEN]) == tg, bar);
            __builtin_amdgcn_fence(__ATOMIC_ACQUIRE, "agent");
            xb_add(&bar[XB_XGEN(b.x)], 1u);
            asm volatile("s_waitcnt vmcnt(0)" ::: "memory");
        } else {
            XB_SPIN(xb_ld(&bar[XB_XGEN(b.x)]) == gen, bar);
            __builtin_amdgcn_fence(__ATOMIC_ACQUIRE, "agent");
            asm volatile("s_waitcnt vmcnt(0)" ::: "memory");
        }
    }
    __syncthreads();
}

constexpr int PH_PER_LAYER = 9, N_PHASES = DEPTH * PH_PER_LAYER + 1;
__device__ __forceinline__ void run_phase(const Frame& F0, const Params& P0, int ph, int sub = 0) {
    Frame F = F0; Params P = P0; asm volatile("" : "+v"(F.tid)); F.lane = F.tid & 63; F.wave = __builtin_amdgcn_readfirstlane(F.tid >> 6); asm volatile("" : "+s"(P.ws));
    const int l = ph / PH_PER_LAYER, k = ph % PH_PER_LAYER;
    unsigned char* ws = P.ws; const float* rowsq = (const float*)(ws + WS_ROWSQ); const LAS float* lrs = (const LAS float*)(F.lds + pg8::LRS_OFF);
    if (ph == N_PHASES - 1) { final_norm(F, P); return; }
#ifdef ONLY_K
    if (k != ONLY_K) return;
#endif
    switch (k) {
    case 0: p0_attn_weights(F, P, l); if (l == 0) p0_input(F, P); break;
    case 1: { p1_ba(F, P); __syncthreads();
        pg8::Gemm g{(const pg8::bf16_t*)(ws + WS_XB), (const pg8::bf16_t*)(ws + WS_WIN), TT, NMIX, DM}; pg8::StaticOrder S; S.init(TT, NMIX, F.G, (int)blockIdx.x);
        pg8::EpiProj E{(pg8::bf16_t*)(ws + WS_UV), (pg8::bf16_t*)(ws + WS_QKVB), (pg8::bf16_t*)(ws + WS_QKVC), (pg8::bf16_t*)(ws + WS_Z), lrs};
        pg8::prep_rstd(F.lds, S, rowsq);
        pg8::gemm_phase<pg8::EpiProj, pg8::StaticOrder, true, true>(F.lds, g, S, E); } break;
    case 2: for (int t = F.vb; t < 1024; t += F.G) dn_pre_task(F, P, l, t); break;
    case 3: { const int sb = (int)blockIdx.x; if (sb < 8) { if (!(sub & 2)) dn_scan(F, P, sb); }
              else if (!(sub & 1)) { const int nb = F.G - 8; for (int t = sb - 8; t < 768; t += nb) { if (t < 256) { if (!(sub & 4)) swa_task(F, P, l, t); } else if (!(sub & 8)) sgu_task(F, P, l, t - 256); } } } break;
    case 4: dn_post(F, P, l); p0_ffn_weights(F, P, l); break;
    case 5: {
#pragma unroll 1
        for (int n = 0; n < 3; ++n) {
            { pg8::Gemm g{(const pg8::bf16_t*)(ws + WS_XB), (const pg8::bf16_t*)(ws + WS_WG) + (size_t)n * 1024 * 1024, TT, DM, DM}; pg8::StaticOrder S; S.init(TT, DM, F.G, (int)blockIdx.x);
              pg8::EpiSig E{(pg8::bf16_t*)(ws + WS_UV), lrs}; if (n == 0) pg8::prep_rstd(F.lds, S, rowsq); pg8::gemm_phase<pg8::EpiSig, pg8::StaticOrder, true, true>(F.lds, g, S, E); }
            __syncthreads();
            { pg8::Gemm g{(const pg8::bf16_t*)(ws + WS_BR) + (size_t)n * TT * 512, (const pg8::bf16_t*)(ws + WS_WBR) + (size_t)n * 1024 * 512, TT, DM, 512}; pg8::StaticOrder S; S.init(TT, DM, F.G, (int)blockIdx.x);
              if (n == 0) { pg8::EpiMerge<0> E{(pg8::bf16_t*)(ws + WS_UV), (float*)(ws + WS_DN)}; pg8::gemm_phase<pg8::EpiMerge<0>, pg8::StaticOrder, true, true>(F.lds, g, S, E); }
              else if (n == 1) { pg8::EpiMerge<1> E{(pg8::bf16_t*)(ws + WS_UV), (float*)(ws + WS_DN)}; pg8::gemm_phase<pg8::EpiMerge<1>, pg8::StaticOrder, true, true>(F.lds, g, S, E); }
              else { pg8::EpiMerge<2> E{(pg8::bf16_t*)(ws + WS_UV), (float*)(ws + WS_DN)}; pg8::gemm_phase<pg8::EpiMerge<2>, pg8::StaticOrder, true, true>(F.lds, g, S, E); } }
            __syncthreads();
        } } break;
    case 6: { pg8::Gemm g{(const pg8::bf16_t*)(ws + WS_UV), (const pg8::bf16_t*)(ws + WS_WOUT), TT, DM, DM}; pg8::StaticOrder S; S.init(TT, DM, F.G, (int)blockIdx.x);
        pg8::EpiResid E{l == 0 ? P.x : P.out, P.out, (pg8::bf16_t*)(ws + WS_XB), (float*)(ws + WS_ROWSQ)}; pg8::gemm_phase<pg8::EpiResid, pg8::StaticOrder, true, true>(F.lds, g, S, E); } break;
    case 7: { pg8::Gemm g{(const pg8::bf16_t*)(ws + WS_XB), (const pg8::bf16_t*)(ws + WS_WGU), TT, 2 * DFF, DM}; pg8::StaticOrder S; S.init(TT, 2 * DFF, F.G, (int)blockIdx.x);
        pg8::EpiGU E{(pg8::bf16_t*)(ws + WS_HID), lrs}; pg8::prep_rstd(F.lds, S, rowsq); pg8::gemm_phase<pg8::EpiGU, pg8::StaticOrder, true, true>(F.lds, g, S, E); } break;
    case 8: { pg8::Gemm g{(const pg8::bf16_t*)(ws + WS_HID), (const pg8::bf16_t*)(ws + WS_WDN), TT, DM, DFF}; pg8::StaticOrder S; S.init(TT, DM, F.G, (int)blockIdx.x);
        pg8::EpiResid E{P.out, P.out, (pg8::bf16_t*)(ws + WS_XB), (float*)(ws + WS_ROWSQ)}; pg8::gemm_phase<pg8::EpiResid, pg8::StaticOrder, true, true>(F.lds, g, S, E); } break;
    }
}

__global__ void __launch_bounds__(NTHR, 2) hgpm_fwd(Params P) {
    extern __shared__ __attribute__((aligned(16))) unsigned char lds_raw[];
    Frame F; F.lds = (LAS unsigned char*)lds_raw; F.tid = threadIdx.x; F.lane = F.tid & 63; F.wave = __builtin_amdgcn_readfirstlane(F.tid >> 6);
    F.G = gridDim.x; { const int bx = blockIdx.x; F.vb = (F.G % 8 == 0) ? (bx % 8) * (F.G / 8) + bx / 8 : bx; }
#if USE_CG_SYNC
    cg::grid_group grid = cg::this_grid();
#define GRID_SYNC() grid.sync()
#else
    volatile LAS unsigned* misc = (volatile LAS unsigned*)(F.lds + MISC_OFF);
    if (F.tid < 64) misc[F.tid] = 0u;
    __syncthreads();
    const XcdBarrier bar = xcd_barrier_post((unsigned*)(P.ws + WS_CTL) + 1024, misc + 8);
#define GRID_SYNC() xcd_barrier(bar)
#endif
    for (int ph = P.ph_lo; ph < P.ph_hi; ++ph) {
        run_phase(F, P, ph);
#ifdef DUPK
#ifndef DUPSUB
#define DUPSUB 0
#endif
        if (ph % PH_PER_LAYER == DUPK && ph != N_PHASES - 1) { GRID_SYNC(); run_phase(F, P, ph, DUPSUB); }
#endif
        if (ph + 1 < P.ph_hi) GRID_SYNC();
    }
}

#ifndef N_LAUNCH_MODE
#define N_LAUNCH_MODE 0
#endif
extern "C" void kernel_launch(void* const* d_in, const int* in_sizes, int n_in, void* d_out, int out_size, void* d_ws, size_t ws_size, hipStream_t stream) {
    static int grid = 0;
    if (grid == 0) {
        if (n_in != 19 || in_sizes[0] != TT * DM || out_size != TT * DM || ws_size < WS_END) { fprintf(stderr, "kernel_launch: unexpected shapes (n_in %d, in0 %d, out %d, ws %zu)\n", n_in, n_in > 0 ? in_sizes[0] : -1, out_size, ws_size); grid = -1; return; }
        int dev = 0, cus = 0, per_cu = 0;
        if (hipGetDevice(&dev) != hipSuccess || hipDeviceGetAttribute(&cus, hipDeviceAttributeMultiprocessorCount, dev) != hipSuccess) { grid = -1; return; }
        if (hipFuncSetAttribute((const void*)hgpm_fwd, hipFuncAttributeMaxDynamicSharedMemorySize, LDS_BYTES) != hipSuccess) { fprintf(stderr, "kernel_launch: hipFuncSetAttribute failed\n"); grid = -1; return; }
        if (hipOccupancyMaxActiveBlocksPerMultiprocessor(&per_cu, (const void*)hgpm_fwd, NTHR, LDS_BYTES) != hipSuccess || per_cu < 1) { fprintf(stderr, "kernel_launch: occupancy query says %d blocks per CU\n", per_cu); per_cu = 1; }
        (void)hipGetLastError();
        grid = cus;
    }
    if (grid < 0) return;
    Params p{};
    p.x = (const float*)d_in[0]; p.pos = (const int*)d_in[1]; p.attn_norm = (const float*)d_in[2]; p.w_in = (const float*)d_in[3]; p.sgu_ln_g = (const float*)d_in[4]; p.sgu_ln_b = (const float*)d_in[5];
    p.sgu_w = (const float*)d_in[6]; p.sgu_b = (const float*)d_in[7]; p.sinks = (const float*)d_in[8]; p.conv_w = (const float*)d_in[9]; p.a_log = (const float*)d_in[10]; p.dt_bias = (const float*)d_in[11];
    p.dn_norm = (const float*)d_in[12]; p.w_branch = (const float*)d_in[13]; p.w_out = (const float*)d_in[14]; p.ffn_norm = (const float*)d_in[15]; p.w_gate_up = (const float*)d_in[16]; p.w_down = (const float*)d_in[17];
    p.final_norm = (const float*)d_in[18]; p.out = (float*)d_out; p.ws = (unsigned char*)d_ws;
#if N_LAUNCH_MODE == 0
    p.ph_lo = 0; p.ph_hi = N_PHASES;
#if USE_CG_SYNC
    void* args[] = {&p};
    hipError_t e = hipLaunchCooperativeKernel((const void*)hgpm_fwd, dim3(grid), dim3(NTHR), args, LDS_BYTES, stream);
    if (e != hipSuccess) fprintf(stderr, "kernel_launch: cooperative launch failed: %s (grid %d)\n", hipGetErrorString(e), grid);
#else
    if (hipMemsetAsync((char*)d_ws + WS_CTL, 0, CTL_ZERO_BYTES, stream) != hipSuccess) { fprintf(stderr, "kernel_launch: hipMemsetAsync failed\n"); return; }
    hipLaunchKernelGGL(hgpm_fwd, dim3(grid), dim3(NTHR), LDS_BYTES, stream, p);
#endif
#else
    for (int ph = 0; ph < N_PHASES; ++ph) { p.ph_lo = ph; p.ph_hi = ph + 1; hipLaunchKernelGGL(hgpm_fwd, dim3(grid), dim3(NTHR), LDS_BYTES, stream, p); }
#endif
}
```

```cpp
#include <hip/hip_runtime.h>
#include <hip/hip_cooperative_groups.h>
#include <cstdio>
#include <cstdint>
namespace cg = cooperative_groups;
namespace pg8 {
#define PG8_LAS __attribute__((address_space(3)))
typedef unsigned short bf16_t;
typedef short bf16x8 __attribute__((ext_vector_type(8)));
typedef float f32x4 __attribute__((ext_vector_type(4)));
typedef unsigned u32x4 __attribute__((ext_vector_type(4)));
constexpr int BM = 256, BK = 64, HALF = 128, HTB = HALF * BK * 2  , STAGE_BYTES = 8 * HTB, NXCD = 8, WGM = 8;

__host__ __device__ __forceinline__ int lds_byte(int r, int c) { const int st = (r >> 4) * 2 + (c >> 5), rr = r & 15, cc = c & 31, ob = rr * 64 + cc * 2; return st * 1024 + (ob ^ (((ob >> 9) & 1) << 5)); }
__host__ __device__ __forceinline__ void stage_rc(int b, int& R, int& C) { const int st = b / 1024, sb = b % 1024, swz = sb ^ (((sb >> 9) & 1) << 5); R = (st >> 1) * 16 + swz / 64; C = (st & 1) * 32 + (swz % 64) / 2; }
__host__ __device__ __forceinline__ int perm32(int rho) { const int n = rho >> 4, i = rho & 15; return 8 * (i >> 2) + 4 * n + (i & 3); }

struct Unit { int pm, pn, idx; };
struct Gemm { const bf16_t* A; const bf16_t* Bt; int M, N, K; };

struct StaticOrder {
    int nM, nN, nwg, G, c;
    __host__ __device__ void init(int M, int N, int G_, int c_) { nM = M / BM; nN = N / BM; nwg = nM * nN; G = G_; c = c_; }
    __host__ __device__ bool next(int i, Unit& u) const {
        const long L = (long)i * G + c; if (L >= nwg) return false;
        int wgid = (int)L; { const int q = nwg / NXCD, r = nwg % NXCD, xcd = wgid % NXCD, off = wgid / NXCD; wgid = (xcd < r ? xcd * (q + 1) : r * (q + 1) + (xcd - r) * q) + off; }
        const int nig = WGM * nN, gid = wgid / nig, fm = gid * WGM, gsz = (nM - fm) < WGM ? (nM - fm) : WGM;
        u.pm = fm + ((wgid % nig) % gsz); u.pn = (wgid % nig) / gsz; u.idx = i; return true;
    }
    __device__ __forceinline__ void a_ready(const Unit&) const {}
    __device__ __forceinline__ void done(const Unit&) const {}
};

typedef float f32x2 __attribute__((ext_vector_type(2)));
typedef __bf16 bf16v2 __attribute__((ext_vector_type(2)));
typedef unsigned u32x2 __attribute__((ext_vector_type(2)));
__device__ __forceinline__ unsigned pk2(float lo, float hi) { f32x2 v = {lo, hi}; bf16v2 r = __builtin_convertvector(v, bf16v2); return __builtin_bit_cast(unsigned, r); }
__device__ __forceinline__ float bflo(unsigned w) { return __uint_as_float(w << 16); }
__device__ __forceinline__ float bfhi(unsigned w) { return __uint_as_float(w & 0xffff0000u); }
__device__ __forceinline__ float fast_sigmoid(float x) { return __builtin_amdgcn_rcpf(1.0f + __expf(-x)); }
__device__ __forceinline__ float gelu_tanh(float x) { const float u = 1.5957691216f * (x + 0.044715f * x * x * x); return x * fast_sigmoid(u); }
constexpr float NORM_EPS = 1e-6f;
__device__ __forceinline__ float row_rstd(const float* rowsq, int row) {
    const f32x4* p = (const f32x4*)(rowsq + (size_t)row * 16); const f32x4 a = p[0], b = p[1], c = p[2], d = p[3];
    const float s = ((a.x + a.y) + (a.z + a.w)) + ((b.x + b.y) + (b.z + b.w)) + ((c.x + c.y) + (c.z + c.w)) + ((d.x + d.y) + (d.z + d.w));
    return __builtin_amdgcn_rsqf(s * (1.0f / 1024.0f) + NORM_EPS);
}
constexpr int LRS_OFF = STAGE_BYTES, LRS_MAX_UNITS = 8;
template <class Sched> __device__ __forceinline__ void prep_rstd(PG8_LAS unsigned char* lds, const Sched& S, const float* rowsq) {
    PG8_LAS float* t = (PG8_LAS float*)(lds + LRS_OFF); Unit u;
#pragma unroll 1
    for (int i = 0; i < LRS_MAX_UNITS; ++i) { if (!S.next(i, u)) break; if (threadIdx.x < 256) t[i * 256 + threadIdx.x] = row_rstd(rowsq, u.pm * BM + threadIdx.x); asm volatile("" ::: "memory"); }
    __syncthreads();
}
struct EpiProj {
    static constexpr bool PERM = true, AFTER_DRAIN = false;
    bf16_t *uv, *qkvb, *qkvc, *z; const PG8_LAS float* lrs;
    __device__ __forceinline__ void operator()(const f32x4 (&acc)[2][2][4][2], const Unit& u, int wr, int wc, int fr, int fq) const {
        const int pn = u.pn; bf16_t* base; int ldc, colt; bool act = false;
        if (pn < 4) { base = uv; ldc = 1024; colt = pn * 256; act = true; }
        else if (pn < 7) { base = qkvb; ldc = 768; colt = (pn - 4) * 256; }
        else if (pn < 13) { base = qkvc; ldc = 1536; colt = (pn - 7) * 256; }
        else { base = z; ldc = 512; colt = (pn - 13) * 256; }
        const int row0 = u.pm * BM + wr * 64 + fr, col0 = colt + wc * 32 + 8 * fq;
#pragma unroll
        for (int ai = 0; ai < 2; ++ai)
#pragma unroll
            for (int m = 0; m < 4; ++m) { const int row = row0 + ai * HALF + m * 16; const float rs = lrs[u.idx * 256 + (row - u.pm * BM)]; bf16_t* rowp = base + (size_t)row * ldc + col0;
#pragma unroll
                for (int bj = 0; bj < 2; ++bj) { f32x4 v0 = acc[ai][bj][m][0] * rs, v1 = acc[ai][bj][m][1] * rs;
                    if (act) {
#pragma unroll
                        for (int j = 0; j < 4; ++j) { v0[j] = gelu_tanh(v0[j]); v1[j] = gelu_tanh(v1[j]); } }
                    u32x4 w; w.x = pk2(v0[0], v0[1]); w.y = pk2(v0[2], v0[3]); w.z = pk2(v1[0], v1[1]); w.w = pk2(v1[2], v1[3]);
                    *(u32x4*)(rowp + bj * HALF) = w; } }
    }
};
struct EpiSig {
    static constexpr bool PERM = true, AFTER_DRAIN = false;
    bf16_t* sig; const PG8_LAS float* lrs;
    __device__ __forceinline__ void operator()(const f32x4 (&acc)[2][2][4][2], const Unit& u, int wr, int wc, int fr, int fq) const {
        const int row0 = u.pm * BM + wr * 64 + fr, col0 = u.pn * BM + wc * 32 + 8 * fq;
#pragma unroll
        for (int ai = 0; ai < 2; ++ai)
#pragma unroll
            for (int m = 0; m < 4; ++m) { const int row = row0 + ai * HALF + m * 16; const float rs = lrs[u.idx * 256 + (row - u.pm * BM)]; bf16_t* rowp = sig + (size_t)row * 1024 + col0;
#pragma unroll
                for (int bj = 0; bj < 2; ++bj) { f32x4 v0 = acc[ai][bj][m][0] * rs, v1 = acc[ai][bj][m][1] * rs;
#pragma unroll
                    for (int j = 0; j < 4; ++j) { v0[j] = fast_sigmoid(v0[j]); v1[j] = fast_sigmoid(v1[j]); }
                    u32x4 w; w.x = pk2(v0[0], v0[1]); w.y = pk2(v0[2], v0[3]); w.z = pk2(v1[0], v1[1]); w.w = pk2(v1[2], v1[3]);
                    *(u32x4*)(rowp + bj * HALF) = w; } }
    }
};
template <int MODE> struct EpiMerge {
    static constexpr bool PERM = true, AFTER_DRAIN = false;
    bf16_t* sig; float* mf;
    __device__ __forceinline__ void operator()(const f32x4 (&acc)[2][2][4][2], const Unit& u, int wr, int wc, int fr, int fq) const {
        const int row0 = u.pm * BM + wr * 64 + fr, col0 = u.pn * BM + wc * 32 + 8 * fq;
#pragma unroll
        for (int ai = 0; ai < 2; ++ai)
#pragma unroll
            for (int m = 0; m < 4; ++m) { const size_t off = (size_t)(row0 + ai * HALF + m * 16) * 1024 + col0;
#pragma unroll
                for (int bj = 0; bj < 2; ++bj) { const u32x4 s = *(const u32x4*)(sig + off + bj * HALF);
                    f32x4 v0 = acc[ai][bj][m][0], v1 = acc[ai][bj][m][1];
                    v0[0] *= bflo(s.x); v0[1] *= bfhi(s.x); v0[2] *= bflo(s.y); v0[3] *= bfhi(s.y); v1[0] *= bflo(s.z); v1[1] *= bfhi(s.z); v1[2] *= bflo(s.w); v1[3] *= bfhi(s.w);
                    float* mp = mf + off + bj * HALF;
                    if (MODE >= 1) { v0 += *(const f32x4*)mp; v1 += *(const f32x4*)(mp + 4); }
                    if (MODE <= 1) { *(f32x4*)mp = v0; *(f32x4*)(mp + 4) = v1; }
                    else { u32x4 w; w.x = pk2(v0[0], v0[1]); w.y = pk2(v0[2], v0[3]); w.z = pk2(v1[0], v1[1]); w.w = pk2(v1[2], v1[3]); *(u32x4*)(sig + off + bj * HALF) = w; } } }
    }
};
struct EpiResid {
    static constexpr bool PERM = false, AFTER_DRAIN = false;
    const float* xin; float* xout; bf16_t* xb; float* rowsq;
    __device__ __forceinline__ void operator()(const f32x4 (&acc)[2][2][4][2], const Unit& u, int wr, int wc, int fr, int fq) const {
        const int row0 = u.pm * BM + wr * 64 + fr, col0 = u.pn * BM + wc * 32 + 4 * fq;
#pragma unroll
        for (int ai = 0; ai < 2; ++ai)
#pragma unroll
            for (int m = 0; m < 4; ++m) { const int row = row0 + ai * HALF + m * 16; const size_t off = (size_t)row * 1024 + col0; float ss = 0.f;
#pragma unroll
                for (int bj = 0; bj < 2; ++bj)
#pragma unroll
                    for (int n = 0; n < 2; ++n) { const size_t o = off + bj * HALF + n * 16; const f32x4 v = *(const f32x4*)(xin + o) + acc[ai][bj][m][n];
                        *(f32x4*)(xout + o) = v; u32x2 w; w.x = pk2(v[0], v[1]); w.y = pk2(v[2], v[3]); *(u32x2*)(xb + o) = w;
                        ss += (v[0] * v[0] + v[1] * v[1]) + (v[2] * v[2] + v[3] * v[3]); }
                ss += __shfl_xor(ss, 16); ss += __shfl_xor(ss, 32);
                if (fq == 0) rowsq[(size_t)row * 16 + u.pn * 4 + wc] = ss; }
    }
};
struct EpiGU {
    static constexpr bool PERM = true, AFTER_DRAIN = false;
    bf16_t* hid; const PG8_LAS float* lrs;
    __device__ __forceinline__ void operator()(const f32x4 (&acc)[2][2][4][2], const Unit& u, int wr, int wc, int fr, int fq) const {
        const int row0 = u.pm * BM + wr * 64 + fr, col0 = u.pn * HALF + wc * 32 + 8 * fq;
#pragma unroll
        for (int ai = 0; ai < 2; ++ai)
#pragma unroll
            for (int m = 0; m < 4; ++m) { const int row = row0 + ai * HALF + m * 16; const float rs = lrs[u.idx * 256 + (row - u.pm * BM)];
                float o[8];
#pragma unroll
                for (int n = 0; n < 2; ++n)
#pragma unroll
                    for (int j = 0; j < 4; ++j) { const float g = acc[ai][0][m][n][j] * rs, up = acc[ai][1][m][n][j] * rs; o[n * 4 + j] = g * fast_sigmoid(g) * up; }
                u32x4 w; w.x = pk2(o[0], o[1]); w.y = pk2(o[2], o[3]); w.z = pk2(o[4], o[5]); w.w = pk2(o[6], o[7]);
                *(u32x4*)(hid + (size_t)row * 2816 + col0) = w; }
    }
};

template <class Epi, class Sched, bool ALIGN_EPI = false, bool SP2 = false>
__device__ __forceinline__ void gemm_phase(PG8_LAS unsigned char* lds, const Gemm g, const Sched& S, const Epi& E) {
    int tid_ = threadIdx.x; asm volatile("" : "+v"(tid_));
    const int tid = tid_, wid = __builtin_amdgcn_readfirstlane(tid >> 6), lane = tid & 63, wr = wid >> 2, wc = wid & 3, fr = lane & 15, fq = lane >> 4;
    const int K = g.K, nt = K / BK;
    unsigned voffA[2], voffB[2];
#pragma unroll
    for (int i = 0; i < 2; ++i) { int R, C; stage_rc(tid * 16 + i * 8192, R, C); const int Rb = Epi::PERM ? ((R & ~31) + perm32(R & 31)) : R;
        voffA[i] = (unsigned)(R * K + C) * 2u; voffB[i] = (unsigned)(Rb * K + C) * 2u; }
    const size_t kstep = (size_t)(BK * 2);
    const size_t hstep = (size_t)HALF * K * 2;
    const size_t tstep = 2 * hstep;
    const unsigned ldsw = (unsigned)wid * 1024u;
    const int aoff = lds_byte(wr * 64 + fr, fq * 8), boff = lds_byte(wc * 32 + fr, fq * 8);
#define PG8_SA(b, h) (((b) * 2 + (h)) * HTB)
#define PG8_SB(b, h) ((4 + (b) * 2 + (h)) * HTB)
#define PG8_STAGE(bufoff, gbase, voff) do { _Pragma("unroll") for (int _i = 0; _i < 2; ++_i) \
        __builtin_amdgcn_global_load_lds((const unsigned*)((const char*)(gbase) + (voff)[_i]), (PG8_LAS unsigned*)(lds + (bufoff) + ldsw + _i * 8192), 16, 0, 0); } while (0)
#define PG8_LDA(dst, b, h) do { _Pragma("unroll") for (int m = 0; m < 4; ++m) _Pragma("unroll") for (int k = 0; k < 2; ++k) dst[m][k] = *(const PG8_LAS bf16x8*)(lds + PG8_SA(b, h) + aoff + m * 2048 + k * 1024); } while (0)
#define PG8_LDB(dst, b, h) do { _Pragma("unroll") for (int n = 0; n < 2; ++n) _Pragma("unroll") for (int k = 0; k < 2; ++k) dst[n][k] = *(const PG8_LAS bf16x8*)(lds + PG8_SB(b, h) + boff + n * 2048 + k * 1024); } while (0)
#define PG8_MMA(ai, bj, At, Bt) do { __builtin_amdgcn_s_setprio(1); _Pragma("unroll") for (int m = 0; m < 4; ++m) _Pragma("unroll") for (int n = 0; n < 2; ++n) _Pragma("unroll") for (int k = 0; k < 2; ++k) \
        acc[ai][bj][m][n] = __builtin_amdgcn_mfma_f32_16x16x32_bf16(Bt[n][k], At[m][k], acc[ai][bj][m][n], 0, 0, 0); __builtin_amdgcn_s_setprio(0); } while (0)
#define PG8_WAIT_V(n) asm volatile("s_waitcnt vmcnt(" #n ")" ::: "memory")
#define PG8_WAIT_L(n) asm volatile("s_waitcnt lgkmcnt(" #n ")" ::: "memory")
#define PG8_BAR __builtin_amdgcn_s_barrier()
#define PG8_SCHED __builtin_amdgcn_sched_barrier(0)
    Unit cur, nxt; int ui = 0;
    if (!S.next(0, cur)) return;
    f32x4 acc[2][2][4][2];
#pragma unroll
    for (int a = 0; a < 2; ++a)
#pragma unroll
        for (int b = 0; b < 2; ++b)
#pragma unroll
            for (int m = 0; m < 4; ++m)
#pragma unroll
                for (int n = 0; n < 2; ++n) acc[a][b][m][n] = (f32x4){0.f, 0.f, 0.f, 0.f};
    bf16x8 At[4][2], B0[2][2], B1[2][2];
    const char* cA = (const char*)g.A + (size_t)cur.pm * tstep; const char* cB = (const char*)g.Bt + (size_t)cur.pn * tstep;
    S.a_ready(cur);
    if constexpr (SP2) {
        PG8_STAGE(PG8_SB(0, 0), cB, voffB); PG8_STAGE(PG8_SB(0, 1), cB + hstep, voffB); PG8_STAGE(PG8_SA(0, 0), cA, voffA); PG8_STAGE(PG8_SA(0, 1), cA + hstep, voffA);
        if (wr == 1) PG8_BAR;
        PG8_WAIT_V(2); PG8_BAR;
        PG8_STAGE(PG8_SB(1, 0), cB + kstep, voffB); PG8_STAGE(PG8_SA(1, 0), cA + kstep, voffA); PG8_STAGE(PG8_SB(1, 1), cB + hstep + kstep, voffB);
        PG8_WAIT_V(6); PG8_BAR;
    } else {
        PG8_STAGE(PG8_SB(0, 0), cB, voffB); PG8_STAGE(PG8_SA(0, 0), cA, voffA); PG8_STAGE(PG8_SB(0, 1), cB + hstep, voffB); PG8_STAGE(PG8_SA(0, 1), cA + hstep, voffA);
        if (wr == 1) PG8_BAR;
        PG8_WAIT_V(4); PG8_BAR;
        PG8_STAGE(PG8_SB(1, 0), cB + kstep, voffB); PG8_STAGE(PG8_SA(1, 0), cA + kstep, voffA); PG8_STAGE(PG8_SB(1, 1), cB + hstep + kstep, voffB);
        PG8_WAIT_V(6); PG8_BAR;
    }
    for (;;) {
        const bool has_next = S.next(ui + 1, nxt);
        const char* nA = has_next ? (const char*)g.A + (size_t)nxt.pm * tstep : cA; const char* nB = has_next ? (const char*)g.Bt + (size_t)nxt.pn * tstep : cB;
        for (int t = 0; t < nt; t += 2) {
            const bool last = (t == nt - 2);
            const char* a1 = cA + (size_t)(t + 1) * kstep;
            const char* a2 = last ? nA : cA + (size_t)(t + 2) * kstep; const char* b2 = last ? nB : cB + (size_t)(t + 2) * kstep;
            const char* a3 = a2 + kstep; const char* b3 = b2 + kstep;
            if (last && has_next) S.a_ready(nxt);
            if constexpr (SP2) {
            PG8_LDB(B0, 0, 0); PG8_LDB(B1, 0, 1); PG8_SCHED; PG8_LDA(At, 0, 0); PG8_STAGE(PG8_SA(1, 1), a1 + hstep, voffA);
            PG8_WAIT_V(8); PG8_WAIT_L(0); PG8_BAR; PG8_MMA(0, 0, At, B0); PG8_MMA(0, 1, At, B1); PG8_BAR; PG8_SCHED;
            PG8_LDA(At, 0, 1); PG8_STAGE(PG8_SB(0, 0), b2, voffB); PG8_STAGE(PG8_SB(0, 1), b2 + hstep, voffB); PG8_STAGE(PG8_SA(0, 0), a2, voffA);
            PG8_WAIT_V(8); PG8_WAIT_L(0); PG8_BAR; PG8_MMA(1, 0, At, B0); PG8_MMA(1, 1, At, B1); PG8_BAR; PG8_SCHED;
            PG8_LDB(B0, 1, 0); PG8_LDB(B1, 1, 1); PG8_SCHED; PG8_LDA(At, 1, 0); PG8_STAGE(PG8_SA(0, 1), a2 + hstep, voffA);
            PG8_WAIT_V(8); PG8_WAIT_L(0); PG8_BAR; PG8_MMA(0, 0, At, B0); PG8_MMA(0, 1, At, B1); PG8_BAR; PG8_SCHED;
            PG8_LDA(At, 1, 1); PG8_STAGE(PG8_SB(1, 0), b3, voffB); PG8_STAGE(PG8_SB(1, 1), b3 + hstep, voffB); PG8_STAGE(PG8_SA(1, 0), a3, voffA);
            PG8_WAIT_V(8); PG8_WAIT_L(0); PG8_BAR; PG8_MMA(1, 0, At, B0); PG8_MMA(1, 1, At, B1); PG8_BAR; PG8_SCHED;
            } else {
            PG8_LDB(B0, 0, 0); PG8_SCHED; PG8_LDA(At, 0, 0); PG8_STAGE(PG8_SA(1, 1), a1 + hstep, voffA);
            PG8_WAIT_L(8); PG8_BAR; PG8_WAIT_L(0); PG8_MMA(0, 0, At, B0); PG8_BAR; PG8_SCHED;
            PG8_LDB(B1, 0, 1); PG8_STAGE(PG8_SB(0, 0), b2, voffB);
            PG8_BAR; PG8_WAIT_L(0); PG8_MMA(0, 1, At, B1); PG8_BAR;
            PG8_LDA(At, 0, 1); PG8_STAGE(PG8_SA(0, 0), a2, voffA);
            PG8_BAR; PG8_WAIT_L(0); PG8_MMA(1, 0, At, B0); PG8_BAR; PG8_SCHED;
            PG8_STAGE(PG8_SB(0, 1), b2 + hstep, voffB);
            PG8_WAIT_V(6); PG8_BAR; PG8_MMA(1, 1, At, B1); PG8_BAR;
            PG8_LDB(B0, 1, 0); PG8_SCHED; PG8_LDA(At, 1, 0); PG8_STAGE(PG8_SA(0, 1), a2 + hstep, voffA);
            PG8_WAIT_L(8); PG8_BAR; PG8_WAIT_L(0); PG8_MMA(0, 0, At, B0); PG8_BAR; PG8_SCHED;
            PG8_LDB(B1, 1, 1); PG8_STAGE(PG8_SB(1, 0), b3, voffB);
            PG8_BAR; PG8_WAIT_L(0); PG8_MMA(0, 1, At, B1); PG8_BAR;
            PG8_LDA(At, 1, 1); PG8_STAGE(PG8_SA(1, 0), a3, voffA);
            PG8_BAR; PG8_WAIT_L(0); PG8_MMA(1, 0, At, B0); PG8_BAR; PG8_SCHED;
            PG8_STAGE(PG8_SB(1, 1), b3 + hstep, voffB);
            PG8_WAIT_V(6); PG8_BAR; PG8_MMA(1, 1, At, B1); PG8_BAR;
            }
        }
        if constexpr (ALIGN_EPI) { if (wr == 0) PG8_BAR; }
        if constexpr (!Epi::AFTER_DRAIN) { E(acc, cur, wr, wc, fr, fq); S.done(cur); }
        if (!has_next) break;
#pragma unroll
        for (int a = 0; a < 2; ++a)
#pragma unroll
            for (int b = 0; b < 2; ++b)
#pragma unroll
                for (int m = 0; m < 4; ++m)
#pragma unroll
                    for (int n = 0; n < 2; ++n) acc[a][b][m][n] = (f32x4){0.f, 0.f, 0.f, 0.f};
        cur = nxt; cA = nA; cB = nB; ++ui;
        if constexpr (ALIGN_EPI) { if (wr == 1) PG8_BAR; }
    }
    PG8_WAIT_V(0);
    if constexpr (!ALIGN_EPI) { if (wr == 0) PG8_BAR; }
    PG8_BAR;
    if constexpr (Epi::AFTER_DRAIN) { E.fused(acc, cur, wr, wc, fr, fq, lds, wid, lane); S.done(cur); }
#undef PG8_SA
#undef PG8_SB
#undef PG8_STAGE
#undef PG8_LDA
#undef PG8_LDB
#undef PG8_MMA
#undef PG8_WAIT_V
#undef PG8_WAIT_L
#undef PG8_BAR
#undef PG8_SCHED
}
}

#ifndef USE_CG_SYNC
#define USE_CG_SYNC 0
#endif
constexpr int NWAVES = 8, NTHR = 512;
constexpr int TT = 16384, SEQ = 8192, DM = 1024, DEPTH = 2, INC = 6920, DFF = 2816;
constexpr int C_QKVC = 1792, C_BETA = 3840, C_GATE = 3848;
constexpr int NMIX = 3840;
constexpr size_t MiB = 1u << 20, KiB = 1u << 10;
constexpr size_t WS_CTL = 0, CTL_ZERO_BYTES = 64 * KiB;
constexpr size_t WS_ROWSQ = 1 * MiB;
constexpr size_t WS_BA = 2 * MiB;
constexpr size_t WS_CD = 2 * MiB + 512 * KiB;
constexpr size_t WS_WBA = WS_CD + 64 * KiB;
constexpr size_t WS_SGUW = 2 * MiB + 768 * KiB;
constexpr size_t WS_WIN = 3 * MiB;
constexpr size_t WS_WG = WS_WIN + 3840 * 1024 * 2;
constexpr size_t WS_WBR = WS_WG + 3072 * 1024 * 2;
constexpr size_t WS_WOUT = WS_WBR + 3 * 1024 * 512 * 2;
constexpr size_t WS_XB = 22 * MiB;
constexpr size_t WS_UV = 54 * MiB;
constexpr size_t WS_QKVB = 86 * MiB;
constexpr size_t WS_WGU = WS_QKVB;
constexpr size_t WS_WDN = WS_QKVB + 5632 * 1024 * 2;
constexpr size_t WS_QKVC = 110 * MiB;
constexpr size_t WS_BR = WS_QKVC;
constexpr size_t WS_Z = 158 * MiB;
constexpr size_t WS_DN = 174 * MiB;
constexpr size_t WS_HID = 110 * MiB;
constexpr size_t WS_END = 246 * MiB;
static_assert(WS_WOUT + 1024 * 1024 * 2 <= WS_XB && WS_WDN + 1024 * 2816 * 2 <= WS_QKVC && WS_HID + (size_t)TT * DFF * 2 <= WS_END && WS_DN + 1024 * 72 * KiB <= WS_END, "ws map");
constexpr int DN_TASK_BYTES = 73728, DN_OFF_W = 0, DN_OFF_QD = 16384, DN_OFF_AT = 32768, DN_OFF_KD = 40960, DN_OFF_U = 57344;
constexpr int LDS_BYTES = 163840, MISC_OFF = LDS_BYTES - 256;

#define LAS __attribute__((address_space(3)))
typedef unsigned short bf16;
typedef float f32x4 __attribute__((ext_vector_type(4)));
typedef float f32x16 __attribute__((ext_vector_type(16)));
typedef short bf16x8 __attribute__((ext_vector_type(8)));
typedef unsigned u32x4 __attribute__((ext_vector_type(4)));
typedef unsigned u32x2 __attribute__((ext_vector_type(2)));
using pg8::pk2; using pg8::bflo; using pg8::bfhi; using pg8::fast_sigmoid; using pg8::NORM_EPS;
#define MFMA32(a, b, c) __builtin_amdgcn_mfma_f32_32x32x16_bf16((a), (b), (c), 0, 0, 0)
__device__ __forceinline__ int crow(int reg, int h) { return (reg & 3) + 8 * (reg >> 2) + 4 * h; }
__device__ __forceinline__ bf16x8 pack_step(const f32x16& x, int s) {
    u32x4 p; p.x = pk2(x[8 * s], x[8 * s + 1]); p.y = pk2(x[8 * s + 2], x[8 * s + 3]); p.z = pk2(x[8 * s + 4], x[8 * s + 5]); p.w = pk2(x[8 * s + 6], x[8 * s + 7]);
    return __builtin_bit_cast(bf16x8, p);
}
__device__ __forceinline__ float wave_sum(float v) {
#pragma unroll
    for (int o = 1; o < 64; o <<= 1) v += __shfl_xor(v, o);
    return v;
}
__device__ __forceinline__ f32x16 zero16() { f32x16 z; for (int i = 0; i < 16; ++i) z[i] = 0.f; return z; }

struct Params {
    const float* x; const int* pos; const float* attn_norm; const float* w_in; const float* sgu_ln_g; const float* sgu_ln_b; const float* sgu_w; const float* sgu_b;
    const float* sinks; const float* conv_w; const float* a_log; const float* dt_bias; const float* dn_norm; const float* w_branch; const float* w_out; const float* ffn_norm;
    const float* w_gate_up; const float* w_down; const float* final_norm;
    float* out; unsigned char* ws; int ph_lo, ph_hi;
};
struct Frame { LAS unsigned char* lds; int tid, lane, wave, vb, G; };

template <int MAP> __device__ __forceinline__ void transpose_item(const float* W, int ldw, int ncol0, int K, int N, const float* kscale, bf16* WT, LAS float* scr, int item, int lane) {
    const int nblk = N / 32, kb = item / nblk, nb = item % nblk, k0 = 64 * kb, n0 = 32 * nb;
#pragma unroll 8
    for (int i = 0; i < 32; ++i) { const int kk = 2 * i + (lane >> 5); float v = W[(size_t)(k0 + kk) * ldw + ncol0 + n0 + (lane & 31)]; if (kscale) v *= kscale[k0 + kk]; scr[kk * 33 + (lane & 31)] = v; }
    asm volatile("s_waitcnt lgkmcnt(0)" ::: "memory");
    const int c = lane & 7;
#pragma unroll
    for (int j = 0; j < 4; ++j) { const int n = (lane >> 3) + 8 * j; const LAS float* s = scr + (8 * c) * 33 + n;
        u32x4 o; o.x = pk2(s[0 * 33], s[1 * 33]); o.y = pk2(s[2 * 33], s[3 * 33]); o.z = pk2(s[4 * 33], s[5 * 33]); o.w = pk2(s[6 * 33], s[7 * 33]);
        const int nn = n0 + n; int dr = nn;
        if (MAP == 1) { const int f = nn < DFF ? nn : nn - DFF; dr = (f >> 7) * 256 + (nn < DFF ? 0 : 128) + (f & 127); }
        *(u32x4*)(WT + (size_t)dr * K + k0 + 8 * c) = o; }
    asm volatile("s_waitcnt lgkmcnt(0)" ::: "memory");
}
__device__ __forceinline__ void p0_attn_weights(const Frame& F, const Params& P, int l) {
    LAS float* scr = (LAS float*)(F.lds + F.wave * 8448);
    const int gw = F.vb * NWAVES + F.wave, NGW = F.G * NWAVES;
    const float* win = P.w_in + (size_t)l * DM * INC; const float* an = P.attn_norm + l * DM;
    constexpr int I_MIX = 16 * (NMIX / 32), I_G = 16 * (3072 / 32), I_BR = 8 * 32, I_O = 16 * 32, NIT = I_MIX + I_G + 3 * I_BR + I_O;
    for (int it = gw; it < NIT; it += NGW) {
        int r = it;
        if (r < I_MIX) { transpose_item<0>(win, INC, 0, DM, NMIX, an, (bf16*)(P.ws + WS_WIN), scr, r, F.lane); continue; } r -= I_MIX;
        if (r < I_G) { transpose_item<0>(win, INC, C_GATE, DM, 3072, an, (bf16*)(P.ws + WS_WG), scr, r, F.lane); continue; } r -= I_G;
        if (r < 3 * I_BR) { const int n = r / I_BR; transpose_item<0>(P.w_branch + ((size_t)l * 3 + n) * 512 * 1024, 1024, 0, 512, 1024, nullptr, (bf16*)(P.ws + WS_WBR) + (size_t)n * 1024 * 512, scr, r % I_BR, F.lane); continue; } r -= 3 * I_BR;
        transpose_item<0>(P.w_out + (size_t)l * DM * DM, DM, 0, DM, DM, nullptr, (bf16*)(P.ws + WS_WOUT), scr, r, F.lane);
    }
    const int gt = F.vb * NTHR + F.tid, NGT = F.G * NTHR;
    float* wba = (float*)(P.ws + WS_WBA);
    for (int i = gt; i < 8 * DM; i += NGT) { const int c = i >> 10, k = i & 1023; wba[i] = win[(size_t)k * INC + C_BETA + c] * an[k]; }
    bf16* sw = (bf16*)(P.ws + WS_SGUW); const float* sgw = P.sgu_w + (size_t)l * 4 * 128 * 128;
    for (int i = gt; i < 4 * 128 * 128 / 2; i += NGT) { const int e = 2 * i, s = e & 127, t = (e >> 7) & 127; const float a = s <= t ? sgw[e] : 0.f, b = (s + 1) <= t ? sgw[e + 1] : 0.f; ((unsigned*)sw)[i] = pk2(a, b); }
}
__device__ __forceinline__ void p0_ffn_weights(const Frame& F, const Params& P, int l) {
    LAS float* scr = (LAS float*)(F.lds + F.wave * 8448);
    const int gw = F.vb * NWAVES + F.wave, NGW = F.G * NWAVES;
    constexpr int I_GU = 16 * (2 * DFF / 32), I_DN = (DFF / 64) * 32, NIT = I_GU + I_DN;
    for (int it = gw; it < NIT; it += NGW) {
        if (it < I_GU) transpose_item<1>(P.w_gate_up + (size_t)l * DM * 2 * DFF, 2 * DFF, 0, DM, 2 * DFF, P.ffn_norm + l * DM, (bf16*)(P.ws + WS_WGU), scr, it, F.lane);
        else transpose_item<0>(P.w_down + (size_t)l * DFF * DM, DM, 0, DFF, DM, nullptr, (bf16*)(P.ws + WS_WDN), scr, it - I_GU, F.lane);
    }
}
__device__ __forceinline__ void p0_input(const Frame& F, const Params& P) {
    const int gw = F.vb * NWAVES + F.wave, NGW = F.G * NWAVES;
    bf16* xb = (bf16*)(P.ws + WS_XB); float* rowsq = (float*)(P.ws + WS_ROWSQ);
    for (int m = gw; m < TT; m += NGW) {
        const f32x4* xr = (const f32x4*)(P.x + (size_t)m * DM) + F.lane; float s = 0.f;
        unsigned long long* o8 = (unsigned long long*)(xb + (size_t)m * DM) + F.lane;
#pragma unroll
        for (int j = 0; j < 4; ++j) { const f32x4 v = xr[64 * j]; s += (v.x * v.x + v.y * v.y) + (v.z * v.z + v.w * v.w); o8[64 * j] = (unsigned long long)pk2(v.x, v.y) | ((unsigned long long)pk2(v.z, v.w) << 32); }
        s = wave_sum(s);
        if (F.lane < 16) rowsq[(size_t)m * 16 + F.lane] = F.lane == 0 ? s : 0.f;
    }
}
__device__ __forceinline__ void p1_ba(const Frame& F, const Params& P) {
    const int gw = F.vb * NWAVES + F.wave, NGW = F.G * NWAVES;
    const float* wba = (const float*)(P.ws + WS_WBA); const bf16* xb = (const bf16*)(P.ws + WS_XB); const float* rowsq = (const float*)(P.ws + WS_ROWSQ); float* ba = (float*)(P.ws + WS_BA);
    f32x4 wb[8][4];
#pragma unroll
    for (int c = 0; c < 8; ++c)
#pragma unroll
        for (int j = 0; j < 2; ++j) { const f32x4* p = (const f32x4*)(wba + c * DM + F.lane * 8 + 512 * j); wb[c][2 * j] = p[0]; wb[c][2 * j + 1] = p[1]; }
    for (int m = gw; m < TT; m += NGW) {
        float xv[16];
#pragma unroll
        for (int j = 0; j < 2; ++j) { const u32x4 w = *(const u32x4*)(xb + (size_t)m * DM + F.lane * 8 + 512 * j);
            xv[8 * j + 0] = bflo(w.x); xv[8 * j + 1] = bfhi(w.x); xv[8 * j + 2] = bflo(w.y); xv[8 * j + 3] = bfhi(w.y); xv[8 * j + 4] = bflo(w.z); xv[8 * j + 5] = bfhi(w.z); xv[8 * j + 6] = bflo(w.w); xv[8 * j + 7] = bfhi(w.w); }
        float sq = F.lane < 16 ? rowsq[(size_t)m * 16 + F.lane] : 0.f; sq = wave_sum(sq);
        const float rs = __builtin_amdgcn_rsqf(sq * (1.0f / 1024.0f) + NORM_EPS);
        float mine = 0.f;
#pragma unroll
        for (int c = 0; c < 8; ++c) { float d = 0.f;
#pragma unroll
            for (int q = 0; q < 4; ++q) d += (xv[4 * q] * wb[c][q].x + xv[4 * q + 1] * wb[c][q].y) + (xv[4 * q + 2] * wb[c][q].z + xv[4 * q + 3] * wb[c][q].w);
            d = wave_sum(d); if (F.lane == c) mine = d; }
        if (F.lane < 8) ba[(size_t)m * 8 + F.lane] = mine * rs;
    }
}

__device__ __forceinline__ void sgu_task(const Frame& F, const Params& P, int l, int task) {
    const int g = task & 3, cb = task >> 2, m0 = cb * 128;
    const bf16* uv = (const bf16*)(P.ws + WS_UV); bf16* bra = (bf16*)(P.ws + WS_BR);
    LAS bf16* vnT = (LAS bf16*)F.lds;
    const int r = F.tid >> 2, qq = F.tid & 3;
    { const bf16* vrow = uv + (size_t)(m0 + r) * 1024 + 512 + qq * 128; float s = 0.f, s2 = 0.f;
#pragma unroll
      for (int j = 0; j < 16; ++j) { const u32x4 w = *(const u32x4*)(vrow + 8 * j); const float a0 = bflo(w.x), a1 = bfhi(w.x), a2 = bflo(w.y), a3 = bfhi(w.y), a4 = bflo(w.z), a5 = bfhi(w.z), a6 = bflo(w.w), a7 = bfhi(w.w);
          s += ((a0 + a1) + (a2 + a3)) + ((a4 + a5) + (a6 + a7)); s2 += ((a0 * a0 + a1 * a1) + (a2 * a2 + a3 * a3)) + ((a4 * a4 + a5 * a5) + (a6 * a6 + a7 * a7)); }
      s += __shfl_xor(s, 1); s += __shfl_xor(s, 2); s2 += __shfl_xor(s2, 1); s2 += __shfl_xor(s2, 2);
      const float mean = s * (1.f / 512.f); float var = s2 * (1.f / 512.f) - mean * mean; var = var > 0.f ? var : 0.f; const float rstd = __builtin_amdgcn_rsqf(var + NORM_EPS);
      const bf16* vg = uv + (size_t)(m0 + r) * 1024 + 512 + g * 128 + qq * 32; const float* lg = P.sgu_ln_g + l * 512 + g * 128 + qq * 32; const float* lb = P.sgu_ln_b + l * 512 + g * 128 + qq * 32;
#pragma unroll
      for (int j = 0; j < 4; ++j) { const u32x4 w = *(const u32x4*)(vg + 8 * j); const float a[8] = {bflo(w.x), bfhi(w.x), bflo(w.y), bfhi(w.y), bflo(w.z), bfhi(w.z), bflo(w.w), bfhi(w.w)};
#pragma unroll
          for (int i = 0; i < 8; ++i) { const int c = qq * 32 + 8 * j + i; const float y = (a[i] - mean) * rstd * lg[8 * j + i] + lb[8 * j + i]; vnT[c * 136 + r] = (bf16)(pk2(y, 0.f) & 0xffffu); } }
    }
    __syncthreads();
    const int lr = F.lane & 31, h = F.lane >> 5, ct = F.wave >> 1;
    const bf16* sw = (const bf16*)(P.ws + WS_SGUW) + (size_t)g * 128 * 128;
#pragma unroll
    for (int t2 = 0; t2 < 2; ++t2) { const int tt = 2 * (F.wave & 1) + t2; f32x16 acc = zero16();
        for (int ks = 0; ks < 2 * (tt + 1); ++ks) {
            const bf16x8 a = *(const LAS bf16x8*)(vnT + (32 * ct + lr) * 136 + 16 * ks + 8 * h);
            const bf16x8 b = *(const bf16x8*)(sw + (size_t)(32 * tt + lr) * 128 + 16 * ks + 8 * h);
            acc = MFMA32(a, b, acc); }
        const int t = 32 * tt + lr; const float bias = P.sgu_b[l * 512 + g * 128 + t];
#pragma unroll
        for (int gq = 0; gq < 4; ++gq) { const int c0 = 32 * ct + 8 * gq + 4 * h; const u32x2 uu = *(const u32x2*)(uv + (size_t)(m0 + t) * 1024 + g * 128 + c0);
            u32x2 o; o.x = pk2(bflo(uu.x) * (acc[4 * gq] + bias), bfhi(uu.x) * (acc[4 * gq + 1] + bias)); o.y = pk2(bflo(uu.y) * (acc[4 * gq + 2] + bias), bfhi(uu.y) * (acc[4 * gq + 3] + bias));
            *(u32x2*)(bra + (size_t)(m0 + t) * 512 + g * 128 + c0) = o; } }
    __syncthreads();
}

__device__ __forceinline__ void swa_task(const Frame& F, const Params& P, int l, int task) {
    const int kvh = task & 1, cb = task >> 1, nq = cb & 63, m0 = cb * 128;
    const bf16* qkvb = (const bf16*)(P.ws + WS_QKVB); bf16* brb = (bf16*)(P.ws + WS_BR) + (size_t)TT * 512;
    LAS bf16* Qs = (LAS bf16*)F.lds;
    LAS bf16* Ks = (LAS bf16*)(F.lds + 73728);
    LAS bf16* VT = (LAS bf16*)(F.lds + 110592);
    for (int i = F.tid; i < 4096; i += NTHR) { const int g = i >> 10, r = (i >> 3) & 127, c8 = i & 7; if (c8 < 2) continue;
        const u32x4 w = *(const u32x4*)(qkvb + (size_t)(m0 + r) * 768 + (kvh * 4 + g) * 64 + c8 * 8);
        u32x4 o; o.x = pk2(bflo(w.x) * 0.125f, bfhi(w.x) * 0.125f); o.y = pk2(bflo(w.y) * 0.125f, bfhi(w.y) * 0.125f); o.z = pk2(bflo(w.z) * 0.125f, bfhi(w.z) * 0.125f); o.w = pk2(bflo(w.w) * 0.125f, bfhi(w.w) * 0.125f);
        *(LAS u32x4*)(Qs + (g * 128 + r) * 72 + c8 * 8) = o; }
    const float invf[8] = {1.0f, 0.19392274474868576f, 0.03760603093086393f, 0.007292664737217109f, 0.001414213562373095f, 0.0002742481756762073f, 5.318295896944988e-05f, 1.031338537721246e-05f};
    { const int g = F.tid >> 7, r = F.tid & 127; const float pos = (float)P.pos[m0 + r];
      const bf16* src = qkvb + (size_t)(m0 + r) * 768 + (kvh * 4 + g) * 64; const u32x4 w1 = *(const u32x4*)src, w2 = *(const u32x4*)(src + 8);
      const float x1[8] = {bflo(w1.x), bfhi(w1.x), bflo(w1.y), bfhi(w1.y), bflo(w1.z), bfhi(w1.z), bflo(w1.w), bfhi(w1.w)}, x2[8] = {bflo(w2.x), bfhi(w2.x), bflo(w2.y), bfhi(w2.y), bflo(w2.z), bfhi(w2.z), bflo(w2.w), bfhi(w2.w)};
      float o1[8], o2[8];
#pragma unroll
      for (int i = 0; i < 8; ++i) { float sn, cs; sincosf(pos * invf[i], &sn, &cs); o1[i] = (x1[i] * cs - x2[i] * sn) * 0.125f; o2[i] = (x2[i] * cs + x1[i] * sn) * 0.125f; }
      u32x4 a, b; a.x = pk2(o1[0], o1[1]); a.y = pk2(o1[2], o1[3]); a.z = pk2(o1[4], o1[5]); a.w = pk2(o1[6], o1[7]); b.x = pk2(o2[0], o2[1]); b.y = pk2(o2[2], o2[3]); b.z = pk2(o2[4], o2[5]); b.w = pk2(o2[6], o2[7]);
      *(LAS u32x4*)(Qs + (g * 128 + r) * 72) = a; *(LAS u32x4*)(Qs + (g * 128 + r) * 72 + 8) = b; }
    for (int i = F.tid; i < 2048; i += NTHR) { const int s = i >> 3, c8 = i & 7; const bool ok = nq > 0 || s >= 128; const size_t row = (size_t)(m0 - 128 + s);
        u32x4 kw = {0u, 0u, 0u, 0u}, vw = {0u, 0u, 0u, 0u};
        if (ok) { if (c8 >= 2) kw = *(const u32x4*)(qkvb + row * 768 + 512 + kvh * 64 + c8 * 8); vw = *(const u32x4*)(qkvb + row * 768 + 640 + kvh * 64 + c8 * 8); }
        if (c8 >= 2) *(LAS u32x4*)(Ks + s * 72 + c8 * 8) = kw;
        const int p = (s & ~12) | ((s & 4) << 1) | ((s & 8) >> 1); const unsigned vv[4] = {vw.x, vw.y, vw.z, vw.w};
#pragma unroll
        for (int j = 0; j < 4; ++j) { VT[(c8 * 8 + 2 * j) * 264 + p] = (bf16)(vv[j] & 0xffffu); VT[(c8 * 8 + 2 * j + 1) * 264 + p] = (bf16)(vv[j] >> 16); } }
    if (F.tid < 256) { const int s = F.tid; const bool ok = nq > 0 || s >= 128; u32x4 a = {0u, 0u, 0u, 0u}, b = {0u, 0u, 0u, 0u};
        if (ok) { const size_t row = (size_t)(m0 - 128 + s); const float pos = (float)P.pos[row]; const bf16* src = qkvb + row * 768 + 512 + kvh * 64; const u32x4 w1 = *(const u32x4*)src, w2 = *(const u32x4*)(src + 8);
            const float x1[8] = {bflo(w1.x), bfhi(w1.x), bflo(w1.y), bfhi(w1.y), bflo(w1.z), bfhi(w1.z), bflo(w1.w), bfhi(w1.w)}, x2[8] = {bflo(w2.x), bfhi(w2.x), bflo(w2.y), bfhi(w2.y), bflo(w2.z), bfhi(w2.z), bflo(w2.w), bfhi(w2.w)};
            float o1[8], o2[8];
#pragma unroll
            for (int i = 0; i < 8; ++i) { float sn, cs; sincosf(pos * invf[i], &sn, &cs); o1[i] = x1[i] * cs - x2[i] * sn; o2[i] = x2[i] * cs + x1[i] * sn; }
            a.x = pk2(o1[0], o1[1]); a.y = pk2(o1[2], o1[3]); a.z = pk2(o1[4], o1[5]); a.w = pk2(o1[6], o1[7]); b.x = pk2(o2[0], o2[1]); b.y = pk2(o2[2], o2[3]); b.z = pk2(o2[4], o2[5]); b.w = pk2(o2[6], o2[7]); }
        *(LAS u32x4*)(Ks + s * 72) = a; *(LAS u32x4*)(Ks + s * 72 + 8) = b; }
    __syncthreads();
    const int lr = F.lane & 31, h = F.lane >> 5, g = F.wave >> 1, qh = F.wave & 1;
    const float sink = P.sinks[l * 8 + kvh * 4 + g];
#pragma unroll 1
    for (int q2 = 0; q2 < 2; ++q2) { const int qt = 2 * qh + q2, q0 = 32 * qt, qi = q0 + lr;
        bf16x8 bq[4];
#pragma unroll
        for (int ks = 0; ks < 4; ++ks) bq[ks] = *(const LAS bf16x8*)(Qs + (g * 128 + q0 + lr) * 72 + 16 * ks + 8 * h);
        f32x16 sc[5];
#pragma unroll
        for (int k5 = 0; k5 < 5; ++k5) { sc[k5] = zero16();
#pragma unroll
            for (int ks = 0; ks < 4; ++ks) { const bf16x8 a = *(const LAS bf16x8*)(Ks + (32 * (qt + k5) + lr) * 72 + 16 * ks + 8 * h); sc[k5] = MFMA32(a, bq[ks], sc[k5]); } }
        float mx = sink;
#pragma unroll
        for (int k5 = 0; k5 < 5; ++k5)
#pragma unroll
            for (int rg = 0; rg < 16; ++rg) { const int sj = 32 * (qt + k5) + crow(rg, h); const bool ok = sj >= qi + 1 && sj <= qi + 128 && (nq > 0 || sj >= 128);
                const float v = ok ? sc[k5][rg] : -INFINITY; sc[k5][rg] = v; mx = fmaxf(mx, v); }
        mx = fmaxf(mx, __shfl_xor(mx, 32));
        float sum = 0.f;
#pragma unroll
        for (int k5 = 0; k5 < 5; ++k5)
#pragma unroll
            for (int rg = 0; rg < 16; ++rg) { const float p = __expf(sc[k5][rg] - mx); sc[k5][rg] = p; sum += p; }
        sum += __shfl_xor(sum, 32); sum += __expf(sink - mx);
        const float inv = 1.0f / sum;
        f32x16 o[2] = {zero16(), zero16()};
#pragma unroll
        for (int k5 = 0; k5 < 5; ++k5)
#pragma unroll
            for (int s2 = 0; s2 < 2; ++s2) { const bf16x8 pb = pack_step(sc[k5], s2);
#pragma unroll
                for (int dt = 0; dt < 2; ++dt) { const bf16x8 a = *(const LAS bf16x8*)(VT + (32 * dt + lr) * 264 + 32 * (qt + k5) + 16 * s2 + 8 * h); o[dt] = MFMA32(a, pb, o[dt]); } }
        bf16* orow = brb + (size_t)(m0 + qi) * 512 + (kvh * 4 + g) * 64;
#pragma unroll
        for (int dt = 0; dt < 2; ++dt)
#pragma unroll
            for (int gq = 0; gq < 4; ++gq) { u32x2 w; w.x = pk2(o[dt][4 * gq] * inv, o[dt][4 * gq + 1] * inv); w.y = pk2(o[dt][4 * gq + 2] * inv, o[dt][4 * gq + 3] * inv);
                *(u32x2*)(orow + 32 * dt + 8 * gq + 4 * h) = w; }
    }
    __syncthreads();
}

__device__ __forceinline__ void dn_pre_task(const Frame& F, const Params& P, int l, int task) {
    const int hd = task & 3, cbn = task >> 2, b = cbn >> 7, n = cbn & 127, m0 = cbn * 64;
    const bf16* qkvc = (const bf16*)(P.ws + WS_QKVC); const float* ba = (const float*)(P.ws + WS_BA);
    unsigned char* outb = P.ws + WS_DN + (size_t)task * DN_TASK_BYTES;
    LAS bf16* qs = (LAS bf16*)F.lds;
    LAS bf16* ks = (LAS bf16*)(F.lds + 17408);
    LAS bf16* kT = (LAS bf16*)(F.lds + 34816);
    LAS bf16* vT = (LAS bf16*)(F.lds + 53248);
    LAS float* Lm = (LAS float*)(F.lds + 71680);
    LAS bf16* Tm = (LAS bf16*)(F.lds + 89088);
    LAS float* tg = (LAS float*)(F.lds + 98304);
    LAS float *tgc = tg + 64, *tbeta = tg + 128, *teg = tg + 192, *ted = tg + 256, *tsb = tg + 320;
    const int lr = F.lane & 31, h = F.lane >> 5;
    { const int t = F.tid >> 3, seg = F.tid & 7, c0 = seg * 16; const int row = m0 + t;
      const float beta = fast_sigmoid(ba[(size_t)row * 8 + hd]); const float xa = ba[(size_t)row * 8 + 4 + hd] + P.dt_bias[l * 4 + hd];
      const float sp = xa > 20.f ? xa : log1pf(__expf(xa)); const float gt = -__expf(P.a_log[l * 4 + hd]) * sp;
      if (seg == 0) { tg[t] = gt; tbeta[t] = beta; }
#pragma unroll
      for (int part = 0; part < 3; ++part) { const int col0 = part * 512 + hd * 128 + c0; float acc[16];
#pragma unroll
          for (int i = 0; i < 16; ++i) acc[i] = 0.f;
#pragma unroll
          for (int tap = 0; tap < 4; ++tap) { const int sr = n * 64 + t - 3 + tap; if (sr >= 0) {
              const bf16* src = qkvc + (size_t)(b * SEQ + sr) * 1536 + col0; const u32x4 w1 = *(const u32x4*)src, w2 = *(const u32x4*)(src + 8);
              const float xv[16] = {bflo(w1.x), bfhi(w1.x), bflo(w1.y), bfhi(w1.y), bflo(w1.z), bfhi(w1.z), bflo(w1.w), bfhi(w1.w), bflo(w2.x), bfhi(w2.x), bflo(w2.y), bfhi(w2.y), bflo(w2.z), bfhi(w2.z), bflo(w2.w), bfhi(w2.w)};
              const f32x4* cw = (const f32x4*)(P.conv_w + ((size_t)l * 4 + tap) * 1536 + col0);
#pragma unroll
              for (int q = 0; q < 4; ++q) { const f32x4 w = cw[q]; acc[4 * q] += xv[4 * q] * w.x; acc[4 * q + 1] += xv[4 * q + 1] * w.y; acc[4 * q + 2] += xv[4 * q + 2] * w.z; acc[4 * q + 3] += xv[4 * q + 3] * w.w; } } }
          float ss = 0.f;
#pragma unroll
          for (int i = 0; i < 16; ++i) { acc[i] = acc[i] * fast_sigmoid(acc[i]); ss += acc[i] * acc[i]; }
          if (part < 2) { ss += __shfl_xor(ss, 1); ss += __shfl_xor(ss, 2); ss += __shfl_xor(ss, 4); const float rn = __builtin_amdgcn_rsqf(ss + NORM_EPS) * (part == 0 ? 0.08838834764831845f : 1.0f);
#pragma unroll
              for (int i = 0; i < 16; ++i) acc[i] *= rn; }
          else {
#pragma unroll
              for (int i = 0; i < 16; ++i) acc[i] *= beta; }
          unsigned pk[8];
#pragma unroll
          for (int i = 0; i < 8; ++i) pk[i] = pk2(acc[2 * i], acc[2 * i + 1]);
          if (part < 2) { LAS bf16* dst = (part == 0 ? qs : ks) + t * 136 + c0; *(LAS u32x4*)dst = (u32x4){pk[0], pk[1], pk[2], pk[3]}; *(LAS u32x4*)(dst + 8) = (u32x4){pk[4], pk[5], pk[6], pk[7]}; }
          if (part >= 1) { LAS bf16* dT = part == 1 ? kT : vT;
#pragma unroll
              for (int i = 0; i < 8; ++i) { dT[(c0 + 2 * i) * 72 + t] = (bf16)(pk[i] & 0xffffu); dT[(c0 + 2 * i + 1) * 72 + t] = (bf16)(pk[i] >> 16); } }
      }
    }
    __syncthreads();
    if (F.wave == 0) { float x = tg[F.lane];
#pragma unroll
        for (int o = 1; o < 64; o <<= 1) { const float y = __shfl_up(x, o); if (F.lane >= o) x += y; }
        const float gl = __shfl(x, 63); tgc[F.lane] = x; const float e = __expf(x); teg[F.lane] = e; ted[F.lane] = __expf(gl - x); tsb[F.lane] = tbeta[F.lane] * e;
        if (F.lane == 0) ((float*)(P.ws + WS_CD))[task] = __expf(gl); }
    __syncthreads();
    if (F.wave < 4) { const int it = F.wave >> 1, jt = F.wave & 1; f32x16 acc = zero16();
        if (jt <= it) {
#pragma unroll
            for (int s = 0; s < 8; ++s) { const bf16x8 a = *(const LAS bf16x8*)(ks + (32 * it + lr) * 136 + 16 * s + 8 * h), bb = *(const LAS bf16x8*)(ks + (32 * jt + lr) * 136 + 16 * s + 8 * h); acc = MFMA32(a, bb, acc); } }
        const int j = 32 * jt + lr; const float gj = tgc[j];
#pragma unroll
        for (int rg = 0; rg < 16; ++rg) { const int i = 32 * it + crow(rg, h); const float v = i > j ? tbeta[i] * acc[rg] * __expf(tgc[i] - gj) : 0.f; Lm[i * 68 + j] = v; } }
    else { const int w4 = F.wave - 4, jt = w4 >> 1, ct = w4 & 1; f32x16 acc = zero16();
        if (jt <= ct) {
#pragma unroll
            for (int s = 0; s < 8; ++s) { const bf16x8 a = *(const LAS bf16x8*)(ks + (32 * jt + lr) * 136 + 16 * s + 8 * h), bb = *(const LAS bf16x8*)(qs + (32 * ct + lr) * 136 + 16 * s + 8 * h); acc = MFMA32(a, bb, acc); } }
        const int c = 32 * ct + lr; const float gcc = tgc[c];
#pragma unroll
        for (int rg = 0; rg < 16; ++rg) { const int jp = 32 * jt + crow(rg, h); acc[rg] = jp <= c ? acc[rg] * __expf(gcc - tgc[jp]) : 0.f; }
#pragma unroll
        for (int s = 0; s < 2; ++s) *(bf16x8*)(outb + DN_OFF_AT + ((ct * 4 + 2 * jt + s) * 64 + F.lane) * 16) = pack_step(acc, s); }
    __syncthreads();
    if (F.wave == 0) { LAS float* Tf = (LAS float*)(F.lds + 99840);
#pragma unroll 1
        for (int bi = 0; bi < 4; ++bi) { float rr[16];
#pragma unroll
            for (int ii = 0; ii < 16; ++ii) rr[ii] = (F.lane == 16 * bi + ii) ? 1.f : 0.f;
#pragma unroll 1
            for (int j = 0; j < 16 * bi; j += 4) { const float t0 = Tf[j * 64 + F.lane], t1 = Tf[(j + 1) * 64 + F.lane], t2 = Tf[(j + 2) * 64 + F.lane], t3 = Tf[(j + 3) * 64 + F.lane];
#pragma unroll
                for (int ii = 0; ii < 16; ++ii) { const f32x4 lv = *(const LAS f32x4*)(Lm + (16 * bi + ii) * 68 + j); rr[ii] -= (lv.x * t0 + lv.y * t1) + (lv.z * t2 + lv.w * t3); } }
#pragma unroll
            for (int ii = 0; ii < 16; ++ii) {
#pragma unroll
                for (int j4 = 0; j4 < ii; j4 += 4) { const f32x4 lv = *(const LAS f32x4*)(Lm + (16 * bi + ii) * 68 + 16 * bi + j4);
                    rr[ii] -= lv.x * rr[j4]; if (j4 + 1 < ii) rr[ii] -= lv.y * rr[j4 + 1]; if (j4 + 2 < ii) rr[ii] -= lv.z * rr[j4 + 2]; if (j4 + 3 < ii) rr[ii] -= lv.w * rr[j4 + 3]; }
                Tf[(16 * bi + ii) * 64 + F.lane] = rr[ii]; Tm[(16 * bi + ii) * 72 + F.lane] = (bf16)(pk2(rr[ii], 0.f) & 0xffffu); } } }
    else { for (int f = F.wave - 1; f < 32; f += 7) {
            if (f < 16) { const int mt = f >> 3, s = f & 7, c = 32 * mt + lr; const float e = teg[c];
                const u32x2 lo = *(const LAS u32x2*)(qs + c * 136 + 16 * s + 4 * h), hi = *(const LAS u32x2*)(qs + c * 136 + 16 * s + 8 + 4 * h);
                u32x4 o; o.x = pk2(bflo(lo.x) * e, bfhi(lo.x) * e); o.y = pk2(bflo(lo.y) * e, bfhi(lo.y) * e); o.z = pk2(bflo(hi.x) * e, bfhi(hi.x) * e); o.w = pk2(bflo(hi.y) * e, bfhi(hi.y) * e);
                *(u32x4*)(outb + DN_OFF_QD + ((mt * 8 + s) * 64 + F.lane) * 16) = o; }
            else { const int f2 = f - 16, dt = f2 >> 2, s = f2 & 3, d = 32 * dt + lr;
                const u32x2 lo = *(const LAS u32x2*)(kT + d * 72 + 16 * s + 4 * h), hi = *(const LAS u32x2*)(kT + d * 72 + 16 * s + 8 + 4 * h);
                const f32x4 e0 = *(const LAS f32x4*)(ted + 16 * s + 4 * h), e1 = *(const LAS f32x4*)(ted + 16 * s + 8 + 4 * h);
                u32x4 o; o.x = pk2(bflo(lo.x) * e0.x, bfhi(lo.x) * e0.y); o.y = pk2(bflo(lo.y) * e0.z, bfhi(lo.y) * e0.w); o.z = pk2(bflo(hi.x) * e1.x, bfhi(hi.x) * e1.y); o.w = pk2(bflo(hi.y) * e1.z, bfhi(hi.y) * e1.w);
                *(u32x4*)(outb + DN_OFF_KD + ((dt * 4 + s) * 64 + F.lane) * 16) = o; } } }
    __syncthreads();
    { const int it = F.wave >> 2, et = F.wave & 3; f32x16 acc = zero16();
#pragma unroll
      for (int s = 0; s < 4; ++s) { const bf16x8 a = *(const LAS bf16x8*)(Tm + (32 * it + lr) * 72 + 16 * s + 8 * h), bb = *(const LAS bf16x8*)(vT + (32 * et + lr) * 72 + 16 * s + 8 * h); acc = MFMA32(a, bb, acc); }
      u32x4 o0, o1; o0.x = pk2(acc[0], acc[1]); o0.y = pk2(acc[2], acc[3]); o0.z = pk2(acc[4], acc[5]); o0.w = pk2(acc[6], acc[7]); o1.x = pk2(acc[8], acc[9]); o1.y = pk2(acc[10], acc[11]); o1.z = pk2(acc[12], acc[13]); o1.w = pk2(acc[14], acc[15]);
      unsigned char* up = outb + DN_OFF_U + ((et * 2 + it) * 64 + F.lane) * 32; *(u32x4*)up = o0; *(u32x4*)(up + 16) = o1; }
    { const int dt = F.wave >> 1, it = F.wave & 1; f32x16 acc = zero16();
#pragma unroll
      for (int s = 0; s < 4; ++s) { const u32x4 kw = *(const LAS u32x4*)(kT + (32 * dt + lr) * 72 + 16 * s + 8 * h); const f32x4 e0 = *(const LAS f32x4*)(tsb + 16 * s + 8 * h), e1 = *(const LAS f32x4*)(tsb + 16 * s + 8 * h + 4);
          u32x4 aw; aw.x = pk2(bflo(kw.x) * e0.x, bfhi(kw.x) * e0.y); aw.y = pk2(bflo(kw.y) * e0.z, bfhi(kw.y) * e0.w); aw.z = pk2(bflo(kw.z) * e1.x, bfhi(kw.z) * e1.y); aw.w = pk2(bflo(kw.w) * e1.z, bfhi(kw.w) * e1.w);
          const bf16x8 bb = *(const LAS bf16x8*)(Tm + (32 * it + lr) * 72 + 16 * s + 8 * h); acc = MFMA32(__builtin_bit_cast(bf16x8, aw), bb, acc); }
#pragma unroll
      for (int s = 0; s < 2; ++s) *(bf16x8*)(outb + DN_OFF_W + ((it * 8 + 2 * dt + s) * 64 + F.lane) * 16) = pack_step(acc, s); }
    __syncthreads();
}
constexpr int SC_BUF = 49152;
__device__ __forceinline__ void dn_scan(const Frame& F, const Params& P, int bh) {
    const int b = bh >> 2, hd = bh & 3; const int es = F.wave;
    unsigned char* dn = P.ws + WS_DN; const float* cdv = (const float*)(P.ws + WS_CD);
#define task_of(n_) ((((b) * 128 + (n_)) << 2) | (hd))
#define SC_SRC(n_, i_) ((const u32x4*)(dn + (size_t)task_of(n_) * DN_TASK_BYTES + ((i_) < 4 ? 0 : ((i_) < 8 ? DN_OFF_KD - 16384 : DN_OFF_U - 32768))) + t4 + 256 * (i_))
    if (F.wave >= 4) {
        const int t4 = F.tid - 256; u32x4 R0[12], R1[12], R2[12];
        { LAS u32x4* dst = (LAS u32x4*)F.lds;
#pragma unroll
          for (int i = 0; i < 12; ++i) R0[i] = *SC_SRC(0, i);
#pragma unroll
          for (int i = 0; i < 12; ++i) dst[t4 + 256 * i] = R0[i]; }
#pragma unroll
        for (int i = 0; i < 12; ++i) { R0[i] = *SC_SRC(1, i); R1[i] = *SC_SRC(2, i); R2[i] = *SC_SRC(3, i); }
        __syncthreads();
#define SC_LSTEP(R, n_) if ((n_) < 128) { if ((n_) + 1 < 128) { LAS u32x4* dst = (LAS u32x4*)(F.lds + (((n_) + 1) & 1) * SC_BUF); \
            _Pragma("unroll") for (int i = 0; i < 12; ++i) dst[t4 + 256 * i] = R[i]; } \
            if ((n_) + 4 < 128) { _Pragma("unroll") for (int i = 0; i < 12; ++i) R[i] = *SC_SRC((n_) + 4, i); } \
            __syncthreads(); }
#pragma unroll 1
        for (int n = 0; n < 129; n += 3) { SC_LSTEP(R0, n) SC_LSTEP(R1, n + 1) SC_LSTEP(R2, n + 2) }
#undef SC_LSTEP
    } else {
        f32x16 S[4] = {zero16(), zero16(), zero16(), zero16()};
        float cd = cdv[task_of(0)];
        __syncthreads();
#pragma unroll 1
        for (int n = 0; n < 128; ++n) {
            const LAS unsigned char* cur = F.lds + (n & 1) * SC_BUF; unsigned char* tb = dn + (size_t)task_of(n) * DN_TASK_BYTES;
            const float cdn = cdv[task_of(n + 1 < 128 ? n + 1 : n)];
            bf16x8 Sb[8];
#pragma unroll
            for (int dt = 0; dt < 4; ++dt) { Sb[2 * dt] = pack_step(S[dt], 0); Sb[2 * dt + 1] = pack_step(S[dt], 1); }
            { unsigned char* hp = tb + (es < 2 ? 0 : DN_OFF_KD) + ((es & 1) * 8 * 64 + F.lane) * 16;
#pragma unroll
              for (int s = 0; s < 8; ++s) *(bf16x8*)(hp + s * 1024) = Sb[s]; }
            f32x16 Pw[2] = {zero16(), zero16()};
#pragma unroll
            for (int ct = 0; ct < 2; ++ct)
#pragma unroll
                for (int s = 0; s < 8; ++s) { const bf16x8 a = *(const LAS bf16x8*)(cur + ((ct * 8 + s) * 64 + F.lane) * 16); Pw[ct] = MFMA32(a, Sb[s], Pw[ct]); }
            bf16x8 Vb[4];
#pragma unroll
            for (int ct = 0; ct < 2; ++ct) { const LAS u32x4* up = (const LAS u32x4*)(cur + 32768 + ((es * 2 + ct) * 64 + F.lane) * 32); const u32x4 u0 = up[0], u1 = up[1];
                const unsigned uw[8] = {u0.x, u0.y, u0.z, u0.w, u1.x, u1.y, u1.z, u1.w}; f32x16 v;
#pragma unroll
                for (int p = 0; p < 8; ++p) { v[2 * p] = bflo(uw[p]) - Pw[ct][2 * p]; v[2 * p + 1] = bfhi(uw[p]) - Pw[ct][2 * p + 1]; }
                Vb[2 * ct] = pack_step(v, 0); Vb[2 * ct + 1] = pack_step(v, 1); }
            { unsigned char* vp = tb + DN_OFF_U + (es * 4 * 64 + F.lane) * 16;
#pragma unroll
              for (int s = 0; s < 4; ++s) *(bf16x8*)(vp + s * 1024) = Vb[s]; }
#pragma unroll
            for (int dt = 0; dt < 4; ++dt) { S[dt] = S[dt] * cd;
#pragma unroll
                for (int s = 0; s < 4; ++s) { const bf16x8 a = *(const LAS bf16x8*)(cur + 16384 + ((dt * 4 + s) * 64 + F.lane) * 16); S[dt] = MFMA32(a, Vb[s], S[dt]); } }
            cd = cdn;
            __syncthreads();
        }
    }
#undef SC_SRC
#undef task_of
}
__device__ __forceinline__ void dn_out_task(const Frame& F, const Params& P, int l, int task) {
    const int hd = task & 3, cbn = task >> 2, m0 = cbn * 64; const int lr = F.lane & 31, h = F.lane >> 5, ct = F.wave >> 2, es = F.wave & 3;
    const unsigned char* tb = P.ws + WS_DN + (size_t)task * DN_TASK_BYTES; bf16* brc = (bf16*)(P.ws + WS_BR) + (size_t)2 * TT * 512; const bf16* z = (const bf16*)(P.ws + WS_Z);
    LAS float* ssq = (LAS float*)F.lds;
    f32x16 o = zero16();
    { const unsigned char* hp = tb + (es < 2 ? 0 : DN_OFF_KD) + ((es & 1) * 8 * 64 + F.lane) * 16;
#pragma unroll
      for (int s = 0; s < 8; ++s) { const bf16x8 a = *(const bf16x8*)(tb + DN_OFF_QD + ((ct * 8 + s) * 64 + F.lane) * 16), bb = *(const bf16x8*)(hp + s * 1024); o = MFMA32(a, bb, o); }
      const unsigned char* vp = tb + DN_OFF_U + (es * 4 * 64 + F.lane) * 16;
#pragma unroll
      for (int s = 0; s < 4; ++s) { const bf16x8 a = *(const bf16x8*)(tb + DN_OFF_AT + ((ct * 4 + s) * 64 + F.lane) * 16), bb = *(const bf16x8*)(vp + s * 1024); o = MFMA32(a, bb, o); } }
    float q[16];
#pragma unroll
    for (int rg = 0; rg < 16; ++rg) { float v = o[rg] * o[rg]; v += __shfl_xor(v, 1); v += __shfl_xor(v, 2); v += __shfl_xor(v, 4); v += __shfl_xor(v, 8); v += __shfl_xor(v, 16); q[rg] = v; }
    if (lr == 0) {
#pragma unroll
        for (int rg = 0; rg < 16; ++rg) ssq[(ct * 4 + es) * 32 + crow(rg, h)] = q[rg]; }
    __syncthreads();
    const int e = hd * 128 + es * 32 + lr; const float gn = P.dn_norm[l * 128 + es * 32 + lr];
#pragma unroll
    for (int rg = 0; rg < 16; ++rg) { const int r = crow(rg, h); const float tot = (ssq[(ct * 4 + 0) * 32 + r] + ssq[(ct * 4 + 1) * 32 + r]) + (ssq[(ct * 4 + 2) * 32 + r] + ssq[(ct * 4 + 3) * 32 + r]);
        const float rs = __builtin_amdgcn_rsqf(tot * (1.f / 128.f) + NORM_EPS); const size_t idx = (size_t)(m0 + 32 * ct + r) * 512 + e;
        const float zz = __uint_as_float(((unsigned)z[idx]) << 16); brc[idx] = (bf16)(pk2(o[rg] * rs * gn * (zz * fast_sigmoid(zz)), 0.f) & 0xffffu); }
    __syncthreads();
}
__device__ __forceinline__ void final_norm(const Frame& F, const Params& P) {
    const int gw = F.vb * NWAVES + F.wave, NGW = F.G * NWAVES; const float* rowsq = (const float*)(P.ws + WS_ROWSQ);
    f32x4 gn[4];
#pragma unroll
    for (int j = 0; j < 4; ++j) gn[j] = ((const f32x4*)P.final_norm)[F.lane + 64 * j];
    for (int m = gw; m < TT; m += NGW) { float sq = F.lane < 16 ? rowsq[(size_t)m * 16 + F.lane] : 0.f; sq = wave_sum(sq); const float rs = __builtin_amdgcn_rsqf(sq * (1.f / 1024.f) + NORM_EPS);
        f32x4* xr = (f32x4*)(P.out + (size_t)m * DM) + F.lane;
#pragma unroll
        for (int j = 0; j < 4; ++j) xr[64 * j] = xr[64 * j] * rs * gn[j]; }
}

#define RLX_AGENT __ATOMIC_RELAXED, __HIP_MEMORY_SCOPE_AGENT
#define XB_TMO      128
#define XB_XCNT(j)  (256  + 64 * (j))
#define XB_XSUB(j)  (1280 + 64 * (j))
#define XB_XGEN(j)  (2304 + 64 * (j))
#define XB_TOP      3328
#define XB_TOPGEN   3392
#define XCD_BAR_WORDS 3456
#define XB_SPIN_CAP (1u << 18)

__device__ __forceinline__ unsigned xb_ld(unsigned* p)              { return __hip_atomic_load(p, __ATOMIC_RELAXED, __HIP_MEMORY_SCOPE_AGENT); }
__device__ __forceinline__ unsigned xb_add(unsigned* p, unsigned v) { return __hip_atomic_fetch_add(p, v, __ATOMIC_RELAXED, __HIP_MEMORY_SCOPE_AGENT); }
__device__ __forceinline__ unsigned xb_xcc_id() { return (unsigned)__builtin_amdgcn_s_getreg((3 << 11) | 20) & 0xFu; }
#define XB_SPIN(cond, bar) do { unsigned _sp = 0; while (cond) { __builtin_amdgcn_s_sleep(1); \
    if ((++_sp & 255u) == 0u) { if (xb_ld(&(bar)[XB_TMO])) break; if (_sp > XB_SPIN_CAP) { atomicAdd(&(bar)[XB_TMO], 1u); break; } } } } while (0)

struct XcdBarrier {
    unsigned* bar; unsigned x;
    volatile LAS unsigned* st;
};

__device__ __forceinline__ XcdBarrier xcd_barrier_post(unsigned* bar, volatile LAS unsigned* st) {
    XcdBarrier b; b.bar = bar; b.x = xb_xcc_id(); b.st = st;
    if (threadIdx.x == 0) (void)xb_add(&bar[XB_XCNT(b.x)], 1u);
    return b;
}
__device__ __forceinline__ void xcd_barrier_complete(unsigned* bar, unsigned x, unsigned& nloc, unsigned& nx) {
    const unsigned G = gridDim.x * gridDim.y * gridDim.z;
    unsigned sum, cnt, mine, sp = 0u;
    for (;;) {
        sum = 0u; cnt = 0u; mine = 0u;
#pragma unroll
        for (unsigned j = 0; j < 16; ++j) { const unsigned c = xb_ld(&bar[XB_XCNT(j)]); sum += c; cnt += (c > 0u) ? 1u : 0u; mine = (j == x) ? c : mine; }
        if (sum == G) break;
        __builtin_amdgcn_s_sleep(1);
        if ((++sp & 255u) == 0u) { if (xb_ld(&bar[XB_TMO])) break; if (sp > XB_SPIN_CAP) { atomicAdd(&bar[XB_TMO], 1u); break; } }
    }
    nloc = mine > 0u ? mine : 1u; nx = cnt > 0u ? cnt : 1u;
}

__device__ __forceinline__ void xcd_barrier(const XcdBarrier& b) {
    asm volatile("s_waitcnt vmcnt(0)" ::: "memory");
    __syncthreads();
    if (threadIdx.x == 0) {
        unsigned* bar = b.bar;
        __builtin_amdgcn_s_waitcnt(0);
        unsigned nloc = b.st[0], nx = b.st[1];
        if (nloc == 0u) { xcd_barrier_complete(bar, b.x, nloc, nx); b.st[0] = nloc; b.st[1] = nx; }
        const unsigned old = xb_add(&bar[XB_XSUB(b.x)], 1u);
        const unsigned gen = old / nloc;
        if (old + 1u == (gen + 1u) * nloc) {
            __builtin_amdgcn_fence(__ATOMIC_RELEASE, "agent");
            asm volatile("s_waitcnt vmcnt(0)" ::: "memory");
            const unsigned og = xb_add(&bar[XB_TOP], 1u);
            const unsigned tg = og / nx;
            if (og + 1u == (tg + 1u) * nx) xb_add(&bar[XB_TOPGEN], 1u);
            else XB_SPIN(xb_ld(&bar[XB_TOPGEN]) == tg, bar);
            __builtin_amdgcn_fence(__ATOMIC_ACQUIRE, "agent");
            xb_add(&bar[XB_XGEN(b.x)], 1u);
            asm volatile("s_waitcnt vmcnt(0)" ::: "memory");
        } else {
            XB_SPIN(xb_ld(&bar[XB_XGEN(b.x)]) == gen, bar);
            __builtin_amdgcn_fence(__ATOMIC_ACQUIRE, "agent");
            asm volatile("s_waitcnt vmcnt(0)" ::: "memory");
        }
    }
    __syncthreads();
}

constexpr int PH_PER_LAYER = 9, N_PHASES = DEPTH * PH_PER_LAYER + 1;
__device__ __forceinline__ void run_phase(const Frame& F0, const Params& P0, int ph, int sub = 0) {
    Frame F = F0; Params P = P0; asm volatile("" : "+v"(F.tid)); F.lane = F.tid & 63; F.wave = __builtin_amdgcn_readfirstlane(F.tid >> 6); asm volatile("" : "+s"(P.ws));
    const int l = ph / PH_PER_LAYER, k = ph % PH_PER_LAYER;
    unsigned char* ws = P.ws; const float* rowsq = (const float*)(ws + WS_ROWSQ); const LAS float* lrs = (const LAS float*)(F.lds + pg8::LRS_OFF);
    if (ph == N_PHASES - 1) { final_norm(F, P); return; }
#ifdef ONLY_K
    if (k != ONLY_K) return;
#endif
    switch (k) {
    case 0: p0_attn_weights(F, P, l); if (l == 0) p0_input(F, P); break;
    case 1: { p1_ba(F, P); __syncthreads();
        pg8::Gemm g{(const pg8::bf16_t*)(ws + WS_XB), (const pg8::bf16_t*)(ws + WS_WIN), TT, NMIX, DM}; pg8::StaticOrder S; S.init(TT, NMIX, F.G, (int)blockIdx.x);
        pg8::EpiProj E{(pg8::bf16_t*)(ws + WS_UV), (pg8::bf16_t*)(ws + WS_QKVB), (pg8::bf16_t*)(ws + WS_QKVC), (pg8::bf16_t*)(ws + WS_Z), lrs};
        pg8::prep_rstd(F.lds, S, rowsq);
        pg8::gemm_phase<pg8::EpiProj, pg8::StaticOrder, true, true>(F.lds, g, S, E); } break;
    case 2: for (int t = F.vb; t < 1024; t += F.G) dn_pre_task(F, P, l, t); break;
    case 3: { const int sb = (int)blockIdx.x; if (sb < 8) { if (!(sub & 2)) dn_scan(F, P, sb); }
              else if (!(sub & 1)) { const int nb = F.G - 8; for (int t = sb - 8; t < 768; t += nb) { if (t < 256) { if (!(sub & 4)) swa_task(F, P, l, t); } else if (!(sub & 8)) sgu_task(F, P, l, t - 256); } } } break;
    case 4: for (int t = F.vb; t < 1024; t += F.G) dn_out_task(F, P, l, t); p0_ffn_weights(F, P, l); break;
    case 5: {
#pragma unroll 1
        for (int n = 0; n < 3; ++n) {
            { pg8::Gemm g{(const pg8::bf16_t*)(ws + WS_XB), (const pg8::bf16_t*)(ws + WS_WG) + (size_t)n * 1024 * 1024, TT, DM, DM}; pg8::StaticOrder S; S.init(TT, DM, F.G, (int)blockIdx.x);
              pg8::EpiSig E{(pg8::bf16_t*)(ws + WS_UV), lrs}; if (n == 0) pg8::prep_rstd(F.lds, S, rowsq); pg8::gemm_phase<pg8::EpiSig, pg8::StaticOrder, true, true>(F.lds, g, S, E); }
            __syncthreads();
            { pg8::Gemm g{(const pg8::bf16_t*)(ws + WS_BR) + (size_t)n * TT * 512, (const pg8::bf16_t*)(ws + WS_WBR) + (size_t)n * 1024 * 512, TT, DM, 512}; pg8::StaticOrder S; S.init(TT, DM, F.G, (int)blockIdx.x);
              if (n == 0) { pg8::EpiMerge<0> E{(pg8::bf16_t*)(ws + WS_UV), (float*)(ws + WS_DN)}; pg8::gemm_phase<pg8::EpiMerge<0>, pg8::StaticOrder, true, true>(F.lds, g, S, E); }
              else if (n == 1) { pg8::EpiMerge<1> E{(pg8::bf16_t*)(ws + WS_UV), (float*)(ws + WS_DN)}; pg8::gemm_phase<pg8::EpiMerge<1>, pg8::StaticOrder, true, true>(F.lds, g, S, E); }
              else { pg8::EpiMerge<2> E{(pg8::bf16_t*)(ws + WS_UV), (float*)(ws + WS_DN)}; pg8::gemm_phase<pg8::EpiMerge<2>, pg8::StaticOrder, true, true>(F.lds, g, S, E); } }
            __syncthreads();
        } } break;
    case 6: { pg8::Gemm g{(const pg8::bf16_t*)(ws + WS_UV), (const pg8::bf16_t*)(ws + WS_WOUT), TT, DM, DM}; pg8::StaticOrder S; S.init(TT, DM, F.G, (int)blockIdx.x);
        pg8::EpiResid E{l == 0 ? P.x : P.out, P.out, (pg8::bf16_t*)(ws + WS_XB), (float*)(ws + WS_ROWSQ)}; pg8::gemm_phase<pg8::EpiResid, pg8::StaticOrder, true, true>(F.lds, g, S, E); } break;
    case 7: { pg8::Gemm g{(const pg8::bf16_t*)(ws + WS_XB), (const pg8::bf16_t*)(ws + WS_WGU), TT, 2 * DFF, DM}; pg8::StaticOrder S; S.init(TT, 2 * DFF, F.G, (int)blockIdx.x);
        pg8::EpiGU E{(pg8::bf16_t*)(ws + WS_HID), lrs}; pg8::prep_rstd(F.lds, S, rowsq); pg8::gemm_phase<pg8::EpiGU, pg8::StaticOrder, true, true>(F.lds, g, S, E); } break;
    case 8: { pg8::Gemm g{(const pg8::bf16_t*)(ws + WS_HID), (const pg8::bf16_t*)(ws + WS_WDN), TT, DM, DFF}; pg8::StaticOrder S; S.init(TT, DM, F.G, (int)blockIdx.x);
        pg8::EpiResid E{P.out, P.out, (pg8::bf16_t*)(ws + WS_XB), (float*)(ws + WS_ROWSQ)}; pg8::gemm_phase<pg8::EpiResid, pg8::StaticOrder, true, true>(F.lds, g, S, E); } break;
    }
}

__global__ void __launch_bounds__(NTHR, 2) hgpm_fwd(Params P) {
    extern __shared__ __attribute__((aligned(16))) unsigned char lds_raw[];
    Frame F; F.lds = (LAS unsigned char*)lds_raw; F.tid = threadIdx.x; F.lane = F.tid & 63; F.wave = __builtin_amdgcn_readfirstlane(F.tid >> 6);
    F.G = gridDim.x; { const int bx = blockIdx.x; F.vb = (F.G % 8 == 0) ? (bx % 8) * (F.G / 8) + bx / 8 : bx; }
#if USE_CG_SYNC
    cg::grid_group grid = cg::this_grid();
#define GRID_SYNC() grid.sync()
#else
    volatile LAS unsigned* misc = (volatile LAS unsigned*)(F.lds + MISC_OFF);
    if (F.tid < 64) misc[F.tid] = 0u;
    __syncthreads();
    const XcdBarrier bar = xcd_barrier_post((unsigned*)(P.ws + WS_CTL) + 1024, misc + 8);
#define GRID_SYNC() xcd_barrier(bar)
#endif
    for (int ph = P.ph_lo; ph < P.ph_hi; ++ph) {
        run_phase(F, P, ph);
#ifdef DUPK
#ifndef DUPSUB
#define DUPSUB 0
#endif
        if (ph % PH_PER_LAYER == DUPK && ph != N_PHASES - 1) { GRID_SYNC(); run_phase(F, P, ph, DUPSUB); }
#endif
        if (ph + 1 < P.ph_hi) GRID_SYNC();
    }
}

#ifndef N_LAUNCH_MODE
#define N_LAUNCH_MODE 0
#endif
extern "C" void kernel_launch(void* const* d_in, const int* in_sizes, int n_in, void* d_out, int out_size, void* d_ws, size_t ws_size, hipStream_t stream) {
    static int grid = 0;
    if (grid == 0) {
        if (n_in != 19 || in_sizes[0] != TT * DM || out_size != TT * DM || ws_size < WS_END) { fprintf(stderr, "kernel_launch: unexpected shapes (n_in %d, in0 %d, out %d, ws %zu)\n", n_in, n_in > 0 ? in_sizes[0] : -1, out_size, ws_size); grid = -1; return; }
        int dev = 0, cus = 0, per_cu = 0;
        if (hipGetDevice(&dev) != hipSuccess || hipDeviceGetAttribute(&cus, hipDeviceAttributeMultiprocessorCount, dev) != hipSuccess) { grid = -1; return; }
        if (hipFuncSetAttribute((const void*)hgpm_fwd, hipFuncAttributeMaxDynamicSharedMemorySize, LDS_BYTES) != hipSuccess) { fprintf(stderr, "kernel_launch: hipFuncSetAttribute failed\n"); grid = -1; return; }
        if (hipOccupancyMaxActiveBlocksPerMultiprocessor(&per_cu, (const void*)hgpm_fwd, NTHR, LDS_BYTES) != hipSuccess || per_cu < 1) { fprintf(stderr, "kernel_launch: occupancy query says %d blocks per CU\n", per_cu); per_cu = 1; }
        (void)hipGetLastError();
        grid = cus;
    }
    if (grid < 0) return;
    Params p{};
    p.x = (const float*)d_in[0]; p.pos = (const int*)d_in[1]; p.attn_norm = (const float*)d_in[2]; p.w_in = (const float*)d_in[3]; p.sgu_ln_g = (const float*)d_in[4]; p.sgu_ln_b = (const float*)d_in[5];
    p.sgu_w = (const float*)d_in[6]; p.sgu_b = (const float*)d_in[7]; p.sinks = (const float*)d_in[8]; p.conv_w = (const float*)d_in[9]; p.a_log = (const float*)d_in[10]; p.dt_bias = (const float*)d_in[11];
    p.dn_norm = (const float*)d_in[12]; p.w_branch = (const float*)d_in[13]; p.w_out = (const float*)d_in[14]; p.ffn_norm = (const float*)d_in[15]; p.w_gate_up = (const float*)d_in[16]; p.w_down = (const float*)d_in[17];
    p.final_norm = (const float*)d_in[18]; p.out = (float*)d_out; p.ws = (unsigned char*)d_ws;
#if N_LAUNCH_MODE == 0
    p.ph_lo = 0; p.ph_hi = N_PHASES;
#if USE_CG_SYNC
    void* args[] = {&p};
    hipError_t e = hipLaunchCooperativeKernel((const void*)hgpm_fwd, dim3(grid), dim3(NTHR), args, LDS_BYTES, stream);
    if (e != hipSuccess) fprintf(stderr, "kernel_launch: cooperative launch failed: %s (grid %d)\n", hipGetErrorString(e), grid);
#else
    if (hipMemsetAsync((char*)d_ws + WS_CTL, 0, CTL_ZERO_BYTES, stream) != hipSuccess) { fprintf(stderr, "kernel_launch: hipMemsetAsync failed\n"); return; }
    hipLaunchKernelGGL(hgpm_fwd, dim3(grid), dim3(NTHR), LDS_BYTES, stream, p);
#endif
#else
    for (int ph = 0; ph < N_PHASES; ++ph) { p.ph_lo = ph; p.ph_hi = ph + 1; hipLaunchKernelGGL(hgpm_fwd, dim3(grid), dim3(NTHR), LDS_BYTES, stream, p); }
#endif
}
```

```cpp
#include <hip/hip_runtime.h>
#include <hip/hip_cooperative_groups.h>
#include <cstdio>
#include <cstdint>
namespace cg = cooperative_groups;
namespace pg8 {
#define PG8_LAS __attribute__((address_space(3)))
typedef unsigned short bf16_t;
typedef short bf16x8 __attribute__((ext_vector_type(8)));
typedef float f32x4 __attribute__((ext_vector_type(4)));
typedef unsigned u32x4 __attribute__((ext_vector_type(4)));
constexpr int BM = 256, BK = 64, HALF = 128, HTB = HALF * BK * 2  , STAGE_BYTES = 8 * HTB, NXCD = 8, WGM = 8;

__host__ __device__ __forceinline__ int lds_byte(int r, int c) { const int st = (r >> 4) * 2 + (c >> 5), rr = r & 15, cc = c & 31, ob = rr * 64 + cc * 2; return st * 1024 + (ob ^ (((ob >> 9) & 1) << 5)); }
__host__ __device__ __forceinline__ void stage_rc(int b, int& R, int& C) { const int st = b / 1024, sb = b % 1024, swz = sb ^ (((sb >> 9) & 1) << 5); R = (st >> 1) * 16 + swz / 64; C = (st & 1) * 32 + (swz % 64) / 2; }
__host__ __device__ __forceinline__ int perm32(int rho) { const int n = rho >> 4, i = rho & 15; return 8 * (i >> 2) + 4 * n + (i & 3); }

struct Unit { int pm, pn, idx; };
struct Gemm { const bf16_t* A; const bf16_t* Bt; int M, N, K; };

struct StaticOrder {
    int nM, nN, nwg, G, c;
    __host__ __device__ void init(int M, int N, int G_, int c_) { nM = M / BM; nN = N / BM; nwg = nM * nN; G = G_; c = c_; }
    __host__ __device__ bool next(int i, Unit& u) const {
        const long L = (long)i * G + c; if (L >= nwg) return false;
        int wgid = (int)L; { const int q = nwg / NXCD, r = nwg % NXCD, xcd = wgid % NXCD, off = wgid / NXCD; wgid = (xcd < r ? xcd * (q + 1) : r * (q + 1) + (xcd - r) * q) + off; }
        const int nig = WGM * nN, gid = wgid / nig, fm = gid * WGM, gsz = (nM - fm) < WGM ? (nM - fm) : WGM;
        u.pm = fm + ((wgid % nig) % gsz); u.pn = (wgid % nig) / gsz; u.idx = i; return true;
    }
    __device__ __forceinline__ void a_ready(const Unit&) const {}
    __device__ __forceinline__ void done(const Unit&) const {}
};

typedef float f32x2 __attribute__((ext_vector_type(2)));
typedef __bf16 bf16v2 __attribute__((ext_vector_type(2)));
typedef unsigned u32x2 __attribute__((ext_vector_type(2)));
__device__ __forceinline__ unsigned pk2(float lo, float hi) { f32x2 v = {lo, hi}; bf16v2 r = __builtin_convertvector(v, bf16v2); return __builtin_bit_cast(unsigned, r); }
__device__ __forceinline__ float bflo(unsigned w) { return __uint_as_float(w << 16); }
__device__ __forceinline__ float bfhi(unsigned w) { return __uint_as_float(w & 0xffff0000u); }
__device__ __forceinline__ float fast_sigmoid(float x) { return __builtin_amdgcn_rcpf(1.0f + __expf(-x)); }
__device__ __forceinline__ float gelu_tanh(float x) { const float u = 1.5957691216f * (x + 0.044715f * x * x * x); return x * fast_sigmoid(u); }
constexpr float NORM_EPS = 1e-6f;
__device__ __forceinline__ float row_rstd(const float* rowsq, int row) {
    const f32x4* p = (const f32x4*)(rowsq + (size_t)row * 16); const f32x4 a = p[0], b = p[1], c = p[2], d = p[3];
    const float s = ((a.x + a.y) + (a.z + a.w)) + ((b.x + b.y) + (b.z + b.w)) + ((c.x + c.y) + (c.z + c.w)) + ((d.x + d.y) + (d.z + d.w));
    return __builtin_amdgcn_rsqf(s * (1.0f / 1024.0f) + NORM_EPS);
}
constexpr int LRS_OFF = STAGE_BYTES, LRS_MAX_UNITS = 8;
template <class Sched> __device__ __forceinline__ void prep_rstd(PG8_LAS unsigned char* lds, const Sched& S, const float* rowsq) {
    PG8_LAS float* t = (PG8_LAS float*)(lds + LRS_OFF); Unit u;
#pragma unroll 1
    for (int i = 0; i < LRS_MAX_UNITS; ++i) { if (!S.next(i, u)) break; if (threadIdx.x < 256) t[i * 256 + threadIdx.x] = row_rstd(rowsq, u.pm * BM + threadIdx.x); asm volatile("" ::: "memory"); }
    __syncthreads();
}
struct EpiProj {
    static constexpr bool PERM = true, AFTER_DRAIN = false;
    bf16_t *uv, *qkvb, *qkvc, *z; const PG8_LAS float* lrs;
    __device__ __forceinline__ void operator()(const f32x4 (&acc)[2][2][4][2], const Unit& u, int wr, int wc, int fr, int fq) const {
        const int pn = u.pn; bf16_t* base; int ldc, colt; bool act = false;
        if (pn < 4) { base = uv; ldc = 1024; colt = pn * 256; act = true; }
        else if (pn < 7) { base = qkvb; ldc = 768; colt = (pn - 4) * 256; }
        else if (pn < 13) { base = qkvc; ldc = 1536; colt = (pn - 7) * 256; }
        else { base = z; ldc = 512; colt = (pn - 13) * 256; }
        const int row0 = u.pm * BM + wr * 64 + fr, col0 = colt + wc * 32 + 8 * fq;
#pragma unroll
        for (int ai = 0; ai < 2; ++ai)
#pragma unroll
            for (int m = 0; m < 4; ++m) { const int row = row0 + ai * HALF + m * 16; const float rs = lrs[u.idx * 256 + (row - u.pm * BM)]; bf16_t* rowp = base + (size_t)row * ldc + col0;
#pragma unroll
                for (int bj = 0; bj < 2; ++bj) { f32x4 v0 = acc[ai][bj][m][0] * rs, v1 = acc[ai][bj][m][1] * rs;
                    if (act) {
#pragma unroll
                        for (int j = 0; j < 4; ++j) { v0[j] = gelu_tanh(v0[j]); v1[j] = gelu_tanh(v1[j]); } }
                    u32x4 w; w.x = pk2(v0[0], v0[1]); w.y = pk2(v0[2], v0[3]); w.z = pk2(v1[0], v1[1]); w.w = pk2(v1[2], v1[3]);
                    *(u32x4*)(rowp + bj * HALF) = w; } }
    }
};
struct EpiSig {
    static constexpr bool PERM = true, AFTER_DRAIN = false;
    bf16_t* sig; const PG8_LAS float* lrs;
    __device__ __forceinline__ void operator()(const f32x4 (&acc)[2][2][4][2], const Unit& u, int wr, int wc, int fr, int fq) const {
        const int row0 = u.pm * BM + wr * 64 + fr, col0 = u.pn * BM + wc * 32 + 8 * fq;
#pragma unroll
        for (int ai = 0; ai < 2; ++ai)
#pragma unroll
            for (int m = 0; m < 4; ++m) { const int row = row0 + ai * HALF + m * 16; const float rs = lrs[u.idx * 256 + (row - u.pm * BM)]; bf16_t* rowp = sig + (size_t)row * 1024 + col0;
#pragma unroll
                for (int bj = 0; bj < 2; ++bj) { f32x4 v0 = acc[ai][bj][m][0] * rs, v1 = acc[ai][bj][m][1] * rs;
#pragma unroll
                    for (int j = 0; j < 4; ++j) { v0[j] = fast_sigmoid(v0[j]); v1[j] = fast_sigmoid(v1[j]); }
                    u32x4 w; w.x = pk2(v0[0], v0[1]); w.y = pk2(v0[2], v0[3]); w.z = pk2(v1[0], v1[1]); w.w = pk2(v1[2], v1[3]);
                    *(u32x4*)(rowp + bj * HALF) = w; } }
    }
};
template <int MODE> struct EpiMerge {
    static constexpr bool PERM = true, AFTER_DRAIN = false;
    bf16_t* sig; float* mf;
    __device__ __forceinline__ void operator()(const f32x4 (&acc)[2][2][4][2], const Unit& u, int wr, int wc, int fr, int fq) const {
        const int row0 = u.pm * BM + wr * 64 + fr, col0 = u.pn * BM + wc * 32 + 8 * fq;
#pragma unroll
        for (int ai = 0; ai < 2; ++ai)
#pragma unroll
            for (int m = 0; m < 4; ++m) { const size_t off = (size_t)(row0 + ai * HALF + m * 16) * 1024 + col0;
#pragma unroll
                for (int bj = 0; bj < 2; ++bj) { const u32x4 s = *(const u32x4*)(sig + off + bj * HALF);
                    f32x4 v0 = acc[ai][bj][m][0], v1 = acc[ai][bj][m][1];
                    v0[0] *= bflo(s.x); v0[1] *= bfhi(s.x); v0[2] *= bflo(s.y); v0[3] *= bfhi(s.y); v1[0] *= bflo(s.z); v1[1] *= bfhi(s.z); v1[2] *= bflo(s.w); v1[3] *= bfhi(s.w);
                    float* mp = mf + off + bj * HALF;
                    if (MODE >= 1) { v0 += *(const f32x4*)mp; v1 += *(const f32x4*)(mp + 4); }
                    if (MODE <= 1) { *(f32x4*)mp = v0; *(f32x4*)(mp + 4) = v1; }
                    else { u32x4 w; w.x = pk2(v0[0], v0[1]); w.y = pk2(v0[2], v0[3]); w.z = pk2(v1[0], v1[1]); w.w = pk2(v1[2], v1[3]); *(u32x4*)(sig + off + bj * HALF) = w; } } }
    }
};
struct EpiResid {
    static constexpr bool PERM = false, AFTER_DRAIN = false;
    const float* xin; float* xout; bf16_t* xb; float* rowsq;
    __device__ __forceinline__ void operator()(const f32x4 (&acc)[2][2][4][2], const Unit& u, int wr, int wc, int fr, int fq) const {
        const int row0 = u.pm * BM + wr * 64 + fr, col0 = u.pn * BM + wc * 32 + 4 * fq;
#pragma unroll
        for (int ai = 0; ai < 2; ++ai)
#pragma unroll
            for (int m = 0; m < 4; ++m) { const int row = row0 + ai * HALF + m * 16; const size_t off = (size_t)row * 1024 + col0; float ss = 0.f;
#pragma unroll
                for (int bj = 0; bj < 2; ++bj)
#pragma unroll
                    for (int n = 0; n < 2; ++n) { const size_t o = off + bj * HALF + n * 16; const f32x4 v = *(const f32x4*)(xin + o) + acc[ai][bj][m][n];
                        *(f32x4*)(xout + o) = v; u32x2 w; w.x = pk2(v[0], v[1]); w.y = pk2(v[2], v[3]); *(u32x2*)(xb + o) = w;
                        ss += (v[0] * v[0] + v[1] * v[1]) + (v[2] * v[2] + v[3] * v[3]); }
                ss += __shfl_xor(ss, 16); ss += __shfl_xor(ss, 32);
                if (fq == 0) rowsq[(size_t)row * 16 + u.pn * 4 + wc] = ss; }
    }
};
struct EpiGU {
    static constexpr bool PERM = true, AFTER_DRAIN = false;
    bf16_t* hid; const PG8_LAS float* lrs;
    __device__ __forceinline__ void operator()(const f32x4 (&acc)[2][2][4][2], const Unit& u, int wr, int wc, int fr, int fq) const {
        const int row0 = u.pm * BM + wr * 64 + fr, col0 = u.pn * HALF + wc * 32 + 8 * fq;
#pragma unroll
        for (int ai = 0; ai < 2; ++ai)
#pragma unroll
            for (int m = 0; m < 4; ++m) { const int row = row0 + ai * HALF + m * 16; const float rs = lrs[u.idx * 256 + (row - u.pm * BM)];
                float o[8];
#pragma unroll
                for (int n = 0; n < 2; ++n)
#pragma unroll
                    for (int j = 0; j < 4; ++j) { const float g = acc[ai][0][m][n][j] * rs, up = acc[ai][1][m][n][j] * rs; o[n * 4 + j] = g * fast_sigmoid(g) * up; }
                u32x4 w; w.x = pk2(o[0], o[1]); w.y = pk2(o[2], o[3]); w.z = pk2(o[4], o[5]); w.w = pk2(o[6], o[7]);
                *(u32x4*)(hid + (size_t)row * 2816 + col0) = w; }
    }
};

template <class Epi, class Sched, bool ALIGN_EPI = false, bool SP2 = false>
__device__ __forceinline__ void gemm_phase(PG8_LAS unsigned char* lds, const Gemm g, const Sched& S, const Epi& E) {
    int tid_ = threadIdx.x; asm volatile("" : "+v"(tid_));
    const int tid = tid_, wid = __builtin_amdgcn_readfirstlane(tid >> 6), lane = tid & 63, wr = wid >> 2, wc = wid & 3, fr = lane & 15, fq = lane >> 4;
    const int K = g.K, nt = K / BK;
    unsigned voffA[2], voffB[2];
#pragma unroll
    for (int i = 0; i < 2; ++i) { int R, C; stage_rc(tid * 16 + i * 8192, R, C); const int Rb = Epi::PERM ? ((R & ~31) + perm32(R & 31)) : R;
        voffA[i] = (unsigned)(R * K + C) * 2u; voffB[i] = (unsigned)(Rb * K + C) * 2u; }
    const size_t kstep = (size_t)(BK * 2);
    const size_t hstep = (size_t)HALF * K * 2;
    const size_t tstep = 2 * hstep;
    const unsigned ldsw = (unsigned)wid * 1024u;
    const int aoff = lds_byte(wr * 64 + fr, fq * 8), boff = lds_byte(wc * 32 + fr, fq * 8);
#define PG8_SA(b, h) (((b) * 2 + (h)) * HTB)
#define PG8_SB(b, h) ((4 + (b) * 2 + (h)) * HTB)
#define PG8_STAGE(bufoff, gbase, voff) do { _Pragma("unroll") for (int _i = 0; _i < 2; ++_i) \
        __builtin_amdgcn_global_load_lds((const unsigned*)((const char*)(gbase) + (voff)[_i]), (PG8_LAS unsigned*)(lds + (bufoff) + ldsw + _i * 8192), 16, 0, 0); } while (0)
#define PG8_LDA(dst, b, h) do { _Pragma("unroll") for (int m = 0; m < 4; ++m) _Pragma("unroll") for (int k = 0; k < 2; ++k) dst[m][k] = *(const PG8_LAS bf16x8*)(lds + PG8_SA(b, h) + aoff + m * 2048 + k * 1024); } while (0)
#define PG8_LDB(dst, b, h) do { _Pragma("unroll") for (int n = 0; n < 2; ++n) _Pragma("unroll") for (int k = 0; k < 2; ++k) dst[n][k] = *(const PG8_LAS bf16x8*)(lds + PG8_SB(b, h) + boff + n * 2048 + k * 1024); } while (0)
#define PG8_MMA(ai, bj, At, Bt) do { __builtin_amdgcn_s_setprio(1); _Pragma("unroll") for (int m = 0; m < 4; ++m) _Pragma("unroll") for (int n = 0; n < 2; ++n) _Pragma("unroll") for (int k = 0; k < 2; ++k) \
        acc[ai][bj][m][n] = __builtin_amdgcn_mfma_f32_16x16x32_bf16(Bt[n][k], At[m][k], acc[ai][bj][m][n], 0, 0, 0); __builtin_amdgcn_s_setprio(0); } while (0)
#define PG8_WAIT_V(n) asm volatile("s_waitcnt vmcnt(" #n ")" ::: "memory")
#define PG8_WAIT_L(n) asm volatile("s_waitcnt lgkmcnt(" #n ")" ::: "memory")
#define PG8_BAR __builtin_amdgcn_s_barrier()
#define PG8_SCHED __builtin_amdgcn_sched_barrier(0)
    Unit cur, nxt; int ui = 0;
    if (!S.next(0, cur)) return;
    f32x4 acc[2][2][4][2];
#pragma unroll
    for (int a = 0; a < 2; ++a)
#pragma unroll
        for (int b = 0; b < 2; ++b)
#pragma unroll
            for (int m = 0; m < 4; ++m)
#pragma unroll
                for (int n = 0; n < 2; ++n) acc[a][b][m][n] = (f32x4){0.f, 0.f, 0.f, 0.f};
    bf16x8 At[4][2], B0[2][2], B1[2][2];
    const char* cA = (const char*)g.A + (size_t)cur.pm * tstep; const char* cB = (const char*)g.Bt + (size_t)cur.pn * tstep;
    S.a_ready(cur);
    if constexpr (SP2) {
        PG8_STAGE(PG8_SB(0, 0), cB, voffB); PG8_STAGE(PG8_SB(0, 1), cB + hstep, voffB); PG8_STAGE(PG8_SA(0, 0), cA, voffA); PG8_STAGE(PG8_SA(0, 1), cA + hstep, voffA);
        if (wr == 1) PG8_BAR;
        PG8_WAIT_V(2); PG8_BAR;
        PG8_STAGE(PG8_SB(1, 0), cB + kstep, voffB); PG8_STAGE(PG8_SA(1, 0), cA + kstep, voffA); PG8_STAGE(PG8_SB(1, 1), cB + hstep + kstep, voffB);
        PG8_WAIT_V(6); PG8_BAR;
    } else {
        PG8_STAGE(PG8_SB(0, 0), cB, voffB); PG8_STAGE(PG8_SA(0, 0), cA, voffA); PG8_STAGE(PG8_SB(0, 1), cB + hstep, voffB); PG8_STAGE(PG8_SA(0, 1), cA + hstep, voffA);
        if (wr == 1) PG8_BAR;
        PG8_WAIT_V(4); PG8_BAR;
        PG8_STAGE(PG8_SB(1, 0), cB + kstep, voffB); PG8_STAGE(PG8_SA(1, 0), cA + kstep, voffA); PG8_STAGE(PG8_SB(1, 1), cB + hstep + kstep, voffB);
        PG8_WAIT_V(6); PG8_BAR;
    }
    for (;;) {
        const bool has_next = S.next(ui + 1, nxt);
        const char* nA = has_next ? (const char*)g.A + (size_t)nxt.pm * tstep : cA; const char* nB = has_next ? (const char*)g.Bt + (size_t)nxt.pn * tstep : cB;
        for (int t = 0; t < nt; t += 2) {
            const bool last = (t == nt - 2);
            const char* a1 = cA + (size_t)(t + 1) * kstep;
            const char* a2 = last ? nA : cA + (size_t)(t + 2) * kstep; const char* b2 = last ? nB : cB + (size_t)(t + 2) * kstep;
            const char* a3 = a2 + kstep; const char* b3 = b2 + kstep;
            if (last && has_next) S.a_ready(nxt);
            if constexpr (SP2) {
            PG8_LDB(B0, 0, 0); PG8_LDB(B1, 0, 1); PG8_SCHED; PG8_LDA(At, 0, 0); PG8_STAGE(PG8_SA(1, 1), a1 + hstep, voffA);
            PG8_WAIT_V(8); PG8_WAIT_L(0); PG8_BAR; PG8_MMA(0, 0, At, B0); PG8_MMA(0, 1, At, B1); PG8_BAR; PG8_SCHED;
            PG8_LDA(At, 0, 1); PG8_STAGE(PG8_SB(0, 0), b2, voffB); PG8_STAGE(PG8_SB(0, 1), b2 + hstep, voffB); PG8_STAGE(PG8_SA(0, 0), a2, voffA);
            PG8_WAIT_V(8); PG8_WAIT_L(0); PG8_BAR; PG8_MMA(1, 0, At, B0); PG8_MMA(1, 1, At, B1); PG8_BAR; PG8_SCHED;
            PG8_LDB(B0, 1, 0); PG8_LDB(B1, 1, 1); PG8_SCHED; PG8_LDA(At, 1, 0); PG8_STAGE(PG8_SA(0, 1), a2 + hstep, voffA);
            PG8_WAIT_V(8); PG8_WAIT_L(0); PG8_BAR; PG8_MMA(0, 0, At, B0); PG8_MMA(0, 1, At, B1); PG8_BAR; PG8_SCHED;
            PG8_LDA(At, 1, 1); PG8_STAGE(PG8_SB(1, 0), b3, voffB); PG8_STAGE(PG8_SB(1, 1), b3 + hstep, voffB); PG8_STAGE(PG8_SA(1, 0), a3, voffA);
            PG8_WAIT_V(8); PG8_WAIT_L(0); PG8_BAR; PG8_MMA(1, 0, At, B0); PG8_MMA(1, 1, At, B1); PG8_BAR; PG8_SCHED;
            } else {
            PG8_LDB(B0, 0, 0); PG8_SCHED; PG8_LDA(At, 0, 0); PG8_STAGE(PG8_SA(1, 1), a1 + hstep, voffA);
            PG8_WAIT_L(8); PG8_BAR; PG8_WAIT_L(0); PG8_MMA(0, 0, At, B0); PG8_BAR; PG8_SCHED;
            PG8_LDB(B1, 0, 1); PG8_STAGE(PG8_SB(0, 0), b2, voffB);
            PG8_BAR; PG8_WAIT_L(0); PG8_MMA(0, 1, At, B1); PG8_BAR;
            PG8_LDA(At, 0, 1); PG8_STAGE(PG8_SA(0, 0), a2, voffA);
            PG8_BAR; PG8_WAIT_L(0); PG8_MMA(1, 0, At, B0); PG8_BAR; PG8_SCHED;
            PG8_STAGE(PG8_SB(0, 1), b2 + hstep, voffB);
            PG8_WAIT_V(6); PG8_BAR; PG8_MMA(1, 1, At, B1); PG8_BAR;
            PG8_LDB(B0, 1, 0); PG8_SCHED; PG8_LDA(At, 1, 0); PG8_STAGE(PG8_SA(0, 1), a2 + hstep, voffA);
            PG8_WAIT_L(8); PG8_BAR; PG8_WAIT_L(0); PG8_MMA(0, 0, At, B0); PG8_BAR; PG8_SCHED;
            PG8_LDB(B1, 1, 1); PG8_STAGE(PG8_SB(1, 0), b3, voffB);
            PG8_BAR; PG8_WAIT_L(0); PG8_MMA(0, 1, At, B1); PG8_BAR;
            PG8_LDA(At, 1, 1); PG8_STAGE(PG8_SA(1, 0), a3, voffA);
            PG8_BAR; PG8_WAIT_L(0); PG8_MMA(1, 0, At, B0); PG8_BAR; PG8_SCHED;
            PG8_STAGE(PG8_SB(1, 1), b3 + hstep, voffB);
            PG8_WAIT_V(6); PG8_BAR; PG8_MMA(1, 1, At, B1); PG8_BAR;
            }
        }
        if constexpr (ALIGN_EPI) { if (wr == 0) PG8_BAR; }
        if constexpr (!Epi::AFTER_DRAIN) { E(acc, cur, wr, wc, fr, fq); S.done(cur); }
        if (!has_next) break;
#pragma unroll
        for (int a = 0; a < 2; ++a)
#pragma unroll
            for (int b = 0; b < 2; ++b)
#pragma unroll
                for (int m = 0; m < 4; ++m)
#pragma unroll
                    for (int n = 0; n < 2; ++n) acc[a][b][m][n] = (f32x4){0.f, 0.f, 0.f, 0.f};
        cur = nxt; cA = nA; cB = nB; ++ui;
        if constexpr (ALIGN_EPI) { if (wr == 1) PG8_BAR; }
    }
    PG8_WAIT_V(0);
    if constexpr (!ALIGN_EPI) { if (wr == 0) PG8_BAR; }
    PG8_BAR;
    if constexpr (Epi::AFTER_DRAIN) { E.fused(acc, cur, wr, wc, fr, fq, lds, wid, lane); S.done(cur); }
#undef PG8_SA
#undef PG8_SB
#undef PG8_STAGE
#undef PG8_LDA
#undef PG8_LDB
#undef PG8_MMA
#undef PG8_WAIT_V
#undef PG8_WAIT_L
#undef PG8_BAR
#undef PG8_SCHED
}
}

#ifndef USE_CG_SYNC
#define USE_CG_SYNC 0
#endif
constexpr int NWAVES = 8, NTHR = 512;
constexpr int TT = 16384, SEQ = 8192, DM = 1024, DEPTH = 2, INC = 6920, DFF = 2816;
constexpr int C_QKVC = 1792, C_BETA = 3840, C_GATE = 3848;
constexpr int NMIX = 3840;
constexpr size_t MiB = 1u << 20, KiB = 1u << 10;
constexpr size_t WS_CTL = 0, CTL_ZERO_BYTES = 64 * KiB;
constexpr size_t WS_ROWSQ = 1 * MiB;
constexpr size_t WS_BA = 2 * MiB;
constexpr size_t WS_CD = 2 * MiB + 512 * KiB;
constexpr size_t WS_WBA = WS_CD + 64 * KiB;
constexpr size_t WS_SGUW = 2 * MiB + 768 * KiB;
constexpr size_t WS_WIN = 3 * MiB;
constexpr size_t WS_WG = WS_WIN + 3840 * 1024 * 2;
constexpr size_t WS_WBR = WS_WG + 3072 * 1024 * 2;
constexpr size_t WS_WOUT = WS_WBR + 3 * 1024 * 512 * 2;
constexpr size_t WS_XB = 22 * MiB;
constexpr size_t WS_UV = 54 * MiB;
constexpr size_t WS_QKVB = 86 * MiB;
constexpr size_t WS_WGU = WS_QKVB;
constexpr size_t WS_WDN = WS_QKVB + 5632 * 1024 * 2;
constexpr size_t WS_QKVC = 110 * MiB;
constexpr size_t WS_BR = WS_QKVC;
constexpr size_t WS_Z = 158 * MiB;
constexpr size_t WS_DN = 174 * MiB;
constexpr size_t WS_HID = 110 * MiB;
constexpr size_t WS_END = 246 * MiB;
static_assert(WS_WOUT + 1024 * 1024 * 2 <= WS_XB && WS_WDN + 1024 * 2816 * 2 <= WS_QKVC && WS_HID + (size_t)TT * DFF * 2 <= WS_END && WS_DN + 1024 * 72 * KiB <= WS_END, "ws map");
constexpr int DN_TASK_BYTES = 73728, DN_OFF_W = 0, DN_OFF_QD = 16384, DN_OFF_AT = 32768, DN_OFF_KD = 40960, DN_OFF_U = 57344;
constexpr int LDS_BYTES = 163840, MISC_OFF = LDS_BYTES - 256;

#define LAS __attribute__((address_space(3)))
typedef unsigned short bf16;
typedef float f32x4 __attribute__((ext_vector_type(4)));
typedef float f32x16 __attribute__((ext_vector_type(16)));
typedef short bf16x8 __attribute__((ext_vector_type(8)));
typedef unsigned u32x4 __attribute__((ext_vector_type(4)));
typedef unsigned u32x2 __attribute__((ext_vector_type(2)));
using pg8::pk2; using pg8::bflo; using pg8::bfhi; using pg8::fast_sigmoid; using pg8::NORM_EPS;
#define MFMA32(a, b, c) __builtin_amdgcn_mfma_f32_32x32x16_bf16((a), (b), (c), 0, 0, 0)
__device__ __forceinline__ int crow(int reg, int h) { return (reg & 3) + 8 * (reg >> 2) + 4 * h; }
__device__ __forceinline__ bf16x8 pack_step(const f32x16& x, int s) {
    u32x4 p; p.x = pk2(x[8 * s], x[8 * s + 1]); p.y = pk2(x[8 * s + 2], x[8 * s + 3]); p.z = pk2(x[8 * s + 4], x[8 * s + 5]); p.w = pk2(x[8 * s + 6], x[8 * s + 7]);
    return __builtin_bit_cast(bf16x8, p);
}
__device__ __forceinline__ float wave_sum(float v) {
#pragma unroll
    for (int o = 1; o < 64; o <<= 1) v += __shfl_xor(v, o);
    return v;
}
__device__ __forceinline__ f32x16 zero16() { f32x16 z; for (int i = 0; i < 16; ++i) z[i] = 0.f; return z; }

struct Params {
    const float* x; const int* pos; const float* attn_norm; const float* w_in; const float* sgu_ln_g; const float* sgu_ln_b; const float* sgu_w; const float* sgu_b;
    const float* sinks; const float* conv_w; const float* a_log; const float* dt_bias; const float* dn_norm; const float* w_branch; const float* w_out; const float* ffn_norm;
    const float* w_gate_up; const float* w_down; const float* final_norm;
    float* out; unsigned char* ws; int ph_lo, ph_hi;
};
struct Frame { LAS unsigned char* lds; int tid, lane, wave, vb, G; };

template <int MAP> __device__ __forceinline__ void transpose_item(const float* W, int ldw, int ncol0, int K, int N, const float* kscale, bf16* WT, LAS float* scr, int item, int lane) {
    const int nblk = N / 32, kb = item / nblk, nb = item % nblk, k0 = 64 * kb, n0 = 32 * nb;
#pragma unroll 8
    for (int i = 0; i < 32; ++i) { const int kk = 2 * i + (lane >> 5); float v = W[(size_t)(k0 + kk) * ldw + ncol0 + n0 + (lane & 31)]; if (kscale) v *= kscale[k0 + kk]; scr[kk * 33 + (lane & 31)] = v; }
    asm volatile("s_waitcnt lgkmcnt(0)" ::: "memory");
    const int c = lane & 7;
#pragma unroll
    for (int j = 0; j < 4; ++j) { const int n = (lane >> 3) + 8 * j; const LAS float* s = scr + (8 * c) * 33 + n;
        u32x4 o; o.x = pk2(s[0 * 33], s[1 * 33]); o.y = pk2(s[2 * 33], s[3 * 33]); o.z = pk2(s[4 * 33], s[5 * 33]); o.w = pk2(s[6 * 33], s[7 * 33]);
        const int nn = n0 + n; int dr = nn;
        if (MAP == 1) { const int f = nn < DFF ? nn : nn - DFF; dr = (f >> 7) * 256 + (nn < DFF ? 0 : 128) + (f & 127); }
        *(u32x4*)(WT + (size_t)dr * K + k0 + 8 * c) = o; }
    asm volatile("s_waitcnt lgkmcnt(0)" ::: "memory");
}
__device__ __forceinline__ void p0_attn_weights(const Frame& F, const Params& P, int l) {
    LAS float* scr = (LAS float*)(F.lds + F.wave * 8448);
    const int gw = F.vb * NWAVES + F.wave, NGW = F.G * NWAVES;
    const float* win = P.w_in + (size_t)l * DM * INC; const float* an = P.attn_norm + l * DM;
    constexpr int I_MIX = 16 * (NMIX / 32), I_G = 16 * (3072 / 32), I_BR = 8 * 32, I_O = 16 * 32, NIT = I_MIX + I_G + 3 * I_BR + I_O;
    for (int it = gw; it < NIT; it += NGW) {
        int r = it;
        if (r < I_MIX) { transpose_item<0>(win, INC, 0, DM, NMIX, an, (bf16*)(P.ws + WS_WIN), scr, r, F.lane); continue; } r -= I_MIX;
        if (r < I_G) { transpose_item<0>(win, INC, C_GATE, DM, 3072, an, (bf16*)(P.ws + WS_WG), scr, r, F.lane); continue; } r -= I_G;
        if (r < 3 * I_BR) { const int n = r / I_BR; transpose_item<0>(P.w_branch + ((size_t)l * 3 + n) * 512 * 1024, 1024, 0, 512, 1024, nullptr, (bf16*)(P.ws + WS_WBR) + (size_t)n * 1024 * 512, scr, r % I_BR, F.lane); continue; } r -= 3 * I_BR;
        transpose_item<0>(P.w_out + (size_t)l * DM * DM, DM, 0, DM, DM, nullptr, (bf16*)(P.ws + WS_WOUT), scr, r, F.lane);
    }
    const int gt = F.vb * NTHR + F.tid, NGT = F.G * NTHR;
    float* wba = (float*)(P.ws + WS_WBA);
    for (int i = gt; i < 8 * DM; i += NGT) { const int c = i >> 10, k = i & 1023; wba[i] = win[(size_t)k * INC + C_BETA + c] * an[k]; }
    bf16* sw = (bf16*)(P.ws + WS_SGUW); const float* sgw = P.sgu_w + (size_t)l * 4 * 128 * 128;
    for (int i = gt; i < 4 * 128 * 128 / 2; i += NGT) { const int e = 2 * i, s = e & 127, t = (e >> 7) & 127; const float a = s <= t ? sgw[e] : 0.f, b = (s + 1) <= t ? sgw[e + 1] : 0.f; ((unsigned*)sw)[i] = pk2(a, b); }
}
__device__ __forceinline__ void p0_ffn_weights(const Frame& F, const Params& P, int l) {
    LAS float* scr = (LAS float*)(F.lds + F.wave * 8448);
    const int gw = F.vb * NWAVES + F.wave, NGW = F.G * NWAVES;
    constexpr int I_GU = 16 * (2 * DFF / 32), I_DN = (DFF / 64) * 32, NIT = I_GU + I_DN;
    for (int it = gw; it < NIT; it += NGW) {
        if (it < I_GU) transpose_item<1>(P.w_gate_up + (size_t)l * DM * 2 * DFF, 2 * DFF, 0, DM, 2 * DFF, P.ffn_norm + l * DM, (bf16*)(P.ws + WS_WGU), scr, it, F.lane);
        else transpose_item<0>(P.w_down + (size_t)l * DFF * DM, DM, 0, DFF, DM, nullptr, (bf16*)(P.ws + WS_WDN), scr, it - I_GU, F.lane);
    }
}
__device__ __forceinline__ void p0_input(const Frame& F, const Params& P) {
    const int gw = F.vb * NWAVES + F.wave, NGW = F.G * NWAVES;
    bf16* xb = (bf16*)(P.ws + WS_XB); float* rowsq = (float*)(P.ws + WS_ROWSQ);
    for (int m = gw; m < TT; m += NGW) {
        const f32x4* xr = (const f32x4*)(P.x + (size_t)m * DM) + F.lane; float s = 0.f;
        unsigned long long* o8 = (unsigned long long*)(xb + (size_t)m * DM) + F.lane;
#pragma unroll
        for (int j = 0; j < 4; ++j) { const f32x4 v = xr[64 * j]; s += (v.x * v.x + v.y * v.y) + (v.z * v.z + v.w * v.w); o8[64 * j] = (unsigned long long)pk2(v.x, v.y) | ((unsigned long long)pk2(v.z, v.w) << 32); }
        s = wave_sum(s);
        if (F.lane < 16) rowsq[(size_t)m * 16 + F.lane] = F.lane == 0 ? s : 0.f;
    }
}
__device__ __forceinline__ void p1_ba(const Frame& F, const Params& P) {
    const int gw = F.vb * NWAVES + F.wave, NGW = F.G * NWAVES;
    const float* wba = (const float*)(P.ws + WS_WBA); const bf16* xb = (const bf16*)(P.ws + WS_XB); const float* rowsq = (const float*)(P.ws + WS_ROWSQ); float* ba = (float*)(P.ws + WS_BA);
    f32x4 wb[8][4];
#pragma unroll
    for (int c = 0; c < 8; ++c)
#pragma unroll
        for (int j = 0; j < 2; ++j) { const f32x4* p = (const f32x4*)(wba + c * DM + F.lane * 8 + 512 * j); wb[c][2 * j] = p[0]; wb[c][2 * j + 1] = p[1]; }
    for (int m = gw; m < TT; m += NGW) {
        float xv[16];
#pragma unroll
        for (int j = 0; j < 2; ++j) { const u32x4 w = *(const u32x4*)(xb + (size_t)m * DM + F.lane * 8 + 512 * j);
            xv[8 * j + 0] = bflo(w.x); xv[8 * j + 1] = bfhi(w.x); xv[8 * j + 2] = bflo(w.y); xv[8 * j + 3] = bfhi(w.y); xv[8 * j + 4] = bflo(w.z); xv[8 * j + 5] = bfhi(w.z); xv[8 * j + 6] = bflo(w.w); xv[8 * j + 7] = bfhi(w.w); }
        float sq = F.lane < 16 ? rowsq[(size_t)m * 16 + F.lane] : 0.f; sq = wave_sum(sq);
        const float rs = __builtin_amdgcn_rsqf(sq * (1.0f / 1024.0f) + NORM_EPS);
        float mine = 0.f;
#pragma unroll
        for (int c = 0; c < 8; ++c) { float d = 0.f;
#pragma unroll
            for (int q = 0; q < 4; ++q) d += (xv[4 * q] * wb[c][q].x + xv[4 * q + 1] * wb[c][q].y) + (xv[4 * q + 2] * wb[c][q].z + xv[4 * q + 3] * wb[c][q].w);
            d = wave_sum(d); if (F.lane == c) mine = d; }
        if (F.lane < 8) ba[(size_t)m * 8 + F.lane] = mine * rs;
    }
}

__device__ __forceinline__ void sgu_task(const Frame& F, const Params& P, int l, int task) {
    const int g = task & 3, cb = task >> 2, m0 = cb * 128;
    const bf16* uv = (const bf16*)(P.ws + WS_UV); bf16* bra = (bf16*)(P.ws + WS_BR);
    LAS bf16* vnT = (LAS bf16*)F.lds;
    const int r = F.tid >> 2, qq = F.tid & 3;
    { const bf16* vrow = uv + (size_t)(m0 + r) * 1024 + 512 + qq * 128; float s = 0.f, s2 = 0.f;
#pragma unroll
      for (int j = 0; j < 16; ++j) { const u32x4 w = *(const u32x4*)(vrow + 8 * j); const float a0 = bflo(w.x), a1 = bfhi(w.x), a2 = bflo(w.y), a3 = bfhi(w.y), a4 = bflo(w.z), a5 = bfhi(w.z), a6 = bflo(w.w), a7 = bfhi(w.w);
          s += ((a0 + a1) + (a2 + a3)) + ((a4 + a5) + (a6 + a7)); s2 += ((a0 * a0 + a1 * a1) + (a2 * a2 + a3 * a3)) + ((a4 * a4 + a5 * a5) + (a6 * a6 + a7 * a7)); }
      s += __shfl_xor(s, 1); s += __shfl_xor(s, 2); s2 += __shfl_xor(s2, 1); s2 += __shfl_xor(s2, 2);
      const float mean = s * (1.f / 512.f); float var = s2 * (1.f / 512.f) - mean * mean; var = var > 0.f ? var : 0.f; const float rstd = __builtin_amdgcn_rsqf(var + NORM_EPS);
      const bf16* vg = uv + (size_t)(m0 + r) * 1024 + 512 + g * 128 + qq * 32; const float* lg = P.sgu_ln_g + l * 512 + g * 128 + qq * 32; const float* lb = P.sgu_ln_b + l * 512 + g * 128 + qq * 32;
#pragma unroll
      for (int j = 0; j < 4; ++j) { const u32x4 w = *(const u32x4*)(vg + 8 * j); const float a[8] = {bflo(w.x), bfhi(w.x), bflo(w.y), bfhi(w.y), bflo(w.z), bfhi(w.z), bflo(w.w), bfhi(w.w)};
#pragma unroll
          for (int i = 0; i < 8; ++i) { const int c = qq * 32 + 8 * j + i; const float y = (a[i] - mean) * rstd * lg[8 * j + i] + lb[8 * j + i]; vnT[c * 136 + r] = (bf16)(pk2(y, 0.f) & 0xffffu); } }
    }
    __syncthreads();
    const int lr = F.lane & 31, h = F.lane >> 5, ct = F.wave >> 1;
    const bf16* sw = (const bf16*)(P.ws + WS_SGUW) + (size_t)g * 128 * 128;
#pragma unroll
    for (int t2 = 0; t2 < 2; ++t2) { const int tt = 2 * (F.wave & 1) + t2; f32x16 acc = zero16();
        for (int ks = 0; ks < 2 * (tt + 1); ++ks) {
            const bf16x8 a = *(const LAS bf16x8*)(vnT + (32 * ct + lr) * 136 + 16 * ks + 8 * h);
            const bf16x8 b = *(const bf16x8*)(sw + (size_t)(32 * tt + lr) * 128 + 16 * ks + 8 * h);
            acc = MFMA32(a, b, acc); }
        const int t = 32 * tt + lr; const float bias = P.sgu_b[l * 512 + g * 128 + t];
#pragma unroll
        for (int gq = 0; gq < 4; ++gq) { const int c0 = 32 * ct + 8 * gq + 4 * h; const u32x2 uu = *(const u32x2*)(uv + (size_t)(m0 + t) * 1024 + g * 128 + c0);
            u32x2 o; o.x = pk2(bflo(uu.x) * (acc[4 * gq] + bias), bfhi(uu.x) * (acc[4 * gq + 1] + bias)); o.y = pk2(bflo(uu.y) * (acc[4 * gq + 2] + bias), bfhi(uu.y) * (acc[4 * gq + 3] + bias));
            *(u32x2*)(bra + (size_t)(m0 + t) * 512 + g * 128 + c0) = o; } }
    __syncthreads();
}

__device__ __forceinline__ void swa_task(const Frame& F, const Params& P, int l, int task) {
    const int kvh = task & 1, cb = task >> 1, nq = cb & 63, m0 = cb * 128;
    const bf16* qkvb = (const bf16*)(P.ws + WS_QKVB); bf16* brb = (bf16*)(P.ws + WS_BR) + (size_t)TT * 512;
    LAS bf16* Qs = (LAS bf16*)F.lds;
    LAS bf16* Ks = (LAS bf16*)(F.lds + 73728);
    LAS bf16* VT = (LAS bf16*)(F.lds + 110592);
    for (int i = F.tid; i < 4096; i += NTHR) { const int g = i >> 10, r = (i >> 3) & 127, c8 = i & 7; if (c8 < 2) continue;
        const u32x4 w = *(const u32x4*)(qkvb + (size_t)(m0 + r) * 768 + (kvh * 4 + g) * 64 + c8 * 8);
        u32x4 o; o.x = pk2(bflo(w.x) * 0.125f, bfhi(w.x) * 0.125f); o.y = pk2(bflo(w.y) * 0.125f, bfhi(w.y) * 0.125f); o.z = pk2(bflo(w.z) * 0.125f, bfhi(w.z) * 0.125f); o.w = pk2(bflo(w.w) * 0.125f, bfhi(w.w) * 0.125f);
        *(LAS u32x4*)(Qs + (g * 128 + r) * 72 + c8 * 8) = o; }
    const float invf[8] = {1.0f, 0.19392274474868576f, 0.03760603093086393f, 0.007292664737217109f, 0.001414213562373095f, 0.0002742481756762073f, 5.318295896944988e-05f, 1.031338537721246e-05f};
    { const int g = F.tid >> 7, r = F.tid & 127; const float pos = (float)P.pos[m0 + r];
      const bf16* src = qkvb + (size_t)(m0 + r) * 768 + (kvh * 4 + g) * 64; const u32x4 w1 = *(const u32x4*)src, w2 = *(const u32x4*)(src + 8);
      const float x1[8] = {bflo(w1.x), bfhi(w1.x), bflo(w1.y), bfhi(w1.y), bflo(w1.z), bfhi(w1.z), bflo(w1.w), bfhi(w1.w)}, x2[8] = {bflo(w2.x), bfhi(w2.x), bflo(w2.y), bfhi(w2.y), bflo(w2.z), bfhi(w2.z), bflo(w2.w), bfhi(w2.w)};
      float o1[8], o2[8];
#pragma unroll
      for (int i = 0; i < 8; ++i) { float sn, cs; sincosf(pos * invf[i], &sn, &cs); o1[i] = (x1[i] * cs - x2[i] * sn) * 0.125f; o2[i] = (x2[i] * cs + x1[i] * sn) * 0.125f; }
      u32x4 a, b; a.x = pk2(o1[0], o1[1]); a.y = pk2(o1[2], o1[3]); a.z = pk2(o1[4], o1[5]); a.w = pk2(o1[6], o1[7]); b.x = pk2(o2[0], o2[1]); b.y = pk2(o2[2], o2[3]); b.z = pk2(o2[4], o2[5]); b.w = pk2(o2[6], o2[7]);
      *(LAS u32x4*)(Qs + (g * 128 + r) * 72) = a; *(LAS u32x4*)(Qs + (g * 128 + r) * 72 + 8) = b; }
    for (int i = F.tid; i < 2048; i += NTHR) { const int s = i >> 3, c8 = i & 7; const bool ok = nq > 0 || s >= 128; const size_t row = (size_t)(m0 - 128 + s);
        u32x4 kw = {0u, 0u, 0u, 0u}, vw = {0u, 0u, 0u, 0u};
        if (ok) { if (c8 >= 2) kw = *(const u32x4*)(qkvb + row * 768 + 512 + kvh * 64 + c8 * 8); vw = *(const u32x4*)(qkvb + row * 768 + 640 + kvh * 64 + c8 * 8); }
        if (c8 >= 2) *(LAS u32x4*)(Ks + s * 72 + c8 * 8) = kw;
        const int p = (s & ~12) | ((s & 4) << 1) | ((s & 8) >> 1); const unsigned vv[4] = {vw.x, vw.y, vw.z, vw.w};
#pragma unroll
        for (int j = 0; j < 4; ++j) { VT[(c8 * 8 + 2 * j) * 264 + p] = (bf16)(vv[j] & 0xffffu); VT[(c8 * 8 + 2 * j + 1) * 264 + p] = (bf16)(vv[j] >> 16); } }
    if (F.tid < 256) { const int s = F.tid; const bool ok = nq > 0 || s >= 128; u32x4 a = {0u, 0u, 0u, 0u}, b = {0u, 0u, 0u, 0u};
        if (ok) { const size_t row = (size_t)(m0 - 128 + s); const float pos = (float)P.pos[row]; const bf16* src = qkvb + row * 768 + 512 + kvh * 64; const u32x4 w1 = *(const u32x4*)src, w2 = *(const u32x4*)(src + 8);
            const float x1[8] = {bflo(w1.x), bfhi(w1.x), bflo(w1.y), bfhi(w1.y), bflo(w1.z), bfhi(w1.z), bflo(w1.w), bfhi(w1.w)}, x2[8] = {bflo(w2.x), bfhi(w2.x), bflo(w2.y), bfhi(w2.y), bflo(w2.z), bfhi(w2.z), bflo(w2.w), bfhi(w2.w)};
            float o1[8], o2[8];
#pragma unroll
            for (int i = 0; i < 8; ++i) { float sn, cs; sincosf(pos * invf[i], &sn, &cs); o1[i] = x1[i] * cs - x2[i] * sn; o2[i] = x2[i] * cs + x1[i] * sn; }
            a.x = pk2(o1[0], o1[1]); a.y = pk2(o1[2], o1[3]); a.z = pk2(o1[4], o1[5]); a.w = pk2(o1[6], o1[7]); b.x = pk2(o2[0], o2[1]); b.y = pk2(o2[2], o2[3]); b.z = pk2(o2[4], o2[5]); b.w = pk2(o2[6], o2[7]); }
        *(LAS u32x4*)(Ks + s * 72) = a; *(LAS u32x4*)(Ks + s * 72 + 8) = b; }
    __syncthreads();
    const int lr = F.lane & 31, h = F.lane >> 5, g = F.wave >> 1, qh = F.wave & 1;
    const float sink = P.sinks[l * 8 + kvh * 4 + g];
#pragma unroll 1
    for (int q2 = 0; q2 < 2; ++q2) { const int qt = 2 * qh + q2, q0 = 32 * qt, qi = q0 + lr;
        bf16x8 bq[4];
#pragma unroll
        for (int ks = 0; ks < 4; ++ks) bq[ks] = *(const LAS bf16x8*)(Qs + (g * 128 + q0 + lr) * 72 + 16 * ks + 8 * h);
        f32x16 sc[5];
#pragma unroll
        for (int k5 = 0; k5 < 5; ++k5) { sc[k5] = zero16();
#pragma unroll
            for (int ks = 0; ks < 4; ++ks) { const bf16x8 a = *(const LAS bf16x8*)(Ks + (32 * (qt + k5) + lr) * 72 + 16 * ks + 8 * h); sc[k5] = MFMA32(a, bq[ks], sc[k5]); } }
        float mx = sink;
#pragma unroll
        for (int k5 = 0; k5 < 5; ++k5)
#pragma unroll
            for (int rg = 0; rg < 16; ++rg) { const int sj = 32 * (qt + k5) + crow(rg, h); const bool ok = sj >= qi + 1 && sj <= qi + 128 && (nq > 0 || sj >= 128);
                const float v = ok ? sc[k5][rg] : -INFINITY; sc[k5][rg] = v; mx = fmaxf(mx, v); }
        mx = fmaxf(mx, __shfl_xor(mx, 32));
        float sum = 0.f;
#pragma unroll
        for (int k5 = 0; k5 < 5; ++k5)
#pragma unroll
            for (int rg = 0; rg < 16; ++rg) { const float p = __expf(sc[k5][rg] - mx); sc[k5][rg] = p; sum += p; }
        sum += __shfl_xor(sum, 32); sum += __expf(sink - mx);
        const float inv = 1.0f / sum;
        f32x16 o[2] = {zero16(), zero16()};
#pragma unroll
        for (int k5 = 0; k5 < 5; ++k5)
#pragma unroll
            for (int s2 = 0; s2 < 2; ++s2) { const bf16x8 pb = pack_step(sc[k5], s2);
#pragma unroll
                for (int dt = 0; dt < 2; ++dt) { const bf16x8 a = *(const LAS bf16x8*)(VT + (32 * dt + lr) * 264 + 32 * (qt + k5) + 16 * s2 + 8 * h); o[dt] = MFMA32(a, pb, o[dt]); } }
        bf16* orow = brb + (size_t)(m0 + qi) * 512 + (kvh * 4 + g) * 64;
#pragma unroll
        for (int dt = 0; dt < 2; ++dt)
#pragma unroll
            for (int gq = 0; gq < 4; ++gq) { u32x2 w; w.x = pk2(o[dt][4 * gq] * inv, o[dt][4 * gq + 1] * inv); w.y = pk2(o[dt][4 * gq + 2] * inv, o[dt][4 * gq + 3] * inv);
                *(u32x2*)(orow + 32 * dt + 8 * gq + 4 * h) = w; }
    }
    __syncthreads();
}

__device__ __forceinline__ void dn_pre_task(const Frame& F, const Params& P, int l, int task) {
    const int hd = task & 3, cbn = task >> 2, b = cbn >> 7, n = cbn & 127, m0 = cbn * 64;
    const bf16* qkvc = (const bf16*)(P.ws + WS_QKVC); const float* ba = (const float*)(P.ws + WS_BA);
    unsigned char* outb = P.ws + WS_DN + (size_t)task * DN_TASK_BYTES;
    LAS bf16* qs = (LAS bf16*)F.lds;
    LAS bf16* ks = (LAS bf16*)(F.lds + 17408);
    LAS bf16* kT = (LAS bf16*)(F.lds + 34816);
    LAS bf16* vT = (LAS bf16*)(F.lds + 53248);
    LAS float* Lm = (LAS float*)(F.lds + 71680);
    LAS bf16* Tm = (LAS bf16*)(F.lds + 89088);
    LAS float* tg = (LAS float*)(F.lds + 98304);
    LAS float *tgc = tg + 64, *tbeta = tg + 128, *teg = tg + 192, *ted = tg + 256, *tsb = tg + 320;
    const int lr = F.lane & 31, h = F.lane >> 5;
    { const int t = F.tid >> 3, seg = F.tid & 7, c0 = seg * 16; const int row = m0 + t;
      const float beta = fast_sigmoid(ba[(size_t)row * 8 + hd]); const float xa = ba[(size_t)row * 8 + 4 + hd] + P.dt_bias[l * 4 + hd];
      const float sp = xa > 20.f ? xa : log1pf(__expf(xa)); const float gt = -__expf(P.a_log[l * 4 + hd]) * sp;
      if (seg == 0) { tg[t] = gt; tbeta[t] = beta; }
#pragma unroll
      for (int part = 0; part < 3; ++part) { const int col0 = part * 512 + hd * 128 + c0; float acc[16];
#pragma unroll
          for (int i = 0; i < 16; ++i) acc[i] = 0.f;
#pragma unroll
          for (int tap = 0; tap < 4; ++tap) { const int sr = n * 64 + t - 3 + tap; if (sr >= 0) {
              const bf16* src = qkvc + (size_t)(b * SEQ + sr) * 1536 + col0; const u32x4 w1 = *(const u32x4*)src, w2 = *(const u32x4*)(src + 8);
              const float xv[16] = {bflo(w1.x), bfhi(w1.x), bflo(w1.y), bfhi(w1.y), bflo(w1.z), bfhi(w1.z), bflo(w1.w), bfhi(w1.w), bflo(w2.x), bfhi(w2.x), bflo(w2.y), bfhi(w2.y), bflo(w2.z), bfhi(w2.z), bflo(w2.w), bfhi(w2.w)};
              const f32x4* cw = (const f32x4*)(P.conv_w + ((size_t)l * 4 + tap) * 1536 + col0);
#pragma unroll
              for (int q = 0; q < 4; ++q) { const f32x4 w = cw[q]; acc[4 * q] += xv[4 * q] * w.x; acc[4 * q + 1] += xv[4 * q + 1] * w.y; acc[4 * q + 2] += xv[4 * q + 2] * w.z; acc[4 * q + 3] += xv[4 * q + 3] * w.w; } } }
          float ss = 0.f;
#pragma unroll
          for (int i = 0; i < 16; ++i) { acc[i] = acc[i] * fast_sigmoid(acc[i]); ss += acc[i] * acc[i]; }
          if (part < 2) { ss += __shfl_xor(ss, 1); ss += __shfl_xor(ss, 2); ss += __shfl_xor(ss, 4); const float rn = __builtin_amdgcn_rsqf(ss + NORM_EPS) * (part == 0 ? 0.08838834764831845f : 1.0f);
#pragma unroll
              for (int i = 0; i < 16; ++i) acc[i] *= rn; }
          else {
#pragma unroll
              for (int i = 0; i < 16; ++i) acc[i] *= beta; }
          unsigned pk[8];
#pragma unroll
          for (int i = 0; i < 8; ++i) pk[i] = pk2(acc[2 * i], acc[2 * i + 1]);
          if (part < 2) { LAS bf16* dst = (part == 0 ? qs : ks) + t * 136 + c0; *(LAS u32x4*)dst = (u32x4){pk[0], pk[1], pk[2], pk[3]}; *(LAS u32x4*)(dst + 8) = (u32x4){pk[4], pk[5], pk[6], pk[7]}; }
          if (part >= 1) { LAS bf16* dT = part == 1 ? kT : vT;
#pragma unroll
              for (int i = 0; i < 8; ++i) { dT[(c0 + 2 * i) * 72 + t] = (bf16)(pk[i] & 0xffffu); dT[(c0 + 2 * i + 1) * 72 + t] = (bf16)(pk[i] >> 16); } }
      }
    }
    __syncthreads();
    if (F.wave == 0) { float x = tg[F.lane];
#pragma unroll
        for (int o = 1; o < 64; o <<= 1) { const float y = __shfl_up(x, o); if (F.lane >= o) x += y; }
        const float gl = __shfl(x, 63); tgc[F.lane] = x; const float e = __expf(x); teg[F.lane] = e; ted[F.lane] = __expf(gl - x); tsb[F.lane] = tbeta[F.lane] * e;
        if (F.lane == 0) ((float*)(P.ws + WS_CD))[task] = __expf(gl); }
    __syncthreads();
    if (F.wave < 4) { const int it = F.wave >> 1, jt = F.wave & 1; f32x16 acc = zero16();
        if (jt <= it) {
#pragma unroll
            for (int s = 0; s < 8; ++s) { const bf16x8 a = *(const LAS bf16x8*)(ks + (32 * it + lr) * 136 + 16 * s + 8 * h), bb = *(const LAS bf16x8*)(ks + (32 * jt + lr) * 136 + 16 * s + 8 * h); acc = MFMA32(a, bb, acc); } }
        const int j = 32 * jt + lr; const float gj = tgc[j];
#pragma unroll
        for (int rg = 0; rg < 16; ++rg) { const int i = 32 * it + crow(rg, h); const float v = i > j ? tbeta[i] * acc[rg] * __expf(tgc[i] - gj) : 0.f; Lm[i * 68 + j] = v; } }
    else { const int w4 = F.wave - 4, jt = w4 >> 1, ct = w4 & 1; f32x16 acc = zero16();
        if (jt <= ct) {
#pragma unroll
            for (int s = 0; s < 8; ++s) { const bf16x8 a = *(const LAS bf16x8*)(ks + (32 * jt + lr) * 136 + 16 * s + 8 * h), bb = *(const LAS bf16x8*)(qs + (32 * ct + lr) * 136 + 16 * s + 8 * h); acc = MFMA32(a, bb, acc); } }
        const int c = 32 * ct + lr; const float gcc = tgc[c];
#pragma unroll
        for (int rg = 0; rg < 16; ++rg) { const int jp = 32 * jt + crow(rg, h); acc[rg] = jp <= c ? acc[rg] * __expf(gcc - tgc[jp]) : 0.f; }
#pragma unroll
        for (int s = 0; s < 2; ++s) *(bf16x8*)(outb + DN_OFF_AT + ((ct * 4 + 2 * jt + s) * 64 + F.lane) * 16) = pack_step(acc, s); }
    __syncthreads();
    if (F.wave == 0) { LAS float* Tf = (LAS float*)(F.lds + 99840);
#pragma unroll 1
        for (int bi = 0; bi < 4; ++bi) { float rr[16];
#pragma unroll
            for (int ii = 0; ii < 16; ++ii) rr[ii] = (F.lane == 16 * bi + ii) ? 1.f : 0.f;
#pragma unroll 1
            for (int j = 0; j < 16 * bi; j += 4) { const float t0 = Tf[j * 64 + F.lane], t1 = Tf[(j + 1) * 64 + F.lane], t2 = Tf[(j + 2) * 64 + F.lane], t3 = Tf[(j + 3) * 64 + F.lane];
#pragma unroll
                for (int ii = 0; ii < 16; ++ii) { const f32x4 lv = *(const LAS f32x4*)(Lm + (16 * bi + ii) * 68 + j); rr[ii] -= (lv.x * t0 + lv.y * t1) + (lv.z * t2 + lv.w * t3); } }
#pragma unroll
            for (int ii = 0; ii < 16; ++ii) {
#pragma unroll
                for (int j4 = 0; j4 < ii; j4 += 4) { const f32x4 lv = *(const LAS f32x4*)(Lm + (16 * bi + ii) * 68 + 16 * bi + j4);
                    rr[ii] -= lv.x * rr[j4]; if (j4 + 1 < ii) rr[ii] -= lv.y * rr[j4 + 1]; if (j4 + 2 < ii) rr[ii] -= lv.z * rr[j4 + 2]; if (j4 + 3 < ii) rr[ii] -= lv.w * rr[j4 + 3]; }
                Tf[(16 * bi + ii) * 64 + F.lane] = rr[ii]; Tm[(16 * bi + ii) * 72 + F.lane] = (bf16)(pk2(rr[ii], 0.f) & 0xffffu); } } }
    else { for (int f = F.wave - 1; f < 32; f += 7) {
            if (f < 16) { const int mt = f >> 3, s = f & 7, c = 32 * mt + lr; const float e = teg[c];
                const u32x2 lo = *(const LAS u32x2*)(qs + c * 136 + 16 * s + 4 * h), hi = *(const LAS u32x2*)(qs + c * 136 + 16 * s + 8 + 4 * h);
                u32x4 o; o.x = pk2(bflo(lo.x) * e, bfhi(lo.x) * e); o.y = pk2(bflo(lo.y) * e, bfhi(lo.y) * e); o.z = pk2(bflo(hi.x) * e, bfhi(hi.x) * e); o.w = pk2(bflo(hi.y) * e, bfhi(hi.y) * e);
                *(u32x4*)(outb + DN_OFF_QD + ((mt * 8 + s) * 64 + F.lane) * 16) = o; }
            else { const int f2 = f - 16, dt = f2 >> 2, s = f2 & 3, d = 32 * dt + lr;
                const u32x2 lo = *(const LAS u32x2*)(kT + d * 72 + 16 * s + 4 * h), hi = *(const LAS u32x2*)(kT + d * 72 + 16 * s + 8 + 4 * h);
                const f32x4 e0 = *(const LAS f32x4*)(ted + 16 * s + 4 * h), e1 = *(const LAS f32x4*)(ted + 16 * s + 8 + 4 * h);
                u32x4 o; o.x = pk2(bflo(lo.x) * e0.x, bfhi(lo.x) * e0.y); o.y = pk2(bflo(lo.y) * e0.z, bfhi(lo.y) * e0.w); o.z = pk2(bflo(hi.x) * e1.x, bfhi(hi.x) * e1.y); o.w = pk2(bflo(hi.y) * e1.z, bfhi(hi.y) * e1.w);
                *(u32x4*)(outb + DN_OFF_KD + ((dt * 4 + s) * 64 + F.lane) * 16) = o; } } }
    __syncthreads();
    { const int it = F.wave >> 2, et = F.wave & 3; f32x16 acc = zero16();
#pragma unroll
      for (int s = 0; s < 4; ++s) { const bf16x8 a = *(const LAS bf16x8*)(Tm + (32 * it + lr) * 72 + 16 * s + 8 * h), bb = *(const LAS bf16x8*)(vT + (32 * et + lr) * 72 + 16 * s + 8 * h); acc = MFMA32(a, bb, acc); }
      u32x4 o0, o1; o0.x = pk2(acc[0], acc[1]); o0.y = pk2(acc[2], acc[3]); o0.z = pk2(acc[4], acc[5]); o0.w = pk2(acc[6], acc[7]); o1.x = pk2(acc[8], acc[9]); o1.y = pk2(acc[10], acc[11]); o1.z = pk2(acc[12], acc[13]); o1.w = pk2(acc[14], acc[15]);
      unsigned char* up = outb + DN_OFF_U + ((et * 2 + it) * 64 + F.lane) * 32; *(u32x4*)up = o0; *(u32x4*)(up + 16) = o1; }
    { const int dt = F.wave >> 1, it = F.wave & 1; f32x16 acc = zero16();
#pragma unroll
      for (int s = 0; s < 4; ++s) { const u32x4 kw = *(const LAS u32x4*)(kT + (32 * dt + lr) * 72 + 16 * s + 8 * h); const f32x4 e0 = *(const LAS f32x4*)(tsb + 16 * s + 8 * h), e1 = *(const LAS f32x4*)(tsb + 16 * s + 8 * h + 4);
          u32x4 aw; aw.x = pk2(bflo(kw.x) * e0.x, bfhi(kw.x) * e0.y); aw.y = pk2(bflo(kw.y) * e0.z, bfhi(kw.y) * e0.w); aw.z = pk2(bflo(kw.z) * e1.x, bfhi(kw.z) * e1.y); aw.w = pk2(bflo(kw.w) * e1.z, bfhi(kw.w) * e1.w);
          const bf16x8 bb = *(const LAS bf16x8*)(Tm + (32 * it + lr) * 72 + 16 * s + 8 * h); acc = MFMA32(__builtin_bit_cast(bf16x8, aw), bb, acc); }
#pragma unroll
      for (int s = 0; s < 2; ++s) *(bf16x8*)(outb + DN_OFF_W + ((it * 8 + 2 * dt + s) * 64 + F.lane) * 16) = pack_step(acc, s); }
    __syncthreads();
}
constexpr int SC_BUF = 49152;
#define SC_BARRIER() do { asm volatile("s_waitcnt lgkmcnt(0)" ::: "memory"); __builtin_amdgcn_s_barrier(); asm volatile("" ::: "memory"); } while (0)
__device__ __forceinline__ void dn_scan(const Frame& F, const Params& P, int bh, bool nostore = false) {
    const int b = bh >> 2, hd = bh & 3; const int es = F.wave;
    unsigned char* dn = P.ws + WS_DN; const float* cdv = (const float*)(P.ws + WS_CD);
#define task_of(n_) ((((b) * 128 + (n_)) << 2) | (hd))
#define SC_SRC(n_, i_) ((const u32x4*)(dn + (size_t)task_of(n_) * DN_TASK_BYTES + ((i_) < 4 ? 0 : ((i_) < 8 ? DN_OFF_KD - 16384 : DN_OFF_U - 32768))) + t4 + 256 * (i_))
    if (F.wave >= 4) {
        const int t4 = F.tid - 256; u32x4 R0[12], R1[12], R2[12]; LAS float* cdl = (LAS float*)(F.lds + 2 * SC_BUF);
        float C0 = cdv[task_of(1)], C1 = cdv[task_of(2)], C2 = cdv[task_of(3)];
        if (t4 == 0) cdl[0] = cdv[task_of(0)];
        { LAS u32x4* dst = (LAS u32x4*)F.lds;
#pragma unroll
          for (int i = 0; i < 12; ++i) R0[i] = *SC_SRC(0, i);
#pragma unroll
          for (int i = 0; i < 12; ++i) dst[t4 + 256 * i] = R0[i]; }
#pragma unroll
        for (int i = 0; i < 12; ++i) { R0[i] = *SC_SRC(1, i); R1[i] = *SC_SRC(2, i); R2[i] = *SC_SRC(3, i); }
        SC_BARRIER();
#define SC_LSTEP(R, C, n_) if ((n_) < 128) { if ((n_) + 1 < 128) { LAS u32x4* dst = (LAS u32x4*)(F.lds + (((n_) + 1) & 1) * SC_BUF); \
            _Pragma("unroll") for (int i = 0; i < 12; ++i) dst[t4 + 256 * i] = R[i]; if (t4 == 0) cdl[((n_) + 1) & 1] = C; } \
            if ((n_) + 4 < 128) { _Pragma("unroll") for (int i = 0; i < 12; ++i) R[i] = *SC_SRC((n_) + 4, i); C = cdv[task_of((n_) + 4)]; } \
            SC_BARRIER(); }
#pragma unroll
        for (int n = 0; n < 129; n += 3) { SC_LSTEP(R0, C0, n) SC_LSTEP(R1, C1, n + 1) SC_LSTEP(R2, C2, n + 2) }
#undef SC_LSTEP
    } else {
        f32x16 S[4] = {zero16(), zero16(), zero16(), zero16()};
        const LAS float* cdl = (const LAS float*)(F.lds + 2 * SC_BUF);
        SC_BARRIER();
#pragma unroll 1
        for (int n = 0; n < 128; ++n) {
            const LAS unsigned char* cur = F.lds + (n & 1) * SC_BUF; unsigned char* tb = dn + (size_t)task_of(n) * DN_TASK_BYTES;
            const float cd = cdl[n & 1];
            bf16x8 Sb[8], A[16];
#pragma unroll
            for (int i = 0; i < 16; ++i) A[i] = *(const LAS bf16x8*)(cur + (i * 64 + F.lane) * 16);
#pragma unroll
            for (int dt = 0; dt < 4; ++dt) { Sb[2 * dt] = pack_step(S[dt], 0); Sb[2 * dt + 1] = pack_step(S[dt], 1); }
            { unsigned char* hp = tb + (es < 2 ? 0 : DN_OFF_KD) + ((es & 1) * 8 * 64 + F.lane) * 16;
              if (!nostore) {
#pragma unroll
              for (int s = 0; s < 8; ++s) *(bf16x8*)(hp + s * 1024) = Sb[s]; } }
            __builtin_amdgcn_sched_barrier(0);
            f32x16 Pw[2] = {zero16(), zero16()};
#pragma unroll
            for (int s = 0; s < 8; ++s) { Pw[0] = MFMA32(A[s], Sb[s], Pw[0]); Pw[1] = MFMA32(A[8 + s], Sb[s], Pw[1]); }
            __builtin_amdgcn_sched_barrier(0);
            u32x4 uu[4];
#pragma unroll
            for (int i = 0; i < 4; ++i) uu[i] = *(const LAS u32x4*)(cur + 32768 + ((es * 2 + (i >> 1)) * 64 + F.lane) * 32 + (i & 1) * 16);
#pragma unroll
            for (int i = 0; i < 16; ++i) A[i] = *(const LAS bf16x8*)(cur + 16384 + (i * 64 + F.lane) * 16);
            __builtin_amdgcn_sched_barrier(0);
            bf16x8 Vb[4];
#pragma unroll
            for (int ct = 0; ct < 2; ++ct) { const unsigned uw[8] = {uu[2 * ct].x, uu[2 * ct].y, uu[2 * ct].z, uu[2 * ct].w, uu[2 * ct + 1].x, uu[2 * ct + 1].y, uu[2 * ct + 1].z, uu[2 * ct + 1].w}; f32x16 v;
#pragma unroll
                for (int p = 0; p < 8; ++p) { v[2 * p] = bflo(uw[p]) - Pw[ct][2 * p]; v[2 * p + 1] = bfhi(uw[p]) - Pw[ct][2 * p + 1]; }
                Vb[2 * ct] = pack_step(v, 0); Vb[2 * ct + 1] = pack_step(v, 1); }
            { unsigned char* vp = tb + DN_OFF_U + (es * 4 * 64 + F.lane) * 16;
              if (!nostore) {
#pragma unroll
              for (int s = 0; s < 4; ++s) *(bf16x8*)(vp + s * 1024) = Vb[s]; } }
#pragma unroll
            for (int dt = 0; dt < 4; ++dt) S[dt] = S[dt] * cd;
            __builtin_amdgcn_sched_barrier(0);
#pragma unroll
            for (int s = 0; s < 4; ++s)
#pragma unroll
                for (int dt = 0; dt < 4; ++dt) S[dt] = MFMA32(A[dt * 4 + s], Vb[s], S[dt]);
            SC_BARRIER();
        }
    }
#undef SC_SRC
#undef task_of
}
__device__ __forceinline__ void dn_out_task(const Frame& F, const Params& P, int l, int task) {
    const int hd = task & 3, cbn = task >> 2, m0 = cbn * 64; const int lr = F.lane & 31, h = F.lane >> 5, ct = F.wave >> 2, es = F.wave & 3;
    const unsigned char* tb = P.ws + WS_DN + (size_t)task * DN_TASK_BYTES; bf16* brc = (bf16*)(P.ws + WS_BR) + (size_t)2 * TT * 512; const bf16* z = (const bf16*)(P.ws + WS_Z);
    LAS float* ssq = (LAS float*)F.lds;
    f32x16 o = zero16();
    { const unsigned char* hp = tb + (es < 2 ? 0 : DN_OFF_KD) + ((es & 1) * 8 * 64 + F.lane) * 16;
#pragma unroll
      for (int s = 0; s < 8; ++s) { const bf16x8 a = *(const bf16x8*)(tb + DN_OFF_QD + ((ct * 8 + s) * 64 + F.lane) * 16), bb = *(const bf16x8*)(hp + s * 1024); o = MFMA32(a, bb, o); }
      const unsigned char* vp = tb + DN_OFF_U + (es * 4 * 64 + F.lane) * 16;
#pragma unroll
      for (int s = 0; s < 4; ++s) { const bf16x8 a = *(const bf16x8*)(tb + DN_OFF_AT + ((ct * 4 + s) * 64 + F.lane) * 16), bb = *(const bf16x8*)(vp + s * 1024); o = MFMA32(a, bb, o); } }
    float q[16];
#pragma unroll
    for (int rg = 0; rg < 16; ++rg) { float v = o[rg] * o[rg]; v += __shfl_xor(v, 1); v += __shfl_xor(v, 2); v += __shfl_xor(v, 4); v += __shfl_xor(v, 8); v += __shfl_xor(v, 16); q[rg] = v; }
    if (lr == 0) {
#pragma unroll
        for (int rg = 0; rg < 16; ++rg) ssq[(ct * 4 + es) * 32 + crow(rg, h)] = q[rg]; }
    __syncthreads();
    const int e = hd * 128 + es * 32 + lr; const float gn = P.dn_norm[l * 128 + es * 32 + lr];
#pragma unroll
    for (int rg = 0; rg < 16; ++rg) { const int r = crow(rg, h); const float tot = (ssq[(ct * 4 + 0) * 32 + r] + ssq[(ct * 4 + 1) * 32 + r]) + (ssq[(ct * 4 + 2) * 32 + r] + ssq[(ct * 4 + 3) * 32 + r]);
        const float rs = __builtin_amdgcn_rsqf(tot * (1.f / 128.f) + NORM_EPS); const size_t idx = (size_t)(m0 + 32 * ct + r) * 512 + e;
        const float zz = __uint_as_float(((unsigned)z[idx]) << 16); brc[idx] = (bf16)(pk2(o[rg] * rs * gn * (zz * fast_sigmoid(zz)), 0.f) & 0xffffu); }
    __syncthreads();
}
__device__ __forceinline__ void final_norm(const Frame& F, const Params& P) {
    const int gw = F.vb * NWAVES + F.wave, NGW = F.G * NWAVES; const float* rowsq = (const float*)(P.ws + WS_ROWSQ);
    f32x4 gn[4];
#pragma unroll
    for (int j = 0; j < 4; ++j) gn[j] = ((const f32x4*)P.final_norm)[F.lane + 64 * j];
    for (int m = gw; m < TT; m += NGW) { float sq = F.lane < 16 ? rowsq[(size_t)m * 16 + F.lane] : 0.f; sq = wave_sum(sq); const float rs = __builtin_amdgcn_rsqf(sq * (1.f / 1024.f) + NORM_EPS);
        f32x4* xr = (f32x4*)(P.out + (size_t)m * DM) + F.lane;
#pragma unroll
        for (int j = 0; j < 4; ++j) xr[64 * j] = xr[64 * j] * rs * gn[j]; }
}

#define RLX_AGENT __ATOMIC_RELAXED, __HIP_MEMORY_SCOPE_AGENT
#define XB_TMO      128
#define XB_XCNT(j)  (256  + 64 * (j))
#define XB_XSUB(j)  (1280 + 64 * (j))
#define XB_XGEN(j)  (2304 + 64 * (j))
#define XB_TOP      3328
#define XB_TOPGEN   3392
#define XCD_BAR_WORDS 3456
#define XB_SPIN_CAP (1u << 18)

__device__ __forceinline__ unsigned xb_ld(unsigned* p)              { return __hip_atomic_load(p, __ATOMIC_RELAXED, __HIP_MEMORY_SCOPE_AGENT); }
__device__ __forceinline__ unsigned xb_add(unsigned* p, unsigned v) { return __hip_atomic_fetch_add(p, v, __ATOMIC_RELAXED, __HIP_MEMORY_SCOPE_AGENT); }
__device__ __forceinline__ unsigned xb_xcc_id() { return (unsigned)__builtin_amdgcn_s_getreg((3 << 11) | 20) & 0xFu; }
#define XB_SPIN(cond, bar) do { unsigned _sp = 0; while (cond) { __builtin_amdgcn_s_sleep(1); \
    if ((++_sp & 255u) == 0u) { if (xb_ld(&(bar)[XB_TMO])) break; if (_sp > XB_SPIN_CAP) { atomicAdd(&(bar)[XB_TMO], 1u); break; } } } } while (0)

struct XcdBarrier {
    unsigned* bar; unsigned x;
    volatile LAS unsigned* st;
};

__device__ __forceinline__ XcdBarrier xcd_barrier_post(unsigned* bar, volatile LAS unsigned* st) {
    XcdBarrier b; b.bar = bar; b.x = xb_xcc_id(); b.st = st;
    if (threadIdx.x == 0) (void)xb_add(&bar[XB_XCNT(b.x)], 1u);
    return b;
}
__device__ __forceinline__ void xcd_barrier_complete(unsigned* bar, unsigned x, unsigned& nloc, unsigned& nx) {
    const unsigned G = gridDim.x * gridDim.y * gridDim.z;
    unsigned sum, cnt, mine, sp = 0u;
    for (;;) {
        sum = 0u; cnt = 0u; mine = 0u;
#pragma unroll
        for (unsigned j = 0; j < 16; ++j) { const unsigned c = xb_ld(&bar[XB_XCNT(j)]); sum += c; cnt += (c > 0u) ? 1u : 0u; mine = (j == x) ? c : mine; }
        if (sum == G) break;
        __builtin_amdgcn_s_sleep(1);
        if ((++sp & 255u) == 0u) { if (xb_ld(&bar[XB_TMO])) break; if (sp > XB_SPIN_CAP) { atomicAdd(&bar[XB_TMO], 1u); break; } }
    }
    nloc = mine > 0u ? mine : 1u; nx = cnt > 0u ? cnt : 1u;
}

__device__ __forceinline__ void xcd_barrier(const XcdBarrier& b) {
    asm volatile("s_waitcnt vmcnt(0)" ::: "memory");
    __syncthreads();
    if (threadIdx.x == 0) {
        unsigned* bar = b.bar;
        __builtin_amdgcn_s_waitcnt(0);
        unsigned nloc = b.st[0], nx = b.st[1];
        if (nloc == 0u) { xcd_barrier_complete(bar, b.x, nloc, nx); b.st[0] = nloc; b.st[1] = nx; }
        const unsigned old = xb_add(&bar[XB_XSUB(b.x)], 1u);
        const unsigned gen = old / nloc;
        if (old + 1u == (gen + 1u) * nloc) {
            __builtin_amdgcn_fence(__ATOMIC_RELEASE, "agent");
            asm volatile("s_waitcnt vmcnt(0)" ::: "memory");
            const unsigned og = xb_add(&bar[XB_TOP], 1u);
            const unsigned tg = og / nx;
            if (og + 1u == (tg + 1u) * nx) xb_add(&bar[XB_TOPGEN], 1u);
            else XB_SPIN(xb_ld(&bar[XB_TOPGEN]) == tg, bar);
            __builtin_amdgcn_fence(__ATOMIC_ACQUIRE, "agent");
            xb_add(&bar[XB_XGEN(b.x)], 1u);
            asm volatile("s_waitcnt vmcnt(0)" ::: "memory");
        } else {
            XB_SPIN(xb_ld(&bar[XB_XGEN(b.x)]) == gen, bar);
            __builtin_amdgcn_fence(__ATOMIC_ACQUIRE, "agent");
            asm volatile("s_waitcnt vmcnt(0)" ::: "memory");
        }
    }
    __syncthreads();
}

constexpr int PH_PER_LAYER = 9, N_PHASES = DEPTH * PH_PER_LAYER + 1;
__device__ __forceinline__ void run_phase(const Frame& F0, const Params& P0, int ph, int sub = 0) {
    Frame F = F0; Params P = P0; asm volatile("" : "+v"(F.tid)); F.lane = F.tid & 63; F.wave = __builtin_amdgcn_readfirstlane(F.tid >> 6);
    { size_t zoff = 0; asm volatile("" : "+s"(zoff)); P.ws = P0.ws + zoff; }
    const int l = ph / PH_PER_LAYER, k = ph % PH_PER_LAYER;
    unsigned char* ws = P.ws; const float* rowsq = (const float*)(ws + WS_ROWSQ); const LAS float* lrs = (const LAS float*)(F.lds + pg8::LRS_OFF);
    if (ph == N_PHASES - 1) { final_norm(F, P); return; }
#ifdef ONLY_K
    if (k != ONLY_K) return;
#endif
    switch (k) {
    case 0: p0_attn_weights(F, P, l); if (l == 0) p0_input(F, P); break;
    case 1: { p1_ba(F, P); __syncthreads();
        pg8::Gemm g{(const pg8::bf16_t*)(ws + WS_XB), (const pg8::bf16_t*)(ws + WS_WIN), TT, NMIX, DM}; pg8::StaticOrder S; S.init(TT, NMIX, F.G, (int)blockIdx.x);
        pg8::EpiProj E{(pg8::bf16_t*)(ws + WS_UV), (pg8::bf16_t*)(ws + WS_QKVB), (pg8::bf16_t*)(ws + WS_QKVC), (pg8::bf16_t*)(ws + WS_Z), lrs};
        pg8::prep_rstd(F.lds, S, rowsq);
        pg8::gemm_phase<pg8::EpiProj, pg8::StaticOrder, true, true>(F.lds, g, S, E); } break;
    case 2: for (int t = F.vb; t < 1024; t += F.G) dn_pre_task(F, P, l, t); break;
    case 3: { const int sb = (int)blockIdx.x; if (sb < 8) { if (!(sub & 2)) dn_scan(F, P, sb, (sub & 16) != 0); }
              else if (!(sub & 1)) { const int nb = F.G - 8; for (int t = sb - 8; t < 768; t += nb) { if (t < 256) { if (!(sub & 4)) swa_task(F, P, l, t); } else if (!(sub & 8)) sgu_task(F, P, l, t - 256); } } } break;
    case 4: for (int t = F.vb; t < 1024; t += F.G) dn_out_task(F, P, l, t); p0_ffn_weights(F, P, l); break;
    case 5: {
#pragma unroll 1
        for (int n = 0; n < 3; ++n) {
            { pg8::Gemm g{(const pg8::bf16_t*)(ws + WS_XB), (const pg8::bf16_t*)(ws + WS_WG) + (size_t)n * 1024 * 1024, TT, DM, DM}; pg8::StaticOrder S; S.init(TT, DM, F.G, (int)blockIdx.x);
              pg8::EpiSig E{(pg8::bf16_t*)(ws + WS_UV), lrs}; if (n == 0) pg8::prep_rstd(F.lds, S, rowsq); pg8::gemm_phase<pg8::EpiSig, pg8::StaticOrder, true, true>(F.lds, g, S, E); }
            __syncthreads();
            { pg8::Gemm g{(const pg8::bf16_t*)(ws + WS_BR) + (size_t)n * TT * 512, (const pg8::bf16_t*)(ws + WS_WBR) + (size_t)n * 1024 * 512, TT, DM, 512}; pg8::StaticOrder S; S.init(TT, DM, F.G, (int)blockIdx.x);
              if (n == 0) { pg8::EpiMerge<0> E{(pg8::bf16_t*)(ws + WS_UV), (float*)(ws + WS_DN)}; pg8::gemm_phase<pg8::EpiMerge<0>, pg8::StaticOrder, true, true>(F.lds, g, S, E); }
              else if (n == 1) { pg8::EpiMerge<1> E{(pg8::bf16_t*)(ws + WS_UV), (float*)(ws + WS_DN)}; pg8::gemm_phase<pg8::EpiMerge<1>, pg8::StaticOrder, true, true>(F.lds, g, S, E); }
              else { pg8::EpiMerge<2> E{(pg8::bf16_t*)(ws + WS_UV), (float*)(ws + WS_DN)}; pg8::gemm_phase<pg8::EpiMerge<2>, pg8::StaticOrder, true, true>(F.lds, g, S, E); } }
            __syncthreads();
        } } break;
    case 6: { pg8::Gemm g{(const pg8::bf16_t*)(ws + WS_UV), (const pg8::bf16_t*)(ws + WS_WOUT), TT, DM, DM}; pg8::StaticOrder S; S.init(TT, DM, F.G, (int)blockIdx.x);
        pg8::EpiResid E{l == 0 ? P.x : P.out, P.out, (pg8::bf16_t*)(ws + WS_XB), (float*)(ws + WS_ROWSQ)}; pg8::gemm_phase<pg8::EpiResid, pg8::StaticOrder, true, true>(F.lds, g, S, E); } break;
    case 7: { pg8::Gemm g{(const pg8::bf16_t*)(ws + WS_XB), (const pg8::bf16_t*)(ws + WS_WGU), TT, 2 * DFF, DM}; pg8::StaticOrder S; S.init(TT, 2 * DFF, F.G, (int)blockIdx.x);
        pg8::EpiGU E{(pg8::bf16_t*)(ws + WS_HID), lrs}; pg8::prep_rstd(F.lds, S, rowsq); pg8::gemm_phase<pg8::EpiGU, pg8::StaticOrder, true, true>(F.lds, g, S, E); } break;
    case 8: { pg8::Gemm g{(const pg8::bf16_t*)(ws + WS_HID), (const pg8::bf16_t*)(ws + WS_WDN), TT, DM, DFF}; pg8::StaticOrder S; S.init(TT, DM, F.G, (int)blockIdx.x);
        pg8::EpiResid E{P.out, P.out, (pg8::bf16_t*)(ws + WS_XB), (float*)(ws + WS_ROWSQ)}; pg8::gemm_phase<pg8::EpiResid, pg8::StaticOrder, true, true>(F.lds, g, S, E); } break;
    }
}

__global__ void __launch_bounds__(NTHR, 2) hgpm_fwd(Params P) {
    extern __shared__ __attribute__((aligned(16))) unsigned char lds_raw[];
    Frame F; F.lds = (LAS unsigned char*)lds_raw; F.tid = threadIdx.x; F.lane = F.tid & 63; F.wave = __builtin_amdgcn_readfirstlane(F.tid >> 6);
    F.G = gridDim.x; { const int bx = blockIdx.x; F.vb = (F.G % 8 == 0) ? (bx % 8) * (F.G / 8) + bx / 8 : bx; }
#if USE_CG_SYNC
    cg::grid_group grid = cg::this_grid();
#define GRID_SYNC() grid.sync()
#else
    volatile LAS unsigned* misc = (volatile LAS unsigned*)(F.lds + MISC_OFF);
    if (F.tid < 64) misc[F.tid] = 0u;
    __syncthreads();
    const XcdBarrier bar = xcd_barrier_post((unsigned*)(P.ws + WS_CTL) + 1024, misc + 8);
#define GRID_SYNC() xcd_barrier(bar)
#endif
    for (int ph = P.ph_lo; ph < P.ph_hi; ++ph) {
        run_phase(F, P, ph);
#ifdef DUPK
#ifndef DUPSUB
#define DUPSUB 0
#endif
        if (ph % PH_PER_LAYER == DUPK && ph != N_PHASES - 1) { GRID_SYNC(); run_phase(F, P, ph, DUPSUB); }
        if (DUPK == 23 && ph % PH_PER_LAYER == 3) { GRID_SYNC(); run_phase(F, P, ph - 1, 0); GRID_SYNC(); run_phase(F, P, ph, 0); }
#endif
        if (ph + 1 < P.ph_hi) GRID_SYNC();
    }
}

#ifndef N_LAUNCH_MODE
#define N_LAUNCH_MODE 0
#endif
extern "C" void kernel_launch(void* const* d_in, const int* in_sizes, int n_in, void* d_out, int out_size, void* d_ws, size_t ws_size, hipStream_t stream) {
    static int grid = 0;
    if (grid == 0) {
        if (n_in != 19 || in_sizes[0] != TT * DM || out_size != TT * DM || ws_size < WS_END) { fprintf(stderr, "kernel_launch: unexpected shapes (n_in %d, in0 %d, out %d, ws %zu)\n", n_in, n_in > 0 ? in_sizes[0] : -1, out_size, ws_size); grid = -1; return; }
        int dev = 0, cus = 0, per_cu = 0;
        if (hipGetDevice(&dev) != hipSuccess || hipDeviceGetAttribute(&cus, hipDeviceAttributeMultiprocessorCount, dev) != hipSuccess) { grid = -1; return; }
        if (hipFuncSetAttribute((const void*)hgpm_fwd, hipFuncAttributeMaxDynamicSharedMemorySize, LDS_BYTES) != hipSuccess) { fprintf(stderr, "kernel_launch: hipFuncSetAttribute failed\n"); grid = -1; return; }
        if (hipOccupancyMaxActiveBlocksPerMultiprocessor(&per_cu, (const void*)hgpm_fwd, NTHR, LDS_BYTES) != hipSuccess || per_cu < 1) { fprintf(stderr, "kernel_launch: occupancy query says %d blocks per CU\n", per_cu); per_cu = 1; }
        (void)hipGetLastError();
        grid = cus;
    }
    if (grid < 0) return;
    Params p{};
    p.x = (const float*)d_in[0]; p.pos = (const int*)d_in[1]; p.attn_norm = (const float*)d_in[2]; p.w_in = (const float*)d_in[3]; p.sgu_ln_g = (const float*)d_in[4]; p.sgu_ln_b = (const float*)d_in[5];
    p.sgu_w = (const float*)d_in[6]; p.sgu_b = (const float*)d_in[7]; p.sinks = (const float*)d_in[8]; p.conv_w = (const float*)d_in[9]; p.a_log = (const float*)d_in[10]; p.dt_bias = (const float*)d_in[11];
    p.dn_norm = (const float*)d_in[12]; p.w_branch = (const float*)d_in[13]; p.w_out = (const float*)d_in[14]; p.ffn_norm = (const float*)d_in[15]; p.w_gate_up = (const float*)d_in[16]; p.w_down = (const float*)d_in[17];
    p.final_norm = (const float*)d_in[18]; p.out = (float*)d_out; p.ws = (unsigned char*)d_ws;
#if N_LAUNCH_MODE == 0
    p.ph_lo = 0; p.ph_hi = N_PHASES;
#if USE_CG_SYNC
    void* args[] = {&p};
    hipError_t e = hipLaunchCooperativeKernel((const void*)hgpm_fwd, dim3(grid), dim3(NTHR), args, LDS_BYTES, stream);
    if (e != hipSuccess) fprintf(stderr, "kernel_launch: cooperative launch failed: %s (grid %d)\n", hipGetErrorString(e), grid);
#else
    if (hipMemsetAsync((char*)d_ws + WS_CTL, 0, CTL_ZERO_BYTES, stream) != hipSuccess) { fprintf(stderr, "kernel_launch: hipMemsetAsync failed\n"); return; }
    hipLaunchKernelGGL(hgpm_fwd, dim3(grid), dim3(NTHR), LDS_BYTES, stream, p);
#endif
#else
    for (int ph = 0; ph < N_PHASES; ++ph) { p.ph_lo = ph; p.ph_hi = ph + 1; hipLaunchKernelGGL(hgpm_fwd, dim3(grid), dim3(NTHR), LDS_BYTES, stream, p); }
#endif
}
```

```cpp
#include <hip/hip_runtime.h>
#include <hip/hip_cooperative_groups.h>
#include <cstdio>
#include <cstdint>
namespace cg = cooperative_groups;
namespace pg8 {
#define PG8_LAS __attribute__((address_space(3)))
typedef unsigned short bf16_t;
typedef short bf16x8 __attribute__((ext_vector_type(8)));
typedef float f32x4 __attribute__((ext_vector_type(4)));
typedef unsigned u32x4 __attribute__((ext_vector_type(4)));
constexpr int BM = 256, BK = 64, HALF = 128, HTB = HALF * BK * 2  , STAGE_BYTES = 8 * HTB, NXCD = 8, WGM = 8;

__host__ __device__ __forceinline__ int lds_byte(int r, int c) { const int st = (r >> 4) * 2 + (c >> 5), rr = r & 15, cc = c & 31, ob = rr * 64 + cc * 2; return st * 1024 + (ob ^ (((ob >> 9) & 1) << 5)); }
__host__ __device__ __forceinline__ void stage_rc(int b, int& R, int& C) { const int st = b / 1024, sb = b % 1024, swz = sb ^ (((sb >> 9) & 1) << 5); R = (st >> 1) * 16 + swz / 64; C = (st & 1) * 32 + (swz % 64) / 2; }
__host__ __device__ __forceinline__ int perm32(int rho) { const int n = rho >> 4, i = rho & 15; return 8 * (i >> 2) + 4 * n + (i & 3); }

struct Unit { int pm, pn, idx; };
struct Gemm { const bf16_t* A; const bf16_t* Bt; int M, N, K; };

struct StaticOrder {
    int nM, nN, nwg, G, c;
    __host__ __device__ void init(int M, int N, int G_, int c_) { nM = M / BM; nN = N / BM; nwg = nM * nN; G = G_; c = c_; }
    __host__ __device__ bool next(int i, Unit& u) const {
        const long L = (long)i * G + c; if (L >= nwg) return false;
        int wgid = (int)L; { const int q = nwg / NXCD, r = nwg % NXCD, xcd = wgid % NXCD, off = wgid / NXCD; wgid = (xcd < r ? xcd * (q + 1) : r * (q + 1) + (xcd - r) * q) + off; }
        const int nig = WGM * nN, gid = wgid / nig, fm = gid * WGM, gsz = (nM - fm) < WGM ? (nM - fm) : WGM;
        u.pm = fm + ((wgid % nig) % gsz); u.pn = (wgid % nig) / gsz; u.idx = i; return true;
    }
    __device__ __forceinline__ void a_ready(const Unit&) const {}
    __device__ __forceinline__ void done(const Unit&) const {}
};

typedef float f32x2 __attribute__((ext_vector_type(2)));
typedef __bf16 bf16v2 __attribute__((ext_vector_type(2)));
typedef unsigned u32x2 __attribute__((ext_vector_type(2)));
__device__ __forceinline__ unsigned pk2(float lo, float hi) { f32x2 v = {lo, hi}; bf16v2 r = __builtin_convertvector(v, bf16v2); return __builtin_bit_cast(unsigned, r); }
__device__ __forceinline__ float bflo(unsigned w) { return __uint_as_float(w << 16); }
__device__ __forceinline__ float bfhi(unsigned w) { return __uint_as_float(w & 0xffff0000u); }
__device__ __forceinline__ float fast_sigmoid(float x) { return __builtin_amdgcn_rcpf(1.0f + __expf(-x)); }
__device__ __forceinline__ float gelu_tanh(float x) { const float u = 1.5957691216f * (x + 0.044715f * x * x * x); return x * fast_sigmoid(u); }
constexpr float NORM_EPS = 1e-6f;
__device__ __forceinline__ float row_rstd(const float* rowsq, int row) {
    const f32x4* p = (const f32x4*)(rowsq + (size_t)row * 16); const f32x4 a = p[0], b = p[1], c = p[2], d = p[3];
    const float s = ((a.x + a.y) + (a.z + a.w)) + ((b.x + b.y) + (b.z + b.w)) + ((c.x + c.y) + (c.z + c.w)) + ((d.x + d.y) + (d.z + d.w));
    return __builtin_amdgcn_rsqf(s * (1.0f / 1024.0f) + NORM_EPS);
}
constexpr int LRS_OFF = STAGE_BYTES, LRS_MAX_UNITS = 8;
template <class Sched> __device__ __forceinline__ void prep_rstd(PG8_LAS unsigned char* lds, const Sched& S, const float* rowsq) {
    PG8_LAS float* t = (PG8_LAS float*)(lds + LRS_OFF); Unit u;
#pragma unroll 1
    for (int i = 0; i < LRS_MAX_UNITS; ++i) { if (!S.next(i, u)) break; if (threadIdx.x < 256) t[i * 256 + threadIdx.x] = row_rstd(rowsq, u.pm * BM + threadIdx.x); asm volatile("" ::: "memory"); }
    __syncthreads();
}
struct EpiProj {
    static constexpr bool PERM = true, AFTER_DRAIN = false;
    bf16_t *uv, *qkvb, *qkvc, *z; const PG8_LAS float* lrs;
    __device__ __forceinline__ void operator()(const f32x4 (&acc)[2][2][4][2], const Unit& u, int wr, int wc, int fr, int fq) const {
        const int pn = u.pn; bf16_t* base; int ldc, colt; bool act = false;
        if (pn < 4) { base = uv; ldc = 1024; colt = pn * 256; act = true; }
        else if (pn < 7) { base = qkvb; ldc = 768; colt = (pn - 4) * 256; }
        else if (pn < 13) { base = qkvc; ldc = 1536; colt = (pn - 7) * 256; }
        else { base = z; ldc = 512; colt = (pn - 13) * 256; }
        const int row0 = u.pm * BM + wr * 64 + fr, col0 = colt + wc * 32 + 8 * fq;
#pragma unroll
        for (int ai = 0; ai < 2; ++ai)
#pragma unroll
            for (int m = 0; m < 4; ++m) { const int row = row0 + ai * HALF + m * 16; const float rs = lrs[u.idx * 256 + (row - u.pm * BM)]; bf16_t* rowp = base + (size_t)row * ldc + col0;
#pragma unroll
                for (int bj = 0; bj < 2; ++bj) { f32x4 v0 = acc[ai][bj][m][0] * rs, v1 = acc[ai][bj][m][1] * rs;
                    if (act) {
#pragma unroll
                        for (int j = 0; j < 4; ++j) { v0[j] = gelu_tanh(v0[j]); v1[j] = gelu_tanh(v1[j]); } }
                    u32x4 w; w.x = pk2(v0[0], v0[1]); w.y = pk2(v0[2], v0[3]); w.z = pk2(v1[0], v1[1]); w.w = pk2(v1[2], v1[3]);
                    *(u32x4*)(rowp + bj * HALF) = w; } }
    }
};
struct EpiSig {
    static constexpr bool PERM = true, AFTER_DRAIN = false;
    bf16_t* sig; const PG8_LAS float* lrs;
    __device__ __forceinline__ void operator()(const f32x4 (&acc)[2][2][4][2], const Unit& u, int wr, int wc, int fr, int fq) const {
        const int row0 = u.pm * BM + wr * 64 + fr, col0 = u.pn * BM + wc * 32 + 8 * fq;
#pragma unroll
        for (int ai = 0; ai < 2; ++ai)
#pragma unroll
            for (int m = 0; m < 4; ++m) { const int row = row0 + ai * HALF + m * 16; const float rs = lrs[u.idx * 256 + (row - u.pm * BM)]; bf16_t* rowp = sig + (size_t)row * 1024 + col0;
#pragma unroll
                for (int bj = 0; bj < 2; ++bj) { f32x4 v0 = acc[ai][bj][m][0] * rs, v1 = acc[ai][bj][m][1] * rs;
#pragma unroll
                    for (int j = 0; j < 4; ++j) { v0[j] = fast_sigmoid(v0[j]); v1[j] = fast_sigmoid(v1[j]); }
                    u32x4 w; w.x = pk2(v0[0], v0[1]); w.y = pk2(v0[2], v0[3]); w.z = pk2(v1[0], v1[1]); w.w = pk2(v1[2], v1[3]);
                    *(u32x4*)(rowp + bj * HALF) = w; } }
    }
};
template <int MODE> struct EpiMerge {
    static constexpr bool PERM = true, AFTER_DRAIN = false;
    bf16_t* sig; float* mf;
    __device__ __forceinline__ void operator()(const f32x4 (&acc)[2][2][4][2], const Unit& u, int wr, int wc, int fr, int fq) const {
        const int row0 = u.pm * BM + wr * 64 + fr, col0 = u.pn * BM + wc * 32 + 8 * fq;
#pragma unroll
        for (int ai = 0; ai < 2; ++ai)
#pragma unroll
            for (int m = 0; m < 4; ++m) { const size_t off = (size_t)(row0 + ai * HALF + m * 16) * 1024 + col0;
#pragma unroll
                for (int bj = 0; bj < 2; ++bj) { const u32x4 s = *(const u32x4*)(sig + off + bj * HALF);
                    f32x4 v0 = acc[ai][bj][m][0], v1 = acc[ai][bj][m][1];
                    v0[0] *= bflo(s.x); v0[1] *= bfhi(s.x); v0[2] *= bflo(s.y); v0[3] *= bfhi(s.y); v1[0] *= bflo(s.z); v1[1] *= bfhi(s.z); v1[2] *= bflo(s.w); v1[3] *= bfhi(s.w);
                    float* mp = mf + off + bj * HALF;
                    if (MODE >= 1) { v0 += *(const f32x4*)mp; v1 += *(const f32x4*)(mp + 4); }
                    if (MODE <= 1) { *(f32x4*)mp = v0; *(f32x4*)(mp + 4) = v1; }
                    else { u32x4 w; w.x = pk2(v0[0], v0[1]); w.y = pk2(v0[2], v0[3]); w.z = pk2(v1[0], v1[1]); w.w = pk2(v1[2], v1[3]); *(u32x4*)(sig + off + bj * HALF) = w; } } }
    }
};
template <bool F32OUT> struct EpiResid {
    static constexpr bool PERM = true, AFTER_DRAIN = false;
    bf16_t* xb; float* rowsq; float* xout;
    __device__ __forceinline__ void operator()(const f32x4 (&acc)[2][2][4][2], const Unit& u, int wr, int wc, int fr, int fq) const {
        const int row0 = u.pm * BM + wr * 64 + fr, col0 = u.pn * BM + wc * 32 + 8 * fq;
#pragma unroll
        for (int ai = 0; ai < 2; ++ai)
#pragma unroll
            for (int m = 0; m < 4; ++m) { const int row = row0 + ai * HALF + m * 16; const size_t off = (size_t)row * 1024 + col0; float ss = 0.f;
#pragma unroll
                for (int bj = 0; bj < 2; ++bj) { const u32x4 xo = *(const u32x4*)(xb + off + bj * HALF);
                    f32x4 v0 = acc[ai][bj][m][0], v1 = acc[ai][bj][m][1];
                    v0[0] += bflo(xo.x); v0[1] += bfhi(xo.x); v0[2] += bflo(xo.y); v0[3] += bfhi(xo.y); v1[0] += bflo(xo.z); v1[1] += bfhi(xo.z); v1[2] += bflo(xo.w); v1[3] += bfhi(xo.w);
                    if (F32OUT) { *(f32x4*)(xout + off + bj * HALF) = v0; *(f32x4*)(xout + off + bj * HALF + 4) = v1; }
                    else { u32x4 w; w.x = pk2(v0[0], v0[1]); w.y = pk2(v0[2], v0[3]); w.z = pk2(v1[0], v1[1]); w.w = pk2(v1[2], v1[3]); *(u32x4*)(xb + off + bj * HALF) = w; }
                    ss += ((v0[0] * v0[0] + v0[1] * v0[1]) + (v0[2] * v0[2] + v0[3] * v0[3])) + ((v1[0] * v1[0] + v1[1] * v1[1]) + (v1[2] * v1[2] + v1[3] * v1[3])); }
                ss += __shfl_xor(ss, 16); ss += __shfl_xor(ss, 32);
                if (fq == 0) rowsq[(size_t)row * 16 + u.pn * 4 + wc] = ss; }
    }
};
struct EpiGU {
    static constexpr bool PERM = true, AFTER_DRAIN = false;
    bf16_t* hid; const PG8_LAS float* lrs;
    __device__ __forceinline__ void operator()(const f32x4 (&acc)[2][2][4][2], const Unit& u, int wr, int wc, int fr, int fq) const {
        const int row0 = u.pm * BM + wr * 64 + fr, col0 = u.pn * HALF + wc * 32 + 8 * fq;
#pragma unroll
        for (int ai = 0; ai < 2; ++ai)
#pragma unroll
            for (int m = 0; m < 4; ++m) { const int row = row0 + ai * HALF + m * 16; const float rs = lrs[u.idx * 256 + (row - u.pm * BM)];
                float o[8];
#pragma unroll
                for (int n = 0; n < 2; ++n)
#pragma unroll
                    for (int j = 0; j < 4; ++j) { const float g = acc[ai][0][m][n][j] * rs, up = acc[ai][1][m][n][j] * rs; o[n * 4 + j] = g * fast_sigmoid(g) * up; }
                u32x4 w; w.x = pk2(o[0], o[1]); w.y = pk2(o[2], o[3]); w.z = pk2(o[4], o[5]); w.w = pk2(o[6], o[7]);
                *(u32x4*)(hid + (size_t)row * 2816 + col0) = w; }
    }
};

template <class Epi, class Sched, bool ALIGN_EPI = false, bool SP2 = false>
__device__ __forceinline__ void gemm_phase(PG8_LAS unsigned char* lds, const Gemm g, const Sched& S, const Epi& E) {
    int tid_ = threadIdx.x; asm volatile("" : "+v"(tid_));
    const int tid = tid_, wid = __builtin_amdgcn_readfirstlane(tid >> 6), lane = tid & 63, wr = wid >> 2, wc = wid & 3, fr = lane & 15, fq = lane >> 4;
    const int K = g.K, nt = K / BK;
    unsigned voffA[2], voffB[2];
#pragma unroll
    for (int i = 0; i < 2; ++i) { int R, C; stage_rc(tid * 16 + i * 8192, R, C); const int Rb = Epi::PERM ? ((R & ~31) + perm32(R & 31)) : R;
        voffA[i] = (unsigned)(R * K + C) * 2u; voffB[i] = (unsigned)(Rb * K + C) * 2u; }
    const size_t kstep = (size_t)(BK * 2);
    const size_t hstep = (size_t)HALF * K * 2;
    const size_t tstep = 2 * hstep;
    const unsigned ldsw = (unsigned)wid * 1024u;
    const int aoff = lds_byte(wr * 64 + fr, fq * 8), boff = lds_byte(wc * 32 + fr, fq * 8);
#define PG8_SA(b, h) (((b) * 2 + (h)) * HTB)
#define PG8_SB(b, h) ((4 + (b) * 2 + (h)) * HTB)
#define PG8_STAGE(bufoff, gbase, voff) do { _Pragma("unroll") for (int _i = 0; _i < 2; ++_i) \
        __builtin_amdgcn_global_load_lds((const unsigned*)((const char*)(gbase) + (voff)[_i]), (PG8_LAS unsigned*)(lds + (bufoff) + ldsw + _i * 8192), 16, 0, 0); } while (0)
#define PG8_LDA(dst, b, h) do { _Pragma("unroll") for (int m = 0; m < 4; ++m) _Pragma("unroll") for (int k = 0; k < 2; ++k) dst[m][k] = *(const PG8_LAS bf16x8*)(lds + PG8_SA(b, h) + aoff + m * 2048 + k * 1024); } while (0)
#define PG8_LDB(dst, b, h) do { _Pragma("unroll") for (int n = 0; n < 2; ++n) _Pragma("unroll") for (int k = 0; k < 2; ++k) dst[n][k] = *(const PG8_LAS bf16x8*)(lds + PG8_SB(b, h) + boff + n * 2048 + k * 1024); } while (0)
#define PG8_MMA(ai, bj, At, Bt) do { __builtin_amdgcn_s_setprio(1); _Pragma("unroll") for (int m = 0; m < 4; ++m) _Pragma("unroll") for (int n = 0; n < 2; ++n) _Pragma("unroll") for (int k = 0; k < 2; ++k) \
        acc[ai][bj][m][n] = __builtin_amdgcn_mfma_f32_16x16x32_bf16(Bt[n][k], At[m][k], acc[ai][bj][m][n], 0, 0, 0); __builtin_amdgcn_s_setprio(0); } while (0)
#define PG8_WAIT_V(n) asm volatile("s_waitcnt vmcnt(" #n ")" ::: "memory")
#define PG8_WAIT_L(n) asm volatile("s_waitcnt lgkmcnt(" #n ")" ::: "memory")
#define PG8_BAR __builtin_amdgcn_s_barrier()
#define PG8_SCHED __builtin_amdgcn_sched_barrier(0)
    Unit cur, nxt; int ui = 0;
    if (!S.next(0, cur)) return;
    f32x4 acc[2][2][4][2];
#pragma unroll
    for (int a = 0; a < 2; ++a)
#pragma unroll
        for (int b = 0; b < 2; ++b)
#pragma unroll
            for (int m = 0; m < 4; ++m)
#pragma unroll
                for (int n = 0; n < 2; ++n) acc[a][b][m][n] = (f32x4){0.f, 0.f, 0.f, 0.f};
    bf16x8 At[4][2], B0[2][2], B1[2][2];
    const char* cA = (const char*)g.A + (size_t)cur.pm * tstep; const char* cB = (const char*)g.Bt + (size_t)cur.pn * tstep;
    S.a_ready(cur);
    if constexpr (SP2) {
        PG8_STAGE(PG8_SB(0, 0), cB, voffB); PG8_STAGE(PG8_SB(0, 1), cB + hstep, voffB); PG8_STAGE(PG8_SA(0, 0), cA, voffA); PG8_STAGE(PG8_SA(0, 1), cA + hstep, voffA);
        if (wr == 1) PG8_BAR;
        PG8_WAIT_V(2); PG8_BAR;
        PG8_STAGE(PG8_SB(1, 0), cB + kstep, voffB); PG8_STAGE(PG8_SA(1, 0), cA + kstep, voffA); PG8_STAGE(PG8_SB(1, 1), cB + hstep + kstep, voffB);
        PG8_WAIT_V(6); PG8_BAR;
    } else {
        PG8_STAGE(PG8_SB(0, 0), cB, voffB); PG8_STAGE(PG8_SA(0, 0), cA, voffA); PG8_STAGE(PG8_SB(0, 1), cB + hstep, voffB); PG8_STAGE(PG8_SA(0, 1), cA + hstep, voffA);
        if (wr == 1) PG8_BAR;
        PG8_WAIT_V(4); PG8_BAR;
        PG8_STAGE(PG8_SB(1, 0), cB + kstep, voffB); PG8_STAGE(PG8_SA(1, 0), cA + kstep, voffA); PG8_STAGE(PG8_SB(1, 1), cB + hstep + kstep, voffB);
        PG8_WAIT_V(6); PG8_BAR;
    }
    for (;;) {
        const bool has_next = S.next(ui + 1, nxt);
        const char* nA = has_next ? (const char*)g.A + (size_t)nxt.pm * tstep : cA; const char* nB = has_next ? (const char*)g.Bt + (size_t)nxt.pn * tstep : cB;
        for (int t = 0; t < nt; t += 2) {
            const bool last = (t == nt - 2);
            const char* a1 = cA + (size_t)(t + 1) * kstep;
            const char* a2 = last ? nA : cA + (size_t)(t + 2) * kstep; const char* b2 = last ? nB : cB + (size_t)(t + 2) * kstep;
            const char* a3 = a2 + kstep; const char* b3 = b2 + kstep;
            if (last && has_next) S.a_ready(nxt);
            if constexpr (SP2) {
            PG8_LDB(B0, 0, 0); PG8_LDB(B1, 0, 1); PG8_SCHED; PG8_LDA(At, 0, 0); PG8_STAGE(PG8_SA(1, 1), a1 + hstep, voffA);
            PG8_WAIT_V(8); PG8_WAIT_L(0); PG8_BAR; PG8_MMA(0, 0, At, B0); PG8_MMA(0, 1, At, B1); PG8_BAR; PG8_SCHED;
            PG8_LDA(At, 0, 1); PG8_STAGE(PG8_SB(0, 0), b2, voffB); PG8_STAGE(PG8_SB(0, 1), b2 + hstep, voffB); PG8_STAGE(PG8_SA(0, 0), a2, voffA);
            PG8_WAIT_V(8); PG8_WAIT_L(0); PG8_BAR; PG8_MMA(1, 0, At, B0); PG8_MMA(1, 1, At, B1); PG8_BAR; PG8_SCHED;
            PG8_LDB(B0, 1, 0); PG8_LDB(B1, 1, 1); PG8_SCHED; PG8_LDA(At, 1, 0); PG8_STAGE(PG8_SA(0, 1), a2 + hstep, voffA);
            PG8_WAIT_V(8); PG8_WAIT_L(0); PG8_BAR; PG8_MMA(0, 0, At, B0); PG8_MMA(0, 1, At, B1); PG8_BAR; PG8_SCHED;
            PG8_LDA(At, 1, 1); PG8_STAGE(PG8_SB(1, 0), b3, voffB); PG8_STAGE(PG8_SB(1, 1), b3 + hstep, voffB); PG8_STAGE(PG8_SA(1, 0), a3, voffA);
            PG8_WAIT_V(8); PG8_WAIT_L(0); PG8_BAR; PG8_MMA(1, 0, At, B0); PG8_MMA(1, 1, At, B1); PG8_BAR; PG8_SCHED;
            } else {
            PG8_LDB(B0, 0, 0); PG8_SCHED; PG8_LDA(At, 0, 0); PG8_STAGE(PG8_SA(1, 1), a1 + hstep, voffA);
            PG8_WAIT_L(8); PG8_BAR; PG8_WAIT_L(0); PG8_MMA(0, 0, At, B0); PG8_BAR; PG8_SCHED;
            PG8_LDB(B1, 0, 1); PG8_STAGE(PG8_SB(0, 0), b2, voffB);
            PG8_BAR; PG8_WAIT_L(0); PG8_MMA(0, 1, At, B1); PG8_BAR;
            PG8_LDA(At, 0, 1); PG8_STAGE(PG8_SA(0, 0), a2, voffA);
            PG8_BAR; PG8_WAIT_L(0); PG8_MMA(1, 0, At, B0); PG8_BAR; PG8_SCHED;
            PG8_STAGE(PG8_SB(0, 1), b2 + hstep, voffB);
            PG8_WAIT_V(6); PG8_BAR; PG8_MMA(1, 1, At, B1); PG8_BAR;
            PG8_LDB(B0, 1, 0); PG8_SCHED; PG8_LDA(At, 1, 0); PG8_STAGE(PG8_SA(0, 1), a2 + hstep, voffA);
            PG8_WAIT_L(8); PG8_BAR; PG8_WAIT_L(0); PG8_MMA(0, 0, At, B0); PG8_BAR; PG8_SCHED;
            PG8_LDB(B1, 1, 1); PG8_STAGE(PG8_SB(1, 0), b3, voffB);
            PG8_BAR; PG8_WAIT_L(0); PG8_MMA(0, 1, At, B1); PG8_BAR;
            PG8_LDA(At, 1, 1); PG8_STAGE(PG8_SA(1, 0), a3, voffA);
            PG8_BAR; PG8_WAIT_L(0); PG8_MMA(1, 0, At, B0); PG8_BAR; PG8_SCHED;
            PG8_STAGE(PG8_SB(1, 1), b3 + hstep, voffB);
            PG8_WAIT_V(6); PG8_BAR; PG8_MMA(1, 1, At, B1); PG8_BAR;
            }
        }
        if constexpr (ALIGN_EPI) { if (wr == 0) PG8_BAR; }
        if constexpr (!Epi::AFTER_DRAIN) { E(acc, cur, wr, wc, fr, fq); S.done(cur); }
        if (!has_next) break;
#pragma unroll
        for (int a = 0; a < 2; ++a)
#pragma unroll
            for (int b = 0; b < 2; ++b)
#pragma unroll
                for (int m = 0; m < 4; ++m)
#pragma unroll
                    for (int n = 0; n < 2; ++n) acc[a][b][m][n] = (f32x4){0.f, 0.f, 0.f, 0.f};
        cur = nxt; cA = nA; cB = nB; ++ui;
        if constexpr (ALIGN_EPI) { if (wr == 1) PG8_BAR; }
    }
    PG8_WAIT_V(0);
    if constexpr (!ALIGN_EPI) { if (wr == 0) PG8_BAR; }
    PG8_BAR;
    if constexpr (Epi::AFTER_DRAIN) { E.fused(acc, cur, wr, wc, fr, fq, lds, wid, lane); S.done(cur); }
#undef PG8_SA
#undef PG8_SB
#undef PG8_STAGE
#undef PG8_LDA
#undef PG8_LDB
#undef PG8_MMA
#undef PG8_WAIT_V
#undef PG8_WAIT_L
#undef PG8_BAR
#undef PG8_SCHED
}
}

#ifndef USE_CG_SYNC
#define USE_CG_SYNC 0
#endif
constexpr int NWAVES = 8, NTHR = 512;
constexpr int TT = 16384, SEQ = 8192, DM = 1024, DEPTH = 2, INC = 6920, DFF = 2816;
constexpr int C_QKVC = 1792, C_BETA = 3840, C_GATE = 3848;
constexpr int NMIX = 3840;
constexpr size_t MiB = 1u << 20, KiB = 1u << 10;
constexpr size_t WS_CTL = 0, CTL_ZERO_BYTES = 64 * KiB;
constexpr size_t WS_ROWSQ = 1 * MiB;
constexpr size_t WS_BA = 2 * MiB;
constexpr size_t WS_CD = 2 * MiB + 512 * KiB;
constexpr size_t WS_WBA = WS_CD + 64 * KiB;
constexpr size_t WS_SGUW = 2 * MiB + 768 * KiB;
constexpr size_t WS_WIN = 3 * MiB;
constexpr size_t WS_WG = WS_WIN + 3840 * 1024 * 2;
constexpr size_t WS_WBR = WS_WG + 3072 * 1024 * 2;
constexpr size_t WS_WOUT = WS_WBR + 3 * 1024 * 512 * 2;
constexpr size_t WS_XB = 22 * MiB;
constexpr size_t WS_UV = 54 * MiB;
constexpr size_t WS_QKVB = 86 * MiB;
constexpr size_t WS_WGU = WS_QKVB;
constexpr size_t WS_WDN = WS_QKVB + 5632 * 1024 * 2;
constexpr size_t WS_QKVC = 110 * MiB;
constexpr size_t WS_BR = WS_QKVC;
constexpr size_t WS_Z = 158 * MiB;
constexpr size_t WS_DN = 174 * MiB;
constexpr size_t WS_HID = 110 * MiB;
constexpr size_t WS_END = 246 * MiB;
static_assert(WS_WOUT + 1024 * 1024 * 2 <= WS_XB && WS_WDN + 1024 * 2816 * 2 <= WS_QKVC && WS_HID + (size_t)TT * DFF * 2 <= WS_END && WS_DN + 1024 * 72 * KiB <= WS_END, "ws map");
constexpr int DN_TASK_BYTES = 73728, DN_OFF_W = 0, DN_OFF_QD = 16384, DN_OFF_AT = 32768, DN_OFF_KD = 40960, DN_OFF_U = 57344;
constexpr int LDS_BYTES = 163840, MISC_OFF = LDS_BYTES - 256;

#define LAS __attribute__((address_space(3)))
typedef unsigned short bf16;
typedef float f32x4 __attribute__((ext_vector_type(4)));
typedef float f32x16 __attribute__((ext_vector_type(16)));
typedef short bf16x8 __attribute__((ext_vector_type(8)));
typedef unsigned u32x4 __attribute__((ext_vector_type(4)));
typedef unsigned u32x2 __attribute__((ext_vector_type(2)));
using pg8::pk2; using pg8::bflo; using pg8::bfhi; using pg8::fast_sigmoid; using pg8::NORM_EPS;
#define MFMA32(a, b, c) __builtin_amdgcn_mfma_f32_32x32x16_bf16((a), (b), (c), 0, 0, 0)
__device__ __forceinline__ int crow(int reg, int h) { return (reg & 3) + 8 * (reg >> 2) + 4 * h; }
__device__ __forceinline__ bf16x8 pack_step(const f32x16& x, int s) {
    u32x4 p; p.x = pk2(x[8 * s], x[8 * s + 1]); p.y = pk2(x[8 * s + 2], x[8 * s + 3]); p.z = pk2(x[8 * s + 4], x[8 * s + 5]); p.w = pk2(x[8 * s + 6], x[8 * s + 7]);
    return __builtin_bit_cast(bf16x8, p);
}
__device__ __forceinline__ float wave_sum(float v) {
#pragma unroll
    for (int o = 1; o < 64; o <<= 1) v += __shfl_xor(v, o);
    return v;
}
__device__ __forceinline__ f32x16 zero16() { f32x16 z; for (int i = 0; i < 16; ++i) z[i] = 0.f; return z; }

struct Params {
    const float* x; const int* pos; const float* attn_norm; const float* w_in; const float* sgu_ln_g; const float* sgu_ln_b; const float* sgu_w; const float* sgu_b;
    const float* sinks; const float* conv_w; const float* a_log; const float* dt_bias; const float* dn_norm; const float* w_branch; const float* w_out; const float* ffn_norm;
    const float* w_gate_up; const float* w_down; const float* final_norm;
    float* out; unsigned char* ws; int ph_lo, ph_hi;
};
struct Frame { LAS unsigned char* lds; int tid, lane, wave, vb, G; };

template <int MAP> __device__ __forceinline__ void transpose_item(const float* W, int ldw, int ncol0, int K, int N, const float* kscale, bf16* WT, LAS float* scr, int item, int lane) {
    const int nblk = N / 32, kb = item / nblk, nb = item % nblk, k0 = 64 * kb, n0 = 32 * nb;
#pragma unroll 8
    for (int i = 0; i < 32; ++i) { const int kk = 2 * i + (lane >> 5); float v = W[(size_t)(k0 + kk) * ldw + ncol0 + n0 + (lane & 31)]; if (kscale) v *= kscale[k0 + kk]; scr[kk * 33 + (lane & 31)] = v; }
    asm volatile("s_waitcnt lgkmcnt(0)" ::: "memory");
    const int c = lane & 7;
#pragma unroll
    for (int j = 0; j < 4; ++j) { const int n = (lane >> 3) + 8 * j; const LAS float* s = scr + (8 * c) * 33 + n;
        u32x4 o; o.x = pk2(s[0 * 33], s[1 * 33]); o.y = pk2(s[2 * 33], s[3 * 33]); o.z = pk2(s[4 * 33], s[5 * 33]); o.w = pk2(s[6 * 33], s[7 * 33]);
        const int nn = n0 + n; int dr = nn;
        if (MAP == 1) { const int f = nn < DFF ? nn : nn - DFF; dr = (f >> 7) * 256 + (nn < DFF ? 0 : 128) + (f & 127); }
        *(u32x4*)(WT + (size_t)dr * K + k0 + 8 * c) = o; }
    asm volatile("s_waitcnt lgkmcnt(0)" ::: "memory");
}
__device__ __forceinline__ void p0_attn_weights(const Frame& F, const Params& P, int l) {
    LAS float* scr = (LAS float*)(F.lds + F.wave * 8448);
    const int gw = F.vb * NWAVES + F.wave, NGW = F.G * NWAVES;
    const float* win = P.w_in + (size_t)l * DM * INC; const float* an = P.attn_norm + l * DM;
    constexpr int I_MIX = 16 * (NMIX / 32), I_G = 16 * (3072 / 32), I_BR = 8 * 32, I_O = 16 * 32, NIT = I_MIX + I_G + 3 * I_BR + I_O;
    for (int it = gw; it < NIT; it += NGW) {
        int r = it;
        if (r < I_MIX) { transpose_item<0>(win, INC, 0, DM, NMIX, an, (bf16*)(P.ws + WS_WIN), scr, r, F.lane); continue; } r -= I_MIX;
        if (r < I_G) { transpose_item<0>(win, INC, C_GATE, DM, 3072, an, (bf16*)(P.ws + WS_WG), scr, r, F.lane); continue; } r -= I_G;
        if (r < 3 * I_BR) { const int n = r / I_BR; transpose_item<0>(P.w_branch + ((size_t)l * 3 + n) * 512 * 1024, 1024, 0, 512, 1024, nullptr, (bf16*)(P.ws + WS_WBR) + (size_t)n * 1024 * 512, scr, r % I_BR, F.lane); continue; } r -= 3 * I_BR;
        transpose_item<0>(P.w_out + (size_t)l * DM * DM, DM, 0, DM, DM, nullptr, (bf16*)(P.ws + WS_WOUT), scr, r, F.lane);
    }
    const int gt = F.vb * NTHR + F.tid, NGT = F.G * NTHR;
    float* wba = (float*)(P.ws + WS_WBA);
    for (int i = gt; i < 8 * DM; i += NGT) { const int c = i >> 10, k = i & 1023; wba[i] = win[(size_t)k * INC + C_BETA + c] * an[k]; }
    bf16* sw = (bf16*)(P.ws + WS_SGUW); const float* sgw = P.sgu_w + (size_t)l * 4 * 128 * 128;
    for (int i = gt; i < 4 * 128 * 128 / 2; i += NGT) { const int e = 2 * i, s = e & 127, t = (e >> 7) & 127; const float a = s <= t ? sgw[e] : 0.f, b = (s + 1) <= t ? sgw[e + 1] : 0.f; ((unsigned*)sw)[i] = pk2(a, b); }
}
__device__ __forceinline__ void p0_ffn_weights(const Frame& F, const Params& P, int l) {
    LAS float* scr = (LAS float*)(F.lds + F.wave * 8448);
    const int gw = F.vb * NWAVES + F.wave, NGW = F.G * NWAVES;
    constexpr int I_GU = 16 * (2 * DFF / 32), I_DN = (DFF / 64) * 32, NIT = I_GU + I_DN;
    for (int it = gw; it < NIT; it += NGW) {
        if (it < I_GU) transpose_item<1>(P.w_gate_up + (size_t)l * DM * 2 * DFF, 2 * DFF, 0, DM, 2 * DFF, P.ffn_norm + l * DM, (bf16*)(P.ws + WS_WGU), scr, it, F.lane);
        else transpose_item<0>(P.w_down + (size_t)l * DFF * DM, DM, 0, DFF, DM, nullptr, (bf16*)(P.ws + WS_WDN), scr, it - I_GU, F.lane);
    }
}
__device__ __forceinline__ void p0_input(const Frame& F, const Params& P) {
    const int gw = F.vb * NWAVES + F.wave, NGW = F.G * NWAVES;
    bf16* xb = (bf16*)(P.ws + WS_XB); float* rowsq = (float*)(P.ws + WS_ROWSQ);
    for (int m = gw; m < TT; m += NGW) {
        const f32x4* xr = (const f32x4*)(P.x + (size_t)m * DM) + F.lane; float s = 0.f;
        unsigned long long* o8 = (unsigned long long*)(xb + (size_t)m * DM) + F.lane;
#pragma unroll
        for (int j = 0; j < 4; ++j) { const f32x4 v = xr[64 * j]; s += (v.x * v.x + v.y * v.y) + (v.z * v.z + v.w * v.w); o8[64 * j] = (unsigned long long)pk2(v.x, v.y) | ((unsigned long long)pk2(v.z, v.w) << 32); }
        s = wave_sum(s);
        if (F.lane < 16) rowsq[(size_t)m * 16 + F.lane] = F.lane == 0 ? s : 0.f;
    }
}
__device__ __forceinline__ void p1_ba(const Frame& F, const Params& P) {
    const int gw = F.vb * NWAVES + F.wave, NGW = F.G * NWAVES;
    const float* wba = (const float*)(P.ws + WS_WBA); const bf16* xb = (const bf16*)(P.ws + WS_XB); const float* rowsq = (const float*)(P.ws + WS_ROWSQ); float* ba = (float*)(P.ws + WS_BA);
    f32x4 wb[8][4];
#pragma unroll
    for (int c = 0; c < 8; ++c)
#pragma unroll
        for (int j = 0; j < 2; ++j) { const f32x4* p = (const f32x4*)(wba + c * DM + F.lane * 8 + 512 * j); wb[c][2 * j] = p[0]; wb[c][2 * j + 1] = p[1]; }
    for (int m = gw; m < TT; m += NGW) {
        float xv[16];
#pragma unroll
        for (int j = 0; j < 2; ++j) { const u32x4 w = *(const u32x4*)(xb + (size_t)m * DM + F.lane * 8 + 512 * j);
            xv[8 * j + 0] = bflo(w.x); xv[8 * j + 1] = bfhi(w.x); xv[8 * j + 2] = bflo(w.y); xv[8 * j + 3] = bfhi(w.y); xv[8 * j + 4] = bflo(w.z); xv[8 * j + 5] = bfhi(w.z); xv[8 * j + 6] = bflo(w.w); xv[8 * j + 7] = bfhi(w.w); }
        float sq = F.lane < 16 ? rowsq[(size_t)m * 16 + F.lane] : 0.f; sq = wave_sum(sq);
        const float rs = __builtin_amdgcn_rsqf(sq * (1.0f / 1024.0f) + NORM_EPS);
        float mine = 0.f;
#pragma unroll
        for (int c = 0; c < 8; ++c) { float d = 0.f;
#pragma unroll
            for (int q = 0; q < 4; ++q) d += (xv[4 * q] * wb[c][q].x + xv[4 * q + 1] * wb[c][q].y) + (xv[4 * q + 2] * wb[c][q].z + xv[4 * q + 3] * wb[c][q].w);
            d = wave_sum(d); if (F.lane == c) mine = d; }
        if (F.lane < 8) ba[(size_t)m * 8 + F.lane] = mine * rs;
    }
}

__device__ __forceinline__ void sgu_task(const Frame& F, const Params& P, int l, int task) {
    const int g = task & 3, cb = task >> 2, m0 = cb * 128;
    const bf16* uv = (const bf16*)(P.ws + WS_UV); bf16* bra = (bf16*)(P.ws + WS_BR);
    LAS bf16* vnT = (LAS bf16*)F.lds;
    const int r = F.tid >> 2, qq = F.tid & 3;
    { const bf16* vrow = uv + (size_t)(m0 + r) * 1024 + 512 + qq * 128; float s = 0.f, s2 = 0.f;
#pragma unroll
      for (int j = 0; j < 16; ++j) { const u32x4 w = *(const u32x4*)(vrow + 8 * j); const float a0 = bflo(w.x), a1 = bfhi(w.x), a2 = bflo(w.y), a3 = bfhi(w.y), a4 = bflo(w.z), a5 = bfhi(w.z), a6 = bflo(w.w), a7 = bfhi(w.w);
          s += ((a0 + a1) + (a2 + a3)) + ((a4 + a5) + (a6 + a7)); s2 += ((a0 * a0 + a1 * a1) + (a2 * a2 + a3 * a3)) + ((a4 * a4 + a5 * a5) + (a6 * a6 + a7 * a7)); }
      s += __shfl_xor(s, 1); s += __shfl_xor(s, 2); s2 += __shfl_xor(s2, 1); s2 += __shfl_xor(s2, 2);
      const float mean = s * (1.f / 512.f); float var = s2 * (1.f / 512.f) - mean * mean; var = var > 0.f ? var : 0.f; const float rstd = __builtin_amdgcn_rsqf(var + NORM_EPS);
      const bf16* vg = uv + (size_t)(m0 + r) * 1024 + 512 + g * 128 + qq * 32; const float* lg = P.sgu_ln_g + l * 512 + g * 128 + qq * 32; const float* lb = P.sgu_ln_b + l * 512 + g * 128 + qq * 32;
#pragma unroll
      for (int j = 0; j < 4; ++j) { const u32x4 w = *(const u32x4*)(vg + 8 * j); const float a[8] = {bflo(w.x), bfhi(w.x), bflo(w.y), bfhi(w.y), bflo(w.z), bfhi(w.z), bflo(w.w), bfhi(w.w)};
#pragma unroll
          for (int i = 0; i < 8; ++i) { const int c = qq * 32 + 8 * j + i; const float y = (a[i] - mean) * rstd * lg[8 * j + i] + lb[8 * j + i]; vnT[c * 136 + r] = (bf16)(pk2(y, 0.f) & 0xffffu); } }
    }
    __syncthreads();
    const int lr = F.lane & 31, h = F.lane >> 5, ct = F.wave >> 1;
    const bf16* sw = (const bf16*)(P.ws + WS_SGUW) + (size_t)g * 128 * 128;
#pragma unroll
    for (int t2 = 0; t2 < 2; ++t2) { const int tt = 2 * (F.wave & 1) + t2; f32x16 acc = zero16();
        for (int ks = 0; ks < 2 * (tt + 1); ++ks) {
            const bf16x8 a = *(const LAS bf16x8*)(vnT + (32 * ct + lr) * 136 + 16 * ks + 8 * h);
            const bf16x8 b = *(const bf16x8*)(sw + (size_t)(32 * tt + lr) * 128 + 16 * ks + 8 * h);
            acc = MFMA32(a, b, acc); }
        const int t = 32 * tt + lr; const float bias = P.sgu_b[l * 512 + g * 128 + t];
#pragma unroll
        for (int gq = 0; gq < 4; ++gq) { const int c0 = 32 * ct + 8 * gq + 4 * h; const u32x2 uu = *(const u32x2*)(uv + (size_t)(m0 + t) * 1024 + g * 128 + c0);
            u32x2 o; o.x = pk2(bflo(uu.x) * (acc[4 * gq] + bias), bfhi(uu.x) * (acc[4 * gq + 1] + bias)); o.y = pk2(bflo(uu.y) * (acc[4 * gq + 2] + bias), bfhi(uu.y) * (acc[4 * gq + 3] + bias));
            *(u32x2*)(bra + (size_t)(m0 + t) * 512 + g * 128 + c0) = o; } }
    __syncthreads();
}

__device__ __forceinline__ void swa_task(const Frame& F, const Params& P, int l, int task) {
    const int kvh = task & 1, cb = task >> 1, nq = cb & 63, m0 = cb * 128;
    const bf16* qkvb = (const bf16*)(P.ws + WS_QKVB); bf16* brb = (bf16*)(P.ws + WS_BR) + (size_t)TT * 512;
    LAS bf16* Qs = (LAS bf16*)F.lds;
    LAS bf16* Ks = (LAS bf16*)(F.lds + 73728);
    LAS bf16* VT = (LAS bf16*)(F.lds + 110592);
    for (int i = F.tid; i < 4096; i += NTHR) { const int g = i >> 10, r = (i >> 3) & 127, c8 = i & 7; if (c8 < 2) continue;
        const u32x4 w = *(const u32x4*)(qkvb + (size_t)(m0 + r) * 768 + (kvh * 4 + g) * 64 + c8 * 8);
        u32x4 o; o.x = pk2(bflo(w.x) * 0.125f, bfhi(w.x) * 0.125f); o.y = pk2(bflo(w.y) * 0.125f, bfhi(w.y) * 0.125f); o.z = pk2(bflo(w.z) * 0.125f, bfhi(w.z) * 0.125f); o.w = pk2(bflo(w.w) * 0.125f, bfhi(w.w) * 0.125f);
        *(LAS u32x4*)(Qs + (g * 128 + r) * 72 + c8 * 8) = o; }
    const float invf[8] = {1.0f, 0.19392274474868576f, 0.03760603093086393f, 0.007292664737217109f, 0.001414213562373095f, 0.0002742481756762073f, 5.318295896944988e-05f, 1.031338537721246e-05f};
    { const int g = F.tid >> 7, r = F.tid & 127; const float pos = (float)P.pos[m0 + r];
      const bf16* src = qkvb + (size_t)(m0 + r) * 768 + (kvh * 4 + g) * 64; const u32x4 w1 = *(const u32x4*)src, w2 = *(const u32x4*)(src + 8);
      const float x1[8] = {bflo(w1.x), bfhi(w1.x), bflo(w1.y), bfhi(w1.y), bflo(w1.z), bfhi(w1.z), bflo(w1.w), bfhi(w1.w)}, x2[8] = {bflo(w2.x), bfhi(w2.x), bflo(w2.y), bfhi(w2.y), bflo(w2.z), bfhi(w2.z), bflo(w2.w), bfhi(w2.w)};
      float o1[8], o2[8];
#pragma unroll
      for (int i = 0; i < 8; ++i) { float sn, cs; sincosf(pos * invf[i], &sn, &cs); o1[i] = (x1[i] * cs - x2[i] * sn) * 0.125f; o2[i] = (x2[i] * cs + x1[i] * sn) * 0.125f; }
      u32x4 a, b; a.x = pk2(o1[0], o1[1]); a.y = pk2(o1[2], o1[3]); a.z = pk2(o1[4], o1[5]); a.w = pk2(o1[6], o1[7]); b.x = pk2(o2[0], o2[1]); b.y = pk2(o2[2], o2[3]); b.z = pk2(o2[4], o2[5]); b.w = pk2(o2[6], o2[7]);
      *(LAS u32x4*)(Qs + (g * 128 + r) * 72) = a; *(LAS u32x4*)(Qs + (g * 128 + r) * 72 + 8) = b; }
    for (int i = F.tid; i < 2048; i += NTHR) { const int s = i >> 3, c8 = i & 7; const bool ok = nq > 0 || s >= 128; const size_t row = (size_t)(m0 - 128 + s);
        u32x4 kw = {0u, 0u, 0u, 0u}, vw = {0u, 0u, 0u, 0u};
        if (ok) { if (c8 >= 2) kw = *(const u32x4*)(qkvb + row * 768 + 512 + kvh * 64 + c8 * 8); vw = *(const u32x4*)(qkvb + row * 768 + 640 + kvh * 64 + c8 * 8); }
        if (c8 >= 2) *(LAS u32x4*)(Ks + s * 72 + c8 * 8) = kw;
        const int p = (s & ~12) | ((s & 4) << 1) | ((s & 8) >> 1); const unsigned vv[4] = {vw.x, vw.y, vw.z, vw.w};
#pragma unroll
        for (int j = 0; j < 4; ++j) { VT[(c8 * 8 + 2 * j) * 264 + p] = (bf16)(vv[j] & 0xffffu); VT[(c8 * 8 + 2 * j + 1) * 264 + p] = (bf16)(vv[j] >> 16); } }
    if (F.tid < 256) { const int s = F.tid; const bool ok = nq > 0 || s >= 128; u32x4 a = {0u, 0u, 0u, 0u}, b = {0u, 0u, 0u, 0u};
        if (ok) { const size_t row = (size_t)(m0 - 128 + s); const float pos = (float)P.pos[row]; const bf16* src = qkvb + row * 768 + 512 + kvh * 64; const u32x4 w1 = *(const u32x4*)src, w2 = *(const u32x4*)(src + 8);
            const float x1[8] = {bflo(w1.x), bfhi(w1.x), bflo(w1.y), bfhi(w1.y), bflo(w1.z), bfhi(w1.z), bflo(w1.w), bfhi(w1.w)}, x2[8] = {bflo(w2.x), bfhi(w2.x), bflo(w2.y), bfhi(w2.y), bflo(w2.z), bfhi(w2.z), bflo(w2.w), bfhi(w2.w)};
            float o1[8], o2[8];
#pragma unroll
            for (int i = 0; i < 8; ++i) { float sn, cs; sincosf(pos * invf[i], &sn, &cs); o1[i] = x1[i] * cs - x2[i] * sn; o2[i] = x2[i] * cs + x1[i] * sn; }
            a.x = pk2(o1[0], o1[1]); a.y = pk2(o1[2], o1[3]); a.z = pk2(o1[4], o1[5]); a.w = pk2(o1[6], o1[7]); b.x = pk2(o2[0], o2[1]); b.y = pk2(o2[2], o2[3]); b.z = pk2(o2[4], o2[5]); b.w = pk2(o2[6], o2[7]); }
        *(LAS u32x4*)(Ks + s * 72) = a; *(LAS u32x4*)(Ks + s * 72 + 8) = b; }
    __syncthreads();
    const int lr = F.lane & 31, h = F.lane >> 5, g = F.wave >> 1, qh = F.wave & 1;
    const float sink = P.sinks[l * 8 + kvh * 4 + g];
#pragma unroll 1
    for (int q2 = 0; q2 < 2; ++q2) { const int qt = 2 * qh + q2, q0 = 32 * qt, qi = q0 + lr;
        bf16x8 bq[4];
#pragma unroll
        for (int ks = 0; ks < 4; ++ks) bq[ks] = *(const LAS bf16x8*)(Qs + (g * 128 + q0 + lr) * 72 + 16 * ks + 8 * h);
        f32x16 sc[5];
#pragma unroll
        for (int k5 = 0; k5 < 5; ++k5) { sc[k5] = zero16();
#pragma unroll
            for (int ks = 0; ks < 4; ++ks) { const bf16x8 a = *(const LAS bf16x8*)(Ks + (32 * (qt + k5) + lr) * 72 + 16 * ks + 8 * h); sc[k5] = MFMA32(a, bq[ks], sc[k5]); } }
        float mx = sink;
#pragma unroll
        for (int k5 = 0; k5 < 5; ++k5)
#pragma unroll
            for (int rg = 0; rg < 16; ++rg) { const int sj = 32 * (qt + k5) + crow(rg, h); const bool ok = sj >= qi + 1 && sj <= qi + 128 && (nq > 0 || sj >= 128);
                const float v = ok ? sc[k5][rg] : -INFINITY; sc[k5][rg] = v; mx = fmaxf(mx, v); }
        mx = fmaxf(mx, __shfl_xor(mx, 32));
        float sum = 0.f;
#pragma unroll
        for (int k5 = 0; k5 < 5; ++k5)
#pragma unroll
            for (int rg = 0; rg < 16; ++rg) { const float p = __expf(sc[k5][rg] - mx); sc[k5][rg] = p; sum += p; }
        sum += __shfl_xor(sum, 32); sum += __expf(sink - mx);
        const float inv = 1.0f / sum;
        f32x16 o[2] = {zero16(), zero16()};
#pragma unroll
        for (int k5 = 0; k5 < 5; ++k5)
#pragma unroll
            for (int s2 = 0; s2 < 2; ++s2) { const bf16x8 pb = pack_step(sc[k5], s2);
#pragma unroll
                for (int dt = 0; dt < 2; ++dt) { const bf16x8 a = *(const LAS bf16x8*)(VT + (32 * dt + lr) * 264 + 32 * (qt + k5) + 16 * s2 + 8 * h); o[dt] = MFMA32(a, pb, o[dt]); } }
        bf16* orow = brb + (size_t)(m0 + qi) * 512 + (kvh * 4 + g) * 64;
#pragma unroll
        for (int dt = 0; dt < 2; ++dt)
#pragma unroll
            for (int gq = 0; gq < 4; ++gq) { u32x2 w; w.x = pk2(o[dt][4 * gq] * inv, o[dt][4 * gq + 1] * inv); w.y = pk2(o[dt][4 * gq + 2] * inv, o[dt][4 * gq + 3] * inv);
                *(u32x2*)(orow + 32 * dt + 8 * gq + 4 * h) = w; }
    }
    __syncthreads();
}

__device__ __forceinline__ void dn_pre_task(const Frame& F, const Params& P, int l, int task) {
    const int hd = task & 3, cbn = task >> 2, b = cbn >> 7, n = cbn & 127, m0 = cbn * 64;
    const bf16* qkvc = (const bf16*)(P.ws + WS_QKVC); const float* ba = (const float*)(P.ws + WS_BA);
    unsigned char* outb = P.ws + WS_DN + (size_t)task * DN_TASK_BYTES;
    LAS bf16* qs = (LAS bf16*)F.lds;
    LAS bf16* ks = (LAS bf16*)(F.lds + 17408);
    LAS bf16* kT = (LAS bf16*)(F.lds + 34816);
    LAS bf16* vT = (LAS bf16*)(F.lds + 53248);
    LAS float* Lm = (LAS float*)(F.lds + 71680);
    LAS bf16* Tm = (LAS bf16*)(F.lds + 89088);
    LAS float* tg = (LAS float*)(F.lds + 98304);
    LAS float *tgc = tg + 64, *tbeta = tg + 128, *teg = tg + 192, *ted = tg + 256, *tsb = tg + 320;
    const int lr = F.lane & 31, h = F.lane >> 5;
    { const int t = F.tid >> 3, seg = F.tid & 7, c0 = seg * 16; const int row = m0 + t;
      const float beta = fast_sigmoid(ba[(size_t)row * 8 + hd]); const float xa = ba[(size_t)row * 8 + 4 + hd] + P.dt_bias[l * 4 + hd];
      const float sp = xa > 20.f ? xa : log1pf(__expf(xa)); const float gt = -__expf(P.a_log[l * 4 + hd]) * sp;
      if (seg == 0) { tg[t] = gt; tbeta[t] = beta; }
#pragma unroll
      for (int part = 0; part < 3; ++part) { const int col0 = part * 512 + hd * 128 + c0; float acc[16];
#pragma unroll
          for (int i = 0; i < 16; ++i) acc[i] = 0.f;
#pragma unroll
          for (int tap = 0; tap < 4; ++tap) { const int sr = n * 64 + t - 3 + tap; if (sr >= 0) {
              const bf16* src = qkvc + (size_t)(b * SEQ + sr) * 1536 + col0; const u32x4 w1 = *(const u32x4*)src, w2 = *(const u32x4*)(src + 8);
              const float xv[16] = {bflo(w1.x), bfhi(w1.x), bflo(w1.y), bfhi(w1.y), bflo(w1.z), bfhi(w1.z), bflo(w1.w), bfhi(w1.w), bflo(w2.x), bfhi(w2.x), bflo(w2.y), bfhi(w2.y), bflo(w2.z), bfhi(w2.z), bflo(w2.w), bfhi(w2.w)};
              const f32x4* cw = (const f32x4*)(P.conv_w + ((size_t)l * 4 + tap) * 1536 + col0);
#pragma unroll
              for (int q = 0; q < 4; ++q) { const f32x4 w = cw[q]; acc[4 * q] += xv[4 * q] * w.x; acc[4 * q + 1] += xv[4 * q + 1] * w.y; acc[4 * q + 2] += xv[4 * q + 2] * w.z; acc[4 * q + 3] += xv[4 * q + 3] * w.w; } } }
          float ss = 0.f;
#pragma unroll
          for (int i = 0; i < 16; ++i) { acc[i] = acc[i] * fast_sigmoid(acc[i]); ss += acc[i] * acc[i]; }
          if (part < 2) { ss += __shfl_xor(ss, 1); ss += __shfl_xor(ss, 2); ss += __shfl_xor(ss, 4); const float rn = __builtin_amdgcn_rsqf(ss + NORM_EPS) * (part == 0 ? 0.08838834764831845f : 1.0f);
#pragma unroll
              for (int i = 0; i < 16; ++i) acc[i] *= rn; }
          else {
#pragma unroll
              for (int i = 0; i < 16; ++i) acc[i] *= beta; }
          unsigned pk[8];
#pragma unroll
          for (int i = 0; i < 8; ++i) pk[i] = pk2(acc[2 * i], acc[2 * i + 1]);
          if (part < 2) { LAS bf16* dst = (part == 0 ? qs : ks) + t * 136 + c0; *(LAS u32x4*)dst = (u32x4){pk[0], pk[1], pk[2], pk[3]}; *(LAS u32x4*)(dst + 8) = (u32x4){pk[4], pk[5], pk[6], pk[7]}; }
          if (part >= 1) { LAS bf16* dT = part == 1 ? kT : vT;
#pragma unroll
              for (int i = 0; i < 8; ++i) { dT[(c0 + 2 * i) * 72 + t] = (bf16)(pk[i] & 0xffffu); dT[(c0 + 2 * i + 1) * 72 + t] = (bf16)(pk[i] >> 16); } }
      }
    }
    __syncthreads();
    if (F.wave == 0) { float x = tg[F.lane];
#pragma unroll
        for (int o = 1; o < 64; o <<= 1) { const float y = __shfl_up(x, o); if (F.lane >= o) x += y; }
        const float gl = __shfl(x, 63); tgc[F.lane] = x; const float e = __expf(x); teg[F.lane] = e; ted[F.lane] = __expf(gl - x); tsb[F.lane] = tbeta[F.lane] * e;
        if (F.lane == 0) ((float*)(P.ws + WS_CD))[task] = __expf(gl); }
    __syncthreads();
    if (F.wave < 4) { const int it = F.wave >> 1, jt = F.wave & 1; f32x16 acc = zero16();
        if (jt <= it) {
#pragma unroll
            for (int s = 0; s < 8; ++s) { const bf16x8 a = *(const LAS bf16x8*)(ks + (32 * it + lr) * 136 + 16 * s + 8 * h), bb = *(const LAS bf16x8*)(ks + (32 * jt + lr) * 136 + 16 * s + 8 * h); acc = MFMA32(a, bb, acc); } }
        const int j = 32 * jt + lr; const float gj = tgc[j];
#pragma unroll
        for (int rg = 0; rg < 16; ++rg) { const int i = 32 * it + crow(rg, h); const float v = i > j ? tbeta[i] * acc[rg] * __expf(tgc[i] - gj) : 0.f; Lm[i * 68 + j] = v; } }
    else { const int w4 = F.wave - 4, jt = w4 >> 1, ct = w4 & 1; f32x16 acc = zero16();
        if (jt <= ct) {
#pragma unroll
            for (int s = 0; s < 8; ++s) { const bf16x8 a = *(const LAS bf16x8*)(ks + (32 * jt + lr) * 136 + 16 * s + 8 * h), bb = *(const LAS bf16x8*)(qs + (32 * ct + lr) * 136 + 16 * s + 8 * h); acc = MFMA32(a, bb, acc); } }
        const int c = 32 * ct + lr; const float gcc = tgc[c];
#pragma unroll
        for (int rg = 0; rg < 16; ++rg) { const int jp = 32 * jt + crow(rg, h); acc[rg] = jp <= c ? acc[rg] * __expf(gcc - tgc[jp]) : 0.f; }
#pragma unroll
        for (int s = 0; s < 2; ++s) *(bf16x8*)(outb + DN_OFF_AT + ((ct * 4 + 2 * jt + s) * 64 + F.lane) * 16) = pack_step(acc, s); }
    __syncthreads();
    if (F.wave == 0) { LAS float* Tf = (LAS float*)(F.lds + 99840);
#pragma unroll 1
        for (int bi = 0; bi < 4; ++bi) { float rr[16];
#pragma unroll
            for (int ii = 0; ii < 16; ++ii) rr[ii] = (F.lane == 16 * bi + ii) ? 1.f : 0.f;
#pragma unroll 1
            for (int j = 0; j < 16 * bi; j += 4) { const float t0 = Tf[j * 64 + F.lane], t1 = Tf[(j + 1) * 64 + F.lane], t2 = Tf[(j + 2) * 64 + F.lane], t3 = Tf[(j + 3) * 64 + F.lane];
#pragma unroll
                for (int ii = 0; ii < 16; ++ii) { const f32x4 lv = *(const LAS f32x4*)(Lm + (16 * bi + ii) * 68 + j); rr[ii] -= (lv.x * t0 + lv.y * t1) + (lv.z * t2 + lv.w * t3); } }
#pragma unroll
            for (int ii = 0; ii < 16; ++ii) {
#pragma unroll
                for (int j4 = 0; j4 < ii; j4 += 4) { const f32x4 lv = *(const LAS f32x4*)(Lm + (16 * bi + ii) * 68 + 16 * bi + j4);
                    rr[ii] -= lv.x * rr[j4]; if (j4 + 1 < ii) rr[ii] -= lv.y * rr[j4 + 1]; if (j4 + 2 < ii) rr[ii] -= lv.z * rr[j4 + 2]; if (j4 + 3 < ii) rr[ii] -= lv.w * rr[j4 + 3]; }
                Tf[(16 * bi + ii) * 64 + F.lane] = rr[ii]; Tm[(16 * bi + ii) * 72 + F.lane] = (bf16)(pk2(rr[ii], 0.f) & 0xffffu); } } }
    else { for (int f = F.wave - 1; f < 32; f += 7) {
            if (f < 16) { const int mt = f >> 3, s = f & 7, c = 32 * mt + lr; const float e = teg[c];
                const u32x2 lo = *(const LAS u32x2*)(qs + c * 136 + 16 * s + 4 * h), hi = *(const LAS u32x2*)(qs + c * 136 + 16 * s + 8 + 4 * h);
                u32x4 o; o.x = pk2(bflo(lo.x) * e, bfhi(lo.x) * e); o.y = pk2(bflo(lo.y) * e, bfhi(lo.y) * e); o.z = pk2(bflo(hi.x) * e, bfhi(hi.x) * e); o.w = pk2(bflo(hi.y) * e, bfhi(hi.y) * e);
                *(u32x4*)(outb + DN_OFF_QD + ((mt * 8 + s) * 64 + F.lane) * 16) = o; }
            else { const int f2 = f - 16, dt = f2 >> 2, s = f2 & 3, d = 32 * dt + lr;
                const u32x2 lo = *(const LAS u32x2*)(kT + d * 72 + 16 * s + 4 * h), hi = *(const LAS u32x2*)(kT + d * 72 + 16 * s + 8 + 4 * h);
                const f32x4 e0 = *(const LAS f32x4*)(ted + 16 * s + 4 * h), e1 = *(const LAS f32x4*)(ted + 16 * s + 8 + 4 * h);
                u32x4 o; o.x = pk2(bflo(lo.x) * e0.x, bfhi(lo.x) * e0.y); o.y = pk2(bflo(lo.y) * e0.z, bfhi(lo.y) * e0.w); o.z = pk2(bflo(hi.x) * e1.x, bfhi(hi.x) * e1.y); o.w = pk2(bflo(hi.y) * e1.z, bfhi(hi.y) * e1.w);
                *(u32x4*)(outb + DN_OFF_KD + ((dt * 4 + s) * 64 + F.lane) * 16) = o; } } }
    __syncthreads();
    { const int it = F.wave >> 2, et = F.wave & 3; f32x16 acc = zero16();
#pragma unroll
      for (int s = 0; s < 4; ++s) { const bf16x8 a = *(const LAS bf16x8*)(Tm + (32 * it + lr) * 72 + 16 * s + 8 * h), bb = *(const LAS bf16x8*)(vT + (32 * et + lr) * 72 + 16 * s + 8 * h); acc = MFMA32(a, bb, acc); }
      u32x4 o0, o1; o0.x = pk2(acc[0], acc[1]); o0.y = pk2(acc[2], acc[3]); o0.z = pk2(acc[4], acc[5]); o0.w = pk2(acc[6], acc[7]); o1.x = pk2(acc[8], acc[9]); o1.y = pk2(acc[10], acc[11]); o1.z = pk2(acc[12], acc[13]); o1.w = pk2(acc[14], acc[15]);
      unsigned char* up = outb + DN_OFF_U + ((et * 2 + it) * 64 + F.lane) * 32; *(u32x4*)up = o0; *(u32x4*)(up + 16) = o1; }
    { const int dt = F.wave >> 1, it = F.wave & 1; f32x16 acc = zero16();
#pragma unroll
      for (int s = 0; s < 4; ++s) { const u32x4 kw = *(const LAS u32x4*)(kT + (32 * dt + lr) * 72 + 16 * s + 8 * h); const f32x4 e0 = *(const LAS f32x4*)(tsb + 16 * s + 8 * h), e1 = *(const LAS f32x4*)(tsb + 16 * s + 8 * h + 4);
          u32x4 aw; aw.x = pk2(bflo(kw.x) * e0.x, bfhi(kw.x) * e0.y); aw.y = pk2(bflo(kw.y) * e0.z, bfhi(kw.y) * e0.w); aw.z = pk2(bflo(kw.z) * e1.x, bfhi(kw.z) * e1.y); aw.w = pk2(bflo(kw.w) * e1.z, bfhi(kw.w) * e1.w);
          const bf16x8 bb = *(const LAS bf16x8*)(Tm + (32 * it + lr) * 72 + 16 * s + 8 * h); acc = MFMA32(__builtin_bit_cast(bf16x8, aw), bb, acc); }
#pragma unroll
      for (int s = 0; s < 2; ++s) *(bf16x8*)(outb + DN_OFF_W + ((it * 8 + 2 * dt + s) * 64 + F.lane) * 16) = pack_step(acc, s); }
    __syncthreads();
}
constexpr int SC_BUF = 49152;
#define SC_BARRIER() do { asm volatile("s_waitcnt lgkmcnt(0)" ::: "memory"); __builtin_amdgcn_s_barrier(); asm volatile("" ::: "memory"); } while (0)
__device__ __forceinline__ void dn_scan(const Frame& F, const Params& P, int bh, bool nostore = false) {
    const int b = bh >> 2, hd = bh & 3; const int es = F.wave;
    unsigned char* dn = P.ws + WS_DN; const float* cdv = (const float*)(P.ws + WS_CD);
#define task_of(n_) ((((b) * 128 + (n_)) << 2) | (hd))
#define SC_SRC(n_, i_) ((const u32x4*)(dn + (size_t)task_of(n_) * DN_TASK_BYTES + ((i_) < 4 ? 0 : ((i_) < 8 ? DN_OFF_KD - 16384 : DN_OFF_U - 32768))) + t4 + 256 * (i_))
    if (F.wave >= 4) {
        const int t4 = F.tid - 256; u32x4 R0[12], R1[12], R2[12]; LAS float* cdl = (LAS float*)(F.lds + 2 * SC_BUF);
        float C0 = cdv[task_of(1)], C1 = cdv[task_of(2)], C2 = cdv[task_of(3)];
        if (t4 == 0) cdl[0] = cdv[task_of(0)];
        { LAS u32x4* dst = (LAS u32x4*)F.lds;
#pragma unroll
          for (int i = 0; i < 12; ++i) R0[i] = *SC_SRC(0, i);
#pragma unroll
          for (int i = 0; i < 12; ++i) dst[t4 + 256 * i] = R0[i]; }
#pragma unroll
        for (int i = 0; i < 12; ++i) { R0[i] = *SC_SRC(1, i); R1[i] = *SC_SRC(2, i); R2[i] = *SC_SRC(3, i); }
        SC_BARRIER();
#define SC_LSTEP(R, C, n_) if ((n_) < 128) { if ((n_) + 1 < 128) { LAS u32x4* dst = (LAS u32x4*)(F.lds + (((n_) + 1) & 1) * SC_BUF); \
            _Pragma("unroll") for (int i = 0; i < 12; ++i) dst[t4 + 256 * i] = R[i]; if (t4 == 0) cdl[((n_) + 1) & 1] = C; } \
            if ((n_) + 4 < 128) { _Pragma("unroll") for (int i = 0; i < 12; ++i) R[i] = *SC_SRC((n_) + 4, i); C = cdv[task_of((n_) + 4)]; } \
            SC_BARRIER(); }
#pragma unroll
        for (int n = 0; n < 129; n += 3) { SC_LSTEP(R0, C0, n) SC_LSTEP(R1, C1, n + 1) SC_LSTEP(R2, C2, n + 2) }
#undef SC_LSTEP
    } else {
        f32x16 S[4] = {zero16(), zero16(), zero16(), zero16()};
        const LAS float* cdl = (const LAS float*)(F.lds + 2 * SC_BUF);
        SC_BARRIER();
#pragma unroll 1
        for (int n = 0; n < 128; ++n) {
            const LAS unsigned char* cur = F.lds + (n & 1) * SC_BUF; unsigned char* tb = dn + (size_t)task_of(n) * DN_TASK_BYTES;
            const float cd = cdl[n & 1];
            bf16x8 Sb[8], A[16];
#pragma unroll
            for (int i = 0; i < 16; ++i) A[i] = *(const LAS bf16x8*)(cur + (i * 64 + F.lane) * 16);
#pragma unroll
            for (int dt = 0; dt < 4; ++dt) { Sb[2 * dt] = pack_step(S[dt], 0); Sb[2 * dt + 1] = pack_step(S[dt], 1); }
            { unsigned char* hp = tb + (es < 2 ? 0 : DN_OFF_KD) + ((es & 1) * 8 * 64 + F.lane) * 16;
              if (!nostore) {
#pragma unroll
              for (int s = 0; s < 8; ++s) *(bf16x8*)(hp + s * 1024) = Sb[s]; } }
            __builtin_amdgcn_sched_barrier(0);
            f32x16 Pw[2] = {zero16(), zero16()};
#pragma unroll
            for (int s = 0; s < 8; ++s) { Pw[0] = MFMA32(A[s], Sb[s], Pw[0]); Pw[1] = MFMA32(A[8 + s], Sb[s], Pw[1]); }
            __builtin_amdgcn_sched_barrier(0);
            u32x4 uu[4];
#pragma unroll
            for (int i = 0; i < 4; ++i) uu[i] = *(const LAS u32x4*)(cur + 32768 + ((es * 2 + (i >> 1)) * 64 + F.lane) * 32 + (i & 1) * 16);
#pragma unroll
            for (int i = 0; i < 16; ++i) A[i] = *(const LAS bf16x8*)(cur + 16384 + (i * 64 + F.lane) * 16);
            __builtin_amdgcn_sched_barrier(0);
            bf16x8 Vb[4];
#pragma unroll
            for (int ct = 0; ct < 2; ++ct) { const unsigned uw[8] = {uu[2 * ct].x, uu[2 * ct].y, uu[2 * ct].z, uu[2 * ct].w, uu[2 * ct + 1].x, uu[2 * ct + 1].y, uu[2 * ct + 1].z, uu[2 * ct + 1].w}; f32x16 v;
#pragma unroll
                for (int p = 0; p < 8; ++p) { v[2 * p] = bflo(uw[p]) - Pw[ct][2 * p]; v[2 * p + 1] = bfhi(uw[p]) - Pw[ct][2 * p + 1]; }
                Vb[2 * ct] = pack_step(v, 0); Vb[2 * ct + 1] = pack_step(v, 1); }
            { unsigned char* vp = tb + DN_OFF_U + (es * 4 * 64 + F.lane) * 16;
              if (!nostore) {
#pragma unroll
              for (int s = 0; s < 4; ++s) *(bf16x8*)(vp + s * 1024) = Vb[s]; } }
#pragma unroll
            for (int dt = 0; dt < 4; ++dt) S[dt] = S[dt] * cd;
            __builtin_amdgcn_sched_barrier(0);
#pragma unroll
            for (int s = 0; s < 4; ++s)
#pragma unroll
                for (int dt = 0; dt < 4; ++dt) S[dt] = MFMA32(A[dt * 4 + s], Vb[s], S[dt]);
            SC_BARRIER();
        }
    }
#undef SC_SRC
#undef task_of
}
__device__ __forceinline__ void dn_out_task(const Frame& F, const Params& P, int l, int task) {
    const int hd = task & 3, cbn = task >> 2, m0 = cbn * 64; const int lr = F.lane & 31, h = F.lane >> 5, ct = F.wave >> 2, es = F.wave & 3;
    const unsigned char* tb = P.ws + WS_DN + (size_t)task * DN_TASK_BYTES; bf16* brc = (bf16*)(P.ws + WS_BR) + (size_t)2 * TT * 512; const bf16* z = (const bf16*)(P.ws + WS_Z);
    LAS float* ssq = (LAS float*)F.lds;
    f32x16 o = zero16();
    { const unsigned char* hp = tb + (es < 2 ? 0 : DN_OFF_KD) + ((es & 1) * 8 * 64 + F.lane) * 16;
#pragma unroll
      for (int s = 0; s < 8; ++s) { const bf16x8 a = *(const bf16x8*)(tb + DN_OFF_QD + ((ct * 8 + s) * 64 + F.lane) * 16), bb = *(const bf16x8*)(hp + s * 1024); o = MFMA32(a, bb, o); }
      const unsigned char* vp = tb + DN_OFF_U + (es * 4 * 64 + F.lane) * 16;
#pragma unroll
      for (int s = 0; s < 4; ++s) { const bf16x8 a = *(const bf16x8*)(tb + DN_OFF_AT + ((ct * 4 + s) * 64 + F.lane) * 16), bb = *(const bf16x8*)(vp + s * 1024); o = MFMA32(a, bb, o); } }
    float q[16];
#pragma unroll
    for (int rg = 0; rg < 16; ++rg) { float v = o[rg] * o[rg]; v += __shfl_xor(v, 1); v += __shfl_xor(v, 2); v += __shfl_xor(v, 4); v += __shfl_xor(v, 8); v += __shfl_xor(v, 16); q[rg] = v; }
    if (lr == 0) {
#pragma unroll
        for (int rg = 0; rg < 16; ++rg) ssq[(ct * 4 + es) * 32 + crow(rg, h)] = q[rg]; }
    __syncthreads();
    const int e = hd * 128 + es * 32 + lr; const float gn = P.dn_norm[l * 128 + es * 32 + lr];
#pragma unroll
    for (int rg = 0; rg < 16; ++rg) { const int r = crow(rg, h); const float tot = (ssq[(ct * 4 + 0) * 32 + r] + ssq[(ct * 4 + 1) * 32 + r]) + (ssq[(ct * 4 + 2) * 32 + r] + ssq[(ct * 4 + 3) * 32 + r]);
        const float rs = __builtin_amdgcn_rsqf(tot * (1.f / 128.f) + NORM_EPS); const size_t idx = (size_t)(m0 + 32 * ct + r) * 512 + e;
        const float zz = __uint_as_float(((unsigned)z[idx]) << 16); brc[idx] = (bf16)(pk2(o[rg] * rs * gn * (zz * fast_sigmoid(zz)), 0.f) & 0xffffu); }
    __syncthreads();
}
__device__ __forceinline__ void final_norm(const Frame& F, const Params& P) {
    const int gw = F.vb * NWAVES + F.wave, NGW = F.G * NWAVES; const float* rowsq = (const float*)(P.ws + WS_ROWSQ);
    f32x4 gn[4];
#pragma unroll
    for (int j = 0; j < 4; ++j) gn[j] = ((const f32x4*)P.final_norm)[F.lane + 64 * j];
    for (int m = gw; m < TT; m += NGW) { float sq = F.lane < 16 ? rowsq[(size_t)m * 16 + F.lane] : 0.f; sq = wave_sum(sq); const float rs = __builtin_amdgcn_rsqf(sq * (1.f / 1024.f) + NORM_EPS);
        f32x4* xr = (f32x4*)(P.out + (size_t)m * DM) + F.lane;
#pragma unroll
        for (int j = 0; j < 4; ++j) xr[64 * j] = xr[64 * j] * rs * gn[j]; }
}

#define RLX_AGENT __ATOMIC_RELAXED, __HIP_MEMORY_SCOPE_AGENT
#define XB_TMO      128
#define XB_XCNT(j)  (256  + 64 * (j))
#define XB_XSUB(j)  (1280 + 64 * (j))
#define XB_XGEN(j)  (2304 + 64 * (j))
#define XB_TOP      3328
#define XB_TOPGEN   3392
#define XCD_BAR_WORDS 3456
#define XB_SPIN_CAP (1u << 18)

__device__ __forceinline__ unsigned xb_ld(unsigned* p)              { return __hip_atomic_load(p, __ATOMIC_RELAXED, __HIP_MEMORY_SCOPE_AGENT); }
__device__ __forceinline__ unsigned xb_add(unsigned* p, unsigned v) { return __hip_atomic_fetch_add(p, v, __ATOMIC_RELAXED, __HIP_MEMORY_SCOPE_AGENT); }
__device__ __forceinline__ unsigned xb_xcc_id() { return (unsigned)__builtin_amdgcn_s_getreg((3 << 11) | 20) & 0xFu; }
#define XB_SPIN(cond, bar) do { unsigned _sp = 0; while (cond) { __builtin_amdgcn_s_sleep(1); \
    if ((++_sp & 255u) == 0u) { if (xb_ld(&(bar)[XB_TMO])) break; if (_sp > XB_SPIN_CAP) { atomicAdd(&(bar)[XB_TMO], 1u); break; } } } } while (0)

struct XcdBarrier {
    unsigned* bar; unsigned x;
    volatile LAS unsigned* st;
};

__device__ __forceinline__ XcdBarrier xcd_barrier_post(unsigned* bar, volatile LAS unsigned* st) {
    XcdBarrier b; b.bar = bar; b.x = xb_xcc_id(); b.st = st;
    if (threadIdx.x == 0) (void)xb_add(&bar[XB_XCNT(b.x)], 1u);
    return b;
}
__device__ __forceinline__ void xcd_barrier_complete(unsigned* bar, unsigned x, unsigned& nloc, unsigned& nx) {
    const unsigned G = gridDim.x * gridDim.y * gridDim.z;
    unsigned sum, cnt, mine, sp = 0u;
    for (;;) {
        sum = 0u; cnt = 0u; mine = 0u;
#pragma unroll
        for (unsigned j = 0; j < 16; ++j) { const unsigned c = xb_ld(&bar[XB_XCNT(j)]); sum += c; cnt += (c > 0u) ? 1u : 0u; mine = (j == x) ? c : mine; }
        if (sum == G) break;
        __builtin_amdgcn_s_sleep(1);
        if ((++sp & 255u) == 0u) { if (xb_ld(&bar[XB_TMO])) break; if (sp > XB_SPIN_CAP) { atomicAdd(&bar[XB_TMO], 1u); break; } }
    }
    nloc = mine > 0u ? mine : 1u; nx = cnt > 0u ? cnt : 1u;
}

__device__ __forceinline__ void xcd_barrier(const XcdBarrier& b) {
    asm volatile("s_waitcnt vmcnt(0)" ::: "memory");
    __syncthreads();
    if (threadIdx.x == 0) {
        unsigned* bar = b.bar;
        __builtin_amdgcn_s_waitcnt(0);
        unsigned nloc = b.st[0], nx = b.st[1];
        if (nloc == 0u) { xcd_barrier_complete(bar, b.x, nloc, nx); b.st[0] = nloc; b.st[1] = nx; }
        const unsigned old = xb_add(&bar[XB_XSUB(b.x)], 1u);
        const unsigned gen = old / nloc;
        if (old + 1u == (gen + 1u) * nloc) {
            __builtin_amdgcn_fence(__ATOMIC_RELEASE, "agent");
            asm volatile("s_waitcnt vmcnt(0)" ::: "memory");
            const unsigned og = xb_add(&bar[XB_TOP], 1u);
            const unsigned tg = og / nx;
            if (og + 1u == (tg + 1u) * nx) xb_add(&bar[XB_TOPGEN], 1u);
            else XB_SPIN(xb_ld(&bar[XB_TOPGEN]) == tg, bar);
            __builtin_amdgcn_fence(__ATOMIC_ACQUIRE, "agent");
            xb_add(&bar[XB_XGEN(b.x)], 1u);
            asm volatile("s_waitcnt vmcnt(0)" ::: "memory");
        } else {
            XB_SPIN(xb_ld(&bar[XB_XGEN(b.x)]) == gen, bar);
            __builtin_amdgcn_fence(__ATOMIC_ACQUIRE, "agent");
            asm volatile("s_waitcnt vmcnt(0)" ::: "memory");
        }
    }
    __syncthreads();
}

constexpr int PH_PER_LAYER = 9, N_PHASES = DEPTH * PH_PER_LAYER + 1;
__device__ __forceinline__ void run_phase(const Frame& F0, const Params& P0, int ph, int sub = 0) {
    Frame F = F0; Params P = P0; asm volatile("" : "+v"(F.tid)); F.lane = F.tid & 63; F.wave = __builtin_amdgcn_readfirstlane(F.tid >> 6);
    { size_t zoff = 0; asm volatile("" : "+s"(zoff)); P.ws = P0.ws + zoff; }
    const int l = ph / PH_PER_LAYER, k = ph % PH_PER_LAYER;
    unsigned char* ws = P.ws; const float* rowsq = (const float*)(ws + WS_ROWSQ); const LAS float* lrs = (const LAS float*)(F.lds + pg8::LRS_OFF);
    if (ph == N_PHASES - 1) { final_norm(F, P); return; }
#ifdef ONLY_K
    if (k != ONLY_K) return;
#endif
    switch (k) {
    case 0: p0_attn_weights(F, P, l); if (l == 0) p0_input(F, P); break;
    case 1: { p1_ba(F, P); __syncthreads();
        pg8::Gemm g{(const pg8::bf16_t*)(ws + WS_XB), (const pg8::bf16_t*)(ws + WS_WIN), TT, NMIX, DM}; pg8::StaticOrder S; S.init(TT, NMIX, F.G, (int)blockIdx.x);
        pg8::EpiProj E{(pg8::bf16_t*)(ws + WS_UV), (pg8::bf16_t*)(ws + WS_QKVB), (pg8::bf16_t*)(ws + WS_QKVC), (pg8::bf16_t*)(ws + WS_Z), lrs};
        pg8::prep_rstd(F.lds, S, rowsq);
        pg8::gemm_phase<pg8::EpiProj, pg8::StaticOrder, true, true>(F.lds, g, S, E); } break;
    case 2: for (int t = F.vb; t < 1024; t += F.G) dn_pre_task(F, P, l, t); break;
    case 3: { const int sb = (int)blockIdx.x; if (sb < 8) { if (!(sub & 2)) dn_scan(F, P, sb, (sub & 16) != 0); }
              else if (!(sub & 1)) { const int nb = F.G - 8; for (int t = sb - 8; t < 768; t += nb) { if (t < 256) { if (!(sub & 4)) swa_task(F, P, l, t); } else if (!(sub & 8)) sgu_task(F, P, l, t - 256); } } } break;
    case 4: for (int t = F.vb; t < 1024; t += F.G) dn_out_task(F, P, l, t); p0_ffn_weights(F, P, l); break;
    case 5: {
#pragma unroll 1
        for (int n = 0; n < 3; ++n) {
            { pg8::Gemm g{(const pg8::bf16_t*)(ws + WS_XB), (const pg8::bf16_t*)(ws + WS_WG) + (size_t)n * 1024 * 1024, TT, DM, DM}; pg8::StaticOrder S; S.init(TT, DM, F.G, (int)blockIdx.x);
              pg8::EpiSig E{(pg8::bf16_t*)(ws + WS_UV), lrs}; if (n == 0) pg8::prep_rstd(F.lds, S, rowsq); pg8::gemm_phase<pg8::EpiSig, pg8::StaticOrder, true, true>(F.lds, g, S, E); }
            __syncthreads();
            { pg8::Gemm g{(const pg8::bf16_t*)(ws + WS_BR) + (size_t)n * TT * 512, (const pg8::bf16_t*)(ws + WS_WBR) + (size_t)n * 1024 * 512, TT, DM, 512}; pg8::StaticOrder S; S.init(TT, DM, F.G, (int)blockIdx.x);
              if (n == 0) { pg8::EpiMerge<0> E{(pg8::bf16_t*)(ws + WS_UV), (float*)(ws + WS_DN)}; pg8::gemm_phase<pg8::EpiMerge<0>, pg8::StaticOrder, true, true>(F.lds, g, S, E); }
              else if (n == 1) { pg8::EpiMerge<1> E{(pg8::bf16_t*)(ws + WS_UV), (float*)(ws + WS_DN)}; pg8::gemm_phase<pg8::EpiMerge<1>, pg8::StaticOrder, true, true>(F.lds, g, S, E); }
              else { pg8::EpiMerge<2> E{(pg8::bf16_t*)(ws + WS_UV), (float*)(ws + WS_DN)}; pg8::gemm_phase<pg8::EpiMerge<2>, pg8::StaticOrder, true, true>(F.lds, g, S, E); } }
            __syncthreads();
        } } break;
    case 6: { pg8::Gemm g{(const pg8::bf16_t*)(ws + WS_UV), (const pg8::bf16_t*)(ws + WS_WOUT), TT, DM, DM}; pg8::StaticOrder S; S.init(TT, DM, F.G, (int)blockIdx.x);
        pg8::EpiResid<false> E{(pg8::bf16_t*)(ws + WS_XB), (float*)(ws + WS_ROWSQ), nullptr}; pg8::gemm_phase<pg8::EpiResid<false>, pg8::StaticOrder, true, true>(F.lds, g, S, E); } break;
    case 7: { pg8::Gemm g{(const pg8::bf16_t*)(ws + WS_XB), (const pg8::bf16_t*)(ws + WS_WGU), TT, 2 * DFF, DM}; pg8::StaticOrder S; S.init(TT, 2 * DFF, F.G, (int)blockIdx.x);
        pg8::EpiGU E{(pg8::bf16_t*)(ws + WS_HID), lrs}; pg8::prep_rstd(F.lds, S, rowsq); pg8::gemm_phase<pg8::EpiGU, pg8::StaticOrder, true, true>(F.lds, g, S, E); } break;
    case 8: { pg8::Gemm g{(const pg8::bf16_t*)(ws + WS_HID), (const pg8::bf16_t*)(ws + WS_WDN), TT, DM, DFF}; pg8::StaticOrder S; S.init(TT, DM, F.G, (int)blockIdx.x);
        if (l < DEPTH - 1) { pg8::EpiResid<false> E{(pg8::bf16_t*)(ws + WS_XB), (float*)(ws + WS_ROWSQ), nullptr}; pg8::gemm_phase<pg8::EpiResid<false>, pg8::StaticOrder, true, true>(F.lds, g, S, E); }
        else { pg8::EpiResid<true> E{(pg8::bf16_t*)(ws + WS_XB), (float*)(ws + WS_ROWSQ), P.out}; pg8::gemm_phase<pg8::EpiResid<true>, pg8::StaticOrder, true, true>(F.lds, g, S, E); } } break;
    }
}

__global__ void __launch_bounds__(NTHR, 2) hgpm_fwd(Params P) {
    extern __shared__ __attribute__((aligned(16))) unsigned char lds_raw[];
    Frame F; F.lds = (LAS unsigned char*)lds_raw; F.tid = threadIdx.x; F.lane = F.tid & 63; F.wave = __builtin_amdgcn_readfirstlane(F.tid >> 6);
    F.G = gridDim.x; { const int bx = blockIdx.x; F.vb = (F.G % 8 == 0) ? (bx % 8) * (F.G / 8) + bx / 8 : bx; }
#if USE_CG_SYNC
    cg::grid_group grid = cg::this_grid();
#define GRID_SYNC() grid.sync()
#else
    volatile LAS unsigned* misc = (volatile LAS unsigned*)(F.lds + MISC_OFF);
    if (F.tid < 64) misc[F.tid] = 0u;
    __syncthreads();
    const XcdBarrier bar = xcd_barrier_post((unsigned*)(P.ws + WS_CTL) + 1024, misc + 8);
#define GRID_SYNC() xcd_barrier(bar)
#endif
    for (int ph = P.ph_lo; ph < P.ph_hi; ++ph) {
        run_phase(F, P, ph);
#ifdef DUPK
#ifndef DUPSUB
#define DUPSUB 0
#endif
        if (ph % PH_PER_LAYER == DUPK && ph != N_PHASES - 1 && (DUPK != 6 || ph < PH_PER_LAYER)) { GRID_SYNC(); run_phase(F, P, ph, DUPSUB); }
        if (DUPK == 23 && ph % PH_PER_LAYER == 3) { GRID_SYNC(); run_phase(F, P, ph - 1, 0); GRID_SYNC(); run_phase(F, P, ph, 0); }
#endif
        if (ph + 1 < P.ph_hi) GRID_SYNC();
    }
}

#ifndef N_LAUNCH_MODE
#define N_LAUNCH_MODE 0
#endif
extern "C" void kernel_launch(void* const* d_in, const int* in_sizes, int n_in, void* d_out, int out_size, void* d_ws, size_t ws_size, hipStream_t stream) {
    static int grid = 0;
    if (grid == 0) {
        if (n_in != 19 || in_sizes[0] != TT * DM || out_size != TT * DM || ws_size < WS_END) { fprintf(stderr, "kernel_launch: unexpected shapes (n_in %d, in0 %d, out %d, ws %zu)\n", n_in, n_in > 0 ? in_sizes[0] : -1, out_size, ws_size); grid = -1; return; }
        int dev = 0, cus = 0, per_cu = 0;
        if (hipGetDevice(&dev) != hipSuccess || hipDeviceGetAttribute(&cus, hipDeviceAttributeMultiprocessorCount, dev) != hipSuccess) { grid = -1; return; }
        if (hipFuncSetAttribute((const void*)hgpm_fwd, hipFuncAttributeMaxDynamicSharedMemorySize, LDS_BYTES) != hipSuccess) { fprintf(stderr, "kernel_launch: hipFuncSetAttribute failed\n"); grid = -1; return; }
        if (hipOccupancyMaxActiveBlocksPerMultiprocessor(&per_cu, (const void*)hgpm_fwd, NTHR, LDS_BYTES) != hipSuccess || per_cu < 1) { fprintf(stderr, "kernel_launch: occupancy query says %d blocks per CU\n", per_cu); per_cu = 1; }
        (void)hipGetLastError();
        grid = cus;
    }
    if (grid < 0) return;
    Params p{};
    p.x = (const float*)d_in[0]; p.pos = (const int*)d_in[1]; p.attn_norm = (const float*)d_in[2]; p.w_in = (const float*)d_in[3]; p.sgu_ln_g = (const float*)d_in[4]; p.sgu_ln_b = (const float*)d_in[5];
    p.sgu_w = (const float*)d_in[6]; p.sgu_b = (const float*)d_in[7]; p.sinks = (const float*)d_in[8]; p.conv_w = (const float*)d_in[9]; p.a_log = (const float*)d_in[10]; p.dt_bias = (const float*)d_in[11];
    p.dn_norm = (const float*)d_in[12]; p.w_branch = (const float*)d_in[13]; p.w_out = (const float*)d_in[14]; p.ffn_norm = (const float*)d_in[15]; p.w_gate_up = (const float*)d_in[16]; p.w_down = (const float*)d_in[17];
    p.final_norm = (const float*)d_in[18]; p.out = (float*)d_out; p.ws = (unsigned char*)d_ws;
#if N_LAUNCH_MODE == 0
    p.ph_lo = 0; p.ph_hi = N_PHASES;
#if USE_CG_SYNC
    void* args[] = {&p};
    hipError_t e = hipLaunchCooperativeKernel((const void*)hgpm_fwd, dim3(grid), dim3(NTHR), args, LDS_BYTES, stream);
    if (e != hipSuccess) fprintf(stderr, "kernel_launch: cooperative launch failed: %s (grid %d)\n", hipGetErrorString(e), grid);
#else
    if (hipMemsetAsync((char*)d_ws + WS_CTL, 0, CTL_ZERO_BYTES, stream) != hipSuccess) { fprintf(stderr, "kernel_launch: hipMemsetAsync failed\n"); return; }
    hipLaunchKernelGGL(hgpm_fwd, dim3(grid), dim3(NTHR), LDS_BYTES, stream, p);
#endif
#else
    for (int ph = 0; ph < N_PHASES; ++ph) { p.ph_lo = ph; p.ph_hi = ph + 1; hipLaunchKernelGGL(hgpm_fwd, dim3(grid), dim3(NTHR), LDS_BYTES, stream, p); }
#endif
}
```

```cpp
#include <hip/hip_runtime.h>
#include <hip/hip_cooperative_groups.h>
#include <cstdio>
#include <cstdint>
namespace cg = cooperative_groups;
namespace pg8 {
#define PG8_LAS __attribute__((address_space(3)))
typedef unsigned short bf16_t;
typedef short bf16x8 __attribute__((ext_vector_type(8)));
typedef float f32x4 __attribute__((ext_vector_type(4)));
typedef unsigned u32x4 __attribute__((ext_vector_type(4)));
constexpr int BM = 256, BK = 64, HALF = 128, HTB = HALF * BK * 2  , STAGE_BYTES = 8 * HTB, NXCD = 8, WGM = 8;

__host__ __device__ __forceinline__ int lds_byte(int r, int c) { const int st = (r >> 4) * 2 + (c >> 5), rr = r & 15, cc = c & 31, ob = rr * 64 + cc * 2; return st * 1024 + (ob ^ (((ob >> 9) & 1) << 5)); }
__host__ __device__ __forceinline__ void stage_rc(int b, int& R, int& C) { const int st = b / 1024, sb = b % 1024, swz = sb ^ (((sb >> 9) & 1) << 5); R = (st >> 1) * 16 + swz / 64; C = (st & 1) * 32 + (swz % 64) / 2; }
__host__ __device__ __forceinline__ int perm32(int rho) { const int n = rho >> 4, i = rho & 15; return 8 * (i >> 2) + 4 * n + (i & 3); }

struct Unit { int pm, pn, idx; };
struct Gemm { const bf16_t* A; const bf16_t* Bt; int M, N, K; };

struct StaticOrder {
    int nM, nN, nwg, G, c;
    __host__ __device__ void init(int M, int N, int G_, int c_) { nM = M / BM; nN = N / BM; nwg = nM * nN; G = G_; c = c_; }
    __host__ __device__ bool next(int i, Unit& u) const {
        const long L = (long)i * G + c; if (L >= nwg) return false;
        int wgid = (int)L; { const int q = nwg / NXCD, r = nwg % NXCD, xcd = wgid % NXCD, off = wgid / NXCD; wgid = (xcd < r ? xcd * (q + 1) : r * (q + 1) + (xcd - r) * q) + off; }
        const int nig = WGM * nN, gid = wgid / nig, fm = gid * WGM, gsz = (nM - fm) < WGM ? (nM - fm) : WGM;
        u.pm = fm + ((wgid % nig) % gsz); u.pn = (wgid % nig) / gsz; u.idx = i; return true;
    }
    __device__ __forceinline__ void a_ready(const Unit&) const {}
    __device__ __forceinline__ void done(const Unit&) const {}
};

typedef float f32x2 __attribute__((ext_vector_type(2)));
typedef __bf16 bf16v2 __attribute__((ext_vector_type(2)));
typedef unsigned u32x2 __attribute__((ext_vector_type(2)));
__device__ __forceinline__ unsigned pk2(float lo, float hi) { f32x2 v = {lo, hi}; bf16v2 r = __builtin_convertvector(v, bf16v2); return __builtin_bit_cast(unsigned, r); }
__device__ __forceinline__ float bflo(unsigned w) { return __uint_as_float(w << 16); }
__device__ __forceinline__ float bfhi(unsigned w) { return __uint_as_float(w & 0xffff0000u); }
__device__ __forceinline__ float fast_sigmoid(float x) { return __builtin_amdgcn_rcpf(1.0f + __expf(-x)); }
__device__ __forceinline__ float gelu_tanh(float x) { const float u = 1.5957691216f * (x + 0.044715f * x * x * x); return x * fast_sigmoid(u); }
constexpr float NORM_EPS = 1e-6f;
__device__ __forceinline__ float row_rstd(const float* rowsq, int row) {
    const f32x4* p = (const f32x4*)(rowsq + (size_t)row * 16); const f32x4 a = p[0], b = p[1], c = p[2], d = p[3];
    const float s = ((a.x + a.y) + (a.z + a.w)) + ((b.x + b.y) + (b.z + b.w)) + ((c.x + c.y) + (c.z + c.w)) + ((d.x + d.y) + (d.z + d.w));
    return __builtin_amdgcn_rsqf(s * (1.0f / 1024.0f) + NORM_EPS);
}
constexpr int LRS_OFF = STAGE_BYTES, LRS_MAX_UNITS = 8;
template <class Sched> __device__ __forceinline__ void prep_rstd(PG8_LAS unsigned char* lds, const Sched& S, const float* rowsq) {
    PG8_LAS float* t = (PG8_LAS float*)(lds + LRS_OFF); Unit u;
#pragma unroll 1
    for (int i = 0; i < LRS_MAX_UNITS; ++i) { if (!S.next(i, u)) break; if (threadIdx.x < 256) t[i * 256 + threadIdx.x] = row_rstd(rowsq, u.pm * BM + threadIdx.x); asm volatile("" ::: "memory"); }
    __syncthreads();
}
struct EpiProj {
    static constexpr bool PERM = true, AFTER_DRAIN = false;
    bf16_t *uv, *qkvb, *qkvc, *z; const PG8_LAS float* lrs;
    __device__ __forceinline__ void operator()(const f32x4 (&acc)[2][2][4][2], const Unit& u, int wr, int wc, int fr, int fq) const {
        const int pn = u.pn; bf16_t* base; int ldc, colt; bool act = false;
        if (pn < 4) { base = uv; ldc = 1024; colt = pn * 256; act = true; }
        else if (pn < 7) { base = qkvb; ldc = 768; colt = (pn - 4) * 256; }
        else if (pn < 13) { base = qkvc; ldc = 1536; colt = (pn - 7) * 256; }
        else { base = z; ldc = 512; colt = (pn - 13) * 256; }
        const int row0 = u.pm * BM + wr * 64 + fr, col0 = colt + wc * 32 + 8 * fq;
#pragma unroll
        for (int ai = 0; ai < 2; ++ai)
#pragma unroll
            for (int m = 0; m < 4; ++m) { const int row = row0 + ai * HALF + m * 16; const float rs = lrs[u.idx * 256 + (row - u.pm * BM)]; bf16_t* rowp = base + (size_t)row * ldc + col0;
#pragma unroll
                for (int bj = 0; bj < 2; ++bj) { f32x4 v0 = acc[ai][bj][m][0] * rs, v1 = acc[ai][bj][m][1] * rs;
                    if (act) {
#pragma unroll
                        for (int j = 0; j < 4; ++j) { v0[j] = gelu_tanh(v0[j]); v1[j] = gelu_tanh(v1[j]); } }
                    u32x4 w; w.x = pk2(v0[0], v0[1]); w.y = pk2(v0[2], v0[3]); w.z = pk2(v1[0], v1[1]); w.w = pk2(v1[2], v1[3]);
                    *(u32x4*)(rowp + bj * HALF) = w; } }
    }
};
struct EpiSig {
    static constexpr bool PERM = true, AFTER_DRAIN = false;
    bf16_t* sig; const PG8_LAS float* lrs;
    __device__ __forceinline__ void operator()(const f32x4 (&acc)[2][2][4][2], const Unit& u, int wr, int wc, int fr, int fq) const {
        const int row0 = u.pm * BM + wr * 64 + fr, col0 = u.pn * BM + wc * 32 + 8 * fq;
#pragma unroll
        for (int ai = 0; ai < 2; ++ai)
#pragma unroll
            for (int m = 0; m < 4; ++m) { const int row = row0 + ai * HALF + m * 16; const float rs = lrs[u.idx * 256 + (row - u.pm * BM)]; bf16_t* rowp = sig + (size_t)row * 1024 + col0;
#pragma unroll
                for (int bj = 0; bj < 2; ++bj) { f32x4 v0 = acc[ai][bj][m][0] * rs, v1 = acc[ai][bj][m][1] * rs;
#pragma unroll
                    for (int j = 0; j < 4; ++j) { v0[j] = fast_sigmoid(v0[j]); v1[j] = fast_sigmoid(v1[j]); }
                    u32x4 w; w.x = pk2(v0[0], v0[1]); w.y = pk2(v0[2], v0[3]); w.z = pk2(v1[0], v1[1]); w.w = pk2(v1[2], v1[3]);
                    *(u32x4*)(rowp + bj * HALF) = w; } }
    }
};
template <int MODE> struct EpiMerge {
    static constexpr bool PERM = true, AFTER_DRAIN = false;
    bf16_t* sig; float* mf;
    __device__ __forceinline__ void operator()(const f32x4 (&acc)[2][2][4][2], const Unit& u, int wr, int wc, int fr, int fq) const {
        const int row0 = u.pm * BM + wr * 64 + fr, col0 = u.pn * BM + wc * 32 + 8 * fq;
#pragma unroll
        for (int ai = 0; ai < 2; ++ai)
#pragma unroll
            for (int m = 0; m < 4; ++m) { const size_t off = (size_t)(row0 + ai * HALF + m * 16) * 1024 + col0;
#pragma unroll
                for (int bj = 0; bj < 2; ++bj) { const u32x4 s = *(const u32x4*)(sig + off + bj * HALF);
                    f32x4 v0 = acc[ai][bj][m][0], v1 = acc[ai][bj][m][1];
                    v0[0] *= bflo(s.x); v0[1] *= bfhi(s.x); v0[2] *= bflo(s.y); v0[3] *= bfhi(s.y); v1[0] *= bflo(s.z); v1[1] *= bfhi(s.z); v1[2] *= bflo(s.w); v1[3] *= bfhi(s.w);
                    float* mp = mf + off + bj * HALF;
                    if (MODE >= 1) { v0 += *(const f32x4*)mp; v1 += *(const f32x4*)(mp + 4); }
                    if (MODE <= 1) { *(f32x4*)mp = v0; *(f32x4*)(mp + 4) = v1; }
                    else { u32x4 w; w.x = pk2(v0[0], v0[1]); w.y = pk2(v0[2], v0[3]); w.z = pk2(v1[0], v1[1]); w.w = pk2(v1[2], v1[3]); *(u32x4*)(sig + off + bj * HALF) = w; } } }
    }
};
template <bool F32OUT> struct EpiResid {
    static constexpr bool PERM = true, AFTER_DRAIN = false;
    bf16_t* xb; float* rowsq; float* xout;
    __device__ __forceinline__ void operator()(const f32x4 (&acc)[2][2][4][2], const Unit& u, int wr, int wc, int fr, int fq) const {
        const int row0 = u.pm * BM + wr * 64 + fr, col0 = u.pn * BM + wc * 32 + 8 * fq;
#pragma unroll
        for (int ai = 0; ai < 2; ++ai)
#pragma unroll
            for (int m = 0; m < 4; ++m) { const int row = row0 + ai * HALF + m * 16; const size_t off = (size_t)row * 1024 + col0; float ss = 0.f;
#pragma unroll
                for (int bj = 0; bj < 2; ++bj) { const u32x4 xo = *(const u32x4*)(xb + off + bj * HALF);
                    f32x4 v0 = acc[ai][bj][m][0], v1 = acc[ai][bj][m][1];
                    v0[0] += bflo(xo.x); v0[1] += bfhi(xo.x); v0[2] += bflo(xo.y); v0[3] += bfhi(xo.y); v1[0] += bflo(xo.z); v1[1] += bfhi(xo.z); v1[2] += bflo(xo.w); v1[3] += bfhi(xo.w);
                    if (F32OUT) { *(f32x4*)(xout + off + bj * HALF) = v0; *(f32x4*)(xout + off + bj * HALF + 4) = v1; }
                    else { u32x4 w; w.x = pk2(v0[0], v0[1]); w.y = pk2(v0[2], v0[3]); w.z = pk2(v1[0], v1[1]); w.w = pk2(v1[2], v1[3]); *(u32x4*)(xb + off + bj * HALF) = w; }
                    ss += ((v0[0] * v0[0] + v0[1] * v0[1]) + (v0[2] * v0[2] + v0[3] * v0[3])) + ((v1[0] * v1[0] + v1[1] * v1[1]) + (v1[2] * v1[2] + v1[3] * v1[3])); }
                ss += __shfl_xor(ss, 16); ss += __shfl_xor(ss, 32);
                if (fq == 0) rowsq[(size_t)row * 16 + u.pn * 4 + wc] = ss; }
    }
};
struct EpiGU {
    static constexpr bool PERM = true, AFTER_DRAIN = false;
    bf16_t* hid; const PG8_LAS float* lrs;
    __device__ __forceinline__ void operator()(const f32x4 (&acc)[2][2][4][2], const Unit& u, int wr, int wc, int fr, int fq) const {
        const int row0 = u.pm * BM + wr * 64 + fr, col0 = u.pn * HALF + wc * 32 + 8 * fq;
#pragma unroll
        for (int ai = 0; ai < 2; ++ai)
#pragma unroll
            for (int m = 0; m < 4; ++m) { const int row = row0 + ai * HALF + m * 16; const float rs = lrs[u.idx * 256 + (row - u.pm * BM)];
                float o[8];
#pragma unroll
                for (int n = 0; n < 2; ++n)
#pragma unroll
                    for (int j = 0; j < 4; ++j) { const float g = acc[ai][0][m][n][j] * rs, up = acc[ai][1][m][n][j] * rs; o[n * 4 + j] = g * fast_sigmoid(g) * up; }
                u32x4 w; w.x = pk2(o[0], o[1]); w.y = pk2(o[2], o[3]); w.z = pk2(o[4], o[5]); w.w = pk2(o[6], o[7]);
                *(u32x4*)(hid + (size_t)row * 2816 + col0) = w; }
    }
};

template <class Epi, class Sched, bool ALIGN_EPI = false, bool SP2 = false>
__device__ __forceinline__ void gemm_phase(PG8_LAS unsigned char* lds, const Gemm g, const Sched& S, const Epi& E) {
    int tid_ = threadIdx.x; asm volatile("" : "+v"(tid_));
    const int tid = tid_, wid = __builtin_amdgcn_readfirstlane(tid >> 6), lane = tid & 63, wr = wid >> 2, wc = wid & 3, fr = lane & 15, fq = lane >> 4;
    const int K = g.K, nt = K / BK;
    unsigned voffA[2], voffB[2];
#pragma unroll
    for (int i = 0; i < 2; ++i) { int R, C; stage_rc(tid * 16 + i * 8192, R, C); const int Rb = Epi::PERM ? ((R & ~31) + perm32(R & 31)) : R;
        voffA[i] = (unsigned)(R * K + C) * 2u; voffB[i] = (unsigned)(Rb * K + C) * 2u; }
    const size_t kstep = (size_t)(BK * 2);
    const size_t hstep = (size_t)HALF * K * 2;
    const size_t tstep = 2 * hstep;
    const unsigned ldsw = (unsigned)wid * 1024u;
    const int aoff = lds_byte(wr * 64 + fr, fq * 8), boff = lds_byte(wc * 32 + fr, fq * 8);
#define PG8_SA(b, h) (((b) * 2 + (h)) * HTB)
#define PG8_SB(b, h) ((4 + (b) * 2 + (h)) * HTB)
#define PG8_STAGE(bufoff, gbase, voff) do { _Pragma("unroll") for (int _i = 0; _i < 2; ++_i) \
        __builtin_amdgcn_global_load_lds((const unsigned*)((const char*)(gbase) + (voff)[_i]), (PG8_LAS unsigned*)(lds + (bufoff) + ldsw + _i * 8192), 16, 0, 0); } while (0)
#define PG8_LDA(dst, b, h) do { _Pragma("unroll") for (int m = 0; m < 4; ++m) _Pragma("unroll") for (int k = 0; k < 2; ++k) dst[m][k] = *(const PG8_LAS bf16x8*)(lds + PG8_SA(b, h) + aoff + m * 2048 + k * 1024); } while (0)
#define PG8_LDB(dst, b, h) do { _Pragma("unroll") for (int n = 0; n < 2; ++n) _Pragma("unroll") for (int k = 0; k < 2; ++k) dst[n][k] = *(const PG8_LAS bf16x8*)(lds + PG8_SB(b, h) + boff + n * 2048 + k * 1024); } while (0)
#define PG8_MMA(ai, bj, At, Bt) do { __builtin_amdgcn_s_setprio(1); _Pragma("unroll") for (int m = 0; m < 4; ++m) _Pragma("unroll") for (int n = 0; n < 2; ++n) _Pragma("unroll") for (int k = 0; k < 2; ++k) \
        acc[ai][bj][m][n] = __builtin_amdgcn_mfma_f32_16x16x32_bf16(Bt[n][k], At[m][k], acc[ai][bj][m][n], 0, 0, 0); __builtin_amdgcn_s_setprio(0); } while (0)
#define PG8_WAIT_V(n) asm volatile("s_waitcnt vmcnt(" #n ")" ::: "memory")
#define PG8_WAIT_L(n) asm volatile("s_waitcnt lgkmcnt(" #n ")" ::: "memory")
#define PG8_BAR __builtin_amdgcn_s_barrier()
#define PG8_SCHED __builtin_amdgcn_sched_barrier(0)
    Unit cur, nxt; int ui = 0;
    if (!S.next(0, cur)) return;
    f32x4 acc[2][2][4][2];
#pragma unroll
    for (int a = 0; a < 2; ++a)
#pragma unroll
        for (int b = 0; b < 2; ++b)
#pragma unroll
            for (int m = 0; m < 4; ++m)
#pragma unroll
                for (int n = 0; n < 2; ++n) acc[a][b][m][n] = (f32x4){0.f, 0.f, 0.f, 0.f};
    bf16x8 At[4][2], B0[2][2], B1[2][2];
    const char* cA = (const char*)g.A + (size_t)cur.pm * tstep; const char* cB = (const char*)g.Bt + (size_t)cur.pn * tstep;
    S.a_ready(cur);
    if constexpr (SP2) {
        PG8_STAGE(PG8_SB(0, 0), cB, voffB); PG8_STAGE(PG8_SB(0, 1), cB + hstep, voffB); PG8_STAGE(PG8_SA(0, 0), cA, voffA); PG8_STAGE(PG8_SA(0, 1), cA + hstep, voffA);
        if (wr == 1) PG8_BAR;
        PG8_WAIT_V(2); PG8_BAR;
        PG8_STAGE(PG8_SB(1, 0), cB + kstep, voffB); PG8_STAGE(PG8_SA(1, 0), cA + kstep, voffA); PG8_STAGE(PG8_SB(1, 1), cB + hstep + kstep, voffB);
        PG8_WAIT_V(6); PG8_BAR;
    } else {
        PG8_STAGE(PG8_SB(0, 0), cB, voffB); PG8_STAGE(PG8_SA(0, 0), cA, voffA); PG8_STAGE(PG8_SB(0, 1), cB + hstep, voffB); PG8_STAGE(PG8_SA(0, 1), cA + hstep, voffA);
        if (wr == 1) PG8_BAR;
        PG8_WAIT_V(4); PG8_BAR;
        PG8_STAGE(PG8_SB(1, 0), cB + kstep, voffB); PG8_STAGE(PG8_SA(1, 0), cA + kstep, voffA); PG8_STAGE(PG8_SB(1, 1), cB + hstep + kstep, voffB);
        PG8_WAIT_V(6); PG8_BAR;
    }
    for (;;) {
        const bool has_next = S.next(ui + 1, nxt);
        const char* nA = has_next ? (const char*)g.A + (size_t)nxt.pm * tstep : cA; const char* nB = has_next ? (const char*)g.Bt + (size_t)nxt.pn * tstep : cB;
        for (int t = 0; t < nt; t += 2) {
            const bool last = (t == nt - 2);
            const char* a1 = cA + (size_t)(t + 1) * kstep;
            const char* a2 = last ? nA : cA + (size_t)(t + 2) * kstep; const char* b2 = last ? nB : cB + (size_t)(t + 2) * kstep;
            const char* a3 = a2 + kstep; const char* b3 = b2 + kstep;
            if (last && has_next) S.a_ready(nxt);
            if constexpr (SP2) {
            PG8_LDB(B0, 0, 0); PG8_LDB(B1, 0, 1); PG8_SCHED; PG8_LDA(At, 0, 0); PG8_STAGE(PG8_SA(1, 1), a1 + hstep, voffA);
            PG8_WAIT_V(8); PG8_WAIT_L(0); PG8_BAR; PG8_MMA(0, 0, At, B0); PG8_MMA(0, 1, At, B1); PG8_BAR; PG8_SCHED;
            PG8_LDA(At, 0, 1); PG8_STAGE(PG8_SB(0, 0), b2, voffB); PG8_STAGE(PG8_SB(0, 1), b2 + hstep, voffB); PG8_STAGE(PG8_SA(0, 0), a2, voffA);
            PG8_WAIT_V(8); PG8_WAIT_L(0); PG8_BAR; PG8_MMA(1, 0, At, B0); PG8_MMA(1, 1, At, B1); PG8_BAR; PG8_SCHED;
            PG8_LDB(B0, 1, 0); PG8_LDB(B1, 1, 1); PG8_SCHED; PG8_LDA(At, 1, 0); PG8_STAGE(PG8_SA(0, 1), a2 + hstep, voffA);
            PG8_WAIT_V(8); PG8_WAIT_L(0); PG8_BAR; PG8_MMA(0, 0, At, B0); PG8_MMA(0, 1, At, B1); PG8_BAR; PG8_SCHED;
            PG8_LDA(At, 1, 1); PG8_STAGE(PG8_SB(1, 0), b3, voffB); PG8_STAGE(PG8_SB(1, 1), b3 + hstep, voffB); PG8_STAGE(PG8_SA(1, 0), a3, voffA);
            PG8_WAIT_V(8); PG8_WAIT_L(0); PG8_BAR; PG8_MMA(1, 0, At, B0); PG8_MMA(1, 1, At, B1); PG8_BAR; PG8_SCHED;
            } else {
            PG8_LDB(B0, 0, 0); PG8_SCHED; PG8_LDA(At, 0, 0); PG8_STAGE(PG8_SA(1, 1), a1 + hstep, voffA);
            PG8_WAIT_L(8); PG8_BAR; PG8_WAIT_L(0); PG8_MMA(0, 0, At, B0); PG8_BAR; PG8_SCHED;
            PG8_LDB(B1, 0, 1); PG8_STAGE(PG8_SB(0, 0), b2, voffB);
            PG8_BAR; PG8_WAIT_L(0); PG8_MMA(0, 1, At, B1); PG8_BAR;
            PG8_LDA(At, 0, 1); PG8_STAGE(PG8_SA(0, 0), a2, voffA);
            PG8_BAR; PG8_WAIT_L(0); PG8_MMA(1, 0, At, B0); PG8_BAR; PG8_SCHED;
            PG8_STAGE(PG8_SB(0, 1), b2 + hstep, voffB);
            PG8_WAIT_V(6); PG8_BAR; PG8_MMA(1, 1, At, B1); PG8_BAR;
            PG8_LDB(B0, 1, 0); PG8_SCHED; PG8_LDA(At, 1, 0); PG8_STAGE(PG8_SA(0, 1), a2 + hstep, voffA);
            PG8_WAIT_L(8); PG8_BAR; PG8_WAIT_L(0); PG8_MMA(0, 0, At, B0); PG8_BAR; PG8_SCHED;
            PG8_LDB(B1, 1, 1); PG8_STAGE(PG8_SB(1, 0), b3, voffB);
            PG8_BAR; PG8_WAIT_L(0); PG8_MMA(0, 1, At, B1); PG8_BAR;
            PG8_LDA(At, 1, 1); PG8_STAGE(PG8_SA(1, 0), a3, voffA);
            PG8_BAR; PG8_WAIT_L(0); PG8_MMA(1, 0, At, B0); PG8_BAR; PG8_SCHED;
            PG8_STAGE(PG8_SB(1, 1), b3 + hstep, voffB);
            PG8_WAIT_V(6); PG8_BAR; PG8_MMA(1, 1, At, B1); PG8_BAR;
            }
        }
        if constexpr (ALIGN_EPI) { if (wr == 0) PG8_BAR; }
        if constexpr (!Epi::AFTER_DRAIN) { E(acc, cur, wr, wc, fr, fq); S.done(cur); }
        if (!has_next) break;
#pragma unroll
        for (int a = 0; a < 2; ++a)
#pragma unroll
            for (int b = 0; b < 2; ++b)
#pragma unroll
                for (int m = 0; m < 4; ++m)
#pragma unroll
                    for (int n = 0; n < 2; ++n) acc[a][b][m][n] = (f32x4){0.f, 0.f, 0.f, 0.f};
        cur = nxt; cA = nA; cB = nB; ++ui;
        if constexpr (ALIGN_EPI) { if (wr == 1) PG8_BAR; }
    }
    PG8_WAIT_V(0);
    if constexpr (!ALIGN_EPI) { if (wr == 0) PG8_BAR; }
    PG8_BAR;
    if constexpr (Epi::AFTER_DRAIN) { E.fused(acc, cur, wr, wc, fr, fq, lds, wid, lane); S.done(cur); }
#undef PG8_SA
#undef PG8_SB
#undef PG8_STAGE
#undef PG8_LDA
#undef PG8_LDB
#undef PG8_MMA
#undef PG8_WAIT_V
#undef PG8_WAIT_L
#undef PG8_BAR
#undef PG8_SCHED
}
}

#ifndef USE_CG_SYNC
#define USE_CG_SYNC 0
#endif
constexpr int NWAVES = 8, NTHR = 512;
constexpr int TT = 16384, SEQ = 8192, DM = 1024, DEPTH = 2, INC = 6920, DFF = 2816;
constexpr int C_QKVC = 1792, C_BETA = 3840, C_GATE = 3848;
constexpr int NMIX = 3840;
constexpr size_t MiB = 1u << 20, KiB = 1u << 10;
constexpr size_t WS_CTL = 0, CTL_ZERO_BYTES = 64 * KiB;
constexpr size_t WS_ROWSQ = 1 * MiB;
constexpr size_t WS_BA = 2 * MiB;
constexpr size_t WS_CD = 2 * MiB + 512 * KiB;
constexpr size_t WS_WBA = WS_CD + 64 * KiB;
constexpr size_t WS_SGUW = 2 * MiB + 768 * KiB;
constexpr size_t WS_WIN = 3 * MiB;
constexpr size_t WS_WG = WS_WIN + 3840 * 1024 * 2;
constexpr size_t WS_WBR = WS_WG + 3072 * 1024 * 2;
constexpr size_t WS_WOUT = WS_WBR + 3 * 1024 * 512 * 2;
constexpr size_t WS_XB = 22 * MiB;
constexpr size_t WS_UV = 54 * MiB;
constexpr size_t WS_QKVB = 86 * MiB;
constexpr size_t WS_WGU = WS_QKVB;
constexpr size_t WS_WDN = WS_QKVB + 5632 * 1024 * 2;
constexpr size_t WS_QKVC = 110 * MiB;
constexpr size_t WS_BR = WS_QKVC;
constexpr size_t WS_Z = 158 * MiB;
constexpr size_t WS_DN = 174 * MiB;
constexpr size_t WS_HID = 110 * MiB;
constexpr size_t WS_END = 246 * MiB;
static_assert(WS_WOUT + 1024 * 1024 * 2 <= WS_XB && WS_WDN + 1024 * 2816 * 2 <= WS_QKVC && WS_HID + (size_t)TT * DFF * 2 <= WS_END && WS_DN + 1024 * 72 * KiB <= WS_END, "ws map");
constexpr int DN_TASK_BYTES = 73728, DN_OFF_W = 0, DN_OFF_QD = 16384, DN_OFF_AT = 32768, DN_OFF_KD = 40960, DN_OFF_U = 57344;
constexpr int LDS_BYTES = 163840, MISC_OFF = LDS_BYTES - 256;

#define LAS __attribute__((address_space(3)))
typedef unsigned short bf16;
typedef float f32x4 __attribute__((ext_vector_type(4)));
typedef float f32x16 __attribute__((ext_vector_type(16)));
typedef short bf16x8 __attribute__((ext_vector_type(8)));
typedef unsigned u32x4 __attribute__((ext_vector_type(4)));
typedef unsigned u32x2 __attribute__((ext_vector_type(2)));
using pg8::pk2; using pg8::bflo; using pg8::bfhi; using pg8::fast_sigmoid; using pg8::NORM_EPS;
#define MFMA32(a, b, c) __builtin_amdgcn_mfma_f32_32x32x16_bf16((a), (b), (c), 0, 0, 0)
__device__ __forceinline__ int crow(int reg, int h) { return (reg & 3) + 8 * (reg >> 2) + 4 * h; }
__device__ __forceinline__ bf16x8 pack_step(const f32x16& x, int s) {
    u32x4 p; p.x = pk2(x[8 * s], x[8 * s + 1]); p.y = pk2(x[8 * s + 2], x[8 * s + 3]); p.z = pk2(x[8 * s + 4], x[8 * s + 5]); p.w = pk2(x[8 * s + 6], x[8 * s + 7]);
    return __builtin_bit_cast(bf16x8, p);
}
__device__ __forceinline__ float wave_sum(float v) {
#pragma unroll
    for (int o = 1; o < 64; o <<= 1) v += __shfl_xor(v, o);
    return v;
}
__device__ __forceinline__ f32x16 zero16() { f32x16 z; for (int i = 0; i < 16; ++i) z[i] = 0.f; return z; }

struct Params {
    const float* x; const int* pos; const float* attn_norm; const float* w_in; const float* sgu_ln_g; const float* sgu_ln_b; const float* sgu_w; const float* sgu_b;
    const float* sinks; const float* conv_w; const float* a_log; const float* dt_bias; const float* dn_norm; const float* w_branch; const float* w_out; const float* ffn_norm;
    const float* w_gate_up; const float* w_down; const float* final_norm;
    float* out; unsigned char* ws; int ph_lo, ph_hi;
};
struct Frame { LAS unsigned char* lds; int tid, lane, wave, vb, G; };

constexpr int TR_SCR = 64 * 68 * 4;
template <int MAP> __device__ __forceinline__ void transpose_item(const float* W, int ldw, int ncol0, int K, int N, const float* kscale, bf16* WT, LAS float* scr, int item, int lane) {
    const int nblk = N / 64, kb = item / nblk, nb = item % nblk, k0 = 64 * kb, n0 = 64 * nb, r4 = lane >> 4, c4 = lane & 15;
    f32x4 v[16];
#pragma unroll
    for (int i = 0; i < 16; ++i) v[i] = *(const f32x4*)(W + (size_t)(k0 + 4 * i + r4) * ldw + ncol0 + n0 + 4 * c4);
    if (kscale) {
#pragma unroll
        for (int i = 0; i < 16; ++i) v[i] = v[i] * kscale[k0 + 4 * i + r4]; }
#pragma unroll
    for (int i = 0; i < 16; ++i) { const int r = 4 * i + r4; *(LAS f32x4*)(scr + r * 68 + ((4 * c4 + 4 * (r >> 3)) & 63)) = v[i]; }
    asm volatile("s_waitcnt lgkmcnt(0)" ::: "memory");
    const int kc = lane & 7, nn = lane >> 3;
#pragma unroll
    for (int j = 0; j < 8; ++j) { const int n = nn + 8 * j; const LAS float* sp = scr + (8 * kc) * 68 + ((n + 4 * kc) & 63);
        u32x4 o; o.x = pk2(sp[0 * 68], sp[1 * 68]); o.y = pk2(sp[2 * 68], sp[3 * 68]); o.z = pk2(sp[4 * 68], sp[5 * 68]); o.w = pk2(sp[6 * 68], sp[7 * 68]);
        const int gn = n0 + n; int dr = gn;
        if (MAP == 1) { const int f = gn < DFF ? gn : gn - DFF; dr = (f >> 7) * 256 + (gn < DFF ? 0 : 128) + (f & 127); }
        *(u32x4*)(WT + (size_t)dr * K + k0 + 8 * kc) = o; }
    asm volatile("s_waitcnt lgkmcnt(0)" ::: "memory");
}
__device__ __forceinline__ void p0_attn_weights(const Frame& F, const Params& P, int l) {
    LAS float* scr = (LAS float*)(F.lds + F.wave * TR_SCR);
    const int gw = F.vb * NWAVES + F.wave, NGW = F.G * NWAVES;
    const float* win = P.w_in + (size_t)l * DM * INC; const float* an = P.attn_norm + l * DM;
    constexpr int I_MIX = 16 * (NMIX / 64), I_G = 16 * (3072 / 64), I_BR = 8 * 16, I_O = 16 * 16, NIT = I_MIX + I_G + 3 * I_BR + I_O;
#pragma unroll 1
    for (int it = gw; it < NIT; it += NGW) {
        int r = it;
        if (r < I_MIX) { transpose_item<0>(win, INC, 0, DM, NMIX, an, (bf16*)(P.ws + WS_WIN), scr, r, F.lane); continue; } r -= I_MIX;
        if (r < I_G) { transpose_item<0>(win, INC, C_GATE, DM, 3072, an, (bf16*)(P.ws + WS_WG), scr, r, F.lane); continue; } r -= I_G;
        if (r < 3 * I_BR) { const int n = r / I_BR; transpose_item<0>(P.w_branch + ((size_t)l * 3 + n) * 512 * 1024, 1024, 0, 512, 1024, nullptr, (bf16*)(P.ws + WS_WBR) + (size_t)n * 1024 * 512, scr, r % I_BR, F.lane); continue; } r -= 3 * I_BR;
        transpose_item<0>(P.w_out + (size_t)l * DM * DM, DM, 0, DM, DM, nullptr, (bf16*)(P.ws + WS_WOUT), scr, r, F.lane);
    }
    const int gt = F.vb * NTHR + F.tid, NGT = F.G * NTHR;
    float* wba = (float*)(P.ws + WS_WBA);
    for (int i = gt; i < 8 * DM; i += NGT) { const int c = i >> 10, k = i & 1023; wba[i] = win[(size_t)k * INC + C_BETA + c] * an[k]; }
    bf16* sw = (bf16*)(P.ws + WS_SGUW); const float* sgw = P.sgu_w + (size_t)l * 4 * 128 * 128;
    for (int i = gt; i < 4 * 128 * 128 / 2; i += NGT) { const int e = 2 * i, s = e & 127, t = (e >> 7) & 127; const float a = s <= t ? sgw[e] : 0.f, b = (s + 1) <= t ? sgw[e + 1] : 0.f; ((unsigned*)sw)[i] = pk2(a, b); }
}
__device__ __forceinline__ void p0_ffn_weights(const Frame& F, const Params& P, int l) {
    LAS float* scr = (LAS float*)(F.lds + F.wave * TR_SCR);
    const int gw = F.vb * NWAVES + F.wave, NGW = F.G * NWAVES;
    constexpr int I_GU = 16 * (2 * DFF / 64), I_DN = (DFF / 64) * 16, NIT = I_GU + I_DN;
#pragma unroll 1
    for (int it = gw; it < NIT; it += NGW) {
        if (it < I_GU) transpose_item<1>(P.w_gate_up + (size_t)l * DM * 2 * DFF, 2 * DFF, 0, DM, 2 * DFF, P.ffn_norm + l * DM, (bf16*)(P.ws + WS_WGU), scr, it, F.lane);
        else transpose_item<0>(P.w_down + (size_t)l * DFF * DM, DM, 0, DFF, DM, nullptr, (bf16*)(P.ws + WS_WDN), scr, it - I_GU, F.lane);
    }
}
__device__ __forceinline__ void p0_input(const Frame& F, const Params& P) {
    const int gw = F.vb * NWAVES + F.wave, NGW = F.G * NWAVES;
    bf16* xb = (bf16*)(P.ws + WS_XB); float* rowsq = (float*)(P.ws + WS_ROWSQ);
    for (int m = gw; m < TT; m += NGW) {
        const f32x4* xr = (const f32x4*)(P.x + (size_t)m * DM) + F.lane; float s = 0.f;
        unsigned long long* o8 = (unsigned long long*)(xb + (size_t)m * DM) + F.lane;
#pragma unroll
        for (int j = 0; j < 4; ++j) { const f32x4 v = xr[64 * j]; s += (v.x * v.x + v.y * v.y) + (v.z * v.z + v.w * v.w); o8[64 * j] = (unsigned long long)pk2(v.x, v.y) | ((unsigned long long)pk2(v.z, v.w) << 32); }
        s = wave_sum(s);
        if (F.lane < 16) rowsq[(size_t)m * 16 + F.lane] = F.lane == 0 ? s : 0.f;
    }
}
__device__ __forceinline__ void p1_ba(const Frame& F, const Params& P) {
    const int gw = F.vb * NWAVES + F.wave, NGW = F.G * NWAVES;
    const float* wba = (const float*)(P.ws + WS_WBA); const bf16* xb = (const bf16*)(P.ws + WS_XB); const float* rowsq = (const float*)(P.ws + WS_ROWSQ); float* ba = (float*)(P.ws + WS_BA);
    f32x4 wb[8][4];
#pragma unroll
    for (int c = 0; c < 8; ++c)
#pragma unroll
        for (int j = 0; j < 2; ++j) { const f32x4* p = (const f32x4*)(wba + c * DM + F.lane * 8 + 512 * j); wb[c][2 * j] = p[0]; wb[c][2 * j + 1] = p[1]; }
    for (int m = gw; m < TT; m += NGW) {
        float xv[16];
#pragma unroll
        for (int j = 0; j < 2; ++j) { const u32x4 w = *(const u32x4*)(xb + (size_t)m * DM + F.lane * 8 + 512 * j);
            xv[8 * j + 0] = bflo(w.x); xv[8 * j + 1] = bfhi(w.x); xv[8 * j + 2] = bflo(w.y); xv[8 * j + 3] = bfhi(w.y); xv[8 * j + 4] = bflo(w.z); xv[8 * j + 5] = bfhi(w.z); xv[8 * j + 6] = bflo(w.w); xv[8 * j + 7] = bfhi(w.w); }
        float sq = F.lane < 16 ? rowsq[(size_t)m * 16 + F.lane] : 0.f; sq = wave_sum(sq);
        const float rs = __builtin_amdgcn_rsqf(sq * (1.0f / 1024.0f) + NORM_EPS);
        float mine = 0.f;
#pragma unroll
        for (int c = 0; c < 8; ++c) { float d = 0.f;
#pragma unroll
            for (int q = 0; q < 4; ++q) d += (xv[4 * q] * wb[c][q].x + xv[4 * q + 1] * wb[c][q].y) + (xv[4 * q + 2] * wb[c][q].z + xv[4 * q + 3] * wb[c][q].w);
            d = wave_sum(d); if (F.lane == c) mine = d; }
        if (F.lane < 8) ba[(size_t)m * 8 + F.lane] = mine * rs;
    }
}

__device__ __forceinline__ void sgu_task(const Frame& F, const Params& P, int l, int task) {
    const int g = task & 3, cb = task >> 2, m0 = cb * 128;
    const bf16* uv = (const bf16*)(P.ws + WS_UV); bf16* bra = (bf16*)(P.ws + WS_BR);
    LAS bf16* vnT = (LAS bf16*)F.lds;
    const int r = F.tid >> 2, qq = F.tid & 3;
    { const bf16* vrow = uv + (size_t)(m0 + r) * 1024 + 512 + qq * 128; float s = 0.f, s2 = 0.f;
#pragma unroll
      for (int j = 0; j < 16; ++j) { const u32x4 w = *(const u32x4*)(vrow + 8 * j); const float a0 = bflo(w.x), a1 = bfhi(w.x), a2 = bflo(w.y), a3 = bfhi(w.y), a4 = bflo(w.z), a5 = bfhi(w.z), a6 = bflo(w.w), a7 = bfhi(w.w);
          s += ((a0 + a1) + (a2 + a3)) + ((a4 + a5) + (a6 + a7)); s2 += ((a0 * a0 + a1 * a1) + (a2 * a2 + a3 * a3)) + ((a4 * a4 + a5 * a5) + (a6 * a6 + a7 * a7)); }
      s += __shfl_xor(s, 1); s += __shfl_xor(s, 2); s2 += __shfl_xor(s2, 1); s2 += __shfl_xor(s2, 2);
      const float mean = s * (1.f / 512.f); float var = s2 * (1.f / 512.f) - mean * mean; var = var > 0.f ? var : 0.f; const float rstd = __builtin_amdgcn_rsqf(var + NORM_EPS);
      const bf16* vg = uv + (size_t)(m0 + r) * 1024 + 512 + g * 128 + qq * 32; const float* lg = P.sgu_ln_g + l * 512 + g * 128 + qq * 32; const float* lb = P.sgu_ln_b + l * 512 + g * 128 + qq * 32;
#pragma unroll
      for (int j = 0; j < 4; ++j) { const u32x4 w = *(const u32x4*)(vg + 8 * j); const float a[8] = {bflo(w.x), bfhi(w.x), bflo(w.y), bfhi(w.y), bflo(w.z), bfhi(w.z), bflo(w.w), bfhi(w.w)};
#pragma unroll
          for (int i = 0; i < 8; ++i) { const int c = qq * 32 + 8 * j + i; const float y = (a[i] - mean) * rstd * lg[8 * j + i] + lb[8 * j + i]; vnT[c * 136 + r] = (bf16)(pk2(y, 0.f) & 0xffffu); } }
    }
    __syncthreads();
    const int lr = F.lane & 31, h = F.lane >> 5, ct = F.wave >> 1;
    const bf16* sw = (const bf16*)(P.ws + WS_SGUW) + (size_t)g * 128 * 128;
#pragma unroll
    for (int t2 = 0; t2 < 2; ++t2) { const int tt = 2 * (F.wave & 1) + t2; f32x16 acc = zero16();
        for (int ks = 0; ks < 2 * (tt + 1); ++ks) {
            const bf16x8 a = *(const LAS bf16x8*)(vnT + (32 * ct + lr) * 136 + 16 * ks + 8 * h);
            const bf16x8 b = *(const bf16x8*)(sw + (size_t)(32 * tt + lr) * 128 + 16 * ks + 8 * h);
            acc = MFMA32(a, b, acc); }
        const int t = 32 * tt + lr; const float bias = P.sgu_b[l * 512 + g * 128 + t];
#pragma unroll
        for (int gq = 0; gq < 4; ++gq) { const int c0 = 32 * ct + 8 * gq + 4 * h; const u32x2 uu = *(const u32x2*)(uv + (size_t)(m0 + t) * 1024 + g * 128 + c0);
            u32x2 o; o.x = pk2(bflo(uu.x) * (acc[4 * gq] + bias), bfhi(uu.x) * (acc[4 * gq + 1] + bias)); o.y = pk2(bflo(uu.y) * (acc[4 * gq + 2] + bias), bfhi(uu.y) * (acc[4 * gq + 3] + bias));
            *(u32x2*)(bra + (size_t)(m0 + t) * 512 + g * 128 + c0) = o; } }
    __syncthreads();
}

__device__ __forceinline__ void swa_task(const Frame& F, const Params& P, int l, int task) {
    const int kvh = task & 1, cb = task >> 1, nq = cb & 63, m0 = cb * 128;
    const bf16* qkvb = (const bf16*)(P.ws + WS_QKVB); bf16* brb = (bf16*)(P.ws + WS_BR) + (size_t)TT * 512;
    LAS bf16* Qs = (LAS bf16*)F.lds;
    LAS bf16* Ks = (LAS bf16*)(F.lds + 73728);
    LAS bf16* VT = (LAS bf16*)(F.lds + 110592);
    for (int i = F.tid; i < 4096; i += NTHR) { const int g = i >> 10, r = (i >> 3) & 127, c8 = i & 7; if (c8 < 2) continue;
        const u32x4 w = *(const u32x4*)(qkvb + (size_t)(m0 + r) * 768 + (kvh * 4 + g) * 64 + c8 * 8);
        u32x4 o; o.x = pk2(bflo(w.x) * 0.125f, bfhi(w.x) * 0.125f); o.y = pk2(bflo(w.y) * 0.125f, bfhi(w.y) * 0.125f); o.z = pk2(bflo(w.z) * 0.125f, bfhi(w.z) * 0.125f); o.w = pk2(bflo(w.w) * 0.125f, bfhi(w.w) * 0.125f);
        *(LAS u32x4*)(Qs + (g * 128 + r) * 72 + c8 * 8) = o; }
    const float invf[8] = {1.0f, 0.19392274474868576f, 0.03760603093086393f, 0.007292664737217109f, 0.001414213562373095f, 0.0002742481756762073f, 5.318295896944988e-05f, 1.031338537721246e-05f};
    { const int g = F.tid >> 7, r = F.tid & 127; const float pos = (float)P.pos[m0 + r];
      const bf16* src = qkvb + (size_t)(m0 + r) * 768 + (kvh * 4 + g) * 64; const u32x4 w1 = *(const u32x4*)src, w2 = *(const u32x4*)(src + 8);
      const float x1[8] = {bflo(w1.x), bfhi(w1.x), bflo(w1.y), bfhi(w1.y), bflo(w1.z), bfhi(w1.z), bflo(w1.w), bfhi(w1.w)}, x2[8] = {bflo(w2.x), bfhi(w2.x), bflo(w2.y), bfhi(w2.y), bflo(w2.z), bfhi(w2.z), bflo(w2.w), bfhi(w2.w)};
      float o1[8], o2[8];
#pragma unroll
      for (int i = 0; i < 8; ++i) { float sn, cs; sincosf(pos * invf[i], &sn, &cs); o1[i] = (x1[i] * cs - x2[i] * sn) * 0.125f; o2[i] = (x2[i] * cs + x1[i] * sn) * 0.125f; }
      u32x4 a, b; a.x = pk2(o1[0], o1[1]); a.y = pk2(o1[2], o1[3]); a.z = pk2(o1[4], o1[5]); a.w = pk2(o1[6], o1[7]); b.x = pk2(o2[0], o2[1]); b.y = pk2(o2[2], o2[3]); b.z = pk2(o2[4], o2[5]); b.w = pk2(o2[6], o2[7]);
      *(LAS u32x4*)(Qs + (g * 128 + r) * 72) = a; *(LAS u32x4*)(Qs + (g * 128 + r) * 72 + 8) = b; }
    for (int i = F.tid; i < 2048; i += NTHR) { const int s = i >> 3, c8 = i & 7; const bool ok = nq > 0 || s >= 128; const size_t row = (size_t)(m0 - 128 + s);
        u32x4 kw = {0u, 0u, 0u, 0u}, vw = {0u, 0u, 0u, 0u};
        if (ok) { if (c8 >= 2) kw = *(const u32x4*)(qkvb + row * 768 + 512 + kvh * 64 + c8 * 8); vw = *(const u32x4*)(qkvb + row * 768 + 640 + kvh * 64 + c8 * 8); }
        if (c8 >= 2) *(LAS u32x4*)(Ks + s * 72 + c8 * 8) = kw;
        const int p = (s & ~12) | ((s & 4) << 1) | ((s & 8) >> 1); const unsigned vv[4] = {vw.x, vw.y, vw.z, vw.w};
#pragma unroll
        for (int j = 0; j < 4; ++j) { VT[(c8 * 8 + 2 * j) * 264 + p] = (bf16)(vv[j] & 0xffffu); VT[(c8 * 8 + 2 * j + 1) * 264 + p] = (bf16)(vv[j] >> 16); } }
    if (F.tid < 256) { const int s = F.tid; const bool ok = nq > 0 || s >= 128; u32x4 a = {0u, 0u, 0u, 0u}, b = {0u, 0u, 0u, 0u};
        if (ok) { const size_t row = (size_t)(m0 - 128 + s); const float pos = (float)P.pos[row]; const bf16* src = qkvb + row * 768 + 512 + kvh * 64; const u32x4 w1 = *(const u32x4*)src, w2 = *(const u32x4*)(src + 8);
            const float x1[8] = {bflo(w1.x), bfhi(w1.x), bflo(w1.y), bfhi(w1.y), bflo(w1.z), bfhi(w1.z), bflo(w1.w), bfhi(w1.w)}, x2[8] = {bflo(w2.x), bfhi(w2.x), bflo(w2.y), bfhi(w2.y), bflo(w2.z), bfhi(w2.z), bflo(w2.w), bfhi(w2.w)};
            float o1[8], o2[8];
#pragma unroll
            for (int i = 0; i < 8; ++i) { float sn, cs; sincosf(pos * invf[i], &sn, &cs); o1[i] = x1[i] * cs - x2[i] * sn; o2[i] = x2[i] * cs + x1[i] * sn; }
            a.x = pk2(o1[0], o1[1]); a.y = pk2(o1[2], o1[3]); a.z = pk2(o1[4], o1[5]); a.w = pk2(o1[6], o1[7]); b.x = pk2(o2[0], o2[1]); b.y = pk2(o2[2], o2[3]); b.z = pk2(o2[4], o2[5]); b.w = pk2(o2[6], o2[7]); }
        *(LAS u32x4*)(Ks + s * 72) = a; *(LAS u32x4*)(Ks + s * 72 + 8) = b; }
    __syncthreads();
    const int lr = F.lane & 31, h = F.lane >> 5, g = F.wave >> 1, qh = F.wave & 1;
    const float sink = P.sinks[l * 8 + kvh * 4 + g];
#pragma unroll 1
    for (int q2 = 0; q2 < 2; ++q2) { const int qt = 2 * qh + q2, q0 = 32 * qt, qi = q0 + lr;
        bf16x8 bq[4];
#pragma unroll
        for (int ks = 0; ks < 4; ++ks) bq[ks] = *(const LAS bf16x8*)(Qs + (g * 128 + q0 + lr) * 72 + 16 * ks + 8 * h);
        f32x16 sc[5];
#pragma unroll
        for (int k5 = 0; k5 < 5; ++k5) { sc[k5] = zero16();
#pragma unroll
            for (int ks = 0; ks < 4; ++ks) { const bf16x8 a = *(const LAS bf16x8*)(Ks + (32 * (qt + k5) + lr) * 72 + 16 * ks + 8 * h); sc[k5] = MFMA32(a, bq[ks], sc[k5]); } }
        float mx = sink;
#pragma unroll
        for (int k5 = 0; k5 < 5; ++k5)
#pragma unroll
            for (int rg = 0; rg < 16; ++rg) { const int sj = 32 * (qt + k5) + crow(rg, h); const bool ok = sj >= qi + 1 && sj <= qi + 128 && (nq > 0 || sj >= 128);
                const float v = ok ? sc[k5][rg] : -INFINITY; sc[k5][rg] = v; mx = fmaxf(mx, v); }
        mx = fmaxf(mx, __shfl_xor(mx, 32));
        float sum = 0.f;
#pragma unroll
        for (int k5 = 0; k5 < 5; ++k5)
#pragma unroll
            for (int rg = 0; rg < 16; ++rg) { const float p = __expf(sc[k5][rg] - mx); sc[k5][rg] = p; sum += p; }
        sum += __shfl_xor(sum, 32); sum += __expf(sink - mx);
        const float inv = 1.0f / sum;
        f32x16 o[2] = {zero16(), zero16()};
#pragma unroll
        for (int k5 = 0; k5 < 5; ++k5)
#pragma unroll
            for (int s2 = 0; s2 < 2; ++s2) { const bf16x8 pb = pack_step(sc[k5], s2);
#pragma unroll
                for (int dt = 0; dt < 2; ++dt) { const bf16x8 a = *(const LAS bf16x8*)(VT + (32 * dt + lr) * 264 + 32 * (qt + k5) + 16 * s2 + 8 * h); o[dt] = MFMA32(a, pb, o[dt]); } }
        bf16* orow = brb + (size_t)(m0 + qi) * 512 + (kvh * 4 + g) * 64;
#pragma unroll
        for (int dt = 0; dt < 2; ++dt)
#pragma unroll
            for (int gq = 0; gq < 4; ++gq) { u32x2 w; w.x = pk2(o[dt][4 * gq] * inv, o[dt][4 * gq + 1] * inv); w.y = pk2(o[dt][4 * gq + 2] * inv, o[dt][4 * gq + 3] * inv);
                *(u32x2*)(orow + 32 * dt + 8 * gq + 4 * h) = w; }
    }
    __syncthreads();
}

__device__ __forceinline__ void dn_pre_task(const Frame& F, const Params& P, int l, int task) {
    const int hd = task & 3, cbn = task >> 2, b = cbn >> 7, n = cbn & 127, m0 = cbn * 64;
    const bf16* qkvc = (const bf16*)(P.ws + WS_QKVC); const float* ba = (const float*)(P.ws + WS_BA);
    unsigned char* outb = P.ws + WS_DN + (size_t)task * DN_TASK_BYTES;
    LAS bf16* qs = (LAS bf16*)F.lds;
    LAS bf16* ks = (LAS bf16*)(F.lds + 17408);
    LAS bf16* kT = (LAS bf16*)(F.lds + 34816);
    LAS bf16* vT = (LAS bf16*)(F.lds + 53248);
    LAS float* Lm = (LAS float*)(F.lds + 71680);
    LAS bf16* Tm = (LAS bf16*)(F.lds + 89088);
    LAS float* tg = (LAS float*)(F.lds + 98304);
    LAS float *tgc = tg + 64, *tbeta = tg + 128, *teg = tg + 192, *ted = tg + 256, *tsb = tg + 320;
    const int lr = F.lane & 31, h = F.lane >> 5;
    { const int t = F.tid >> 3, seg = F.tid & 7, c0 = seg * 16; const int row = m0 + t;
      const float beta = fast_sigmoid(ba[(size_t)row * 8 + hd]); const float xa = ba[(size_t)row * 8 + 4 + hd] + P.dt_bias[l * 4 + hd];
      const float sp = xa > 20.f ? xa : log1pf(__expf(xa)); const float gt = -__expf(P.a_log[l * 4 + hd]) * sp;
      if (seg == 0) { tg[t] = gt; tbeta[t] = beta; }
#pragma unroll
      for (int part = 0; part < 3; ++part) { const int col0 = part * 512 + hd * 128 + c0; float acc[16];
#pragma unroll
          for (int i = 0; i < 16; ++i) acc[i] = 0.f;
#pragma unroll
          for (int tap = 0; tap < 4; ++tap) { const int sr = n * 64 + t - 3 + tap; if (sr >= 0) {
              const bf16* src = qkvc + (size_t)(b * SEQ + sr) * 1536 + col0; const u32x4 w1 = *(const u32x4*)src, w2 = *(const u32x4*)(src + 8);
              const float xv[16] = {bflo(w1.x), bfhi(w1.x), bflo(w1.y), bfhi(w1.y), bflo(w1.z), bfhi(w1.z), bflo(w1.w), bfhi(w1.w), bflo(w2.x), bfhi(w2.x), bflo(w2.y), bfhi(w2.y), bflo(w2.z), bfhi(w2.z), bflo(w2.w), bfhi(w2.w)};
              const f32x4* cw = (const f32x4*)(P.conv_w + ((size_t)l * 4 + tap) * 1536 + col0);
#pragma unroll
              for (int q = 0; q < 4; ++q) { const f32x4 w = cw[q]; acc[4 * q] += xv[4 * q] * w.x; acc[4 * q + 1] += xv[4 * q + 1] * w.y; acc[4 * q + 2] += xv[4 * q + 2] * w.z; acc[4 * q + 3] += xv[4 * q + 3] * w.w; } } }
          float ss = 0.f;
#pragma unroll
          for (int i = 0; i < 16; ++i) { acc[i] = acc[i] * fast_sigmoid(acc[i]); ss += acc[i] * acc[i]; }
          if (part < 2) { ss += __shfl_xor(ss, 1); ss += __shfl_xor(ss, 2); ss += __shfl_xor(ss, 4); const float rn = __builtin_amdgcn_rsqf(ss + NORM_EPS) * (part == 0 ? 0.08838834764831845f : 1.0f);
#pragma unroll
              for (int i = 0; i < 16; ++i) acc[i] *= rn; }
          else {
#pragma unroll
              for (int i = 0; i < 16; ++i) acc[i] *= beta; }
          unsigned pk[8];
#pragma unroll
          for (int i = 0; i < 8; ++i) pk[i] = pk2(acc[2 * i], acc[2 * i + 1]);
          if (part < 2) { LAS bf16* dst = (part == 0 ? qs : ks) + t * 136 + c0; *(LAS u32x4*)dst = (u32x4){pk[0], pk[1], pk[2], pk[3]}; *(LAS u32x4*)(dst + 8) = (u32x4){pk[4], pk[5], pk[6], pk[7]}; }
          if (part >= 1) { LAS bf16* dT = part == 1 ? kT : vT;
#pragma unroll
              for (int i = 0; i < 8; ++i) { dT[(c0 + 2 * i) * 72 + t] = (bf16)(pk[i] & 0xffffu); dT[(c0 + 2 * i + 1) * 72 + t] = (bf16)(pk[i] >> 16); } }
      }
    }
    __syncthreads();
    if (F.wave == 0) { float x = tg[F.lane];
#pragma unroll
        for (int o = 1; o < 64; o <<= 1) { const float y = __shfl_up(x, o); if (F.lane >= o) x += y; }
        const float gl = __shfl(x, 63); tgc[F.lane] = x; const float e = __expf(x); teg[F.lane] = e; ted[F.lane] = __expf(gl - x); tsb[F.lane] = tbeta[F.lane] * e;
        if (F.lane == 0) ((float*)(P.ws + WS_CD))[task] = __expf(gl); }
    __syncthreads();
    if (F.wave < 4) { const int it = F.wave >> 1, jt = F.wave & 1; f32x16 acc = zero16();
        if (jt <= it) {
#pragma unroll
            for (int s = 0; s < 8; ++s) { const bf16x8 a = *(const LAS bf16x8*)(ks + (32 * it + lr) * 136 + 16 * s + 8 * h), bb = *(const LAS bf16x8*)(ks + (32 * jt + lr) * 136 + 16 * s + 8 * h); acc = MFMA32(a, bb, acc); } }
        const int j = 32 * jt + lr; const float gj = tgc[j];
#pragma unroll
        for (int rg = 0; rg < 16; ++rg) { const int i = 32 * it + crow(rg, h); const float v = i > j ? tbeta[i] * acc[rg] * __expf(tgc[i] - gj) : 0.f; Lm[i * 68 + j] = v; } }
    else { const int w4 = F.wave - 4, jt = w4 >> 1, ct = w4 & 1; f32x16 acc = zero16();
        if (jt <= ct) {
#pragma unroll
            for (int s = 0; s < 8; ++s) { const bf16x8 a = *(const LAS bf16x8*)(ks + (32 * jt + lr) * 136 + 16 * s + 8 * h), bb = *(const LAS bf16x8*)(qs + (32 * ct + lr) * 136 + 16 * s + 8 * h); acc = MFMA32(a, bb, acc); } }
        const int c = 32 * ct + lr; const float gcc = tgc[c];
#pragma unroll
        for (int rg = 0; rg < 16; ++rg) { const int jp = 32 * jt + crow(rg, h); acc[rg] = jp <= c ? acc[rg] * __expf(gcc - tgc[jp]) : 0.f; }
#pragma unroll
        for (int s = 0; s < 2; ++s) *(bf16x8*)(outb + DN_OFF_AT + ((ct * 4 + 2 * jt + s) * 64 + F.lane) * 16) = pack_step(acc, s); }
    __syncthreads();
    if (F.wave == 0) { LAS float* Tf = (LAS float*)(F.lds + 99840);
#pragma unroll 1
        for (int bi = 0; bi < 4; ++bi) { float rr[16];
#pragma unroll
            for (int ii = 0; ii < 16; ++ii) rr[ii] = (F.lane == 16 * bi + ii) ? 1.f : 0.f;
#pragma unroll 1
            for (int j = 0; j < 16 * bi; j += 4) { const float t0 = Tf[j * 64 + F.lane], t1 = Tf[(j + 1) * 64 + F.lane], t2 = Tf[(j + 2) * 64 + F.lane], t3 = Tf[(j + 3) * 64 + F.lane];
#pragma unroll
                for (int ii = 0; ii < 16; ++ii) { const f32x4 lv = *(const LAS f32x4*)(Lm + (16 * bi + ii) * 68 + j); rr[ii] -= (lv.x * t0 + lv.y * t1) + (lv.z * t2 + lv.w * t3); } }
#pragma unroll
            for (int ii = 0; ii < 16; ++ii) {
#pragma unroll
                for (int j4 = 0; j4 < ii; j4 += 4) { const f32x4 lv = *(const LAS f32x4*)(Lm + (16 * bi + ii) * 68 + 16 * bi + j4);
                    rr[ii] -= lv.x * rr[j4]; if (j4 + 1 < ii) rr[ii] -= lv.y * rr[j4 + 1]; if (j4 + 2 < ii) rr[ii] -= lv.z * rr[j4 + 2]; if (j4 + 3 < ii) rr[ii] -= lv.w * rr[j4 + 3]; }
                Tf[(16 * bi + ii) * 64 + F.lane] = rr[ii]; Tm[(16 * bi + ii) * 72 + F.lane] = (bf16)(pk2(rr[ii], 0.f) & 0xffffu); } } }
    else { for (int f = F.wave - 1; f < 32; f += 7) {
            if (f < 16) { const int mt = f >> 3, s = f & 7, c = 32 * mt + lr; const float e = teg[c];
                const u32x2 lo = *(const LAS u32x2*)(qs + c * 136 + 16 * s + 4 * h), hi = *(const LAS u32x2*)(qs + c * 136 + 16 * s + 8 + 4 * h);
                u32x4 o; o.x = pk2(bflo(lo.x) * e, bfhi(lo.x) * e); o.y = pk2(bflo(lo.y) * e, bfhi(lo.y) * e); o.z = pk2(bflo(hi.x) * e, bfhi(hi.x) * e); o.w = pk2(bflo(hi.y) * e, bfhi(hi.y) * e);
                *(u32x4*)(outb + DN_OFF_QD + ((mt * 8 + s) * 64 + F.lane) * 16) = o; }
            else { const int f2 = f - 16, dt = f2 >> 2, s = f2 & 3, d = 32 * dt + lr;
                const u32x2 lo = *(const LAS u32x2*)(kT + d * 72 + 16 * s + 4 * h), hi = *(const LAS u32x2*)(kT + d * 72 + 16 * s + 8 + 4 * h);
                const f32x4 e0 = *(const LAS f32x4*)(ted + 16 * s + 4 * h), e1 = *(const LAS f32x4*)(ted + 16 * s + 8 + 4 * h);
                u32x4 o; o.x = pk2(bflo(lo.x) * e0.x, bfhi(lo.x) * e0.y); o.y = pk2(bflo(lo.y) * e0.z, bfhi(lo.y) * e0.w); o.z = pk2(bflo(hi.x) * e1.x, bfhi(hi.x) * e1.y); o.w = pk2(bflo(hi.y) * e1.z, bfhi(hi.y) * e1.w);
                *(u32x4*)(outb + DN_OFF_KD + ((dt * 4 + s) * 64 + F.lane) * 16) = o; } } }
    __syncthreads();
    { const int it = F.wave >> 2, et = F.wave & 3; f32x16 acc = zero16();
#pragma unroll
      for (int s = 0; s < 4; ++s) { const bf16x8 a = *(const LAS bf16x8*)(Tm + (32 * it + lr) * 72 + 16 * s + 8 * h), bb = *(const LAS bf16x8*)(vT + (32 * et + lr) * 72 + 16 * s + 8 * h); acc = MFMA32(a, bb, acc); }
      u32x4 o0, o1; o0.x = pk2(acc[0], acc[1]); o0.y = pk2(acc[2], acc[3]); o0.z = pk2(acc[4], acc[5]); o0.w = pk2(acc[6], acc[7]); o1.x = pk2(acc[8], acc[9]); o1.y = pk2(acc[10], acc[11]); o1.z = pk2(acc[12], acc[13]); o1.w = pk2(acc[14], acc[15]);
      unsigned char* up = outb + DN_OFF_U + ((et * 2 + it) * 64 + F.lane) * 32; *(u32x4*)up = o0; *(u32x4*)(up + 16) = o1; }
    { const int dt = F.wave >> 1, it = F.wave & 1; f32x16 acc = zero16();
#pragma unroll
      for (int s = 0; s < 4; ++s) { const u32x4 kw = *(const LAS u32x4*)(kT + (32 * dt + lr) * 72 + 16 * s + 8 * h); const f32x4 e0 = *(const LAS f32x4*)(tsb + 16 * s + 8 * h), e1 = *(const LAS f32x4*)(tsb + 16 * s + 8 * h + 4);
          u32x4 aw; aw.x = pk2(bflo(kw.x) * e0.x, bfhi(kw.x) * e0.y); aw.y = pk2(bflo(kw.y) * e0.z, bfhi(kw.y) * e0.w); aw.z = pk2(bflo(kw.z) * e1.x, bfhi(kw.z) * e1.y); aw.w = pk2(bflo(kw.w) * e1.z, bfhi(kw.w) * e1.w);
          const bf16x8 bb = *(const LAS bf16x8*)(Tm + (32 * it + lr) * 72 + 16 * s + 8 * h); acc = MFMA32(__builtin_bit_cast(bf16x8, aw), bb, acc); }
#pragma unroll
      for (int s = 0; s < 2; ++s) *(bf16x8*)(outb + DN_OFF_W + ((it * 8 + 2 * dt + s) * 64 + F.lane) * 16) = pack_step(acc, s); }
    __syncthreads();
}
constexpr int SC_BUF = 49152;
#define SC_BARRIER() do { asm volatile("s_waitcnt lgkmcnt(0)" ::: "memory"); __builtin_amdgcn_s_barrier(); asm volatile("" ::: "memory"); } while (0)
__device__ __forceinline__ void dn_scan(const Frame& F, const Params& P, int bh, bool nostore = false) {
    const int b = bh >> 2, hd = bh & 3; const int es = F.wave;
    unsigned char* dn = P.ws + WS_DN; const float* cdv = (const float*)(P.ws + WS_CD);
#define task_of(n_) ((((b) * 128 + (n_)) << 2) | (hd))
#define SC_SRC(n_, i_) ((const u32x4*)(dn + (size_t)task_of(n_) * DN_TASK_BYTES + ((i_) < 4 ? 0 : ((i_) < 8 ? DN_OFF_KD - 16384 : DN_OFF_U - 32768))) + t4 + 256 * (i_))
    if (F.wave >= 4) {
        const int t4 = F.tid - 256; u32x4 R0[12], R1[12], R2[12]; LAS float* cdl = (LAS float*)(F.lds + 2 * SC_BUF);
        float C0 = cdv[task_of(1)], C1 = cdv[task_of(2)], C2 = cdv[task_of(3)];
        if (t4 == 0) cdl[0] = cdv[task_of(0)];
        { LAS u32x4* dst = (LAS u32x4*)F.lds;
#pragma unroll
          for (int i = 0; i < 12; ++i) R0[i] = *SC_SRC(0, i);
#pragma unroll
          for (int i = 0; i < 12; ++i) dst[t4 + 256 * i] = R0[i]; }
#pragma unroll
        for (int i = 0; i < 12; ++i) { R0[i] = *SC_SRC(1, i); R1[i] = *SC_SRC(2, i); R2[i] = *SC_SRC(3, i); }
        SC_BARRIER();
#define SC_LSTEP(R, C, n_) if ((n_) < 128) { if ((n_) + 1 < 128) { LAS u32x4* dst = (LAS u32x4*)(F.lds + (((n_) + 1) & 1) * SC_BUF); \
            _Pragma("unroll") for (int i = 0; i < 12; ++i) dst[t4 + 256 * i] = R[i]; if (t4 == 0) cdl[((n_) + 1) & 1] = C; } \
            if ((n_) + 4 < 128) { _Pragma("unroll") for (int i = 0; i < 12; ++i) R[i] = *SC_SRC((n_) + 4, i); C = cdv[task_of((n_) + 4)]; } \
            SC_BARRIER(); }
#pragma unroll
        for (int n = 0; n < 129; n += 3) { SC_LSTEP(R0, C0, n) SC_LSTEP(R1, C1, n + 1) SC_LSTEP(R2, C2, n + 2) }
#undef SC_LSTEP
    } else {
        f32x16 S[4] = {zero16(), zero16(), zero16(), zero16()};
        const LAS float* cdl = (const LAS float*)(F.lds + 2 * SC_BUF);
        SC_BARRIER();
#pragma unroll 1
        for (int n = 0; n < 128; ++n) {
            const LAS unsigned char* cur = F.lds + (n & 1) * SC_BUF; unsigned char* tb = dn + (size_t)task_of(n) * DN_TASK_BYTES;
            const float cd = cdl[n & 1];
            bf16x8 Sb[8], A[16];
#pragma unroll
            for (int i = 0; i < 16; ++i) A[i] = *(const LAS bf16x8*)(cur + (i * 64 + F.lane) * 16);
#pragma unroll
            for (int dt = 0; dt < 4; ++dt) { Sb[2 * dt] = pack_step(S[dt], 0); Sb[2 * dt + 1] = pack_step(S[dt], 1); }
            { unsigned char* hp = tb + (es < 2 ? 0 : DN_OFF_KD) + ((es & 1) * 8 * 64 + F.lane) * 16;
              if (!nostore) {
#pragma unroll
              for (int s = 0; s < 8; ++s) *(bf16x8*)(hp + s * 1024) = Sb[s]; } }
            __builtin_amdgcn_sched_barrier(0);
            f32x16 Pw[2] = {zero16(), zero16()};
#pragma unroll
            for (int s = 0; s < 8; ++s) { Pw[0] = MFMA32(A[s], Sb[s], Pw[0]); Pw[1] = MFMA32(A[8 + s], Sb[s], Pw[1]); }
            __builtin_amdgcn_sched_barrier(0);
            u32x4 uu[4];
#pragma unroll
            for (int i = 0; i < 4; ++i) uu[i] = *(const LAS u32x4*)(cur + 32768 + ((es * 2 + (i >> 1)) * 64 + F.lane) * 32 + (i & 1) * 16);
#pragma unroll
            for (int i = 0; i < 16; ++i) A[i] = *(const LAS bf16x8*)(cur + 16384 + (i * 64 + F.lane) * 16);
            __builtin_amdgcn_sched_barrier(0);
            bf16x8 Vb[4];
#pragma unroll
            for (int ct = 0; ct < 2; ++ct) { const unsigned uw[8] = {uu[2 * ct].x, uu[2 * ct].y, uu[2 * ct].z, uu[2 * ct].w, uu[2 * ct + 1].x, uu[2 * ct + 1].y, uu[2 * ct + 1].z, uu[2 * ct + 1].w}; f32x16 v;
#pragma unroll
                for (int p = 0; p < 8; ++p) { v[2 * p] = bflo(uw[p]) - Pw[ct][2 * p]; v[2 * p + 1] = bfhi(uw[p]) - Pw[ct][2 * p + 1]; }
                Vb[2 * ct] = pack_step(v, 0); Vb[2 * ct + 1] = pack_step(v, 1); }
            { unsigned char* vp = tb + DN_OFF_U + (es * 4 * 64 + F.lane) * 16;
              if (!nostore) {
#pragma unroll
              for (int s = 0; s < 4; ++s) *(bf16x8*)(vp + s * 1024) = Vb[s]; } }
#pragma unroll
            for (int dt = 0; dt < 4; ++dt) S[dt] = S[dt] * cd;
            __builtin_amdgcn_sched_barrier(0);
#pragma unroll
            for (int s = 0; s < 4; ++s)
#pragma unroll
                for (int dt = 0; dt < 4; ++dt) S[dt] = MFMA32(A[dt * 4 + s], Vb[s], S[dt]);
            SC_BARRIER();
        }
    }
#undef SC_SRC
#undef task_of
}
__device__ __forceinline__ void dn_out_task(const Frame& F, const Params& P, int l, int task) {
    const int hd = task & 3, cbn = task >> 2, m0 = cbn * 64; const int lr = F.lane & 31, h = F.lane >> 5, ct = F.wave >> 2, es = F.wave & 3;
    const unsigned char* tb = P.ws + WS_DN + (size_t)task * DN_TASK_BYTES; bf16* brc = (bf16*)(P.ws + WS_BR) + (size_t)2 * TT * 512; const bf16* z = (const bf16*)(P.ws + WS_Z);
    LAS float* ssq = (LAS float*)F.lds;
    f32x16 o = zero16();
    { const unsigned char* hp = tb + (es < 2 ? 0 : DN_OFF_KD) + ((es & 1) * 8 * 64 + F.lane) * 16;
#pragma unroll
      for (int s = 0; s < 8; ++s) { const bf16x8 a = *(const bf16x8*)(tb + DN_OFF_QD + ((ct * 8 + s) * 64 + F.lane) * 16), bb = *(const bf16x8*)(hp + s * 1024); o = MFMA32(a, bb, o); }
      const unsigned char* vp = tb + DN_OFF_U + (es * 4 * 64 + F.lane) * 16;
#pragma unroll
      for (int s = 0; s < 4; ++s) { const bf16x8 a = *(const bf16x8*)(tb + DN_OFF_AT + ((ct * 4 + s) * 64 + F.lane) * 16), bb = *(const bf16x8*)(vp + s * 1024); o = MFMA32(a, bb, o); } }
    float q[16];
#pragma unroll
    for (int rg = 0; rg < 16; ++rg) { float v = o[rg] * o[rg]; v += __shfl_xor(v, 1); v += __shfl_xor(v, 2); v += __shfl_xor(v, 4); v += __shfl_xor(v, 8); v += __shfl_xor(v, 16); q[rg] = v; }
    if (lr == 0) {
#pragma unroll
        for (int rg = 0; rg < 16; ++rg) ssq[(ct * 4 + es) * 32 + crow(rg, h)] = q[rg]; }
    __syncthreads();
    const int e = hd * 128 + es * 32 + lr; const float gn = P.dn_norm[l * 128 + es * 32 + lr];
#pragma unroll
    for (int rg = 0; rg < 16; ++rg) { const int r = crow(rg, h); const float tot = (ssq[(ct * 4 + 0) * 32 + r] + ssq[(ct * 4 + 1) * 32 + r]) + (ssq[(ct * 4 + 2) * 32 + r] + ssq[(ct * 4 + 3) * 32 + r]);
        const float rs = __builtin_amdgcn_rsqf(tot * (1.f / 128.f) + NORM_EPS); const size_t idx = (size_t)(m0 + 32 * ct + r) * 512 + e;
        const float zz = __uint_as_float(((unsigned)z[idx]) << 16); brc[idx] = (bf16)(pk2(o[rg] * rs * gn * (zz * fast_sigmoid(zz)), 0.f) & 0xffffu); }
    __syncthreads();
}
__device__ __forceinline__ void final_norm(const Frame& F, const Params& P) {
    const int gw = F.vb * NWAVES + F.wave, NGW = F.G * NWAVES; const float* rowsq = (const float*)(P.ws + WS_ROWSQ);
    f32x4 gn[4];
#pragma unroll
    for (int j = 0; j < 4; ++j) gn[j] = ((const f32x4*)P.final_norm)[F.lane + 64 * j];
    for (int m = gw; m < TT; m += NGW) { float sq = F.lane < 16 ? rowsq[(size_t)m * 16 + F.lane] : 0.f; sq = wave_sum(sq); const float rs = __builtin_amdgcn_rsqf(sq * (1.f / 1024.f) + NORM_EPS);
        f32x4* xr = (f32x4*)(P.out + (size_t)m * DM) + F.lane;
#pragma unroll
        for (int j = 0; j < 4; ++j) xr[64 * j] = xr[64 * j] * rs * gn[j]; }
}

#define RLX_AGENT __ATOMIC_RELAXED, __HIP_MEMORY_SCOPE_AGENT
#define XB_TMO      128
#define XB_XCNT(j)  (256  + 64 * (j))
#define XB_XSUB(j)  (1280 + 64 * (j))
#define XB_XGEN(j)  (2304 + 64 * (j))
#define XB_TOP      3328
#define XB_TOPGEN   3392
#define XCD_BAR_WORDS 3456
#define XB_SPIN_CAP (1u << 18)

__device__ __forceinline__ unsigned xb_ld(unsigned* p)              { return __hip_atomic_load(p, __ATOMIC_RELAXED, __HIP_MEMORY_SCOPE_AGENT); }
__device__ __forceinline__ unsigned xb_add(unsigned* p, unsigned v) { return __hip_atomic_fetch_add(p, v, __ATOMIC_RELAXED, __HIP_MEMORY_SCOPE_AGENT); }
__device__ __forceinline__ unsigned xb_xcc_id() { return (unsigned)__builtin_amdgcn_s_getreg((3 << 11) | 20) & 0xFu; }
#define XB_SPIN(cond, bar) do { unsigned _sp = 0; while (cond) { __builtin_amdgcn_s_sleep(1); \
    if ((++_sp & 255u) == 0u) { if (xb_ld(&(bar)[XB_TMO])) break; if (_sp > XB_SPIN_CAP) { atomicAdd(&(bar)[XB_TMO], 1u); break; } } } } while (0)

struct XcdBarrier {
    unsigned* bar; unsigned x;
    volatile LAS unsigned* st;
};

__device__ __forceinline__ XcdBarrier xcd_barrier_post(unsigned* bar, volatile LAS unsigned* st) {
    XcdBarrier b; b.bar = bar; b.x = xb_xcc_id(); b.st = st;
    if (threadIdx.x == 0) (void)xb_add(&bar[XB_XCNT(b.x)], 1u);
    return b;
}
__device__ __forceinline__ void xcd_barrier_complete(unsigned* bar, unsigned x, unsigned& nloc, unsigned& nx) {
    const unsigned G = gridDim.x * gridDim.y * gridDim.z;
    unsigned sum, cnt, mine, sp = 0u;
    for (;;) {
        sum = 0u; cnt = 0u; mine = 0u;
#pragma unroll
        for (unsigned j = 0; j < 16; ++j) { const unsigned c = xb_ld(&bar[XB_XCNT(j)]); sum += c; cnt += (c > 0u) ? 1u : 0u; mine = (j == x) ? c : mine; }
        if (sum == G) break;
        __builtin_amdgcn_s_sleep(1);
        if ((++sp & 255u) == 0u) { if (xb_ld(&bar[XB_TMO])) break; if (sp > XB_SPIN_CAP) { atomicAdd(&bar[XB_TMO], 1u); break; } }
    }
    nloc = mine > 0u ? mine : 1u; nx = cnt > 0u ? cnt : 1u;
}

__device__ __forceinline__ void xcd_barrier(const XcdBarrier& b) {
    asm volatile("s_waitcnt vmcnt(0)" ::: "memory");
    __syncthreads();
    if (threadIdx.x == 0) {
        unsigned* bar = b.bar;
        __builtin_amdgcn_s_waitcnt(0);
        unsigned nloc = b.st[0], nx = b.st[1];
        if (nloc == 0u) { xcd_barrier_complete(bar, b.x, nloc, nx); b.st[0] = nloc; b.st[1] = nx; }
        const unsigned old = xb_add(&bar[XB_XSUB(b.x)], 1u);
        const unsigned gen = old / nloc;
        if (old + 1u == (gen + 1u) * nloc) {
            __builtin_amdgcn_fence(__ATOMIC_RELEASE, "agent");
            asm volatile("s_waitcnt vmcnt(0)" ::: "memory");
            const unsigned og = xb_add(&bar[XB_TOP], 1u);
            const unsigned tg = og / nx;
            if (og + 1u == (tg + 1u) * nx) xb_add(&bar[XB_TOPGEN], 1u);
            else XB_SPIN(xb_ld(&bar[XB_TOPGEN]) == tg, bar);
            __builtin_amdgcn_fence(__ATOMIC_ACQUIRE, "agent");
            xb_add(&bar[XB_XGEN(b.x)], 1u);
            asm volatile("s_waitcnt vmcnt(0)" ::: "memory");
        } else {
            XB_SPIN(xb_ld(&bar[XB_XGEN(b.x)]) == gen, bar);
            __builtin_amdgcn_fence(__ATOMIC_ACQUIRE, "agent");
            asm volatile("s_waitcnt vmcnt(0)" ::: "memory");
        }
    }
    __syncthreads();
}

constexpr int PH_PER_LAYER = 9, N_PHASES = DEPTH * PH_PER_LAYER + 1;
__device__ __forceinline__ void run_phase(const Frame& F0, const Params& P0, int ph, int sub = 0) {
    Frame F = F0; Params P = P0; asm volatile("" : "+v"(F.tid)); F.lane = F.tid & 63; F.wave = __builtin_amdgcn_readfirstlane(F.tid >> 6);
    { size_t zoff = 0; asm volatile("" : "+s"(zoff)); P.ws = P0.ws + zoff; }
    const int l = ph / PH_PER_LAYER, k = ph % PH_PER_LAYER;
    unsigned char* ws = P.ws; const float* rowsq = (const float*)(ws + WS_ROWSQ); const LAS float* lrs = (const LAS float*)(F.lds + pg8::LRS_OFF);
    if (ph == N_PHASES - 1) { final_norm(F, P); return; }
#ifdef ONLY_K
    if (k != ONLY_K) return;
#endif
    switch (k) {
    case 0: p0_attn_weights(F, P, l); if (l == 0) p0_input(F, P); break;
    case 1: { p1_ba(F, P); __syncthreads();
        pg8::Gemm g{(const pg8::bf16_t*)(ws + WS_XB), (const pg8::bf16_t*)(ws + WS_WIN), TT, NMIX, DM}; pg8::StaticOrder S; S.init(TT, NMIX, F.G, (int)blockIdx.x);
        pg8::EpiProj E{(pg8::bf16_t*)(ws + WS_UV), (pg8::bf16_t*)(ws + WS_QKVB), (pg8::bf16_t*)(ws + WS_QKVC), (pg8::bf16_t*)(ws + WS_Z), lrs};
        pg8::prep_rstd(F.lds, S, rowsq);
        pg8::gemm_phase<pg8::EpiProj, pg8::StaticOrder, true, true>(F.lds, g, S, E); } break;
    case 2: for (int t = F.vb; t < 1024; t += F.G) dn_pre_task(F, P, l, t); break;
    case 3: { const int sb = (int)blockIdx.x; if (sb < 8) { if (!(sub & 2)) dn_scan(F, P, sb, (sub & 16) != 0); }
              else if (!(sub & 1)) { const int nb = F.G - 8; for (int t = sb - 8; t < 768; t += nb) { if (t < 256) { if (!(sub & 4)) swa_task(F, P, l, t); } else if (!(sub & 8)) sgu_task(F, P, l, t - 256); } } } break;
    case 4: for (int t = F.vb; t < 1024; t += F.G) dn_out_task(F, P, l, t); p0_ffn_weights(F, P, l); break;
    case 5: {
#pragma unroll 1
        for (int n = 0; n < 3; ++n) {
            { pg8::Gemm g{(const pg8::bf16_t*)(ws + WS_XB), (const pg8::bf16_t*)(ws + WS_WG) + (size_t)n * 1024 * 1024, TT, DM, DM}; pg8::StaticOrder S; S.init(TT, DM, F.G, (int)blockIdx.x);
              pg8::EpiSig E{(pg8::bf16_t*)(ws + WS_UV), lrs}; if (n == 0) pg8::prep_rstd(F.lds, S, rowsq); pg8::gemm_phase<pg8::EpiSig, pg8::StaticOrder, true, true>(F.lds, g, S, E); }
            __syncthreads();
            { pg8::Gemm g{(const pg8::bf16_t*)(ws + WS_BR) + (size_t)n * TT * 512, (const pg8::bf16_t*)(ws + WS_WBR) + (size_t)n * 1024 * 512, TT, DM, 512}; pg8::StaticOrder S; S.init(TT, DM, F.G, (int)blockIdx.x);
              if (n == 0) { pg8::EpiMerge<0> E{(pg8::bf16_t*)(ws + WS_UV), (float*)(ws + WS_DN)}; pg8::gemm_phase<pg8::EpiMerge<0>, pg8::StaticOrder, true, true>(F.lds, g, S, E); }
              else if (n == 1) { pg8::EpiMerge<1> E{(pg8::bf16_t*)(ws + WS_UV), (float*)(ws + WS_DN)}; pg8::gemm_phase<pg8::EpiMerge<1>, pg8::StaticOrder, true, true>(F.lds, g, S, E); }
              else { pg8::EpiMerge<2> E{(pg8::bf16_t*)(ws + WS_UV), (float*)(ws + WS_DN)}; pg8::gemm_phase<pg8::EpiMerge<2>, pg8::StaticOrder, true, true>(F.lds, g, S, E); } }
            __syncthreads();
        } } break;
    case 6: { pg8::Gemm g{(const pg8::bf16_t*)(ws + WS_UV), (const pg8::bf16_t*)(ws + WS_WOUT), TT, DM, DM}; pg8::StaticOrder S; S.init(TT, DM, F.G, (int)blockIdx.x);
        pg8::EpiResid<false> E{(pg8::bf16_t*)(ws + WS_XB), (float*)(ws + WS_ROWSQ), nullptr}; pg8::gemm_phase<pg8::EpiResid<false>, pg8::StaticOrder, true, true>(F.lds, g, S, E); } break;
    case 7: { pg8::Gemm g{(const pg8::bf16_t*)(ws + WS_XB), (const pg8::bf16_t*)(ws + WS_WGU), TT, 2 * DFF, DM}; pg8::StaticOrder S; S.init(TT, 2 * DFF, F.G, (int)blockIdx.x);
        pg8::EpiGU E{(pg8::bf16_t*)(ws + WS_HID), lrs}; pg8::prep_rstd(F.lds, S, rowsq); pg8::gemm_phase<pg8::EpiGU, pg8::StaticOrder, true, true>(F.lds, g, S, E); } break;
    case 8: { pg8::Gemm g{(const pg8::bf16_t*)(ws + WS_HID), (const pg8::bf16_t*)(ws + WS_WDN), TT, DM, DFF}; pg8::StaticOrder S; S.init(TT, DM, F.G, (int)blockIdx.x);
        if (l < DEPTH - 1) { pg8::EpiResid<false> E{(pg8::bf16_t*)(ws + WS_XB), (float*)(ws + WS_ROWSQ), nullptr}; pg8::gemm_phase<pg8::EpiResid<false>, pg8::StaticOrder, true, true>(F.lds, g, S, E); }
        else { pg8::EpiResid<true> E{(pg8::bf16_t*)(ws + WS_XB), (float*)(ws + WS_ROWSQ), P.out}; pg8::gemm_phase<pg8::EpiResid<true>, pg8::StaticOrder, true, true>(F.lds, g, S, E); } } break;
    }
}

__global__ void __launch_bounds__(NTHR, 2) hgpm_fwd(Params P) {
    extern __shared__ __attribute__((aligned(16))) unsigned char lds_raw[];
    Frame F; F.lds = (LAS unsigned char*)lds_raw; F.tid = threadIdx.x; F.lane = F.tid & 63; F.wave = __builtin_amdgcn_readfirstlane(F.tid >> 6);
    F.G = gridDim.x; { const int bx = blockIdx.x; F.vb = (F.G % 8 == 0) ? (bx % 8) * (F.G / 8) + bx / 8 : bx; }
#if USE_CG_SYNC
    cg::grid_group grid = cg::this_grid();
#define GRID_SYNC() grid.sync()
#else
    volatile LAS unsigned* misc = (volatile LAS unsigned*)(F.lds + MISC_OFF);
    if (F.tid < 64) misc[F.tid] = 0u;
    __syncthreads();
    const XcdBarrier bar = xcd_barrier_post((unsigned*)(P.ws + WS_CTL) + 1024, misc + 8);
#define GRID_SYNC() xcd_barrier(bar)
#endif
    for (int ph = P.ph_lo; ph < P.ph_hi; ++ph) {
        run_phase(F, P, ph);
#ifdef DUPK
#ifndef DUPSUB
#define DUPSUB 0
#endif
        if (ph % PH_PER_LAYER == DUPK && ph != N_PHASES - 1 && (DUPK != 6 || ph < PH_PER_LAYER)) { GRID_SYNC(); run_phase(F, P, ph, DUPSUB); }
        if (DUPK == 23 && ph % PH_PER_LAYER == 3) { GRID_SYNC(); run_phase(F, P, ph - 1, 0); GRID_SYNC(); run_phase(F, P, ph, 0); }
#endif
        if (ph + 1 < P.ph_hi) GRID_SYNC();
    }
}

#ifndef N_LAUNCH_MODE
#define N_LAUNCH_MODE 0
#endif
extern "C" void kernel_launch(void* const* d_in, const int* in_sizes, int n_in, void* d_out, int out_size, void* d_ws, size_t ws_size, hipStream_t stream) {
    static int grid = 0;
    if (grid == 0) {
        if (n_in != 19 || in_sizes[0] != TT * DM || out_size != TT * DM || ws_size < WS_END) { fprintf(stderr, "kernel_launch: unexpected shapes (n_in %d, in0 %d, out %d, ws %zu)\n", n_in, n_in > 0 ? in_sizes[0] : -1, out_size, ws_size); grid = -1; return; }
        int dev = 0, cus = 0, per_cu = 0;
        if (hipGetDevice(&dev) != hipSuccess || hipDeviceGetAttribute(&cus, hipDeviceAttributeMultiprocessorCount, dev) != hipSuccess) { grid = -1; return; }
        if (hipFuncSetAttribute((const void*)hgpm_fwd, hipFuncAttributeMaxDynamicSharedMemorySize, LDS_BYTES) != hipSuccess) { fprintf(stderr, "kernel_launch: hipFuncSetAttribute failed\n"); grid = -1; return; }
        if (hipOccupancyMaxActiveBlocksPerMultiprocessor(&per_cu, (const void*)hgpm_fwd, NTHR, LDS_BYTES) != hipSuccess || per_cu < 1) { fprintf(stderr, "kernel_launch: occupancy query says %d blocks per CU\n", per_cu); per_cu = 1; }
        (void)hipGetLastError();
        grid = cus;
    }
    if (grid < 0) return;
    Params p{};
    p.x = (const float*)d_in[0]; p.pos = (const int*)d_in[1]; p.attn_norm = (const float*)d_in[2]; p.w_in = (const float*)d_in[3]; p.sgu_ln_g = (const float*)d_in[4]; p.sgu_ln_b = (const float*)d_in[5];
    p.sgu_w = (const float*)d_in[6]; p.sgu_b = (const float*)d_in[7]; p.sinks = (const float*)d_in[8]; p.conv_w = (const float*)d_in[9]; p.a_log = (const float*)d_in[10]; p.dt_bias = (const float*)d_in[11];
    p.dn_norm = (const float*)d_in[12]; p.w_branch = (const float*)d_in[13]; p.w_out = (const float*)d_in[14]; p.ffn_norm = (const float*)d_in[15]; p.w_gate_up = (const float*)d_in[16]; p.w_down = (const float*)d_in[17];
    p.final_norm = (const float*)d_in[18]; p.out = (float*)d_out; p.ws = (unsigned char*)d_ws;
#if N_LAUNCH_MODE == 0
    p.ph_lo = 0; p.ph_hi = N_PHASES;
#if USE_CG_SYNC
    void* args[] = {&p};
    hipError_t e = hipLaunchCooperativeKernel((const void*)hgpm_fwd, dim3(grid), dim3(NTHR), args, LDS_BYTES, stream);
    if (e != hipSuccess) fprintf(stderr, "kernel_launch: cooperative launch failed: %s (grid %d)\n", hipGetErrorString(e), grid);
#else
    if (hipMemsetAsync((char*)d_ws + WS_CTL, 0, CTL_ZERO_BYTES, stream) != hipSuccess) { fprintf(stderr, "kernel_launch: hipMemsetAsync failed\n"); return; }
    hipLaunchKernelGGL(hgpm_fwd, dim3(grid), dim3(NTHR), LDS_BYTES, stream, p);
#endif
#else
    for (int ph = 0; ph < N_PHASES; ++ph) { p.ph_lo = ph; p.ph_hi = ph + 1; hipLaunchKernelGGL(hgpm_fwd, dim3(grid), dim3(NTHR), LDS_BYTES, stream, p); }
#endif
}
```

```cpp
#include <hip/hip_runtime.h>
#include <hip/hip_cooperative_groups.h>
#include <cstdio>
#include <cstdint>
namespace cg = cooperative_groups;
namespace pg8 {
#define PG8_LAS __attribute__((address_space(3)))
typedef unsigned short bf16_t;
typedef short bf16x8 __attribute__((ext_vector_type(8)));
typedef float f32x4 __attribute__((ext_vector_type(4)));
typedef unsigned u32x4 __attribute__((ext_vector_type(4)));
constexpr int BM = 256, BK = 64, HALF = 128, HTB = HALF * BK * 2  , STAGE_BYTES = 8 * HTB, NXCD = 8, WGM = 8;

__host__ __device__ __forceinline__ int lds_byte(int r, int c) { const int st = (r >> 4) * 2 + (c >> 5), rr = r & 15, cc = c & 31, ob = rr * 64 + cc * 2; return st * 1024 + (ob ^ (((ob >> 9) & 1) << 5)); }
__host__ __device__ __forceinline__ void stage_rc(int b, int& R, int& C) { const int st = b / 1024, sb = b % 1024, swz = sb ^ (((sb >> 9) & 1) << 5); R = (st >> 1) * 16 + swz / 64; C = (st & 1) * 32 + (swz % 64) / 2; }
__host__ __device__ __forceinline__ int perm32(int rho) { const int n = rho >> 4, i = rho & 15; return 8 * (i >> 2) + 4 * n + (i & 3); }

struct Unit { int pm, pn, idx; };
struct Gemm { const bf16_t* A; const bf16_t* Bt; int M, N, K; };

struct StaticOrder {
    int nM, nN, nwg, G, c;
    __host__ __device__ void init(int M, int N, int G_, int c_) { nM = M / BM; nN = N / BM; nwg = nM * nN; G = G_; c = c_; }
    __host__ __device__ bool next(int i, Unit& u) const {
        const long L = (long)i * G + c; if (L >= nwg) return false;
        int wgid = (int)L; { const int q = nwg / NXCD, r = nwg % NXCD, xcd = wgid % NXCD, off = wgid / NXCD; wgid = (xcd < r ? xcd * (q + 1) : r * (q + 1) + (xcd - r) * q) + off; }
        const int nig = WGM * nN, gid = wgid / nig, fm = gid * WGM, gsz = (nM - fm) < WGM ? (nM - fm) : WGM;
        u.pm = fm + ((wgid % nig) % gsz); u.pn = (wgid % nig) / gsz; u.idx = i; return true;
    }
    __device__ __forceinline__ void a_ready(const Unit&) const {}
    __device__ __forceinline__ void done(const Unit&) const {}
};

typedef float f32x2 __attribute__((ext_vector_type(2)));
typedef __bf16 bf16v2 __attribute__((ext_vector_type(2)));
typedef unsigned u32x2 __attribute__((ext_vector_type(2)));
__device__ __forceinline__ unsigned pk2(float lo, float hi) { f32x2 v = {lo, hi}; bf16v2 r = __builtin_convertvector(v, bf16v2); return __builtin_bit_cast(unsigned, r); }
__device__ __forceinline__ float bflo(unsigned w) { return __uint_as_float(w << 16); }
__device__ __forceinline__ float bfhi(unsigned w) { return __uint_as_float(w & 0xffff0000u); }
__device__ __forceinline__ float fast_sigmoid(float x) { return __builtin_amdgcn_rcpf(1.0f + __expf(-x)); }
__device__ __forceinline__ float gelu_tanh(float x) { const float u = 1.5957691216f * (x + 0.044715f * x * x * x); return x * fast_sigmoid(u); }
constexpr float NORM_EPS = 1e-6f;
__device__ __forceinline__ float row_rstd(const float* rowsq, int row) {
    const f32x4* p = (const f32x4*)(rowsq + (size_t)row * 16); const f32x4 a = p[0], b = p[1], c = p[2], d = p[3];
    const float s = ((a.x + a.y) + (a.z + a.w)) + ((b.x + b.y) + (b.z + b.w)) + ((c.x + c.y) + (c.z + c.w)) + ((d.x + d.y) + (d.z + d.w));
    return __builtin_amdgcn_rsqf(s * (1.0f / 1024.0f) + NORM_EPS);
}
constexpr int LRS_OFF = STAGE_BYTES, LRS_MAX_UNITS = 8;
template <class Sched> __device__ __forceinline__ void prep_rstd(PG8_LAS unsigned char* lds, const Sched& S, const float* rowsq) {
    PG8_LAS float* t = (PG8_LAS float*)(lds + LRS_OFF); Unit u;
#pragma unroll 1
    for (int i = 0; i < LRS_MAX_UNITS; ++i) { if (!S.next(i, u)) break; if (threadIdx.x < 256) t[i * 256 + threadIdx.x] = row_rstd(rowsq, u.pm * BM + threadIdx.x); asm volatile("" ::: "memory"); }
    __syncthreads();
}
struct EpiProj {
    static constexpr bool PERM = true, AFTER_DRAIN = false;
    bf16_t *uv, *qkvb, *qkvc, *z; const PG8_LAS float* lrs; float* ba;
    __device__ __forceinline__ void operator()(const f32x4 (&acc)[2][2][4][2], const Unit& u, int wr, int wc, int fr, int fq) const {
        const int pn = u.pn; bf16_t* base; int ldc, colt; bool act = false;
        if (pn == 15) {
            if (wc == 0 && fq == 0) {
#pragma unroll
                for (int ai = 0; ai < 2; ++ai)
#pragma unroll
                    for (int m = 0; m < 4; ++m) { const int rl = wr * 64 + fr + ai * HALF + m * 16; const float rs = lrs[u.idx * 256 + rl]; float* bp = ba + (size_t)(u.pm * BM + rl) * 8;
                        *(f32x4*)bp = acc[ai][0][m][0] * rs; *(f32x4*)(bp + 4) = acc[ai][0][m][1] * rs; } }
            return; }
        if (pn < 4) { base = uv; ldc = 1024; colt = pn * 256; act = true; }
        else if (pn < 7) { base = qkvb; ldc = 768; colt = (pn - 4) * 256; }
        else if (pn < 13) { base = qkvc; ldc = 1536; colt = (pn - 7) * 256; }
        else { base = z; ldc = 512; colt = (pn - 13) * 256; }
        const int row0 = u.pm * BM + wr * 64 + fr, col0 = colt + wc * 32 + 8 * fq;
#pragma unroll
        for (int ai = 0; ai < 2; ++ai)
#pragma unroll
            for (int m = 0; m < 4; ++m) { const int row = row0 + ai * HALF + m * 16; const float rs = lrs[u.idx * 256 + (row - u.pm * BM)]; bf16_t* rowp = base + (size_t)row * ldc + col0;
#pragma unroll
                for (int bj = 0; bj < 2; ++bj) { f32x4 v0 = acc[ai][bj][m][0] * rs, v1 = acc[ai][bj][m][1] * rs;
                    if (act) {
#pragma unroll
                        for (int j = 0; j < 4; ++j) { v0[j] = gelu_tanh(v0[j]); v1[j] = gelu_tanh(v1[j]); } }
                    u32x4 w; w.x = pk2(v0[0], v0[1]); w.y = pk2(v0[2], v0[3]); w.z = pk2(v1[0], v1[1]); w.w = pk2(v1[2], v1[3]);
                    *(u32x4*)(rowp + bj * HALF) = w; } }
    }
};
struct EpiSig {
    static constexpr bool PERM = true, AFTER_DRAIN = false;
    bf16_t* sig; const PG8_LAS float* lrs;
    __device__ __forceinline__ void operator()(const f32x4 (&acc)[2][2][4][2], const Unit& u, int wr, int wc, int fr, int fq) const {
        const int row0 = u.pm * BM + wr * 64 + fr, col0 = u.pn * BM + wc * 32 + 8 * fq;
#pragma unroll
        for (int ai = 0; ai < 2; ++ai)
#pragma unroll
            for (int m = 0; m < 4; ++m) { const int row = row0 + ai * HALF + m * 16; const float rs = lrs[u.idx * 256 + (row - u.pm * BM)]; bf16_t* rowp = sig + (size_t)row * 1024 + col0;
#pragma unroll
                for (int bj = 0; bj < 2; ++bj) { f32x4 v0 = acc[ai][bj][m][0] * rs, v1 = acc[ai][bj][m][1] * rs;
#pragma unroll
                    for (int j = 0; j < 4; ++j) { v0[j] = fast_sigmoid(v0[j]); v1[j] = fast_sigmoid(v1[j]); }
                    u32x4 w; w.x = pk2(v0[0], v0[1]); w.y = pk2(v0[2], v0[3]); w.z = pk2(v1[0], v1[1]); w.w = pk2(v1[2], v1[3]);
                    *(u32x4*)(rowp + bj * HALF) = w; } }
    }
};
template <bool ACCUM> struct EpiMerge {
    static constexpr bool PERM = true, AFTER_DRAIN = false;
    const bf16_t* sig; bf16_t* mg;
    __device__ __forceinline__ void operator()(const f32x4 (&acc)[2][2][4][2], const Unit& u, int wr, int wc, int fr, int fq) const {
        const int row0 = u.pm * BM + wr * 64 + fr, col0 = u.pn * BM + wc * 32 + 8 * fq;
#pragma unroll
        for (int ai = 0; ai < 2; ++ai)
#pragma unroll
            for (int m = 0; m < 4; ++m) { const size_t off = (size_t)(row0 + ai * HALF + m * 16) * 1024 + col0;
#pragma unroll
                for (int bj = 0; bj < 2; ++bj) { const u32x4 s = *(const u32x4*)(sig + off + bj * HALF);
                    f32x4 v0 = acc[ai][bj][m][0], v1 = acc[ai][bj][m][1];
                    v0[0] *= bflo(s.x); v0[1] *= bfhi(s.x); v0[2] *= bflo(s.y); v0[3] *= bfhi(s.y); v1[0] *= bflo(s.z); v1[1] *= bfhi(s.z); v1[2] *= bflo(s.w); v1[3] *= bfhi(s.w);
                    if (ACCUM) { const u32x4 o = *(const u32x4*)(mg + off + bj * HALF);
                        v0[0] += bflo(o.x); v0[1] += bfhi(o.x); v0[2] += bflo(o.y); v0[3] += bfhi(o.y); v1[0] += bflo(o.z); v1[1] += bfhi(o.z); v1[2] += bflo(o.w); v1[3] += bfhi(o.w); }
                    u32x4 w; w.x = pk2(v0[0], v0[1]); w.y = pk2(v0[2], v0[3]); w.z = pk2(v1[0], v1[1]); w.w = pk2(v1[2], v1[3]); *(u32x4*)(mg + off + bj * HALF) = w; } }
    }
};
template <bool F32OUT> struct EpiResid {
    static constexpr bool PERM = true, AFTER_DRAIN = false;
    bf16_t* xb; float* rowsq; float* xout;
    __device__ __forceinline__ void operator()(const f32x4 (&acc)[2][2][4][2], const Unit& u, int wr, int wc, int fr, int fq) const {
        const int row0 = u.pm * BM + wr * 64 + fr, col0 = u.pn * BM + wc * 32 + 8 * fq;
#pragma unroll
        for (int ai = 0; ai < 2; ++ai)
#pragma unroll
            for (int m = 0; m < 4; ++m) { const int row = row0 + ai * HALF + m * 16; const size_t off = (size_t)row * 1024 + col0; float ss = 0.f;
#pragma unroll
                for (int bj = 0; bj < 2; ++bj) { const u32x4 xo = *(const u32x4*)(xb + off + bj * HALF);
                    f32x4 v0 = acc[ai][bj][m][0], v1 = acc[ai][bj][m][1];
                    v0[0] += bflo(xo.x); v0[1] += bfhi(xo.x); v0[2] += bflo(xo.y); v0[3] += bfhi(xo.y); v1[0] += bflo(xo.z); v1[1] += bfhi(xo.z); v1[2] += bflo(xo.w); v1[3] += bfhi(xo.w);
                    if (F32OUT) { *(f32x4*)(xout + off + bj * HALF) = v0; *(f32x4*)(xout + off + bj * HALF + 4) = v1; }
                    else { u32x4 w; w.x = pk2(v0[0], v0[1]); w.y = pk2(v0[2], v0[3]); w.z = pk2(v1[0], v1[1]); w.w = pk2(v1[2], v1[3]); *(u32x4*)(xb + off + bj * HALF) = w; }
                    ss += ((v0[0] * v0[0] + v0[1] * v0[1]) + (v0[2] * v0[2] + v0[3] * v0[3])) + ((v1[0] * v1[0] + v1[1] * v1[1]) + (v1[2] * v1[2] + v1[3] * v1[3])); }
                ss += __shfl_xor(ss, 16); ss += __shfl_xor(ss, 32);
                if (fq == 0) rowsq[(size_t)row * 16 + u.pn * 4 + wc] = ss; }
    }
};
struct EpiGU {
    static constexpr bool PERM = true, AFTER_DRAIN = false;
    bf16_t* hid; const PG8_LAS float* lrs;
    __device__ __forceinline__ void operator()(const f32x4 (&acc)[2][2][4][2], const Unit& u, int wr, int wc, int fr, int fq) const {
        const int row0 = u.pm * BM + wr * 64 + fr, col0 = u.pn * HALF + wc * 32 + 8 * fq;
#pragma unroll
        for (int ai = 0; ai < 2; ++ai)
#pragma unroll
            for (int m = 0; m < 4; ++m) { const int row = row0 + ai * HALF + m * 16; const float rs = lrs[u.idx * 256 + (row - u.pm * BM)];
                float o[8];
#pragma unroll
                for (int n = 0; n < 2; ++n)
#pragma unroll
                    for (int j = 0; j < 4; ++j) { const float g = acc[ai][0][m][n][j] * rs, up = acc[ai][1][m][n][j] * rs; o[n * 4 + j] = g * fast_sigmoid(g) * up; }
                u32x4 w; w.x = pk2(o[0], o[1]); w.y = pk2(o[2], o[3]); w.z = pk2(o[4], o[5]); w.w = pk2(o[6], o[7]);
                *(u32x4*)(hid + (size_t)row * 2816 + col0) = w; }
    }
};

template <class Epi, class Sched, bool ALIGN_EPI = false, bool SP2 = false>
__device__ __forceinline__ void gemm_phase(PG8_LAS unsigned char* lds, const Gemm g, const Sched& S, const Epi& E) {
    int tid_ = threadIdx.x; asm volatile("" : "+v"(tid_));
    const int tid = tid_, wid = __builtin_amdgcn_readfirstlane(tid >> 6), lane = tid & 63, wr = wid >> 2, wc = wid & 3, fr = lane & 15, fq = lane >> 4;
    const int K = g.K, nt = K / BK;
    unsigned voffA[2], voffB[2];
#pragma unroll
    for (int i = 0; i < 2; ++i) { int R, C; stage_rc(tid * 16 + i * 8192, R, C); const int Rb = Epi::PERM ? ((R & ~31) + perm32(R & 31)) : R;
        voffA[i] = (unsigned)(R * K + C) * 2u; voffB[i] = (unsigned)(Rb * K + C) * 2u; }
    const size_t kstep = (size_t)(BK * 2);
    const size_t hstep = (size_t)HALF * K * 2;
    const size_t tstep = 2 * hstep;
    const unsigned ldsw = (unsigned)wid * 1024u;
    const int aoff = lds_byte(wr * 64 + fr, fq * 8), boff = lds_byte(wc * 32 + fr, fq * 8);
#define PG8_SA(b, h) (((b) * 2 + (h)) * HTB)
#define PG8_SB(b, h) ((4 + (b) * 2 + (h)) * HTB)
#define PG8_STAGE(bufoff, gbase, voff) do { _Pragma("unroll") for (int _i = 0; _i < 2; ++_i) \
        __builtin_amdgcn_global_load_lds((const unsigned*)((const char*)(gbase) + (voff)[_i]), (PG8_LAS unsigned*)(lds + (bufoff) + ldsw + _i * 8192), 16, 0, 0); } while (0)
#define PG8_LDA(dst, b, h) do { _Pragma("unroll") for (int m = 0; m < 4; ++m) _Pragma("unroll") for (int k = 0; k < 2; ++k) dst[m][k] = *(const PG8_LAS bf16x8*)(lds + PG8_SA(b, h) + aoff + m * 2048 + k * 1024); } while (0)
#define PG8_LDB(dst, b, h) do { _Pragma("unroll") for (int n = 0; n < 2; ++n) _Pragma("unroll") for (int k = 0; k < 2; ++k) dst[n][k] = *(const PG8_LAS bf16x8*)(lds + PG8_SB(b, h) + boff + n * 2048 + k * 1024); } while (0)
#define PG8_MMA(ai, bj, At, Bt) do { __builtin_amdgcn_s_setprio(1); _Pragma("unroll") for (int m = 0; m < 4; ++m) _Pragma("unroll") for (int n = 0; n < 2; ++n) _Pragma("unroll") for (int k = 0; k < 2; ++k) \
        acc[ai][bj][m][n] = __builtin_amdgcn_mfma_f32_16x16x32_bf16(Bt[n][k], At[m][k], acc[ai][bj][m][n], 0, 0, 0); __builtin_amdgcn_s_setprio(0); } while (0)
#define PG8_WAIT_V(n) asm volatile("s_waitcnt vmcnt(" #n ")" ::: "memory")
#define PG8_WAIT_L(n) asm volatile("s_waitcnt lgkmcnt(" #n ")" ::: "memory")
#define PG8_BAR __builtin_amdgcn_s_barrier()
#define PG8_SCHED __builtin_amdgcn_sched_barrier(0)
    Unit cur, nxt; int ui = 0;
    if (!S.next(0, cur)) return;
    f32x4 acc[2][2][4][2];
#pragma unroll
    for (int a = 0; a < 2; ++a)
#pragma unroll
        for (int b = 0; b < 2; ++b)
#pragma unroll
            for (int m = 0; m < 4; ++m)
#pragma unroll
                for (int n = 0; n < 2; ++n) acc[a][b][m][n] = (f32x4){0.f, 0.f, 0.f, 0.f};
    bf16x8 At[4][2], B0[2][2], B1[2][2];
    const char* cA = (const char*)g.A + (size_t)cur.pm * tstep; const char* cB = (const char*)g.Bt + (size_t)cur.pn * tstep;
    S.a_ready(cur);
    if constexpr (SP2) {
        PG8_STAGE(PG8_SB(0, 0), cB, voffB); PG8_STAGE(PG8_SB(0, 1), cB + hstep, voffB); PG8_STAGE(PG8_SA(0, 0), cA, voffA); PG8_STAGE(PG8_SA(0, 1), cA + hstep, voffA);
        if (wr == 1) PG8_BAR;
        PG8_WAIT_V(2); PG8_BAR;
        PG8_STAGE(PG8_SB(1, 0), cB + kstep, voffB); PG8_STAGE(PG8_SA(1, 0), cA + kstep, voffA); PG8_STAGE(PG8_SB(1, 1), cB + hstep + kstep, voffB);
        PG8_WAIT_V(6); PG8_BAR;
    } else {
        PG8_STAGE(PG8_SB(0, 0), cB, voffB); PG8_STAGE(PG8_SA(0, 0), cA, voffA); PG8_STAGE(PG8_SB(0, 1), cB + hstep, voffB); PG8_STAGE(PG8_SA(0, 1), cA + hstep, voffA);
        if (wr == 1) PG8_BAR;
        PG8_WAIT_V(4); PG8_BAR;
        PG8_STAGE(PG8_SB(1, 0), cB + kstep, voffB); PG8_STAGE(PG8_SA(1, 0), cA + kstep, voffA); PG8_STAGE(PG8_SB(1, 1), cB + hstep + kstep, voffB);
        PG8_WAIT_V(6); PG8_BAR;
    }
    for (;;) {
        const bool has_next = S.next(ui + 1, nxt);
        const char* nA = has_next ? (const char*)g.A + (size_t)nxt.pm * tstep : cA; const char* nB = has_next ? (const char*)g.Bt + (size_t)nxt.pn * tstep : cB;
        for (int t = 0; t < nt; t += 2) {
            const bool last = (t == nt - 2);
            const char* a1 = cA + (size_t)(t + 1) * kstep;
            const char* a2 = last ? nA : cA + (size_t)(t + 2) * kstep; const char* b2 = last ? nB : cB + (size_t)(t + 2) * kstep;
            const char* a3 = a2 + kstep; const char* b3 = b2 + kstep;
            if (last && has_next) S.a_ready(nxt);
            if constexpr (SP2) {
            PG8_LDB(B0, 0, 0); PG8_LDB(B1, 0, 1); PG8_SCHED; PG8_LDA(At, 0, 0); PG8_STAGE(PG8_SA(1, 1), a1 + hstep, voffA);
            PG8_WAIT_V(8); PG8_WAIT_L(0); PG8_BAR; PG8_MMA(0, 0, At, B0); PG8_MMA(0, 1, At, B1); PG8_BAR; PG8_SCHED;
            PG8_LDA(At, 0, 1); PG8_STAGE(PG8_SB(0, 0), b2, voffB); PG8_STAGE(PG8_SB(0, 1), b2 + hstep, voffB); PG8_STAGE(PG8_SA(0, 0), a2, voffA);
            PG8_WAIT_V(8); PG8_WAIT_L(0); PG8_BAR; PG8_MMA(1, 0, At, B0); PG8_MMA(1, 1, At, B1); PG8_BAR; PG8_SCHED;
            PG8_LDB(B0, 1, 0); PG8_LDB(B1, 1, 1); PG8_SCHED; PG8_LDA(At, 1, 0); PG8_STAGE(PG8_SA(0, 1), a2 + hstep, voffA);
            PG8_WAIT_V(8); PG8_WAIT_L(0); PG8_BAR; PG8_MMA(0, 0, At, B0); PG8_MMA(0, 1, At, B1); PG8_BAR; PG8_SCHED;
            PG8_LDA(At, 1, 1); PG8_STAGE(PG8_SB(1, 0), b3, voffB); PG8_STAGE(PG8_SB(1, 1), b3 + hstep, voffB); PG8_STAGE(PG8_SA(1, 0), a3, voffA);
            PG8_WAIT_V(8); PG8_WAIT_L(0); PG8_BAR; PG8_MMA(1, 0, At, B0); PG8_MMA(1, 1, At, B1); PG8_BAR; PG8_SCHED;
            } else {
            PG8_LDB(B0, 0, 0); PG8_SCHED; PG8_LDA(At, 0, 0); PG8_STAGE(PG8_SA(1, 1), a1 + hstep, voffA);
            PG8_WAIT_L(8); PG8_BAR; PG8_WAIT_L(0); PG8_MMA(0, 0, At, B0); PG8_BAR; PG8_SCHED;
            PG8_LDB(B1, 0, 1); PG8_STAGE(PG8_SB(0, 0), b2, voffB);
            PG8_BAR; PG8_WAIT_L(0); PG8_MMA(0, 1, At, B1); PG8_BAR;
            PG8_LDA(At, 0, 1); PG8_STAGE(PG8_SA(0, 0), a2, voffA);
            PG8_BAR; PG8_WAIT_L(0); PG8_MMA(1, 0, At, B0); PG8_BAR; PG8_SCHED;
            PG8_STAGE(PG8_SB(0, 1), b2 + hstep, voffB);
            PG8_WAIT_V(6); PG8_BAR; PG8_MMA(1, 1, At, B1); PG8_BAR;
            PG8_LDB(B0, 1, 0); PG8_SCHED; PG8_LDA(At, 1, 0); PG8_STAGE(PG8_SA(0, 1), a2 + hstep, voffA);
            PG8_WAIT_L(8); PG8_BAR; PG8_WAIT_L(0); PG8_MMA(0, 0, At, B0); PG8_BAR; PG8_SCHED;
            PG8_LDB(B1, 1, 1); PG8_STAGE(PG8_SB(1, 0), b3, voffB);
            PG8_BAR; PG8_WAIT_L(0); PG8_MMA(0, 1, At, B1); PG8_BAR;
            PG8_LDA(At, 1, 1); PG8_STAGE(PG8_SA(1, 0), a3, voffA);
            PG8_BAR; PG8_WAIT_L(0); PG8_MMA(1, 0, At, B0); PG8_BAR; PG8_SCHED;
            PG8_STAGE(PG8_SB(1, 1), b3 + hstep, voffB);
            PG8_WAIT_V(6); PG8_BAR; PG8_MMA(1, 1, At, B1); PG8_BAR;
            }
        }
        if constexpr (ALIGN_EPI) { if (wr == 0) PG8_BAR; }
        if constexpr (!Epi::AFTER_DRAIN) { E(acc, cur, wr, wc, fr, fq); S.done(cur); }
        if (!has_next) break;
#pragma unroll
        for (int a = 0; a < 2; ++a)
#pragma unroll
            for (int b = 0; b < 2; ++b)
#pragma unroll
                for (int m = 0; m < 4; ++m)
#pragma unroll
                    for (int n = 0; n < 2; ++n) acc[a][b][m][n] = (f32x4){0.f, 0.f, 0.f, 0.f};
        cur = nxt; cA = nA; cB = nB; ++ui;
        if constexpr (ALIGN_EPI) { if (wr == 1) PG8_BAR; }
    }
    PG8_WAIT_V(0);
    if constexpr (!ALIGN_EPI) { if (wr == 0) PG8_BAR; }
    PG8_BAR;
    if constexpr (Epi::AFTER_DRAIN) { E.fused(acc, cur, wr, wc, fr, fq, lds, wid, lane); S.done(cur); }
#undef PG8_SA
#undef PG8_SB
#undef PG8_STAGE
#undef PG8_LDA
#undef PG8_LDB
#undef PG8_MMA
#undef PG8_WAIT_V
#undef PG8_WAIT_L
#undef PG8_BAR
#undef PG8_SCHED
}
}

#ifndef USE_CG_SYNC
#define USE_CG_SYNC 0
#endif
constexpr int NWAVES = 8, NTHR = 512;
constexpr int TT = 16384, SEQ = 8192, DM = 1024, DEPTH = 2, INC = 6920, DFF = 2816;
constexpr int C_QKVC = 1792, C_BETA = 3840, C_GATE = 3848;
constexpr int NMIX = 3840, NMIXP = 4096;
constexpr size_t MiB = 1u << 20, KiB = 1u << 10;
constexpr size_t WS_CTL = 0, CTL_ZERO_BYTES = 64 * KiB;
constexpr size_t WS_ROWSQ = 1 * MiB;
constexpr size_t WS_BA = 2 * MiB;
constexpr size_t WS_CD = 2 * MiB + 512 * KiB;
constexpr size_t WS_WBA = WS_CD + 64 * KiB;
constexpr size_t WS_SGUW = 2 * MiB + 768 * KiB;
constexpr size_t WS_WIN = 3 * MiB;
constexpr size_t WS_WG = WS_WIN + 4096 * 1024 * 2;
constexpr size_t WS_WBR = WS_WG + 3072 * 1024 * 2;
constexpr size_t WS_WOUT = WS_WBR + 3 * 1024 * 512 * 2;
constexpr size_t WS_XB = 22 * MiB;
constexpr size_t WS_UV = 54 * MiB;
constexpr size_t WS_QKVB = 86 * MiB;
constexpr size_t WS_WGU = WS_QKVB;
constexpr size_t WS_WDN = WS_QKVB + 5632 * 1024 * 2;
constexpr size_t WS_QKVC = 110 * MiB;
constexpr size_t WS_BR = WS_QKVC;
constexpr size_t WS_Z = 158 * MiB;
constexpr size_t WS_DN = 174 * MiB;
constexpr size_t WS_HID = 110 * MiB;
constexpr size_t WS_END = 246 * MiB;
static_assert(WS_WOUT + 1024 * 1024 * 2 <= WS_XB && WS_WDN + 1024 * 2816 * 2 <= WS_QKVC && WS_HID + (size_t)TT * DFF * 2 <= WS_END && WS_DN + 1024 * 72 * KiB <= WS_END, "ws map");
constexpr int DN_TASK_BYTES = 73728, DN_OFF_W = 0, DN_OFF_QD = 16384, DN_OFF_AT = 32768, DN_OFF_KD = 40960, DN_OFF_U = 57344;
constexpr int LDS_BYTES = 163840, MISC_OFF = LDS_BYTES - 256;

#define LAS __attribute__((address_space(3)))
typedef unsigned short bf16;
typedef float f32x4 __attribute__((ext_vector_type(4)));
typedef float f32x16 __attribute__((ext_vector_type(16)));
typedef short bf16x8 __attribute__((ext_vector_type(8)));
typedef unsigned u32x4 __attribute__((ext_vector_type(4)));
typedef unsigned u32x2 __attribute__((ext_vector_type(2)));
using pg8::pk2; using pg8::bflo; using pg8::bfhi; using pg8::fast_sigmoid; using pg8::NORM_EPS;
#define MFMA32(a, b, c) __builtin_amdgcn_mfma_f32_32x32x16_bf16((a), (b), (c), 0, 0, 0)
__device__ __forceinline__ int crow(int reg, int h) { return (reg & 3) + 8 * (reg >> 2) + 4 * h; }
__device__ __forceinline__ bf16x8 pack_step(const f32x16& x, int s) {
    u32x4 p; p.x = pk2(x[8 * s], x[8 * s + 1]); p.y = pk2(x[8 * s + 2], x[8 * s + 3]); p.z = pk2(x[8 * s + 4], x[8 * s + 5]); p.w = pk2(x[8 * s + 6], x[8 * s + 7]);
    return __builtin_bit_cast(bf16x8, p);
}
__device__ __forceinline__ float wave_sum(float v) {
#pragma unroll
    for (int o = 1; o < 64; o <<= 1) v += __shfl_xor(v, o);
    return v;
}
__device__ __forceinline__ f32x16 zero16() { f32x16 z; for (int i = 0; i < 16; ++i) z[i] = 0.f; return z; }

struct Params {
    const float* x; const int* pos; const float* attn_norm; const float* w_in; const float* sgu_ln_g; const float* sgu_ln_b; const float* sgu_w; const float* sgu_b;
    const float* sinks; const float* conv_w; const float* a_log; const float* dt_bias; const float* dn_norm; const float* w_branch; const float* w_out; const float* ffn_norm;
    const float* w_gate_up; const float* w_down; const float* final_norm;
    float* out; unsigned char* ws; int ph_lo, ph_hi;
};
struct Frame { LAS unsigned char* lds; int tid, lane, wave, vb, G; };

constexpr int TR_SCR = 64 * 68 * 4;
template <int MAP> __device__ __forceinline__ void transpose_item(const float* W, int ldw, int ncol0, int K, int N, const float* kscale, bf16* WT, LAS float* scr, int item, int lane) {
    const int nblk = N / 64, kb = item / nblk, nb = item % nblk, k0 = 64 * kb, n0 = 64 * nb, r4 = lane >> 4, c4 = lane & 15;
    f32x4 v[16];
#pragma unroll
    for (int i = 0; i < 16; ++i) v[i] = *(const f32x4*)(W + (size_t)(k0 + 4 * i + r4) * ldw + ncol0 + n0 + 4 * c4);
    if (kscale) {
#pragma unroll
        for (int i = 0; i < 16; ++i) v[i] = v[i] * kscale[k0 + 4 * i + r4]; }
#pragma unroll
    for (int i = 0; i < 16; ++i) { const int r = 4 * i + r4; *(LAS f32x4*)(scr + r * 68 + ((4 * c4 + 4 * (r >> 3)) & 63)) = v[i]; }
    asm volatile("s_waitcnt lgkmcnt(0)" ::: "memory");
    const int kc = lane & 7, nn = lane >> 3;
#pragma unroll
    for (int j = 0; j < 8; ++j) { const int n = nn + 8 * j; const LAS float* sp = scr + (8 * kc) * 68 + ((n + 4 * kc) & 63);
        u32x4 o; o.x = pk2(sp[0 * 68], sp[1 * 68]); o.y = pk2(sp[2 * 68], sp[3 * 68]); o.z = pk2(sp[4 * 68], sp[5 * 68]); o.w = pk2(sp[6 * 68], sp[7 * 68]);
        const int gn = n0 + n; int dr = gn;
        if (MAP == 1) { const int f = gn < DFF ? gn : gn - DFF; dr = (f >> 7) * 256 + (gn < DFF ? 0 : 128) + (f & 127); }
        *(u32x4*)(WT + (size_t)dr * K + k0 + 8 * kc) = o; }
    asm volatile("s_waitcnt lgkmcnt(0)" ::: "memory");
}
__device__ __forceinline__ void p0_attn_weights(const Frame& F, const Params& P, int l) {
    LAS float* scr = (LAS float*)(F.lds + F.wave * TR_SCR);
    const int gw = F.vb * NWAVES + F.wave, NGW = F.G * NWAVES;
    const float* win = P.w_in + (size_t)l * DM * INC; const float* an = P.attn_norm + l * DM;
    constexpr int I_MIX = 16 * (NMIX / 64), I_G = 16 * (3072 / 64), I_BR = 8 * 16, I_O = 16 * 16, NIT = I_MIX + I_G + 3 * I_BR + I_O;
#pragma unroll 1
    for (int it = gw; it < NIT; it += NGW) {
        int r = it;
        if (r < I_MIX) { transpose_item<0>(win, INC, 0, DM, NMIX, an, (bf16*)(P.ws + WS_WIN), scr, r, F.lane); continue; } r -= I_MIX;
        if (r < I_G) { transpose_item<0>(win, INC, C_GATE, DM, 3072, an, (bf16*)(P.ws + WS_WG), scr, r, F.lane); continue; } r -= I_G;
        if (r < 3 * I_BR) { const int n = r / I_BR; transpose_item<0>(P.w_branch + ((size_t)l * 3 + n) * 512 * 1024, 1024, 0, 512, 1024, nullptr, (bf16*)(P.ws + WS_WBR) + (size_t)n * 1024 * 512, scr, r % I_BR, F.lane); continue; } r -= 3 * I_BR;
        transpose_item<0>(P.w_out + (size_t)l * DM * DM, DM, 0, DM, DM, nullptr, (bf16*)(P.ws + WS_WOUT), scr, r, F.lane);
    }
    const int gt = F.vb * NTHR + F.tid, NGT = F.G * NTHR;
    bf16* wpad = (bf16*)(P.ws + WS_WIN) + (size_t)NMIX * DM;
    for (int i = gt; i < 8 * DM; i += NGT) { const int c = i >> 10, k = i & 1023; wpad[i] = (bf16)(pk2(win[(size_t)k * INC + C_BETA + c] * an[k], 0.f) & 0xffffu); }
    for (int i = gt; i < 248 * DM / 8; i += NGT) ((u32x4*)(wpad + 8 * DM))[i] = (u32x4){0u, 0u, 0u, 0u};
    bf16* sw = (bf16*)(P.ws + WS_SGUW); const float* sgw = P.sgu_w + (size_t)l * 4 * 128 * 128;
    for (int i = gt; i < 4 * 128 * 128 / 2; i += NGT) { const int e = 2 * i, s = e & 127, t = (e >> 7) & 127; const float a = s <= t ? sgw[e] : 0.f, b = (s + 1) <= t ? sgw[e + 1] : 0.f; ((unsigned*)sw)[i] = pk2(a, b); }
}
__device__ __forceinline__ void p0_ffn_weights(const Frame& F, const Params& P, int l) {
    LAS float* scr = (LAS float*)(F.lds + F.wave * TR_SCR);
    const int gw = F.vb * NWAVES + F.wave, NGW = F.G * NWAVES;
    constexpr int I_GU = 16 * (2 * DFF / 64), I_DN = (DFF / 64) * 16, NIT = I_GU + I_DN;
#pragma unroll 1
    for (int it = gw; it < NIT; it += NGW) {
        if (it < I_GU) transpose_item<1>(P.w_gate_up + (size_t)l * DM * 2 * DFF, 2 * DFF, 0, DM, 2 * DFF, P.ffn_norm + l * DM, (bf16*)(P.ws + WS_WGU), scr, it, F.lane);
        else transpose_item<0>(P.w_down + (size_t)l * DFF * DM, DM, 0, DFF, DM, nullptr, (bf16*)(P.ws + WS_WDN), scr, it - I_GU, F.lane);
    }
}
__device__ __forceinline__ void p0_input(const Frame& F, const Params& P) {
    const int gw = F.vb * NWAVES + F.wave, NGW = F.G * NWAVES;
    bf16* xb = (bf16*)(P.ws + WS_XB); float* rowsq = (float*)(P.ws + WS_ROWSQ);
    for (int m = gw; m < TT; m += NGW) {
        const f32x4* xr = (const f32x4*)(P.x + (size_t)m * DM) + F.lane; float s = 0.f;
        unsigned long long* o8 = (unsigned long long*)(xb + (size_t)m * DM) + F.lane;
#pragma unroll
        for (int j = 0; j < 4; ++j) { const f32x4 v = xr[64 * j]; s += (v.x * v.x + v.y * v.y) + (v.z * v.z + v.w * v.w); o8[64 * j] = (unsigned long long)pk2(v.x, v.y) | ((unsigned long long)pk2(v.z, v.w) << 32); }
        s = wave_sum(s);
        if (F.lane < 16) rowsq[(size_t)m * 16 + F.lane] = F.lane == 0 ? s : 0.f;
    }
}
__device__ __forceinline__ void sgu_task(const Frame& F, const Params& P, int l, int task) {
    const int g = task & 3, cb = task >> 2, m0 = cb * 128;
    const bf16* uv = (const bf16*)(P.ws + WS_UV); bf16* bra = (bf16*)(P.ws + WS_BR);
    LAS bf16* vnT = (LAS bf16*)F.lds;
    const int r = F.tid >> 2, qq = F.tid & 3;
    { const bf16* vrow = uv + (size_t)(m0 + r) * 1024 + 512 + qq * 128; float s = 0.f, s2 = 0.f;
#pragma unroll
      for (int j = 0; j < 16; ++j) { const u32x4 w = *(const u32x4*)(vrow + 8 * j); const float a0 = bflo(w.x), a1 = bfhi(w.x), a2 = bflo(w.y), a3 = bfhi(w.y), a4 = bflo(w.z), a5 = bfhi(w.z), a6 = bflo(w.w), a7 = bfhi(w.w);
          s += ((a0 + a1) + (a2 + a3)) + ((a4 + a5) + (a6 + a7)); s2 += ((a0 * a0 + a1 * a1) + (a2 * a2 + a3 * a3)) + ((a4 * a4 + a5 * a5) + (a6 * a6 + a7 * a7)); }
      s += __shfl_xor(s, 1); s += __shfl_xor(s, 2); s2 += __shfl_xor(s2, 1); s2 += __shfl_xor(s2, 2);
      const float mean = s * (1.f / 512.f); float var = s2 * (1.f / 512.f) - mean * mean; var = var > 0.f ? var : 0.f; const float rstd = __builtin_amdgcn_rsqf(var + NORM_EPS);
      const bf16* vg = uv + (size_t)(m0 + r) * 1024 + 512 + g * 128 + qq * 32; const float* lg = P.sgu_ln_g + l * 512 + g * 128 + qq * 32; const float* lb = P.sgu_ln_b + l * 512 + g * 128 + qq * 32;
#pragma unroll
      for (int j = 0; j < 4; ++j) { const u32x4 w = *(const u32x4*)(vg + 8 * j); const float a[8] = {bflo(w.x), bfhi(w.x), bflo(w.y), bfhi(w.y), bflo(w.z), bfhi(w.z), bflo(w.w), bfhi(w.w)};
#pragma unroll
          for (int i = 0; i < 8; ++i) { const int c = qq * 32 + 8 * j + i; const float y = (a[i] - mean) * rstd * lg[8 * j + i] + lb[8 * j + i]; vnT[c * 136 + r] = (bf16)(pk2(y, 0.f) & 0xffffu); } }
    }
    __syncthreads();
    const int lr = F.lane & 31, h = F.lane >> 5, ct = F.wave >> 1;
    const bf16* sw = (const bf16*)(P.ws + WS_SGUW) + (size_t)g * 128 * 128;
#pragma unroll
    for (int t2 = 0; t2 < 2; ++t2) { const int tt = 2 * (F.wave & 1) + t2; f32x16 acc = zero16();
        for (int ks = 0; ks < 2 * (tt + 1); ++ks) {
            const bf16x8 a = *(const LAS bf16x8*)(vnT + (32 * ct + lr) * 136 + 16 * ks + 8 * h);
            const bf16x8 b = *(const bf16x8*)(sw + (size_t)(32 * tt + lr) * 128 + 16 * ks + 8 * h);
            acc = MFMA32(a, b, acc); }
        const int t = 32 * tt + lr; const float bias = P.sgu_b[l * 512 + g * 128 + t];
#pragma unroll
        for (int gq = 0; gq < 4; ++gq) { const int c0 = 32 * ct + 8 * gq + 4 * h; const u32x2 uu = *(const u32x2*)(uv + (size_t)(m0 + t) * 1024 + g * 128 + c0);
            u32x2 o; o.x = pk2(bflo(uu.x) * (acc[4 * gq] + bias), bfhi(uu.x) * (acc[4 * gq + 1] + bias)); o.y = pk2(bflo(uu.y) * (acc[4 * gq + 2] + bias), bfhi(uu.y) * (acc[4 * gq + 3] + bias));
            *(u32x2*)(bra + (size_t)(m0 + t) * 512 + g * 128 + c0) = o; } }
    __syncthreads();
}

__device__ __forceinline__ void swa_task(const Frame& F, const Params& P, int l, int task) {
    const int kvh = task & 1, cb = task >> 1, nq = cb & 63, m0 = cb * 128;
    const bf16* qkvb = (const bf16*)(P.ws + WS_QKVB); bf16* brb = (bf16*)(P.ws + WS_BR) + (size_t)TT * 512;
    LAS bf16* Qs = (LAS bf16*)F.lds;
    LAS bf16* Ks = (LAS bf16*)(F.lds + 73728);
    LAS bf16* VT = (LAS bf16*)(F.lds + 110592);
    for (int i = F.tid; i < 4096; i += NTHR) { const int g = i >> 10, r = (i >> 3) & 127, c8 = i & 7; if (c8 < 2) continue;
        const u32x4 w = *(const u32x4*)(qkvb + (size_t)(m0 + r) * 768 + (kvh * 4 + g) * 64 + c8 * 8);
        u32x4 o; o.x = pk2(bflo(w.x) * 0.125f, bfhi(w.x) * 0.125f); o.y = pk2(bflo(w.y) * 0.125f, bfhi(w.y) * 0.125f); o.z = pk2(bflo(w.z) * 0.125f, bfhi(w.z) * 0.125f); o.w = pk2(bflo(w.w) * 0.125f, bfhi(w.w) * 0.125f);
        *(LAS u32x4*)(Qs + (g * 128 + r) * 72 + c8 * 8) = o; }
    const float invf[8] = {1.0f, 0.19392274474868576f, 0.03760603093086393f, 0.007292664737217109f, 0.001414213562373095f, 0.0002742481756762073f, 5.318295896944988e-05f, 1.031338537721246e-05f};
    { const int g = F.tid >> 7, r = F.tid & 127; const float pos = (float)P.pos[m0 + r];
      const bf16* src = qkvb + (size_t)(m0 + r) * 768 + (kvh * 4 + g) * 64; const u32x4 w1 = *(const u32x4*)src, w2 = *(const u32x4*)(src + 8);
      const float x1[8] = {bflo(w1.x), bfhi(w1.x), bflo(w1.y), bfhi(w1.y), bflo(w1.z), bfhi(w1.z), bflo(w1.w), bfhi(w1.w)}, x2[8] = {bflo(w2.x), bfhi(w2.x), bflo(w2.y), bfhi(w2.y), bflo(w2.z), bfhi(w2.z), bflo(w2.w), bfhi(w2.w)};
      float o1[8], o2[8];
#pragma unroll
      for (int i = 0; i < 8; ++i) { float sn, cs; sincosf(pos * invf[i], &sn, &cs); o1[i] = (x1[i] * cs - x2[i] * sn) * 0.125f; o2[i] = (x2[i] * cs + x1[i] * sn) * 0.125f; }
      u32x4 a, b; a.x = pk2(o1[0], o1[1]); a.y = pk2(o1[2], o1[3]); a.z = pk2(o1[4], o1[5]); a.w = pk2(o1[6], o1[7]); b.x = pk2(o2[0], o2[1]); b.y = pk2(o2[2], o2[3]); b.z = pk2(o2[4], o2[5]); b.w = pk2(o2[6], o2[7]);
      *(LAS u32x4*)(Qs + (g * 128 + r) * 72) = a; *(LAS u32x4*)(Qs + (g * 128 + r) * 72 + 8) = b; }
    for (int i = F.tid; i < 2048; i += NTHR) { const int s = i >> 3, c8 = i & 7; const bool ok = nq > 0 || s >= 128; const size_t row = (size_t)(m0 - 128 + s);
        u32x4 kw = {0u, 0u, 0u, 0u}, vw = {0u, 0u, 0u, 0u};
        if (ok) { if (c8 >= 2) kw = *(const u32x4*)(qkvb + row * 768 + 512 + kvh * 64 + c8 * 8); vw = *(const u32x4*)(qkvb + row * 768 + 640 + kvh * 64 + c8 * 8); }
        if (c8 >= 2) *(LAS u32x4*)(Ks + s * 72 + c8 * 8) = kw;
        const int p = (s & ~12) | ((s & 4) << 1) | ((s & 8) >> 1); const unsigned vv[4] = {vw.x, vw.y, vw.z, vw.w};
#pragma unroll
        for (int j = 0; j < 4; ++j) { VT[(c8 * 8 + 2 * j) * 264 + p] = (bf16)(vv[j] & 0xffffu); VT[(c8 * 8 + 2 * j + 1) * 264 + p] = (bf16)(vv[j] >> 16); } }
    if (F.tid < 256) { const int s = F.tid; const bool ok = nq > 0 || s >= 128; u32x4 a = {0u, 0u, 0u, 0u}, b = {0u, 0u, 0u, 0u};
        if (ok) { const size_t row = (size_t)(m0 - 128 + s); const float pos = (float)P.pos[row]; const bf16* src = qkvb + row * 768 + 512 + kvh * 64; const u32x4 w1 = *(const u32x4*)src, w2 = *(const u32x4*)(src + 8);
            const float x1[8] = {bflo(w1.x), bfhi(w1.x), bflo(w1.y), bfhi(w1.y), bflo(w1.z), bfhi(w1.z), bflo(w1.w), bfhi(w1.w)}, x2[8] = {bflo(w2.x), bfhi(w2.x), bflo(w2.y), bfhi(w2.y), bflo(w2.z), bfhi(w2.z), bflo(w2.w), bfhi(w2.w)};
            float o1[8], o2[8];
#pragma unroll
            for (int i = 0; i < 8; ++i) { float sn, cs; sincosf(pos * invf[i], &sn, &cs); o1[i] = x1[i] * cs - x2[i] * sn; o2[i] = x2[i] * cs + x1[i] * sn; }
            a.x = pk2(o1[0], o1[1]); a.y = pk2(o1[2], o1[3]); a.z = pk2(o1[4], o1[5]); a.w = pk2(o1[6], o1[7]); b.x = pk2(o2[0], o2[1]); b.y = pk2(o2[2], o2[3]); b.z = pk2(o2[4], o2[5]); b.w = pk2(o2[6], o2[7]); }
        *(LAS u32x4*)(Ks + s * 72) = a; *(LAS u32x4*)(Ks + s * 72 + 8) = b; }
    __syncthreads();
    const int lr = F.lane & 31, h = F.lane >> 5, g = F.wave >> 1, qh = F.wave & 1;
    const float sink = P.sinks[l * 8 + kvh * 4 + g];
#pragma unroll 1
    for (int q2 = 0; q2 < 2; ++q2) { const int qt = 2 * qh + q2, q0 = 32 * qt, qi = q0 + lr;
        bf16x8 bq[4];
#pragma unroll
        for (int ks = 0; ks < 4; ++ks) bq[ks] = *(const LAS bf16x8*)(Qs + (g * 128 + q0 + lr) * 72 + 16 * ks + 8 * h);
        f32x16 sc[5];
#pragma unroll
        for (int k5 = 0; k5 < 5; ++k5) { sc[k5] = zero16();
#pragma unroll
            for (int ks = 0; ks < 4; ++ks) { const bf16x8 a = *(const LAS bf16x8*)(Ks + (32 * (qt + k5) + lr) * 72 + 16 * ks + 8 * h); sc[k5] = MFMA32(a, bq[ks], sc[k5]); } }
        float mx = sink;
#pragma unroll
        for (int k5 = 0; k5 < 5; ++k5)
#pragma unroll
            for (int rg = 0; rg < 16; ++rg) { const int sj = 32 * (qt + k5) + crow(rg, h); const bool ok = sj >= qi + 1 && sj <= qi + 128 && (nq > 0 || sj >= 128);
                const float v = ok ? sc[k5][rg] : -INFINITY; sc[k5][rg] = v; mx = fmaxf(mx, v); }
        mx = fmaxf(mx, __shfl_xor(mx, 32));
        float sum = 0.f;
#pragma unroll
        for (int k5 = 0; k5 < 5; ++k5)
#pragma unroll
            for (int rg = 0; rg < 16; ++rg) { const float p = __expf(sc[k5][rg] - mx); sc[k5][rg] = p; sum += p; }
        sum += __shfl_xor(sum, 32); sum += __expf(sink - mx);
        const float inv = 1.0f / sum;
        f32x16 o[2] = {zero16(), zero16()};
#pragma unroll
        for (int k5 = 0; k5 < 5; ++k5)
#pragma unroll
            for (int s2 = 0; s2 < 2; ++s2) { const bf16x8 pb = pack_step(sc[k5], s2);
#pragma unroll
                for (int dt = 0; dt < 2; ++dt) { const bf16x8 a = *(const LAS bf16x8*)(VT + (32 * dt + lr) * 264 + 32 * (qt + k5) + 16 * s2 + 8 * h); o[dt] = MFMA32(a, pb, o[dt]); } }
        bf16* orow = brb + (size_t)(m0 + qi) * 512 + (kvh * 4 + g) * 64;
#pragma unroll
        for (int dt = 0; dt < 2; ++dt)
#pragma unroll
            for (int gq = 0; gq < 4; ++gq) { u32x2 w; w.x = pk2(o[dt][4 * gq] * inv, o[dt][4 * gq + 1] * inv); w.y = pk2(o[dt][4 * gq + 2] * inv, o[dt][4 * gq + 3] * inv);
                *(u32x2*)(orow + 32 * dt + 8 * gq + 4 * h) = w; }
    }
    __syncthreads();
}

__device__ __forceinline__ void dn_pre_task(const Frame& F, const Params& P, int l, int task) {
    const int hd = task & 3, cbn = task >> 2, b = cbn >> 7, n = cbn & 127, m0 = cbn * 64;
    const bf16* qkvc = (const bf16*)(P.ws + WS_QKVC); const float* ba = (const float*)(P.ws + WS_BA);
    unsigned char* outb = P.ws + WS_DN + (size_t)task * DN_TASK_BYTES;
    LAS bf16* qs = (LAS bf16*)F.lds;
    LAS bf16* ks = (LAS bf16*)(F.lds + 17408);
    LAS bf16* kT = (LAS bf16*)(F.lds + 34816);
    LAS bf16* vT = (LAS bf16*)(F.lds + 53248);
    LAS float* Lm = (LAS float*)(F.lds + 71680);
    LAS bf16* Tm = (LAS bf16*)(F.lds + 89088);
    LAS float* tg = (LAS float*)(F.lds + 98304);
    LAS float *tgc = tg + 64, *tbeta = tg + 128, *teg = tg + 192, *ted = tg + 256, *tsb = tg + 320;
    const int lr = F.lane & 31, h = F.lane >> 5;
    { const int t = F.tid >> 3, seg = F.tid & 7, c0 = seg * 16; const int row = m0 + t;
      const float beta = fast_sigmoid(ba[(size_t)row * 8 + hd]); const float xa = ba[(size_t)row * 8 + 4 + hd] + P.dt_bias[l * 4 + hd];
      const float sp = fmaxf(xa, 0.f) + __logf(1.0f + __expf(-fabsf(xa))); const float gt = -__expf(P.a_log[l * 4 + hd]) * sp;
      if (seg == 0) { tg[t] = gt; tbeta[t] = beta; }
#pragma unroll
      for (int part = 0; part < 3; ++part) { const int col0 = part * 512 + hd * 128 + c0; float acc[16];
#pragma unroll
          for (int i = 0; i < 16; ++i) acc[i] = 0.f;
#pragma unroll
          for (int tap = 0; tap < 4; ++tap) { const int sr = n * 64 + t - 3 + tap; if (sr >= 0) {
              const bf16* src = qkvc + (size_t)(b * SEQ + sr) * 1536 + col0; const u32x4 w1 = *(const u32x4*)src, w2 = *(const u32x4*)(src + 8);
              const float xv[16] = {bflo(w1.x), bfhi(w1.x), bflo(w1.y), bfhi(w1.y), bflo(w1.z), bfhi(w1.z), bflo(w1.w), bfhi(w1.w), bflo(w2.x), bfhi(w2.x), bflo(w2.y), bfhi(w2.y), bflo(w2.z), bfhi(w2.z), bflo(w2.w), bfhi(w2.w)};
              const f32x4* cw = (const f32x4*)(P.conv_w + ((size_t)l * 4 + tap) * 1536 + col0);
#pragma unroll
              for (int q = 0; q < 4; ++q) { const f32x4 w = cw[q]; acc[4 * q] += xv[4 * q] * w.x; acc[4 * q + 1] += xv[4 * q + 1] * w.y; acc[4 * q + 2] += xv[4 * q + 2] * w.z; acc[4 * q + 3] += xv[4 * q + 3] * w.w; } } }
          float ss = 0.f;
#pragma unroll
          for (int i = 0; i < 16; ++i) { acc[i] = acc[i] * fast_sigmoid(acc[i]); ss += acc[i] * acc[i]; }
          if (part < 2) { ss += __shfl_xor(ss, 1); ss += __shfl_xor(ss, 2); ss += __shfl_xor(ss, 4); const float rn = __builtin_amdgcn_rsqf(ss + NORM_EPS) * (part == 0 ? 0.08838834764831845f : 1.0f);
#pragma unroll
              for (int i = 0; i < 16; ++i) acc[i] *= rn; }
          else {
#pragma unroll
              for (int i = 0; i < 16; ++i) acc[i] *= beta; }
          unsigned pk[8];
#pragma unroll
          for (int i = 0; i < 8; ++i) pk[i] = pk2(acc[2 * i], acc[2 * i + 1]);
          if (part < 2) { LAS bf16* dst = (part == 0 ? qs : ks) + t * 136 + c0; *(LAS u32x4*)dst = (u32x4){pk[0], pk[1], pk[2], pk[3]}; *(LAS u32x4*)(dst + 8) = (u32x4){pk[4], pk[5], pk[6], pk[7]}; }
          if (part >= 1) { LAS bf16* dT = part == 1 ? kT : vT;
#pragma unroll
              for (int i = 0; i < 8; ++i) { dT[(c0 + 2 * i) * 72 + t] = (bf16)(pk[i] & 0xffffu); dT[(c0 + 2 * i + 1) * 72 + t] = (bf16)(pk[i] >> 16); } }
      }
    }
    __syncthreads();
    if (F.wave == 0) { float x = tg[F.lane];
#pragma unroll
        for (int o = 1; o < 64; o <<= 1) { const float y = __shfl_up(x, o); if (F.lane >= o) x += y; }
        const float gl = __shfl(x, 63); tgc[F.lane] = x; const float e = __expf(x); teg[F.lane] = e; ted[F.lane] = __expf(gl - x); tsb[F.lane] = tbeta[F.lane] * e;
        if (F.lane == 0) ((float*)(P.ws + WS_CD))[task] = __expf(gl); }
    __syncthreads();
    if (F.wave < 4) { const int it = F.wave >> 1, jt = F.wave & 1; f32x16 acc = zero16();
        if (jt <= it) {
#pragma unroll
            for (int s = 0; s < 8; ++s) { const bf16x8 a = *(const LAS bf16x8*)(ks + (32 * it + lr) * 136 + 16 * s + 8 * h), bb = *(const LAS bf16x8*)(ks + (32 * jt + lr) * 136 + 16 * s + 8 * h); acc = MFMA32(a, bb, acc); } }
        const int j = 32 * jt + lr; const float gj = tgc[j];
#pragma unroll
        for (int rg = 0; rg < 16; ++rg) { const int i = 32 * it + crow(rg, h); const float v = i > j ? tbeta[i] * acc[rg] * __expf(tgc[i] - gj) : 0.f; Lm[i * 68 + j] = v; } }
    else { const int w4 = F.wave - 4, jt = w4 >> 1, ct = w4 & 1; f32x16 acc = zero16();
        if (jt <= ct) {
#pragma unroll
            for (int s = 0; s < 8; ++s) { const bf16x8 a = *(const LAS bf16x8*)(ks + (32 * jt + lr) * 136 + 16 * s + 8 * h), bb = *(const LAS bf16x8*)(qs + (32 * ct + lr) * 136 + 16 * s + 8 * h); acc = MFMA32(a, bb, acc); } }
        const int c = 32 * ct + lr; const float gcc = tgc[c];
#pragma unroll
        for (int rg = 0; rg < 16; ++rg) { const int jp = 32 * jt + crow(rg, h); acc[rg] = jp <= c ? acc[rg] * __expf(gcc - tgc[jp]) : 0.f; }
#pragma unroll
        for (int s = 0; s < 2; ++s) *(bf16x8*)(outb + DN_OFF_AT + ((ct * 4 + 2 * jt + s) * 64 + F.lane) * 16) = pack_step(acc, s); }
    __syncthreads();
    if (F.wave == 0) { LAS float* Tf = (LAS float*)(F.lds + 99840);
#pragma unroll 1
        for (int bi = 0; bi < 4; ++bi) { float rr[16];
#pragma unroll
            for (int ii = 0; ii < 16; ++ii) rr[ii] = (F.lane == 16 * bi + ii) ? 1.f : 0.f;
#pragma unroll 1
            for (int j = 0; j < 16 * bi; j += 4) { const float t0 = Tf[j * 64 + F.lane], t1 = Tf[(j + 1) * 64 + F.lane], t2 = Tf[(j + 2) * 64 + F.lane], t3 = Tf[(j + 3) * 64 + F.lane];
#pragma unroll
                for (int ii = 0; ii < 16; ++ii) { const f32x4 lv = *(const LAS f32x4*)(Lm + (16 * bi + ii) * 68 + j); rr[ii] -= (lv.x * t0 + lv.y * t1) + (lv.z * t2 + lv.w * t3); } }
#pragma unroll
            for (int ii = 0; ii < 16; ++ii) {
#pragma unroll
                for (int j4 = 0; j4 < ii; j4 += 4) { const f32x4 lv = *(const LAS f32x4*)(Lm + (16 * bi + ii) * 68 + 16 * bi + j4);
                    rr[ii] -= lv.x * rr[j4]; if (j4 + 1 < ii) rr[ii] -= lv.y * rr[j4 + 1]; if (j4 + 2 < ii) rr[ii] -= lv.z * rr[j4 + 2]; if (j4 + 3 < ii) rr[ii] -= lv.w * rr[j4 + 3]; }
                Tf[(16 * bi + ii) * 64 + F.lane] = rr[ii]; Tm[(16 * bi + ii) * 72 + F.lane] = (bf16)(pk2(rr[ii], 0.f) & 0xffffu); } } }
    else { for (int f = F.wave - 1; f < 32; f += 7) {
            if (f < 16) { const int mt = f >> 3, s = f & 7, c = 32 * mt + lr; const float e = teg[c];
                const u32x2 lo = *(const LAS u32x2*)(qs + c * 136 + 16 * s + 4 * h), hi = *(const LAS u32x2*)(qs + c * 136 + 16 * s + 8 + 4 * h);
                u32x4 o; o.x = pk2(bflo(lo.x) * e, bfhi(lo.x) * e); o.y = pk2(bflo(lo.y) * e, bfhi(lo.y) * e); o.z = pk2(bflo(hi.x) * e, bfhi(hi.x) * e); o.w = pk2(bflo(hi.y) * e, bfhi(hi.y) * e);
                *(u32x4*)(outb + DN_OFF_QD + ((mt * 8 + s) * 64 + F.lane) * 16) = o; }
            else { const int f2 = f - 16, dt = f2 >> 2, s = f2 & 3, d = 32 * dt + lr;
                const u32x2 lo = *(const LAS u32x2*)(kT + d * 72 + 16 * s + 4 * h), hi = *(const LAS u32x2*)(kT + d * 72 + 16 * s + 8 + 4 * h);
                const f32x4 e0 = *(const LAS f32x4*)(ted + 16 * s + 4 * h), e1 = *(const LAS f32x4*)(ted + 16 * s + 8 + 4 * h);
                u32x4 o; o.x = pk2(bflo(lo.x) * e0.x, bfhi(lo.x) * e0.y); o.y = pk2(bflo(lo.y) * e0.z, bfhi(lo.y) * e0.w); o.z = pk2(bflo(hi.x) * e1.x, bfhi(hi.x) * e1.y); o.w = pk2(bflo(hi.y) * e1.z, bfhi(hi.y) * e1.w);
                *(u32x4*)(outb + DN_OFF_KD + ((dt * 4 + s) * 64 + F.lane) * 16) = o; } } }
    __syncthreads();
    { const int it = F.wave >> 2, et = F.wave & 3; f32x16 acc = zero16();
#pragma unroll
      for (int s = 0; s < 4; ++s) { const bf16x8 a = *(const LAS bf16x8*)(Tm + (32 * it + lr) * 72 + 16 * s + 8 * h), bb = *(const LAS bf16x8*)(vT + (32 * et + lr) * 72 + 16 * s + 8 * h); acc = MFMA32(a, bb, acc); }
      u32x4 o0, o1; o0.x = pk2(acc[0], acc[1]); o0.y = pk2(acc[2], acc[3]); o0.z = pk2(acc[4], acc[5]); o0.w = pk2(acc[6], acc[7]); o1.x = pk2(acc[8], acc[9]); o1.y = pk2(acc[10], acc[11]); o1.z = pk2(acc[12], acc[13]); o1.w = pk2(acc[14], acc[15]);
      unsigned char* up = outb + DN_OFF_U + ((et * 2 + it) * 64 + F.lane) * 32; *(u32x4*)up = o0; *(u32x4*)(up + 16) = o1; }
    { const int dt = F.wave >> 1, it = F.wave & 1; f32x16 acc = zero16();
#pragma unroll
      for (int s = 0; s < 4; ++s) { const u32x4 kw = *(const LAS u32x4*)(kT + (32 * dt + lr) * 72 + 16 * s + 8 * h); const f32x4 e0 = *(const LAS f32x4*)(tsb + 16 * s + 8 * h), e1 = *(const LAS f32x4*)(tsb + 16 * s + 8 * h + 4);
          u32x4 aw; aw.x = pk2(bflo(kw.x) * e0.x, bfhi(kw.x) * e0.y); aw.y = pk2(bflo(kw.y) * e0.z, bfhi(kw.y) * e0.w); aw.z = pk2(bflo(kw.z) * e1.x, bfhi(kw.z) * e1.y); aw.w = pk2(bflo(kw.w) * e1.z, bfhi(kw.w) * e1.w);
          const bf16x8 bb = *(const LAS bf16x8*)(Tm + (32 * it + lr) * 72 + 16 * s + 8 * h); acc = MFMA32(__builtin_bit_cast(bf16x8, aw), bb, acc); }
#pragma unroll
      for (int s = 0; s < 2; ++s) *(bf16x8*)(outb + DN_OFF_W + ((it * 8 + 2 * dt + s) * 64 + F.lane) * 16) = pack_step(acc, s); }
    __syncthreads();
}
constexpr int SC_BUF = 49152;
#define SC_BARRIER() do { asm volatile("s_waitcnt lgkmcnt(0)" ::: "memory"); __builtin_amdgcn_s_barrier(); asm volatile("" ::: "memory"); } while (0)
__device__ __forceinline__ void dn_scan(const Frame& F, const Params& P, int bh, bool nostore = false) {
    const int b = bh >> 2, hd = bh & 3; const int es = F.wave;
    unsigned char* dn = P.ws + WS_DN; const float* cdv = (const float*)(P.ws + WS_CD);
#define task_of(n_) ((((b) * 128 + (n_)) << 2) | (hd))
#define SC_SRC(n_, i_) ((const u32x4*)(dn + (size_t)task_of(n_) * DN_TASK_BYTES + ((i_) < 4 ? 0 : ((i_) < 8 ? DN_OFF_KD - 16384 : DN_OFF_U - 32768))) + t4 + 256 * (i_))
    if (F.wave >= 4) {
        const int t4 = F.tid - 256; u32x4 R0[12], R1[12], R2[12]; LAS float* cdl = (LAS float*)(F.lds + 2 * SC_BUF);
        float C0 = cdv[task_of(1)], C1 = cdv[task_of(2)], C2 = cdv[task_of(3)];
        if (t4 == 0) cdl[0] = cdv[task_of(0)];
        { LAS u32x4* dst = (LAS u32x4*)F.lds;
#pragma unroll
          for (int i = 0; i < 12; ++i) R0[i] = *SC_SRC(0, i);
#pragma unroll
          for (int i = 0; i < 12; ++i) dst[t4 + 256 * i] = R0[i]; }
#pragma unroll
        for (int i = 0; i < 12; ++i) { R0[i] = *SC_SRC(1, i); R1[i] = *SC_SRC(2, i); R2[i] = *SC_SRC(3, i); }
        SC_BARRIER();
#define SC_LSTEP(R, C, n_) if ((n_) < 128) { if ((n_) + 1 < 128) { LAS u32x4* dst = (LAS u32x4*)(F.lds + (((n_) + 1) & 1) * SC_BUF); \
            _Pragma("unroll") for (int i = 0; i < 12; ++i) dst[t4 + 256 * i] = R[i]; if (t4 == 0) cdl[((n_) + 1) & 1] = C; } \
            if ((n_) + 4 < 128) { _Pragma("unroll") for (int i = 0; i < 12; ++i) R[i] = *SC_SRC((n_) + 4, i); C = cdv[task_of((n_) + 4)]; } \
            SC_BARRIER(); }
#pragma unroll
        for (int n = 0; n < 129; n += 3) { SC_LSTEP(R0, C0, n) SC_LSTEP(R1, C1, n + 1) SC_LSTEP(R2, C2, n + 2) }
#undef SC_LSTEP
    } else {
        f32x16 S[4] = {zero16(), zero16(), zero16(), zero16()};
        const LAS float* cdl = (const LAS float*)(F.lds + 2 * SC_BUF);
        SC_BARRIER();
#pragma unroll 1
        for (int n = 0; n < 128; ++n) {
            const LAS unsigned char* cur = F.lds + (n & 1) * SC_BUF; unsigned char* tb = dn + (size_t)task_of(n) * DN_TASK_BYTES;
            const float cd = cdl[n & 1];
            bf16x8 Sb[8], A[16];
#pragma unroll
            for (int i = 0; i < 16; ++i) A[i] = *(const LAS bf16x8*)(cur + (i * 64 + F.lane) * 16);
#pragma unroll
            for (int dt = 0; dt < 4; ++dt) { Sb[2 * dt] = pack_step(S[dt], 0); Sb[2 * dt + 1] = pack_step(S[dt], 1); }
            { unsigned char* hp = tb + (es < 2 ? 0 : DN_OFF_KD) + ((es & 1) * 8 * 64 + F.lane) * 16;
              if (!nostore) {
#pragma unroll
              for (int s = 0; s < 8; ++s) *(bf16x8*)(hp + s * 1024) = Sb[s]; } }
            __builtin_amdgcn_sched_barrier(0);
            f32x16 Pw[2] = {zero16(), zero16()};
#pragma unroll
            for (int s = 0; s < 8; ++s) { Pw[0] = MFMA32(A[s], Sb[s], Pw[0]); Pw[1] = MFMA32(A[8 + s], Sb[s], Pw[1]); }
            __builtin_amdgcn_sched_barrier(0);
            u32x4 uu[4];
#pragma unroll
            for (int i = 0; i < 4; ++i) uu[i] = *(const LAS u32x4*)(cur + 32768 + ((es * 2 + (i >> 1)) * 64 + F.lane) * 32 + (i & 1) * 16);
#pragma unroll
            for (int i = 0; i < 16; ++i) A[i] = *(const LAS bf16x8*)(cur + 16384 + (i * 64 + F.lane) * 16);
            __builtin_amdgcn_sched_barrier(0);
            bf16x8 Vb[4];
#pragma unroll
            for (int ct = 0; ct < 2; ++ct) { const unsigned uw[8] = {uu[2 * ct].x, uu[2 * ct].y, uu[2 * ct].z, uu[2 * ct].w, uu[2 * ct + 1].x, uu[2 * ct + 1].y, uu[2 * ct + 1].z, uu[2 * ct + 1].w}; f32x16 v;
#pragma unroll
                for (int p = 0; p < 8; ++p) { v[2 * p] = bflo(uw[p]) - Pw[ct][2 * p]; v[2 * p + 1] = bfhi(uw[p]) - Pw[ct][2 * p + 1]; }
                Vb[2 * ct] = pack_step(v, 0); Vb[2 * ct + 1] = pack_step(v, 1); }
            { unsigned char* vp = tb + DN_OFF_U + (es * 4 * 64 + F.lane) * 16;
              if (!nostore) {
#pragma unroll
              for (int s = 0; s < 4; ++s) *(bf16x8*)(vp + s * 1024) = Vb[s]; } }
#pragma unroll
            for (int dt = 0; dt < 4; ++dt) S[dt] = S[dt] * cd;
            __builtin_amdgcn_sched_barrier(0);
#pragma unroll
            for (int s = 0; s < 4; ++s)
#pragma unroll
                for (int dt = 0; dt < 4; ++dt) S[dt] = MFMA32(A[dt * 4 + s], Vb[s], S[dt]);
            SC_BARRIER();
        }
    }
#undef SC_SRC
#undef task_of
}
__device__ __forceinline__ void dn_out_task(const Frame& F, const Params& P, int l, int task) {
    const int hd = task & 3, cbn = task >> 2, m0 = cbn * 64; const int lr = F.lane & 31, h = F.lane >> 5, ct = F.wave >> 2, es = F.wave & 3;
    const unsigned char* tb = P.ws + WS_DN + (size_t)task * DN_TASK_BYTES; bf16* brc = (bf16*)(P.ws + WS_BR) + (size_t)2 * TT * 512; const bf16* z = (const bf16*)(P.ws + WS_Z);
    LAS float* ssq = (LAS float*)F.lds;
    f32x16 o = zero16();
    { const unsigned char* hp = tb + (es < 2 ? 0 : DN_OFF_KD) + ((es & 1) * 8 * 64 + F.lane) * 16;
#pragma unroll
      for (int s = 0; s < 8; ++s) { const bf16x8 a = *(const bf16x8*)(tb + DN_OFF_QD + ((ct * 8 + s) * 64 + F.lane) * 16), bb = *(const bf16x8*)(hp + s * 1024); o = MFMA32(a, bb, o); }
      const unsigned char* vp = tb + DN_OFF_U + (es * 4 * 64 + F.lane) * 16;
#pragma unroll
      for (int s = 0; s < 4; ++s) { const bf16x8 a = *(const bf16x8*)(tb + DN_OFF_AT + ((ct * 4 + s) * 64 + F.lane) * 16), bb = *(const bf16x8*)(vp + s * 1024); o = MFMA32(a, bb, o); } }
    float q[16];
#pragma unroll
    for (int rg = 0; rg < 16; ++rg) { float v = o[rg] * o[rg]; v += __shfl_xor(v, 1); v += __shfl_xor(v, 2); v += __shfl_xor(v, 4); v += __shfl_xor(v, 8); v += __shfl_xor(v, 16); q[rg] = v; }
    if (lr == 0) {
#pragma unroll
        for (int rg = 0; rg < 16; ++rg) ssq[(ct * 4 + es) * 32 + crow(rg, h)] = q[rg]; }
    __syncthreads();
    const int e = hd * 128 + es * 32 + lr; const float gn = P.dn_norm[l * 128 + es * 32 + lr];
#pragma unroll
    for (int rg = 0; rg < 16; ++rg) { const int r = crow(rg, h); const float tot = (ssq[(ct * 4 + 0) * 32 + r] + ssq[(ct * 4 + 1) * 32 + r]) + (ssq[(ct * 4 + 2) * 32 + r] + ssq[(ct * 4 + 3) * 32 + r]);
        const float rs = __builtin_amdgcn_rsqf(tot * (1.f / 128.f) + NORM_EPS); const size_t idx = (size_t)(m0 + 32 * ct + r) * 512 + e;
        const float zz = __uint_as_float(((unsigned)z[idx]) << 16); brc[idx] = (bf16)(pk2(o[rg] * rs * gn * (zz * fast_sigmoid(zz)), 0.f) & 0xffffu); }
    __syncthreads();
}
__device__ __forceinline__ void final_norm(const Frame& F, const Params& P) {
    const int gw = F.vb * NWAVES + F.wave, NGW = F.G * NWAVES; const float* rowsq = (const float*)(P.ws + WS_ROWSQ);
    f32x4 gn[4];
#pragma unroll
    for (int j = 0; j < 4; ++j) gn[j] = ((const f32x4*)P.final_norm)[F.lane + 64 * j];
    for (int m = gw; m < TT; m += NGW) { float sq = F.lane < 16 ? rowsq[(size_t)m * 16 + F.lane] : 0.f; sq = wave_sum(sq); const float rs = __builtin_amdgcn_rsqf(sq * (1.f / 1024.f) + NORM_EPS);
        f32x4* xr = (f32x4*)(P.out + (size_t)m * DM) + F.lane;
#pragma unroll
        for (int j = 0; j < 4; ++j) xr[64 * j] = xr[64 * j] * rs * gn[j]; }
}

#define RLX_AGENT __ATOMIC_RELAXED, __HIP_MEMORY_SCOPE_AGENT
#define XB_TMO      128
#define XB_XCNT(j)  (256  + 64 * (j))
#define XB_XSUB(j)  (1280 + 64 * (j))
#define XB_XGEN(j)  (2304 + 64 * (j))
#define XB_TOP      3328
#define XB_TOPGEN   3392
#define XCD_BAR_WORDS 3456
#define XB_SPIN_CAP (1u << 18)

__device__ __forceinline__ unsigned xb_ld(unsigned* p)              { return __hip_atomic_load(p, __ATOMIC_RELAXED, __HIP_MEMORY_SCOPE_AGENT); }
__device__ __forceinline__ unsigned xb_add(unsigned* p, unsigned v) { return __hip_atomic_fetch_add(p, v, __ATOMIC_RELAXED, __HIP_MEMORY_SCOPE_AGENT); }
__device__ __forceinline__ unsigned xb_xcc_id() { return (unsigned)__builtin_amdgcn_s_getreg((3 << 11) | 20) & 0xFu; }
#define XB_SPIN(cond, bar) do { unsigned _sp = 0; while (cond) { __builtin_amdgcn_s_sleep(1); \
    if ((++_sp & 255u) == 0u) { if (xb_ld(&(bar)[XB_TMO])) break; if (_sp > XB_SPIN_CAP) { atomicAdd(&(bar)[XB_TMO], 1u); break; } } } } while (0)

struct XcdBarrier {
    unsigned* bar; unsigned x;
    volatile LAS unsigned* st;
};

__device__ __forceinline__ XcdBarrier xcd_barrier_post(unsigned* bar, volatile LAS unsigned* st) {
    XcdBarrier b; b.bar = bar; b.x = xb_xcc_id(); b.st = st;
    if (threadIdx.x == 0) (void)xb_add(&bar[XB_XCNT(b.x)], 1u);
    return b;
}
__device__ __forceinline__ void xcd_barrier_complete(unsigned* bar, unsigned x, unsigned& nloc, unsigned& nx) {
    const unsigned G = gridDim.x * gridDim.y * gridDim.z;
    unsigned sum, cnt, mine, sp = 0u;
    for (;;) {
        sum = 0u; cnt = 0u; mine = 0u;
#pragma unroll
        for (unsigned j = 0; j < 16; ++j) { const unsigned c = xb_ld(&bar[XB_XCNT(j)]); sum += c; cnt += (c > 0u) ? 1u : 0u; mine = (j == x) ? c : mine; }
        if (sum == G) break;
        __builtin_amdgcn_s_sleep(1);
        if ((++sp & 255u) == 0u) { if (xb_ld(&bar[XB_TMO])) break; if (sp > XB_SPIN_CAP) { atomicAdd(&bar[XB_TMO], 1u); break; } }
    }
    nloc = mine > 0u ? mine : 1u; nx = cnt > 0u ? cnt : 1u;
}

__device__ __forceinline__ void xcd_barrier(const XcdBarrier& b) {
    asm volatile("s_waitcnt vmcnt(0)" ::: "memory");
    __syncthreads();
    if (threadIdx.x == 0) {
        unsigned* bar = b.bar;
        __builtin_amdgcn_s_waitcnt(0);
        unsigned nloc = b.st[0], nx = b.st[1];
        if (nloc == 0u) { xcd_barrier_complete(bar, b.x, nloc, nx); b.st[0] = nloc; b.st[1] = nx; }
        const unsigned old = xb_add(&bar[XB_XSUB(b.x)], 1u);
        const unsigned gen = old / nloc;
        if (old + 1u == (gen + 1u) * nloc) {
            __builtin_amdgcn_fence(__ATOMIC_RELEASE, "agent");
            asm volatile("s_waitcnt vmcnt(0)" ::: "memory");
            const unsigned og = xb_add(&bar[XB_TOP], 1u);
            const unsigned tg = og / nx;
            if (og + 1u == (tg + 1u) * nx) xb_add(&bar[XB_TOPGEN], 1u);
            else XB_SPIN(xb_ld(&bar[XB_TOPGEN]) == tg, bar);
            __builtin_amdgcn_fence(__ATOMIC_ACQUIRE, "agent");
            xb_add(&bar[XB_XGEN(b.x)], 1u);
            asm volatile("s_waitcnt vmcnt(0)" ::: "memory");
        } else {
            XB_SPIN(xb_ld(&bar[XB_XGEN(b.x)]) == gen, bar);
            __builtin_amdgcn_fence(__ATOMIC_ACQUIRE, "agent");
            asm volatile("s_waitcnt vmcnt(0)" ::: "memory");
        }
    }
    __syncthreads();
}

constexpr int PH_PER_LAYER = 9, N_PHASES = DEPTH * PH_PER_LAYER + 1;
__device__ __forceinline__ void run_phase(const Frame& F0, const Params& P0, int ph, int sub = 0) {
    Frame F = F0; Params P = P0; asm volatile("" : "+v"(F.tid)); F.lane = F.tid & 63; F.wave = __builtin_amdgcn_readfirstlane(F.tid >> 6);
    { size_t zoff = 0; asm volatile("" : "+s"(zoff)); P.ws = P0.ws + zoff; }
    const int l = ph / PH_PER_LAYER, k = ph % PH_PER_LAYER;
    unsigned char* ws = P.ws; const float* rowsq = (const float*)(ws + WS_ROWSQ); const LAS float* lrs = (const LAS float*)(F.lds + pg8::LRS_OFF);
    if (ph == N_PHASES - 1) { final_norm(F, P); return; }
#ifdef ONLY_K
    if (k != ONLY_K) return;
#endif
    switch (k) {
    case 0: p0_attn_weights(F, P, l); if (l == 0) p0_input(F, P); break;
    case 1: {
        pg8::Gemm g{(const pg8::bf16_t*)(ws + WS_XB), (const pg8::bf16_t*)(ws + WS_WIN), TT, NMIXP, DM}; pg8::StaticOrder S; S.init(TT, NMIXP, F.G, (int)blockIdx.x);
        pg8::EpiProj E{(pg8::bf16_t*)(ws + WS_UV), (pg8::bf16_t*)(ws + WS_QKVB), (pg8::bf16_t*)(ws + WS_QKVC), (pg8::bf16_t*)(ws + WS_Z), lrs, (float*)(ws + WS_BA)};
        pg8::prep_rstd(F.lds, S, rowsq);
        pg8::gemm_phase<pg8::EpiProj, pg8::StaticOrder, true, true>(F.lds, g, S, E); } break;
    case 2: for (int t = F.vb; t < 1024; t += F.G) dn_pre_task(F, P, l, t); break;
    case 3: { const int sb = (int)blockIdx.x; if (sb < 8) { if (!(sub & 2)) dn_scan(F, P, sb, (sub & 16) != 0); }
              else if (!(sub & 1)) { const int nb = F.G - 8; for (int t = sb - 8; t < 768; t += nb) { if (t < 256) { if (!(sub & 4)) swa_task(F, P, l, t); } else if (!(sub & 8)) sgu_task(F, P, l, t - 256); } } } break;
    case 4: for (int t = F.vb; t < 1024; t += F.G) dn_out_task(F, P, l, t); p0_ffn_weights(F, P, l); break;
    case 5: {
#pragma unroll 1
        for (int n = 0; n < 3; ++n) {
            { pg8::Gemm g{(const pg8::bf16_t*)(ws + WS_XB), (const pg8::bf16_t*)(ws + WS_WG) + (size_t)n * 1024 * 1024, TT, DM, DM}; pg8::StaticOrder S; S.init(TT, DM, F.G, (int)blockIdx.x);
              pg8::EpiSig E{(pg8::bf16_t*)(ws + WS_UV), lrs}; if (n == 0) pg8::prep_rstd(F.lds, S, rowsq); pg8::gemm_phase<pg8::EpiSig, pg8::StaticOrder, true, true>(F.lds, g, S, E); }
            __syncthreads();
            { pg8::Gemm g{(const pg8::bf16_t*)(ws + WS_BR) + (size_t)n * TT * 512, (const pg8::bf16_t*)(ws + WS_WBR) + (size_t)n * 1024 * 512, TT, DM, 512}; pg8::StaticOrder S; S.init(TT, DM, F.G, (int)blockIdx.x);
              if (n == 0) { pg8::EpiMerge<false> E{(const pg8::bf16_t*)(ws + WS_UV), (pg8::bf16_t*)(ws + WS_DN)}; pg8::gemm_phase<pg8::EpiMerge<false>, pg8::StaticOrder, true, true>(F.lds, g, S, E); }
              else { pg8::EpiMerge<true> E{(const pg8::bf16_t*)(ws + WS_UV), (pg8::bf16_t*)(ws + WS_DN)}; pg8::gemm_phase<pg8::EpiMerge<true>, pg8::StaticOrder, true, true>(F.lds, g, S, E); } }
            __syncthreads();
        } } break;
    case 6: { pg8::Gemm g{(const pg8::bf16_t*)(ws + WS_DN), (const pg8::bf16_t*)(ws + WS_WOUT), TT, DM, DM}; pg8::StaticOrder S; S.init(TT, DM, F.G, (int)blockIdx.x);
        pg8::EpiResid<false> E{(pg8::bf16_t*)(ws + WS_XB), (float*)(ws + WS_ROWSQ), nullptr}; pg8::gemm_phase<pg8::EpiResid<false>, pg8::StaticOrder, true, true>(F.lds, g, S, E); } break;
    case 7: { pg8::Gemm g{(const pg8::bf16_t*)(ws + WS_XB), (const pg8::bf16_t*)(ws + WS_WGU), TT, 2 * DFF, DM}; pg8::StaticOrder S; S.init(TT, 2 * DFF, F.G, (int)blockIdx.x);
        pg8::EpiGU E{(pg8::bf16_t*)(ws + WS_HID), lrs}; pg8::prep_rstd(F.lds, S, rowsq); pg8::gemm_phase<pg8::EpiGU, pg8::StaticOrder, true, true>(F.lds, g, S, E); } break;
    case 8: { pg8::Gemm g{(const pg8::bf16_t*)(ws + WS_HID), (const pg8::bf16_t*)(ws + WS_WDN), TT, DM, DFF}; pg8::StaticOrder S; S.init(TT, DM, F.G, (int)blockIdx.x);
        if (l < DEPTH - 1) { pg8::EpiResid<false> E{(pg8::bf16_t*)(ws + WS_XB), (float*)(ws + WS_ROWSQ), nullptr}; pg8::gemm_phase<pg8::EpiResid<false>, pg8::StaticOrder, true, true>(F.lds, g, S, E); }
        else { pg8::EpiResid<true> E{(pg8::bf16_t*)(ws + WS_XB), (float*)(ws + WS_ROWSQ), P.out}; pg8::gemm_phase<pg8::EpiResid<true>, pg8::StaticOrder, true, true>(F.lds, g, S, E); } } break;
    }
}

__global__ void __launch_bounds__(NTHR, 2) hgpm_fwd(Params P) {
    extern __shared__ __attribute__((aligned(16))) unsigned char lds_raw[];
    Frame F; F.lds = (LAS unsigned char*)lds_raw; F.tid = threadIdx.x; F.lane = F.tid & 63; F.wave = __builtin_amdgcn_readfirstlane(F.tid >> 6);
    F.G = gridDim.x; { const int bx = blockIdx.x; F.vb = (F.G % 8 == 0) ? (bx % 8) * (F.G / 8) + bx / 8 : bx; }
#if USE_CG_SYNC
    cg::grid_group grid = cg::this_grid();
#define GRID_SYNC() grid.sync()
#else
    volatile LAS unsigned* misc = (volatile LAS unsigned*)(F.lds + MISC_OFF);
    if (F.tid < 64) misc[F.tid] = 0u;
    __syncthreads();
    const XcdBarrier bar = xcd_barrier_post((unsigned*)(P.ws + WS_CTL) + 1024, misc + 8);
#define GRID_SYNC() xcd_barrier(bar)
#endif
    for (int ph = P.ph_lo; ph < P.ph_hi; ++ph) {
        run_phase(F, P, ph);
#ifdef DUPK
#ifndef DUPSUB
#define DUPSUB 0
#endif
        if (ph % PH_PER_LAYER == DUPK && ph != N_PHASES - 1 && (DUPK != 6 || ph < PH_PER_LAYER)) { GRID_SYNC(); run_phase(F, P, ph, DUPSUB); }
        if (DUPK == 23 && ph % PH_PER_LAYER == 3) { GRID_SYNC(); run_phase(F, P, ph - 1, 0); GRID_SYNC(); run_phase(F, P, ph, 0); }
#endif
        if (ph + 1 < P.ph_hi) GRID_SYNC();
    }
}

#ifndef N_LAUNCH_MODE
#define N_LAUNCH_MODE 0
#endif
extern "C" void kernel_launch(void* const* d_in, const int* in_sizes, int n_in, void* d_out, int out_size, void* d_ws, size_t ws_size, hipStream_t stream) {
    static int grid = 0;
    if (grid == 0) {
        if (n_in != 19 || in_sizes[0] != TT * DM || out_size != TT * DM || ws_size < WS_END) { fprintf(stderr, "kernel_launch: unexpected shapes (n_in %d, in0 %d, out %d, ws %zu)\n", n_in, n_in > 0 ? in_sizes[0] : -1, out_size, ws_size); grid = -1; return; }
        int dev = 0, cus = 0, per_cu = 0;
        if (hipGetDevice(&dev) != hipSuccess || hipDeviceGetAttribute(&cus, hipDeviceAttributeMultiprocessorCount, dev) != hipSuccess) { grid = -1; return; }
        if (hipFuncSetAttribute((const void*)hgpm_fwd, hipFuncAttributeMaxDynamicSharedMemorySize, LDS_BYTES) != hipSuccess) { fprintf(stderr, "kernel_launch: hipFuncSetAttribute failed\n"); grid = -1; return; }
        if (hipOccupancyMaxActiveBlocksPerMultiprocessor(&per_cu, (const void*)hgpm_fwd, NTHR, LDS_BYTES) != hipSuccess || per_cu < 1) { fprintf(stderr, "kernel_launch: occupancy query says %d blocks per CU\n", per_cu); per_cu = 1; }
        (void)hipGetLastError();
        grid = cus;
    }
    if (grid < 0) return;
    Params p{};
    p.x = (const float*)d_in[0]; p.pos = (const int*)d_in[1]; p.attn_norm = (const float*)d_in[2]; p.w_in = (const float*)d_in[3]; p.sgu_ln_g = (const float*)d_in[4]; p.sgu_ln_b = (const float*)d_in[5];
    p.sgu_w = (const float*)d_in[6]; p.sgu_b = (const float*)d_in[7]; p.sinks = (const float*)d_in[8]; p.conv_w = (const float*)d_in[9]; p.a_log = (const float*)d_in[10]; p.dt_bias = (const float*)d_in[11];
    p.dn_norm = (const float*)d_in[12]; p.w_branch = (const float*)d_in[13]; p.w_out = (const float*)d_in[14]; p.ffn_norm = (const float*)d_in[15]; p.w_gate_up = (const float*)d_in[16]; p.w_down = (const float*)d_in[17];
    p.final_norm = (const float*)d_in[18]; p.out = (float*)d_out; p.ws = (unsigned char*)d_ws;
#if N_LAUNCH_MODE == 0
    p.ph_lo = 0; p.ph_hi = N_PHASES;
#if USE_CG_SYNC
    void* args[] = {&p};
    hipError_t e = hipLaunchCooperativeKernel((const void*)hgpm_fwd, dim3(grid), dim3(NTHR), args, LDS_BYTES, stream);
    if (e != hipSuccess) fprintf(stderr, "kernel_launch: cooperative launch failed: %s (grid %d)\n", hipGetErrorString(e), grid);
#else
    if (hipMemsetAsync((char*)d_ws + WS_CTL, 0, CTL_ZERO_BYTES, stream) != hipSuccess) { fprintf(stderr, "kernel_launch: hipMemsetAsync failed\n"); return; }
    hipLaunchKernelGGL(hgpm_fwd, dim3(grid), dim3(NTHR), LDS_BYTES, stream, p);
#endif
#else
    for (int ph = 0; ph < N_PHASES; ++ph) { p.ph_lo = ph; p.ph_hi = ph + 1; hipLaunchKernelGGL(hgpm_fwd, dim3(grid), dim3(NTHR), LDS_BYTES, stream, p); }
#endif
}
```

```cpp
#include <hip/hip_runtime.h>
#include <hip/hip_cooperative_groups.h>
#include <cstdio>
#include <cstdint>
namespace cg = cooperative_groups;
namespace pg8 {
#define PG8_LAS __attribute__((address_space(3)))
typedef unsigned short bf16_t;
typedef short bf16x8 __attribute__((ext_vector_type(8)));
typedef float f32x4 __attribute__((ext_vector_type(4)));
typedef unsigned u32x4 __attribute__((ext_vector_type(4)));
constexpr int BM = 256, BK = 64, HALF = 128, HTB = HALF * BK * 2  , STAGE_BYTES = 8 * HTB, NXCD = 8, WGM = 8;

__host__ __device__ __forceinline__ int lds_byte(int r, int c) { const int st = (r >> 4) * 2 + (c >> 5), rr = r & 15, cc = c & 31, ob = rr * 64 + cc * 2; return st * 1024 + (ob ^ (((ob >> 9) & 1) << 5)); }
__host__ __device__ __forceinline__ void stage_rc(int b, int& R, int& C) { const int st = b / 1024, sb = b % 1024, swz = sb ^ (((sb >> 9) & 1) << 5); R = (st >> 1) * 16 + swz / 64; C = (st & 1) * 32 + (swz % 64) / 2; }
__host__ __device__ __forceinline__ int perm32(int rho) { const int n = rho >> 4, i = rho & 15; return 8 * (i >> 2) + 4 * n + (i & 3); }

struct Unit { int pm, pn, idx; };
struct Gemm { const bf16_t* A; const bf16_t* Bt; int M, N, K; };

struct StaticOrder {
    int nM, nN, nwg, G, c;
    __host__ __device__ void init(int M, int N, int G_, int c_) { nM = M / BM; nN = N / BM; nwg = nM * nN; G = G_; c = c_; }
    __host__ __device__ bool next(int i, Unit& u) const {
        const long L = (long)i * G + c; if (L >= nwg) return false;
        int wgid = (int)L; { const int q = nwg / NXCD, r = nwg % NXCD, xcd = wgid % NXCD, off = wgid / NXCD; wgid = (xcd < r ? xcd * (q + 1) : r * (q + 1) + (xcd - r) * q) + off; }
        const int nig = WGM * nN, gid = wgid / nig, fm = gid * WGM, gsz = (nM - fm) < WGM ? (nM - fm) : WGM;
        u.pm = fm + ((wgid % nig) % gsz); u.pn = (wgid % nig) / gsz; u.idx = i; return true;
    }
    __device__ __forceinline__ void a_ready(const Unit&) const {}
    __device__ __forceinline__ void done(const Unit&) const {}
};

typedef float f32x2 __attribute__((ext_vector_type(2)));
typedef __bf16 bf16v2 __attribute__((ext_vector_type(2)));
typedef unsigned u32x2 __attribute__((ext_vector_type(2)));
__device__ __forceinline__ unsigned pk2(float lo, float hi) { f32x2 v = {lo, hi}; bf16v2 r = __builtin_convertvector(v, bf16v2); return __builtin_bit_cast(unsigned, r); }
__device__ __forceinline__ float bflo(unsigned w) { return __uint_as_float(w << 16); }
__device__ __forceinline__ float bfhi(unsigned w) { return __uint_as_float(w & 0xffff0000u); }
__device__ __forceinline__ float fast_sigmoid(float x) { return __builtin_amdgcn_rcpf(1.0f + __expf(-x)); }
__device__ __forceinline__ float gelu_tanh(float x) { const float u = 1.5957691216f * (x + 0.044715f * x * x * x); return x * fast_sigmoid(u); }
constexpr float NORM_EPS = 1e-6f;
__device__ __forceinline__ float row_rstd(const float* rowsq, int row) {
    const f32x4* p = (const f32x4*)(rowsq + (size_t)row * 16); const f32x4 a = p[0], b = p[1], c = p[2], d = p[3];
    const float s = ((a.x + a.y) + (a.z + a.w)) + ((b.x + b.y) + (b.z + b.w)) + ((c.x + c.y) + (c.z + c.w)) + ((d.x + d.y) + (d.z + d.w));
    return __builtin_amdgcn_rsqf(s * (1.0f / 1024.0f) + NORM_EPS);
}
constexpr int LRS_OFF = STAGE_BYTES, LRS_MAX_UNITS = 8;
template <class Sched> __device__ __forceinline__ void prep_rstd(PG8_LAS unsigned char* lds, const Sched& S, const float* rowsq) {
    PG8_LAS float* t = (PG8_LAS float*)(lds + LRS_OFF); Unit u;
#pragma unroll 1
    for (int i = 0; i < LRS_MAX_UNITS; ++i) { if (!S.next(i, u)) break; if (threadIdx.x < 256) t[i * 256 + threadIdx.x] = row_rstd(rowsq, u.pm * BM + threadIdx.x); asm volatile("" ::: "memory"); }
    __syncthreads();
}
struct EpiProj {
    static constexpr bool PERM = true, AFTER_DRAIN = false;
    bf16_t *uv, *qkvb, *qkvc, *z; const PG8_LAS float* lrs; float* ba;
    __device__ __forceinline__ void operator()(const f32x4 (&acc)[2][2][4][2], const Unit& u, int wr, int wc, int fr, int fq) const {
        const int pn = u.pn; bf16_t* base; int ldc, colt; bool act = false;
        if (pn == 15) {
            if (wc == 0 && fq == 0) {
#pragma unroll
                for (int ai = 0; ai < 2; ++ai)
#pragma unroll
                    for (int m = 0; m < 4; ++m) { const int rl = wr * 64 + fr + ai * HALF + m * 16; const float rs = lrs[u.idx * 256 + rl]; float* bp = ba + (size_t)(u.pm * BM + rl) * 8;
                        *(f32x4*)bp = acc[ai][0][m][0] * rs; *(f32x4*)(bp + 4) = acc[ai][0][m][1] * rs; } }
            return; }
        if (pn < 4) { base = uv; ldc = 1024; colt = pn * 256; act = true; }
        else if (pn < 7) { base = qkvb; ldc = 768; colt = (pn - 4) * 256; }
        else if (pn < 13) { base = qkvc; ldc = 1536; colt = (pn - 7) * 256; }
        else { base = z; ldc = 512; colt = (pn - 13) * 256; }
        const int row0 = u.pm * BM + wr * 64 + fr, col0 = colt + wc * 32 + 8 * fq;
#pragma unroll
        for (int ai = 0; ai < 2; ++ai)
#pragma unroll
            for (int m = 0; m < 4; ++m) { const int row = row0 + ai * HALF + m * 16; const float rs = lrs[u.idx * 256 + (row - u.pm * BM)]; bf16_t* rowp = base + (size_t)row * ldc + col0;
#pragma unroll
                for (int bj = 0; bj < 2; ++bj) { f32x4 v0 = acc[ai][bj][m][0] * rs, v1 = acc[ai][bj][m][1] * rs;
                    if (act) {
#pragma unroll
                        for (int j = 0; j < 4; ++j) { v0[j] = gelu_tanh(v0[j]); v1[j] = gelu_tanh(v1[j]); } }
                    u32x4 w; w.x = pk2(v0[0], v0[1]); w.y = pk2(v0[2], v0[3]); w.z = pk2(v1[0], v1[1]); w.w = pk2(v1[2], v1[3]);
                    *(u32x4*)(rowp + bj * HALF) = w; } }
    }
};
struct EpiSig {
    static constexpr bool PERM = true, AFTER_DRAIN = false;
    bf16_t* sig; const PG8_LAS float* lrs;
    __device__ __forceinline__ void operator()(const f32x4 (&acc)[2][2][4][2], const Unit& u, int wr, int wc, int fr, int fq) const {
        const int row0 = u.pm * BM + wr * 64 + fr, col0 = u.pn * BM + wc * 32 + 8 * fq;
#pragma unroll
        for (int ai = 0; ai < 2; ++ai)
#pragma unroll
            for (int m = 0; m < 4; ++m) { const int row = row0 + ai * HALF + m * 16; const float rs = lrs[u.idx * 256 + (row - u.pm * BM)]; bf16_t* rowp = sig + (size_t)row * 1024 + col0;
#pragma unroll
                for (int bj = 0; bj < 2; ++bj) { f32x4 v0 = acc[ai][bj][m][0] * rs, v1 = acc[ai][bj][m][1] * rs;
#pragma unroll
                    for (int j = 0; j < 4; ++j) { v0[j] = fast_sigmoid(v0[j]); v1[j] = fast_sigmoid(v1[j]); }
                    u32x4 w; w.x = pk2(v0[0], v0[1]); w.y = pk2(v0[2], v0[3]); w.z = pk2(v1[0], v1[1]); w.w = pk2(v1[2], v1[3]);
                    *(u32x4*)(rowp + bj * HALF) = w; } }
    }
};
template <bool ACCUM> struct EpiMerge {
    static constexpr bool PERM = true, AFTER_DRAIN = false;
    const bf16_t* sig; bf16_t* mg;
    __device__ __forceinline__ void operator()(const f32x4 (&acc)[2][2][4][2], const Unit& u, int wr, int wc, int fr, int fq) const {
        const int row0 = u.pm * BM + wr * 64 + fr, col0 = u.pn * BM + wc * 32 + 8 * fq;
#pragma unroll
        for (int ai = 0; ai < 2; ++ai)
#pragma unroll
            for (int m = 0; m < 4; ++m) { const size_t off = (size_t)(row0 + ai * HALF + m * 16) * 1024 + col0;
#pragma unroll
                for (int bj = 0; bj < 2; ++bj) { const u32x4 s = *(const u32x4*)(sig + off + bj * HALF);
                    f32x4 v0 = acc[ai][bj][m][0], v1 = acc[ai][bj][m][1];
                    v0[0] *= bflo(s.x); v0[1] *= bfhi(s.x); v0[2] *= bflo(s.y); v0[3] *= bfhi(s.y); v1[0] *= bflo(s.z); v1[1] *= bfhi(s.z); v1[2] *= bflo(s.w); v1[3] *= bfhi(s.w);
                    if (ACCUM) { const u32x4 o = *(const u32x4*)(mg + off + bj * HALF);
                        v0[0] += bflo(o.x); v0[1] += bfhi(o.x); v0[2] += bflo(o.y); v0[3] += bfhi(o.y); v1[0] += bflo(o.z); v1[1] += bfhi(o.z); v1[2] += bflo(o.w); v1[3] += bfhi(o.w); }
                    u32x4 w; w.x = pk2(v0[0], v0[1]); w.y = pk2(v0[2], v0[3]); w.z = pk2(v1[0], v1[1]); w.w = pk2(v1[2], v1[3]); *(u32x4*)(mg + off + bj * HALF) = w; } }
    }
};
template <bool F32OUT> struct EpiResid {
    static constexpr bool PERM = true, AFTER_DRAIN = false;
    bf16_t* xb; float* rowsq; float* xout;
    __device__ __forceinline__ void operator()(const f32x4 (&acc)[2][2][4][2], const Unit& u, int wr, int wc, int fr, int fq) const {
        const int row0 = u.pm * BM + wr * 64 + fr, col0 = u.pn * BM + wc * 32 + 8 * fq;
#pragma unroll
        for (int ai = 0; ai < 2; ++ai)
#pragma unroll
            for (int m = 0; m < 4; ++m) { const int row = row0 + ai * HALF + m * 16; const size_t off = (size_t)row * 1024 + col0; float ss = 0.f;
#pragma unroll
                for (int bj = 0; bj < 2; ++bj) { const u32x4 xo = *(const u32x4*)(xb + off + bj * HALF);
                    f32x4 v0 = acc[ai][bj][m][0], v1 = acc[ai][bj][m][1];
                    v0[0] += bflo(xo.x); v0[1] += bfhi(xo.x); v0[2] += bflo(xo.y); v0[3] += bfhi(xo.y); v1[0] += bflo(xo.z); v1[1] += bfhi(xo.z); v1[2] += bflo(xo.w); v1[3] += bfhi(xo.w);
                    if (F32OUT) { *(f32x4*)(xout + off + bj * HALF) = v0; *(f32x4*)(xout + off + bj * HALF + 4) = v1; }
                    else { u32x4 w; w.x = pk2(v0[0], v0[1]); w.y = pk2(v0[2], v0[3]); w.z = pk2(v1[0], v1[1]); w.w = pk2(v1[2], v1[3]); *(u32x4*)(xb + off + bj * HALF) = w; }
                    ss += ((v0[0] * v0[0] + v0[1] * v0[1]) + (v0[2] * v0[2] + v0[3] * v0[3])) + ((v1[0] * v1[0] + v1[1] * v1[1]) + (v1[2] * v1[2] + v1[3] * v1[3])); }
                ss += __shfl_xor(ss, 16); ss += __shfl_xor(ss, 32);
                if (fq == 0) rowsq[(size_t)row * 16 + u.pn * 4 + wc] = ss; }
    }
};
struct EpiGU {
    static constexpr bool PERM = true, AFTER_DRAIN = false;
    bf16_t* hid; const PG8_LAS float* lrs;
    __device__ __forceinline__ void operator()(const f32x4 (&acc)[2][2][4][2], const Unit& u, int wr, int wc, int fr, int fq) const {
        const int row0 = u.pm * BM + wr * 64 + fr, col0 = u.pn * HALF + wc * 32 + 8 * fq;
#pragma unroll
        for (int ai = 0; ai < 2; ++ai)
#pragma unroll
            for (int m = 0; m < 4; ++m) { const int row = row0 + ai * HALF + m * 16; const float rs = lrs[u.idx * 256 + (row - u.pm * BM)];
                float o[8];
#pragma unroll
                for (int n = 0; n < 2; ++n)
#pragma unroll
                    for (int j = 0; j < 4; ++j) { const float g = acc[ai][0][m][n][j] * rs, up = acc[ai][1][m][n][j] * rs; o[n * 4 + j] = g * fast_sigmoid(g) * up; }
                u32x4 w; w.x = pk2(o[0], o[1]); w.y = pk2(o[2], o[3]); w.z = pk2(o[4], o[5]); w.w = pk2(o[6], o[7]);
                *(u32x4*)(hid + (size_t)row * 2816 + col0) = w; }
    }
};

template <class Epi, class Sched, bool ALIGN_EPI = false, bool SP2 = false>
__device__ __forceinline__ void gemm_phase(PG8_LAS unsigned char* lds, const Gemm g, const Sched& S, const Epi& E) {
    int tid_ = threadIdx.x; asm volatile("" : "+v"(tid_));
    const int tid = tid_, wid = __builtin_amdgcn_readfirstlane(tid >> 6), lane = tid & 63, wr = wid >> 2, wc = wid & 3, fr = lane & 15, fq = lane >> 4;
    const int K = g.K, nt = K / BK;
    unsigned voffA[2], voffB[2];
#pragma unroll
    for (int i = 0; i < 2; ++i) { int R, C; stage_rc(tid * 16 + i * 8192, R, C); const int Rb = Epi::PERM ? ((R & ~31) + perm32(R & 31)) : R;
        voffA[i] = (unsigned)(R * K + C) * 2u; voffB[i] = (unsigned)(Rb * K + C) * 2u; }
    const size_t kstep = (size_t)(BK * 2);
    const size_t hstep = (size_t)HALF * K * 2;
    const size_t tstep = 2 * hstep;
    const unsigned ldsw = (unsigned)wid * 1024u;
    const int aoff = lds_byte(wr * 64 + fr, fq * 8), boff = lds_byte(wc * 32 + fr, fq * 8);
#define PG8_SA(b, h) (((b) * 2 + (h)) * HTB)
#define PG8_SB(b, h) ((4 + (b) * 2 + (h)) * HTB)
#define PG8_STAGE(bufoff, gbase, voff) do { _Pragma("unroll") for (int _i = 0; _i < 2; ++_i) \
        __builtin_amdgcn_global_load_lds((const unsigned*)((const char*)(gbase) + (voff)[_i]), (PG8_LAS unsigned*)(lds + (bufoff) + ldsw + _i * 8192), 16, 0, 0); } while (0)
#define PG8_LDA(dst, b, h) do { _Pragma("unroll") for (int m = 0; m < 4; ++m) _Pragma("unroll") for (int k = 0; k < 2; ++k) dst[m][k] = *(const PG8_LAS bf16x8*)(lds + PG8_SA(b, h) + aoff + m * 2048 + k * 1024); } while (0)
#define PG8_LDB(dst, b, h) do { _Pragma("unroll") for (int n = 0; n < 2; ++n) _Pragma("unroll") for (int k = 0; k < 2; ++k) dst[n][k] = *(const PG8_LAS bf16x8*)(lds + PG8_SB(b, h) + boff + n * 2048 + k * 1024); } while (0)
#define PG8_MMA(ai, bj, At, Bt) do { __builtin_amdgcn_s_setprio(1); _Pragma("unroll") for (int m = 0; m < 4; ++m) _Pragma("unroll") for (int n = 0; n < 2; ++n) _Pragma("unroll") for (int k = 0; k < 2; ++k) \
        acc[ai][bj][m][n] = __builtin_amdgcn_mfma_f32_16x16x32_bf16(Bt[n][k], At[m][k], acc[ai][bj][m][n], 0, 0, 0); __builtin_amdgcn_s_setprio(0); } while (0)
#define PG8_WAIT_V(n) asm volatile("s_waitcnt vmcnt(" #n ")" ::: "memory")
#define PG8_WAIT_L(n) asm volatile("s_waitcnt lgkmcnt(" #n ")" ::: "memory")
#define PG8_BAR __builtin_amdgcn_s_barrier()
#define PG8_SCHED __builtin_amdgcn_sched_barrier(0)
    Unit cur, nxt; int ui = 0;
    if (!S.next(0, cur)) return;
    f32x4 acc[2][2][4][2];
#pragma unroll
    for (int a = 0; a < 2; ++a)
#pragma unroll
        for (int b = 0; b < 2; ++b)
#pragma unroll
            for (int m = 0; m < 4; ++m)
#pragma unroll
                for (int n = 0; n < 2; ++n) acc[a][b][m][n] = (f32x4){0.f, 0.f, 0.f, 0.f};
    bf16x8 At[4][2], B0[2][2], B1[2][2];
    const char* cA = (const char*)g.A + (size_t)cur.pm * tstep; const char* cB = (const char*)g.Bt + (size_t)cur.pn * tstep;
    S.a_ready(cur);
    if constexpr (SP2) {
        PG8_STAGE(PG8_SB(0, 0), cB, voffB); PG8_STAGE(PG8_SB(0, 1), cB + hstep, voffB); PG8_STAGE(PG8_SA(0, 0), cA, voffA); PG8_STAGE(PG8_SA(0, 1), cA + hstep, voffA);
        if (wr == 1) PG8_BAR;
        PG8_WAIT_V(2); PG8_BAR;
        PG8_STAGE(PG8_SB(1, 0), cB + kstep, voffB); PG8_STAGE(PG8_SA(1, 0), cA + kstep, voffA); PG8_STAGE(PG8_SB(1, 1), cB + hstep + kstep, voffB);
        PG8_WAIT_V(6); PG8_BAR;
    } else {
        PG8_STAGE(PG8_SB(0, 0), cB, voffB); PG8_STAGE(PG8_SA(0, 0), cA, voffA); PG8_STAGE(PG8_SB(0, 1), cB + hstep, voffB); PG8_STAGE(PG8_SA(0, 1), cA + hstep, voffA);
        if (wr == 1) PG8_BAR;
        PG8_WAIT_V(4); PG8_BAR;
        PG8_STAGE(PG8_SB(1, 0), cB + kstep, voffB); PG8_STAGE(PG8_SA(1, 0), cA + kstep, voffA); PG8_STAGE(PG8_SB(1, 1), cB + hstep + kstep, voffB);
        PG8_WAIT_V(6); PG8_BAR;
    }
    for (;;) {
        const bool has_next = S.next(ui + 1, nxt);
        const char* nA = has_next ? (const char*)g.A + (size_t)nxt.pm * tstep : cA; const char* nB = has_next ? (const char*)g.Bt + (size_t)nxt.pn * tstep : cB;
        for (int t = 0; t < nt; t += 2) {
            const bool last = (t == nt - 2);
            const char* a1 = cA + (size_t)(t + 1) * kstep;
            const char* a2 = last ? nA : cA + (size_t)(t + 2) * kstep; const char* b2 = last ? nB : cB + (size_t)(t + 2) * kstep;
            const char* a3 = a2 + kstep; const char* b3 = b2 + kstep;
            if (last && has_next) S.a_ready(nxt);
            if constexpr (SP2) {
            PG8_LDB(B0, 0, 0); PG8_LDB(B1, 0, 1); PG8_SCHED; PG8_LDA(At, 0, 0); PG8_STAGE(PG8_SA(1, 1), a1 + hstep, voffA);
            PG8_WAIT_V(8); PG8_WAIT_L(0); PG8_BAR; PG8_MMA(0, 0, At, B0); PG8_MMA(0, 1, At, B1); PG8_BAR; PG8_SCHED;
            PG8_LDA(At, 0, 1); PG8_STAGE(PG8_SB(0, 0), b2, voffB); PG8_STAGE(PG8_SB(0, 1), b2 + hstep, voffB); PG8_STAGE(PG8_SA(0, 0), a2, voffA);
            PG8_WAIT_V(8); PG8_WAIT_L(0); PG8_BAR; PG8_MMA(1, 0, At, B0); PG8_MMA(1, 1, At, B1); PG8_BAR; PG8_SCHED;
            PG8_LDB(B0, 1, 0); PG8_LDB(B1, 1, 1); PG8_SCHED; PG8_LDA(At, 1, 0); PG8_STAGE(PG8_SA(0, 1), a2 + hstep, voffA);
            PG8_WAIT_V(8); PG8_WAIT_L(0); PG8_BAR; PG8_MMA(0, 0, At, B0); PG8_MMA(0, 1, At, B1); PG8_BAR; PG8_SCHED;
            PG8_LDA(At, 1, 1); PG8_STAGE(PG8_SB(1, 0), b3, voffB); PG8_STAGE(PG8_SB(1, 1), b3 + hstep, voffB); PG8_STAGE(PG8_SA(1, 0), a3, voffA);
            PG8_WAIT_V(8); PG8_WAIT_L(0); PG8_BAR; PG8_MMA(1, 0, At, B0); PG8_MMA(1, 1, At, B1); PG8_BAR; PG8_SCHED;
            } else {
            PG8_LDB(B0, 0, 0); PG8_SCHED; PG8_LDA(At, 0, 0); PG8_STAGE(PG8_SA(1, 1), a1 + hstep, voffA);
            PG8_WAIT_L(8); PG8_BAR; PG8_WAIT_L(0); PG8_MMA(0, 0, At, B0); PG8_BAR; PG8_SCHED;
            PG8_LDB(B1, 0, 1); PG8_STAGE(PG8_SB(0, 0), b2, voffB);
            PG8_BAR; PG8_WAIT_L(0); PG8_MMA(0, 1, At, B1); PG8_BAR;
            PG8_LDA(At, 0, 1); PG8_STAGE(PG8_SA(0, 0), a2, voffA);
            PG8_BAR; PG8_WAIT_L(0); PG8_MMA(1, 0, At, B0); PG8_BAR; PG8_SCHED;
            PG8_STAGE(PG8_SB(0, 1), b2 + hstep, voffB);
            PG8_WAIT_V(6); PG8_BAR; PG8_MMA(1, 1, At, B1); PG8_BAR;
            PG8_LDB(B0, 1, 0); PG8_SCHED; PG8_LDA(At, 1, 0); PG8_STAGE(PG8_SA(0, 1), a2 + hstep, voffA);
            PG8_WAIT_L(8); PG8_BAR; PG8_WAIT_L(0); PG8_MMA(0, 0, At, B0); PG8_BAR; PG8_SCHED;
            PG8_LDB(B1, 1, 1); PG8_STAGE(PG8_SB(1, 0), b3, voffB);
            PG8_BAR; PG8_WAIT_L(0); PG8_MMA(0, 1, At, B1); PG8_BAR;
            PG8_LDA(At, 1, 1); PG8_STAGE(PG8_SA(1, 0), a3, voffA);
            PG8_BAR; PG8_WAIT_L(0); PG8_MMA(1, 0, At, B0); PG8_BAR; PG8_SCHED;
            PG8_STAGE(PG8_SB(1, 1), b3 + hstep, voffB);
            PG8_WAIT_V(6); PG8_BAR; PG8_MMA(1, 1, At, B1); PG8_BAR;
            }
        }
        if constexpr (ALIGN_EPI) { if (wr == 0) PG8_BAR; }
        if constexpr (!Epi::AFTER_DRAIN) { E(acc, cur, wr, wc, fr, fq); S.done(cur); }
        if (!has_next) break;
#pragma unroll
        for (int a = 0; a < 2; ++a)
#pragma unroll
            for (int b = 0; b < 2; ++b)
#pragma unroll
                for (int m = 0; m < 4; ++m)
#pragma unroll
                    for (int n = 0; n < 2; ++n) acc[a][b][m][n] = (f32x4){0.f, 0.f, 0.f, 0.f};
        cur = nxt; cA = nA; cB = nB; ++ui;
        if constexpr (ALIGN_EPI) { if (wr == 1) PG8_BAR; }
    }
    PG8_WAIT_V(0);
    if constexpr (!ALIGN_EPI) { if (wr == 0) PG8_BAR; }
    PG8_BAR;
    if constexpr (Epi::AFTER_DRAIN) { E.fused(acc, cur, wr, wc, fr, fq, lds, wid, lane); S.done(cur); }
#undef PG8_SA
#undef PG8_SB
#undef PG8_STAGE
#undef PG8_LDA
#undef PG8_LDB
#undef PG8_MMA
#undef PG8_WAIT_V
#undef PG8_WAIT_L
#undef PG8_BAR
#undef PG8_SCHED
}
}

#ifndef USE_CG_SYNC
#define USE_CG_SYNC 0
#endif
constexpr int NWAVES = 8, NTHR = 512;
constexpr int TT = 16384, SEQ = 8192, DM = 1024, DEPTH = 2, INC = 6920, DFF = 2816;
constexpr int C_QKVC = 1792, C_BETA = 3840, C_GATE = 3848;
constexpr int NMIX = 3840, NMIXP = 4096;
constexpr size_t MiB = 1u << 20, KiB = 1u << 10;
constexpr size_t WS_CTL = 0, CTL_ZERO_BYTES = 64 * KiB;
constexpr size_t WS_ROWSQ = 1 * MiB;
constexpr size_t WS_BA = 2 * MiB;
constexpr size_t WS_CD = 2 * MiB + 512 * KiB;
constexpr size_t WS_WBA = WS_CD + 64 * KiB;
constexpr size_t WS_SGUW = 2 * MiB + 768 * KiB;
constexpr size_t WS_WIN = 3 * MiB;
constexpr size_t WS_WG = WS_WIN + 4096 * 1024 * 2;
constexpr size_t WS_WBR = WS_WG + 3072 * 1024 * 2;
constexpr size_t WS_WOUT = WS_WBR + 3 * 1024 * 512 * 2;
constexpr size_t WS_XB = 22 * MiB;
constexpr size_t WS_UV = 54 * MiB;
constexpr size_t WS_QKVB = 86 * MiB;
constexpr size_t WS_WGU = WS_QKVB;
constexpr size_t WS_WDN = WS_QKVB + 5632 * 1024 * 2;
constexpr size_t WS_QKVC = 110 * MiB;
constexpr size_t WS_BR = WS_QKVC;
constexpr size_t WS_Z = 158 * MiB;
constexpr size_t WS_DN = 174 * MiB;
constexpr size_t WS_HID = 110 * MiB;
constexpr size_t WS_END = 246 * MiB;
static_assert(WS_WOUT + 1024 * 1024 * 2 <= WS_XB && WS_WDN + 1024 * 2816 * 2 <= WS_QKVC && WS_HID + (size_t)TT * DFF * 2 <= WS_END && WS_DN + 1024 * 72 * KiB <= WS_END, "ws map");
constexpr int DN_TASK_BYTES = 73728, DN_OFF_W = 0, DN_OFF_QD = 16384, DN_OFF_AT = 32768, DN_OFF_KD = 40960, DN_OFF_U = 57344;
constexpr int LDS_BYTES = 163840, MISC_OFF = LDS_BYTES - 256;

#define LAS __attribute__((address_space(3)))
typedef unsigned short bf16;
typedef float f32x4 __attribute__((ext_vector_type(4)));
typedef float f32x16 __attribute__((ext_vector_type(16)));
typedef short bf16x8 __attribute__((ext_vector_type(8)));
typedef unsigned u32x4 __attribute__((ext_vector_type(4)));
typedef unsigned u32x2 __attribute__((ext_vector_type(2)));
using pg8::pk2; using pg8::bflo; using pg8::bfhi; using pg8::fast_sigmoid; using pg8::NORM_EPS;
#define MFMA32(a, b, c) __builtin_amdgcn_mfma_f32_32x32x16_bf16((a), (b), (c), 0, 0, 0)
__device__ __forceinline__ int crow(int reg, int h) { return (reg & 3) + 8 * (reg >> 2) + 4 * h; }
__device__ __forceinline__ bf16x8 pack_step(const f32x16& x, int s) {
    u32x4 p; p.x = pk2(x[8 * s], x[8 * s + 1]); p.y = pk2(x[8 * s + 2], x[8 * s + 3]); p.z = pk2(x[8 * s + 4], x[8 * s + 5]); p.w = pk2(x[8 * s + 6], x[8 * s + 7]);
    return __builtin_bit_cast(bf16x8, p);
}
__device__ __forceinline__ float wave_sum(float v) {
#pragma unroll
    for (int o = 1; o < 64; o <<= 1) v += __shfl_xor(v, o);
    return v;
}
__device__ __forceinline__ f32x16 zero16() { f32x16 z; for (int i = 0; i < 16; ++i) z[i] = 0.f; return z; }

struct Params {
    const float* x; const int* pos; const float* attn_norm; const float* w_in; const float* sgu_ln_g; const float* sgu_ln_b; const float* sgu_w; const float* sgu_b;
    const float* sinks; const float* conv_w; const float* a_log; const float* dt_bias; const float* dn_norm; const float* w_branch; const float* w_out; const float* ffn_norm;
    const float* w_gate_up; const float* w_down; const float* final_norm;
    float* out; unsigned char* ws; int ph_lo, ph_hi;
};
struct Frame { LAS unsigned char* lds; int tid, lane, wave, vb, G; };

constexpr int TR_SCR = 64 * 68 * 4;
template <int MAP> __device__ __forceinline__ void transpose_item(const float* W, int ldw, int ncol0, int K, int N, const float* kscale, bf16* WT, LAS float* scr, int item, int lane) {
    const int nblk = N / 64, kb = item / nblk, nb = item % nblk, k0 = 64 * kb, n0 = 64 * nb, r4 = lane >> 4, c4 = lane & 15;
    f32x4 v[16];
#pragma unroll
    for (int i = 0; i < 16; ++i) v[i] = *(const f32x4*)(W + (size_t)(k0 + 4 * i + r4) * ldw + ncol0 + n0 + 4 * c4);
    if (kscale) {
#pragma unroll
        for (int i = 0; i < 16; ++i) v[i] = v[i] * kscale[k0 + 4 * i + r4]; }
#pragma unroll
    for (int i = 0; i < 16; ++i) { const int r = 4 * i + r4; *(LAS f32x4*)(scr + r * 68 + ((4 * c4 + 4 * (r >> 3)) & 63)) = v[i]; }
    asm volatile("s_waitcnt lgkmcnt(0)" ::: "memory");
    const int kc = lane & 7, nn = lane >> 3;
#pragma unroll
    for (int j = 0; j < 8; ++j) { const int n = nn + 8 * j; const LAS float* sp = scr + (8 * kc) * 68 + ((n + 4 * kc) & 63);
        u32x4 o; o.x = pk2(sp[0 * 68], sp[1 * 68]); o.y = pk2(sp[2 * 68], sp[3 * 68]); o.z = pk2(sp[4 * 68], sp[5 * 68]); o.w = pk2(sp[6 * 68], sp[7 * 68]);
        const int gn = n0 + n; int dr = gn;
        if (MAP == 1) { const int f = gn < DFF ? gn : gn - DFF; dr = (f >> 7) * 256 + (gn < DFF ? 0 : 128) + (f & 127); }
        *(u32x4*)(WT + (size_t)dr * K + k0 + 8 * kc) = o; }
    asm volatile("s_waitcnt lgkmcnt(0)" ::: "memory");
}
__device__ __forceinline__ void p0_attn_weights(const Frame& F, const Params& P, int l) {
    LAS float* scr = (LAS float*)(F.lds + F.wave * TR_SCR);
    const int gw = F.vb * NWAVES + F.wave, NGW = F.G * NWAVES;
    const float* win = P.w_in + (size_t)l * DM * INC; const float* an = P.attn_norm + l * DM;
    constexpr int I_MIX = 16 * (NMIX / 64), I_G = 16 * (3072 / 64), I_BR = 8 * 16, I_O = 16 * 16, NIT = I_MIX + I_G + 3 * I_BR + I_O;
#pragma unroll 1
    for (int it = gw; it < NIT; it += NGW) {
        int r = it;
        if (r < I_MIX) { transpose_item<0>(win, INC, 0, DM, NMIX, an, (bf16*)(P.ws + WS_WIN), scr, r, F.lane); continue; } r -= I_MIX;
        if (r < I_G) { transpose_item<0>(win, INC, C_GATE, DM, 3072, an, (bf16*)(P.ws + WS_WG), scr, r, F.lane); continue; } r -= I_G;
        if (r < 3 * I_BR) { const int n = r / I_BR; transpose_item<0>(P.w_branch + ((size_t)l * 3 + n) * 512 * 1024, 1024, 0, 512, 1024, nullptr, (bf16*)(P.ws + WS_WBR) + (size_t)n * 1024 * 512, scr, r % I_BR, F.lane); continue; } r -= 3 * I_BR;
        transpose_item<0>(P.w_out + (size_t)l * DM * DM, DM, 0, DM, DM, nullptr, (bf16*)(P.ws + WS_WOUT), scr, r, F.lane);
    }
    bf16* wpad = (bf16*)(P.ws + WS_WIN) + (size_t)NMIX * DM;
    const int gi = F.vb * NTHR + F.tid;
    if (F.vb < 16) { const int c = gi >> 10, k = gi & 1023; wpad[gi] = (bf16)(pk2(win[(size_t)k * INC + C_BETA + c] * an[k], 0.f) & 0xffffu); }
    if (F.vb < 62) { unsigned zz = 0u; asm volatile("" : "+v"(zz)); ((u32x4*)(wpad + 8 * DM))[gi] = (u32x4){zz, zz, zz, zz}; }
    if (F.vb < 64) { bf16* sw = (bf16*)(P.ws + WS_SGUW); const float* sgw = P.sgu_w + (size_t)l * 4 * 128 * 128;
        const int e = 2 * gi, sx = e & 127, t = (e >> 7) & 127; const float a = sx <= t ? sgw[e] : 0.f, bq = (sx + 1) <= t ? sgw[e + 1] : 0.f; ((unsigned*)sw)[gi] = pk2(a, bq); }
}
__device__ __forceinline__ void p0_ffn_weights(const Frame& F, const Params& P, int l) {
    LAS float* scr = (LAS float*)(F.lds + F.wave * TR_SCR);
    const int gw = F.vb * NWAVES + F.wave, NGW = F.G * NWAVES;
    constexpr int I_GU = 16 * (2 * DFF / 64), I_DN = (DFF / 64) * 16, NIT = I_GU + I_DN;
#pragma unroll 1
    for (int it = gw; it < NIT; it += NGW) {
        if (it < I_GU) transpose_item<1>(P.w_gate_up + (size_t)l * DM * 2 * DFF, 2 * DFF, 0, DM, 2 * DFF, P.ffn_norm + l * DM, (bf16*)(P.ws + WS_WGU), scr, it, F.lane);
        else transpose_item<0>(P.w_down + (size_t)l * DFF * DM, DM, 0, DFF, DM, nullptr, (bf16*)(P.ws + WS_WDN), scr, it - I_GU, F.lane);
    }
}
__device__ __forceinline__ void p0_input(const Frame& F, const Params& P) {
    const int gw = F.vb * NWAVES + F.wave, NGW = F.G * NWAVES;
    bf16* xb = (bf16*)(P.ws + WS_XB); float* rowsq = (float*)(P.ws + WS_ROWSQ);
    for (int m = gw; m < TT; m += NGW) {
        const f32x4* xr = (const f32x4*)(P.x + (size_t)m * DM) + F.lane; float s = 0.f;
        unsigned long long* o8 = (unsigned long long*)(xb + (size_t)m * DM) + F.lane;
#pragma unroll
        for (int j = 0; j < 4; ++j) { const f32x4 v = xr[64 * j]; s += (v.x * v.x + v.y * v.y) + (v.z * v.z + v.w * v.w); o8[64 * j] = (unsigned long long)pk2(v.x, v.y) | ((unsigned long long)pk2(v.z, v.w) << 32); }
        s = wave_sum(s);
        if (F.lane < 16) rowsq[(size_t)m * 16 + F.lane] = F.lane == 0 ? s : 0.f;
    }
}
__device__ __forceinline__ void sgu_task(const Frame& F, const Params& P, int l, int task) {
    const int g = task & 3, cb = task >> 2, m0 = cb * 128;
    const bf16* uv = (const bf16*)(P.ws + WS_UV); bf16* bra = (bf16*)(P.ws + WS_BR);
    LAS bf16* vnT = (LAS bf16*)F.lds;
    const int r = F.tid >> 2, qq = F.tid & 3;
    { const bf16* vrow = uv + (size_t)(m0 + r) * 1024 + 512 + qq * 128; float s = 0.f, s2 = 0.f;
#pragma unroll
      for (int j = 0; j < 16; ++j) { const u32x4 w = *(const u32x4*)(vrow + 8 * j); const float a0 = bflo(w.x), a1 = bfhi(w.x), a2 = bflo(w.y), a3 = bfhi(w.y), a4 = bflo(w.z), a5 = bfhi(w.z), a6 = bflo(w.w), a7 = bfhi(w.w);
          s += ((a0 + a1) + (a2 + a3)) + ((a4 + a5) + (a6 + a7)); s2 += ((a0 * a0 + a1 * a1) + (a2 * a2 + a3 * a3)) + ((a4 * a4 + a5 * a5) + (a6 * a6 + a7 * a7)); }
      s += __shfl_xor(s, 1); s += __shfl_xor(s, 2); s2 += __shfl_xor(s2, 1); s2 += __shfl_xor(s2, 2);
      const float mean = s * (1.f / 512.f); float var = s2 * (1.f / 512.f) - mean * mean; var = var > 0.f ? var : 0.f; const float rstd = __builtin_amdgcn_rsqf(var + NORM_EPS);
      const bf16* vg = uv + (size_t)(m0 + r) * 1024 + 512 + g * 128 + qq * 32; const float* lg = P.sgu_ln_g + l * 512 + g * 128 + qq * 32; const float* lb = P.sgu_ln_b + l * 512 + g * 128 + qq * 32;
#pragma unroll
      for (int j = 0; j < 4; ++j) { const u32x4 w = *(const u32x4*)(vg + 8 * j); const float a[8] = {bflo(w.x), bfhi(w.x), bflo(w.y), bfhi(w.y), bflo(w.z), bfhi(w.z), bflo(w.w), bfhi(w.w)};
#pragma unroll
          for (int i = 0; i < 8; ++i) { const int c = qq * 32 + 8 * j + i; const float y = (a[i] - mean) * rstd * lg[8 * j + i] + lb[8 * j + i]; vnT[c * 136 + r] = (bf16)(pk2(y, 0.f) & 0xffffu); } }
    }
    __syncthreads();
    const int lr = F.lane & 31, h = F.lane >> 5, ct = F.wave >> 1;
    const bf16* sw = (const bf16*)(P.ws + WS_SGUW) + (size_t)g * 128 * 128;
#pragma unroll
    for (int t2 = 0; t2 < 2; ++t2) { const int tt = 2 * (F.wave & 1) + t2; f32x16 acc = zero16();
        for (int ks = 0; ks < 2 * (tt + 1); ++ks) {
            const bf16x8 a = *(const LAS bf16x8*)(vnT + (32 * ct + lr) * 136 + 16 * ks + 8 * h);
            const bf16x8 b = *(const bf16x8*)(sw + (size_t)(32 * tt + lr) * 128 + 16 * ks + 8 * h);
            acc = MFMA32(a, b, acc); }
        const int t = 32 * tt + lr; const float bias = P.sgu_b[l * 512 + g * 128 + t];
#pragma unroll
        for (int gq = 0; gq < 4; ++gq) { const int c0 = 32 * ct + 8 * gq + 4 * h; const u32x2 uu = *(const u32x2*)(uv + (size_t)(m0 + t) * 1024 + g * 128 + c0);
            u32x2 o; o.x = pk2(bflo(uu.x) * (acc[4 * gq] + bias), bfhi(uu.x) * (acc[4 * gq + 1] + bias)); o.y = pk2(bflo(uu.y) * (acc[4 * gq + 2] + bias), bfhi(uu.y) * (acc[4 * gq + 3] + bias));
            *(u32x2*)(bra + (size_t)(m0 + t) * 512 + g * 128 + c0) = o; } }
    __syncthreads();
}

__device__ __forceinline__ void swa_task(const Frame& F, const Params& P, int l, int task) {
    const int kvh = task & 1, cb = task >> 1, nq = cb & 63, m0 = cb * 128;
    const bf16* qkvb = (const bf16*)(P.ws + WS_QKVB); bf16* brb = (bf16*)(P.ws + WS_BR) + (size_t)TT * 512;
    LAS bf16* Qs = (LAS bf16*)F.lds;
    LAS bf16* Ks = (LAS bf16*)(F.lds + 73728);
    LAS bf16* VT = (LAS bf16*)(F.lds + 110592);
    for (int i = F.tid; i < 4096; i += NTHR) { const int g = i >> 10, r = (i >> 3) & 127, c8 = i & 7; if (c8 < 2) continue;
        const u32x4 w = *(const u32x4*)(qkvb + (size_t)(m0 + r) * 768 + (kvh * 4 + g) * 64 + c8 * 8);
        u32x4 o; o.x = pk2(bflo(w.x) * 0.125f, bfhi(w.x) * 0.125f); o.y = pk2(bflo(w.y) * 0.125f, bfhi(w.y) * 0.125f); o.z = pk2(bflo(w.z) * 0.125f, bfhi(w.z) * 0.125f); o.w = pk2(bflo(w.w) * 0.125f, bfhi(w.w) * 0.125f);
        *(LAS u32x4*)(Qs + (g * 128 + r) * 72 + c8 * 8) = o; }
    const float invf[8] = {1.0f, 0.19392274474868576f, 0.03760603093086393f, 0.007292664737217109f, 0.001414213562373095f, 0.0002742481756762073f, 5.318295896944988e-05f, 1.031338537721246e-05f};
    { const int g = F.tid >> 7, r = F.tid & 127; const float pos = (float)P.pos[m0 + r];
      const bf16* src = qkvb + (size_t)(m0 + r) * 768 + (kvh * 4 + g) * 64; const u32x4 w1 = *(const u32x4*)src, w2 = *(const u32x4*)(src + 8);
      const float x1[8] = {bflo(w1.x), bfhi(w1.x), bflo(w1.y), bfhi(w1.y), bflo(w1.z), bfhi(w1.z), bflo(w1.w), bfhi(w1.w)}, x2[8] = {bflo(w2.x), bfhi(w2.x), bflo(w2.y), bfhi(w2.y), bflo(w2.z), bfhi(w2.z), bflo(w2.w), bfhi(w2.w)};
      float o1[8], o2[8];
#pragma unroll
      for (int i = 0; i < 8; ++i) { float sn, cs; sincosf(pos * invf[i], &sn, &cs); o1[i] = (x1[i] * cs - x2[i] * sn) * 0.125f; o2[i] = (x2[i] * cs + x1[i] * sn) * 0.125f; }
      u32x4 a, b; a.x = pk2(o1[0], o1[1]); a.y = pk2(o1[2], o1[3]); a.z = pk2(o1[4], o1[5]); a.w = pk2(o1[6], o1[7]); b.x = pk2(o2[0], o2[1]); b.y = pk2(o2[2], o2[3]); b.z = pk2(o2[4], o2[5]); b.w = pk2(o2[6], o2[7]);
      *(LAS u32x4*)(Qs + (g * 128 + r) * 72) = a; *(LAS u32x4*)(Qs + (g * 128 + r) * 72 + 8) = b; }
    for (int i = F.tid; i < 2048; i += NTHR) { const int s = i >> 3, c8 = i & 7; const bool ok = nq > 0 || s >= 128; const size_t row = (size_t)(m0 - 128 + s);
        u32x4 kw = {0u, 0u, 0u, 0u}, vw = {0u, 0u, 0u, 0u};
        if (ok) { if (c8 >= 2) kw = *(const u32x4*)(qkvb + row * 768 + 512 + kvh * 64 + c8 * 8); vw = *(const u32x4*)(qkvb + row * 768 + 640 + kvh * 64 + c8 * 8); }
        if (c8 >= 2) *(LAS u32x4*)(Ks + s * 72 + c8 * 8) = kw;
        const int p = (s & ~12) | ((s & 4) << 1) | ((s & 8) >> 1); const unsigned vv[4] = {vw.x, vw.y, vw.z, vw.w};
#pragma unroll
        for (int j = 0; j < 4; ++j) { VT[(c8 * 8 + 2 * j) * 264 + p] = (bf16)(vv[j] & 0xffffu); VT[(c8 * 8 + 2 * j + 1) * 264 + p] = (bf16)(vv[j] >> 16); } }
    if (F.tid < 256) { const int s = F.tid; const bool ok = nq > 0 || s >= 128; u32x4 a = {0u, 0u, 0u, 0u}, b = {0u, 0u, 0u, 0u};
        if (ok) { const size_t row = (size_t)(m0 - 128 + s); const float pos = (float)P.pos[row]; const bf16* src = qkvb + row * 768 + 512 + kvh * 64; const u32x4 w1 = *(const u32x4*)src, w2 = *(const u32x4*)(src + 8);
            const float x1[8] = {bflo(w1.x), bfhi(w1.x), bflo(w1.y), bfhi(w1.y), bflo(w1.z), bfhi(w1.z), bflo(w1.w), bfhi(w1.w)}, x2[8] = {bflo(w2.x), bfhi(w2.x), bflo(w2.y), bfhi(w2.y), bflo(w2.z), bfhi(w2.z), bflo(w2.w), bfhi(w2.w)};
            float o1[8], o2[8];
#pragma unroll
            for (int i = 0; i < 8; ++i) { float sn, cs; sincosf(pos * invf[i], &sn, &cs); o1[i] = x1[i] * cs - x2[i] * sn; o2[i] = x2[i] * cs + x1[i] * sn; }
            a.x = pk2(o1[0], o1[1]); a.y = pk2(o1[2], o1[3]); a.z = pk2(o1[4], o1[5]); a.w = pk2(o1[6], o1[7]); b.x = pk2(o2[0], o2[1]); b.y = pk2(o2[2], o2[3]); b.z = pk2(o2[4], o2[5]); b.w = pk2(o2[6], o2[7]); }
        *(LAS u32x4*)(Ks + s * 72) = a; *(LAS u32x4*)(Ks + s * 72 + 8) = b; }
    __syncthreads();
    const int lr = F.lane & 31, h = F.lane >> 5, g = F.wave >> 1, qh = F.wave & 1;
    const float sink = P.sinks[l * 8 + kvh * 4 + g];
#pragma unroll 1
    for (int q2 = 0; q2 < 2; ++q2) { const int qt = 2 * qh + q2, q0 = 32 * qt, qi = q0 + lr;
        bf16x8 bq[4];
#pragma unroll
        for (int ks = 0; ks < 4; ++ks) bq[ks] = *(const LAS bf16x8*)(Qs + (g * 128 + q0 + lr) * 72 + 16 * ks + 8 * h);
        f32x16 sc[5];
#pragma unroll
        for (int k5 = 0; k5 < 5; ++k5) { sc[k5] = zero16();
#pragma unroll
            for (int ks = 0; ks < 4; ++ks) { const bf16x8 a = *(const LAS bf16x8*)(Ks + (32 * (qt + k5) + lr) * 72 + 16 * ks + 8 * h); sc[k5] = MFMA32(a, bq[ks], sc[k5]); } }
        float mx = sink;
#pragma unroll
        for (int k5 = 0; k5 < 5; ++k5)
#pragma unroll
            for (int rg = 0; rg < 16; ++rg) { const int sj = 32 * (qt + k5) + crow(rg, h); const bool ok = sj >= qi + 1 && sj <= qi + 128 && (nq > 0 || sj >= 128);
                const float v = ok ? sc[k5][rg] : -INFINITY; sc[k5][rg] = v; mx = fmaxf(mx, v); }
        mx = fmaxf(mx, __shfl_xor(mx, 32));
        float sum = 0.f;
#pragma unroll
        for (int k5 = 0; k5 < 5; ++k5)
#pragma unroll
            for (int rg = 0; rg < 16; ++rg) { const float p = __expf(sc[k5][rg] - mx); sc[k5][rg] = p; sum += p; }
        sum += __shfl_xor(sum, 32); sum += __expf(sink - mx);
        const float inv = 1.0f / sum;
        f32x16 o[2] = {zero16(), zero16()};
#pragma unroll
        for (int k5 = 0; k5 < 5; ++k5)
#pragma unroll
            for (int s2 = 0; s2 < 2; ++s2) { const bf16x8 pb = pack_step(sc[k5], s2);
#pragma unroll
                for (int dt = 0; dt < 2; ++dt) { const bf16x8 a = *(const LAS bf16x8*)(VT + (32 * dt + lr) * 264 + 32 * (qt + k5) + 16 * s2 + 8 * h); o[dt] = MFMA32(a, pb, o[dt]); } }
        bf16* orow = brb + (size_t)(m0 + qi) * 512 + (kvh * 4 + g) * 64;
#pragma unroll
        for (int dt = 0; dt < 2; ++dt)
#pragma unroll
            for (int gq = 0; gq < 4; ++gq) { u32x2 w; w.x = pk2(o[dt][4 * gq] * inv, o[dt][4 * gq + 1] * inv); w.y = pk2(o[dt][4 * gq + 2] * inv, o[dt][4 * gq + 3] * inv);
                *(u32x2*)(orow + 32 * dt + 8 * gq + 4 * h) = w; }
    }
    __syncthreads();
}

#define MFMA16F(a, b, c) __builtin_amdgcn_mfma_f32_16x16x4f32((a), (b), (c), 0, 0, 0)
constexpr int DP_HALF = 81920, DP_QS = 0, DP_KS = 17408, DP_LM = 0, DP_TF = 17408, DP_KT = 34816, DP_VT = 53248, DP_TAB = 71680;
__device__ __forceinline__ f32x4 blk_mm(const LAS float* X, const LAS float* Y, f32x4 c, int lane) {
    const int q = lane & 15, g = lane >> 4;
#pragma unroll
    for (int s = 0; s < 4; ++s) c = MFMA16F(X[q * 68 + 4 * s + g], Y[(4 * s + g) * 68 + q], c);
    return c;
}
__device__ __forceinline__ f32x4 blk_mm_acc(const LAS float* Z, const f32x4 p, int lane) {
    const int q = lane & 15, g = lane >> 4; f32x4 c = {0.f, 0.f, 0.f, 0.f};
#pragma unroll
    for (int s = 0; s < 4; ++s) c = MFMA16F(Z[q * 68 + 4 * g + s], p[s], c);
    return c;
}
__device__ __forceinline__ void blk_store_neg(LAS float* T, const f32x4 qv, int lane) {
    const int q = lane & 15, g = lane >> 4;
#pragma unroll
    for (int r = 0; r < 4; ++r) T[(4 * g + r) * 68 + q] = -qv[r];
}
__device__ __forceinline__ void dn_pre_pair(const Frame& F, const Params& P, int l, int pair) {
    const int half = F.wave >> 2, hw = F.wave & 3, ht = F.tid & 255, task = pair * 2 + half;
    const int hd = task & 3, cbn = task >> 2, b = cbn >> 7, n = cbn & 127, m0 = cbn * 64;
    const bf16* qkvc = (const bf16*)(P.ws + WS_QKVC); const float* ba = (const float*)(P.ws + WS_BA);
    unsigned char* outb = P.ws + WS_DN + (size_t)task * DN_TASK_BYTES;
    LAS unsigned char* L0 = F.lds + half * DP_HALF;
    LAS bf16* qs = (LAS bf16*)(L0 + DP_QS);
    LAS bf16* ks = (LAS bf16*)(L0 + DP_KS);
    LAS float* Lm = (LAS float*)(L0 + DP_LM);
    LAS float* Tf = (LAS float*)(L0 + DP_TF);
    LAS bf16* kT = (LAS bf16*)(L0 + DP_KT);
    LAS bf16* vT = (LAS bf16*)(L0 + DP_VT);
    LAS float* tgc = (LAS float*)(L0 + DP_TAB);
    LAS float *tbeta = tgc + 64, *ted = tgc + 128, *tsb = tgc + 192;
    const int lr = F.lane & 31, h = F.lane >> 5;
    float beta_l, gc_l, gl;
    { const int row = m0 + F.lane; beta_l = fast_sigmoid(ba[(size_t)row * 8 + hd]); const float xa = ba[(size_t)row * 8 + 4 + hd] + P.dt_bias[l * 4 + hd];
      const float sp = fmaxf(xa, 0.f) + __logf(1.0f + __expf(-fabsf(xa))); float x = -__expf(P.a_log[l * 4 + hd]) * sp;
#pragma unroll
      for (int o = 1; o < 64; o <<= 1) { const float y = __shfl_up(x, o); if (F.lane >= o) x += y; }
      gc_l = x; gl = __shfl(x, 63);
      if (hw == 0) { tgc[F.lane] = x; tbeta[F.lane] = beta_l; ted[F.lane] = __expf(gl - x); tsb[F.lane] = beta_l * __expf(x); if (F.lane == 0) ((float*)(P.ws + WS_CD))[task] = __expf(gl); } }
    { const int seg = ht & 7, tq = ht >> 3, t0 = 2 * tq, c0 = seg * 16;
      const float be0 = __shfl(beta_l, t0), be1 = __shfl(beta_l, t0 + 1), eg0 = __expf(__shfl(gc_l, t0)), eg1 = __expf(__shfl(gc_l, t0 + 1));
#pragma unroll
      for (int part = 0; part < 3; ++part) { const int col0 = part * 512 + hd * 128 + c0;
          float a0[16], a1[16];
#pragma unroll
          for (int i = 0; i < 16; ++i) { a0[i] = 0.f; a1[i] = 0.f; }
          const f32x4* cw = (const f32x4*)(P.conv_w + (size_t)l * 4 * 1536 + col0);
#pragma unroll
          for (int j = 0; j < 5; ++j) { const int sr = n * 64 + t0 - 3 + j;
              u32x4 w1 = {0u, 0u, 0u, 0u}, w2 = {0u, 0u, 0u, 0u};
              if (sr >= 0) { const bf16* src = qkvc + (size_t)(b * SEQ + sr) * 1536 + col0; w1 = *(const u32x4*)src; w2 = *(const u32x4*)(src + 8); }
              const float xv[16] = {bflo(w1.x), bfhi(w1.x), bflo(w1.y), bfhi(w1.y), bflo(w1.z), bfhi(w1.z), bflo(w1.w), bfhi(w1.w), bflo(w2.x), bfhi(w2.x), bflo(w2.y), bfhi(w2.y), bflo(w2.z), bfhi(w2.z), bflo(w2.w), bfhi(w2.w)};
#pragma unroll
              for (int q = 0; q < 4; ++q) {
                  if (j < 4) { const f32x4 w = cw[j * 384 + q];
#pragma unroll
                      for (int e = 0; e < 4; ++e) a0[4 * q + e] += xv[4 * q + e] * w[e]; }
                  if (j >= 1) { const f32x4 w = cw[(j - 1) * 384 + q];
#pragma unroll
                      for (int e = 0; e < 4; ++e) a1[4 * q + e] += xv[4 * q + e] * w[e]; } } }
          float s0 = 0.f, s1 = 0.f;
#pragma unroll
          for (int i = 0; i < 16; ++i) { a0[i] = a0[i] * fast_sigmoid(a0[i]); a1[i] = a1[i] * fast_sigmoid(a1[i]); s0 += a0[i] * a0[i]; s1 += a1[i] * a1[i]; }
          if (part < 2) { s0 += __shfl_xor(s0, 1); s0 += __shfl_xor(s0, 2); s0 += __shfl_xor(s0, 4); s1 += __shfl_xor(s1, 1); s1 += __shfl_xor(s1, 2); s1 += __shfl_xor(s1, 4);
              const float sc = part == 0 ? 0.08838834764831845f : 1.0f, r0 = __builtin_amdgcn_rsqf(s0 + NORM_EPS) * sc, r1 = __builtin_amdgcn_rsqf(s1 + NORM_EPS) * sc;
#pragma unroll
              for (int i = 0; i < 16; ++i) { a0[i] *= r0; a1[i] *= r1; } }
          else {
#pragma unroll
              for (int i = 0; i < 16; ++i) { a0[i] *= be0; a1[i] *= be1; } }
          if (part < 2) { LAS bf16* d0 = (part == 0 ? qs : ks) + t0 * 136 + c0;
              *(LAS u32x4*)d0 = (u32x4){pk2(a0[0], a0[1]), pk2(a0[2], a0[3]), pk2(a0[4], a0[5]), pk2(a0[6], a0[7])}; *(LAS u32x4*)(d0 + 8) = (u32x4){pk2(a0[8], a0[9]), pk2(a0[10], a0[11]), pk2(a0[12], a0[13]), pk2(a0[14], a0[15])};
              *(LAS u32x4*)(d0 + 136) = (u32x4){pk2(a1[0], a1[1]), pk2(a1[2], a1[3]), pk2(a1[4], a1[5]), pk2(a1[6], a1[7])}; *(LAS u32x4*)(d0 + 144) = (u32x4){pk2(a1[8], a1[9]), pk2(a1[10], a1[11]), pk2(a1[12], a1[13]), pk2(a1[14], a1[15])}; }
          if (part == 0) {
#pragma unroll
              for (int rr = 0; rr < 2; ++rr) { const float* a = rr ? a1 : a0; const float e = rr ? eg1 : eg0; const int t = t0 + rr;
#pragma unroll
                  for (int hh = 0; hh < 2; ++hh) { u32x4 o; o.x = pk2(a[4 * hh] * e, a[4 * hh + 1] * e); o.y = pk2(a[4 * hh + 2] * e, a[4 * hh + 3] * e); o.z = pk2(a[8 + 4 * hh] * e, a[9 + 4 * hh] * e); o.w = pk2(a[10 + 4 * hh] * e, a[11 + 4 * hh] * e);
                      *(u32x4*)(outb + DN_OFF_QD + (((t >> 5) * 8 + seg) * 64 + (t & 31) + 32 * hh) * 16) = o; } } }
          else { LAS bf16* dT = part == 1 ? kT : vT;
#pragma unroll
              for (int i = 0; i < 16; ++i) *(LAS unsigned*)(dT + (c0 + i) * 72 + t0) = pk2(a0[i], a1[i]); }
      }
    }
    __syncthreads();
    f32x16 accG = zero16(), accA = zero16(); const int i2 = hw >> 1, j2 = hw & 1;
    if (j2 <= i2) {
#pragma unroll
        for (int s = 0; s < 8; ++s) { const bf16x8 a = *(const LAS bf16x8*)(ks + (32 * i2 + lr) * 136 + 16 * s + 8 * h), bb = *(const LAS bf16x8*)(ks + (32 * j2 + lr) * 136 + 16 * s + 8 * h); accG = MFMA32(a, bb, accG); } }
    if (i2 <= j2) {
#pragma unroll
        for (int s = 0; s < 8; ++s) { const bf16x8 a = *(const LAS bf16x8*)(ks + (32 * i2 + lr) * 136 + 16 * s + 8 * h), bb = *(const LAS bf16x8*)(qs + (32 * j2 + lr) * 136 + 16 * s + 8 * h); accA = MFMA32(a, bb, accA); } }
    __syncthreads();
    { const int j = 32 * j2 + lr; const float gj = tgc[j];
#pragma unroll
      for (int rg = 0; rg < 16; ++rg) { const int i = 32 * i2 + crow(rg, h); Lm[i * 68 + j] = i > j ? tbeta[i] * accG[rg] * __expf(tgc[i] - gj) : 0.f; }
      const int c = 32 * j2 + lr; const float gcc = tgc[c];
#pragma unroll
      for (int rg = 0; rg < 16; ++rg) { const int jp = 32 * i2 + crow(rg, h); accA[rg] = jp <= c ? accA[rg] * __expf(gcc - tgc[jp]) : 0.f; }
#pragma unroll
      for (int s = 0; s < 2; ++s) *(bf16x8*)(outb + DN_OFF_AT + ((j2 * 4 + 2 * i2 + s) * 64 + F.lane) * 16) = pack_step(accA, s); }
    __syncthreads();
    { const LAS float* Ld = Lm + (16 * hw) * 68 + 16 * hw; LAS float* Td = Tf + (16 * hw) * 68 + 16 * hw; const int c = F.lane & 15; float t[16];
#pragma unroll
      for (int ii = 0; ii < 16; ++ii) { float a = (ii == c) ? 1.f : 0.f;
#pragma unroll
          for (int j4 = 0; j4 < ii; j4 += 4) { const f32x4 lv = *(const LAS f32x4*)(Ld + ii * 68 + j4); a -= lv.x * t[j4]; if (j4 + 1 < ii) a -= lv.y * t[j4 + 1]; if (j4 + 2 < ii) a -= lv.z * t[j4 + 2]; if (j4 + 3 < ii) a -= lv.w * t[j4 + 3]; }
          t[ii] = a; }
      if (F.lane < 16) {
#pragma unroll
          for (int ii = 0; ii < 16; ++ii) Td[ii * 68 + c] = t[ii]; }
      else {
          const int zc = F.lane - 16;
#pragma unroll
          for (int ii = 0; ii < 16; ++ii) { const int col = 16 * hw + 16 + zc; if (col < 64) Tf[(16 * hw + ii) * 68 + col] = 0.f; } } }
    __syncthreads();
    if (hw < 3) { const int i = hw + 1, j = hw; f32x4 p = {0.f, 0.f, 0.f, 0.f};
        p = blk_mm(Lm + (16 * i) * 68 + 16 * j, Tf + (16 * j) * 68 + 16 * j, p, F.lane);
        blk_store_neg(Tf + (16 * i) * 68 + 16 * j, blk_mm_acc(Tf + (16 * i) * 68 + 16 * i, p, F.lane), F.lane); }
    __syncthreads();
    if (hw < 2) { const int i = hw + 2, j = hw; f32x4 p = {0.f, 0.f, 0.f, 0.f};
        p = blk_mm(Lm + (16 * i) * 68 + 16 * j, Tf + (16 * j) * 68 + 16 * j, p, F.lane);
        p = blk_mm(Lm + (16 * i) * 68 + 16 * (j + 1), Tf + (16 * (j + 1)) * 68 + 16 * j, p, F.lane);
        blk_store_neg(Tf + (16 * i) * 68 + 16 * j, blk_mm_acc(Tf + (16 * i) * 68 + 16 * i, p, F.lane), F.lane); }
    __syncthreads();
    if (hw == 0) { f32x4 p = {0.f, 0.f, 0.f, 0.f};
        p = blk_mm(Lm + 48 * 68, Tf, p, F.lane); p = blk_mm(Lm + 48 * 68 + 16, Tf + 16 * 68, p, F.lane); p = blk_mm(Lm + 48 * 68 + 32, Tf + 32 * 68, p, F.lane);
        blk_store_neg(Tf + 48 * 68, blk_mm_acc(Tf + 48 * 68 + 48, p, F.lane), F.lane); }
    __syncthreads();
#define DP_TFRAG(row_, s_) ({ const LAS f32x4* tp_ = (const LAS f32x4*)(Tf + (row_) * 68 + 16 * (s_) + 8 * h); const f32x4 x0_ = tp_[0], x1_ = tp_[1]; \
        u32x4 tw_; tw_.x = pk2(x0_.x, x0_.y); tw_.y = pk2(x0_.z, x0_.w); tw_.z = pk2(x1_.x, x1_.y); tw_.w = pk2(x1_.z, x1_.w); __builtin_bit_cast(bf16x8, tw_); })
#pragma unroll
    for (int it = 0; it < 2; ++it) { const int et = hw; f32x16 acc = zero16();
#pragma unroll
        for (int s = 0; s < 4; ++s) { const bf16x8 a = DP_TFRAG(32 * it + lr, s), bb = *(const LAS bf16x8*)(vT + (32 * et + lr) * 72 + 16 * s + 8 * h); acc = MFMA32(a, bb, acc); }
        u32x4 o0, o1; o0.x = pk2(acc[0], acc[1]); o0.y = pk2(acc[2], acc[3]); o0.z = pk2(acc[4], acc[5]); o0.w = pk2(acc[6], acc[7]); o1.x = pk2(acc[8], acc[9]); o1.y = pk2(acc[10], acc[11]); o1.z = pk2(acc[12], acc[13]); o1.w = pk2(acc[14], acc[15]);
        unsigned char* up = outb + DN_OFF_U + ((et * 2 + it) * 64 + F.lane) * 32; *(u32x4*)up = o0; *(u32x4*)(up + 16) = o1; }
#pragma unroll
    for (int it = 0; it < 2; ++it) { const int dt = hw; f32x16 acc = zero16();
#pragma unroll
        for (int s = 0; s < 4; ++s) { const u32x4 kw = *(const LAS u32x4*)(kT + (32 * dt + lr) * 72 + 16 * s + 8 * h); const f32x4 e0 = *(const LAS f32x4*)(tsb + 16 * s + 8 * h), e1 = *(const LAS f32x4*)(tsb + 16 * s + 8 * h + 4);
            u32x4 aw; aw.x = pk2(bflo(kw.x) * e0.x, bfhi(kw.x) * e0.y); aw.y = pk2(bflo(kw.y) * e0.z, bfhi(kw.y) * e0.w); aw.z = pk2(bflo(kw.z) * e1.x, bfhi(kw.z) * e1.y); aw.w = pk2(bflo(kw.w) * e1.z, bfhi(kw.w) * e1.w);
            const bf16x8 bb = DP_TFRAG(32 * it + lr, s); acc = MFMA32(__builtin_bit_cast(bf16x8, aw), bb, acc); }
#pragma unroll
        for (int s = 0; s < 2; ++s) *(bf16x8*)(outb + DN_OFF_W + ((it * 8 + 2 * dt + s) * 64 + F.lane) * 16) = pack_step(acc, s); }
#undef DP_TFRAG
#pragma unroll
    for (int s = 0; s < 4; ++s) { const int dt = hw, d = 32 * dt + lr;
        const u32x2 lo = *(const LAS u32x2*)(kT + d * 72 + 16 * s + 4 * h), hi = *(const LAS u32x2*)(kT + d * 72 + 16 * s + 8 + 4 * h);
        const f32x4 e0 = *(const LAS f32x4*)(ted + 16 * s + 4 * h), e1 = *(const LAS f32x4*)(ted + 16 * s + 8 + 4 * h);
        u32x4 o; o.x = pk2(bflo(lo.x) * e0.x, bfhi(lo.x) * e0.y); o.y = pk2(bflo(lo.y) * e0.z, bfhi(lo.y) * e0.w); o.z = pk2(bflo(hi.x) * e1.x, bfhi(hi.x) * e1.y); o.w = pk2(bflo(hi.y) * e1.z, bfhi(hi.y) * e1.w);
        *(u32x4*)(outb + DN_OFF_KD + ((dt * 4 + s) * 64 + F.lane) * 16) = o; }
    __syncthreads();
}
constexpr int SC_BUF = 49152;
#define SC_BARRIER() do { asm volatile("s_waitcnt lgkmcnt(0)" ::: "memory"); __builtin_amdgcn_s_barrier(); asm volatile("" ::: "memory"); } while (0)
__device__ __forceinline__ void dn_scan(const Frame& F, const Params& P, int bh, bool nostore = false) {
    const int b = bh >> 2, hd = bh & 3; const int es = F.wave;
    unsigned char* dn = P.ws + WS_DN; const float* cdv = (const float*)(P.ws + WS_CD);
#define task_of(n_) ((((b) * 128 + (n_)) << 2) | (hd))
#define SC_SRC(n_, i_) ((const u32x4*)(dn + (size_t)task_of(n_) * DN_TASK_BYTES + ((i_) < 4 ? 0 : ((i_) < 8 ? DN_OFF_KD - 16384 : DN_OFF_U - 32768))) + t4 + 256 * (i_))
    if (F.wave >= 4) {
        const int t4 = F.tid - 256; u32x4 R0[12], R1[12], R2[12]; LAS float* cdl = (LAS float*)(F.lds + 2 * SC_BUF);
        float C0 = cdv[task_of(1)], C1 = cdv[task_of(2)], C2 = cdv[task_of(3)];
        if (t4 == 0) cdl[0] = cdv[task_of(0)];
        { LAS u32x4* dst = (LAS u32x4*)F.lds;
#pragma unroll
          for (int i = 0; i < 12; ++i) R0[i] = *SC_SRC(0, i);
#pragma unroll
          for (int i = 0; i < 12; ++i) dst[t4 + 256 * i] = R0[i]; }
#pragma unroll
        for (int i = 0; i < 12; ++i) { R0[i] = *SC_SRC(1, i); R1[i] = *SC_SRC(2, i); R2[i] = *SC_SRC(3, i); }
        SC_BARRIER();
#define SC_LSTEP(R, C, n_) if ((n_) < 128) { if ((n_) + 1 < 128) { LAS u32x4* dst = (LAS u32x4*)(F.lds + (((n_) + 1) & 1) * SC_BUF); \
            _Pragma("unroll") for (int i = 0; i < 12; ++i) dst[t4 + 256 * i] = R[i]; if (t4 == 0) cdl[((n_) + 1) & 1] = C; } \
            if ((n_) + 4 < 128) { _Pragma("unroll") for (int i = 0; i < 12; ++i) R[i] = *SC_SRC((n_) + 4, i); C = cdv[task_of((n_) + 4)]; } \
            SC_BARRIER(); }
#pragma unroll
        for (int n = 0; n < 129; n += 3) { SC_LSTEP(R0, C0, n) SC_LSTEP(R1, C1, n + 1) SC_LSTEP(R2, C2, n + 2) }
#undef SC_LSTEP
    } else {
        f32x16 S[4] = {zero16(), zero16(), zero16(), zero16()};
        const LAS float* cdl = (const LAS float*)(F.lds + 2 * SC_BUF);
        SC_BARRIER();
#pragma unroll 1
        for (int n = 0; n < 128; ++n) {
            const LAS unsigned char* cur = F.lds + (n & 1) * SC_BUF; unsigned char* tb = dn + (size_t)task_of(n) * DN_TASK_BYTES;
            const float cd = cdl[n & 1];
            bf16x8 Sb[8], A[16];
#pragma unroll
            for (int i = 0; i < 16; ++i) A[i] = *(const LAS bf16x8*)(cur + (i * 64 + F.lane) * 16);
#pragma unroll
            for (int dt = 0; dt < 4; ++dt) { Sb[2 * dt] = pack_step(S[dt], 0); Sb[2 * dt + 1] = pack_step(S[dt], 1); }
            { unsigned char* hp = tb + (es < 2 ? 0 : DN_OFF_KD) + ((es & 1) * 8 * 64 + F.lane) * 16;
              if (!nostore) {
#pragma unroll
              for (int s = 0; s < 8; ++s) *(bf16x8*)(hp + s * 1024) = Sb[s]; } }
            __builtin_amdgcn_sched_barrier(0);
            f32x16 Pw[2] = {zero16(), zero16()};
#pragma unroll
            for (int s = 0; s < 8; ++s) { Pw[0] = MFMA32(A[s], Sb[s], Pw[0]); Pw[1] = MFMA32(A[8 + s], Sb[s], Pw[1]); }
            __builtin_amdgcn_sched_barrier(0);
            u32x4 uu[4];
#pragma unroll
            for (int i = 0; i < 4; ++i) uu[i] = *(const LAS u32x4*)(cur + 32768 + ((es * 2 + (i >> 1)) * 64 + F.lane) * 32 + (i & 1) * 16);
#pragma unroll
            for (int i = 0; i < 16; ++i) A[i] = *(const LAS bf16x8*)(cur + 16384 + (i * 64 + F.lane) * 16);
            __builtin_amdgcn_sched_barrier(0);
            bf16x8 Vb[4];
#pragma unroll
            for (int ct = 0; ct < 2; ++ct) { const unsigned uw[8] = {uu[2 * ct].x, uu[2 * ct].y, uu[2 * ct].z, uu[2 * ct].w, uu[2 * ct + 1].x, uu[2 * ct + 1].y, uu[2 * ct + 1].z, uu[2 * ct + 1].w}; f32x16 v;
#pragma unroll
                for (int p = 0; p < 8; ++p) { v[2 * p] = bflo(uw[p]) - Pw[ct][2 * p]; v[2 * p + 1] = bfhi(uw[p]) - Pw[ct][2 * p + 1]; }
                Vb[2 * ct] = pack_step(v, 0); Vb[2 * ct + 1] = pack_step(v, 1); }
            { unsigned char* vp = tb + DN_OFF_U + (es * 4 * 64 + F.lane) * 16;
              if (!nostore) {
#pragma unroll
              for (int s = 0; s < 4; ++s) *(bf16x8*)(vp + s * 1024) = Vb[s]; } }
#pragma unroll
            for (int dt = 0; dt < 4; ++dt) S[dt] = S[dt] * cd;
            __builtin_amdgcn_sched_barrier(0);
#pragma unroll
            for (int s = 0; s < 4; ++s)
#pragma unroll
                for (int dt = 0; dt < 4; ++dt) S[dt] = MFMA32(A[dt * 4 + s], Vb[s], S[dt]);
            SC_BARRIER();
        }
    }
#undef SC_SRC
#undef task_of
}
__device__ __forceinline__ void dn_out_task(const Frame& F, const Params& P, int l, int task) {
    const int hd = task & 3, cbn = task >> 2, m0 = cbn * 64; const int lr = F.lane & 31, h = F.lane >> 5, ct = F.wave >> 2, es = F.wave & 3;
    const unsigned char* tb = P.ws + WS_DN + (size_t)task * DN_TASK_BYTES; bf16* brc = (bf16*)(P.ws + WS_BR) + (size_t)2 * TT * 512; const bf16* z = (const bf16*)(P.ws + WS_Z);
    LAS float* ssq = (LAS float*)F.lds;
    f32x16 o = zero16();
    { const unsigned char* hp = tb + (es < 2 ? 0 : DN_OFF_KD) + ((es & 1) * 8 * 64 + F.lane) * 16;
#pragma unroll
      for (int s = 0; s < 8; ++s) { const bf16x8 a = *(const bf16x8*)(tb + DN_OFF_QD + ((ct * 8 + s) * 64 + F.lane) * 16), bb = *(const bf16x8*)(hp + s * 1024); o = MFMA32(a, bb, o); }
      const unsigned char* vp = tb + DN_OFF_U + (es * 4 * 64 + F.lane) * 16;
#pragma unroll
      for (int s = 0; s < 4; ++s) { const bf16x8 a = *(const bf16x8*)(tb + DN_OFF_AT + ((ct * 4 + s) * 64 + F.lane) * 16), bb = *(const bf16x8*)(vp + s * 1024); o = MFMA32(a, bb, o); } }
    float q[16];
#pragma unroll
    for (int rg = 0; rg < 16; ++rg) { float v = o[rg] * o[rg]; v += __shfl_xor(v, 1); v += __shfl_xor(v, 2); v += __shfl_xor(v, 4); v += __shfl_xor(v, 8); v += __shfl_xor(v, 16); q[rg] = v; }
    if (lr == 0) {
#pragma unroll
        for (int rg = 0; rg < 16; ++rg) ssq[(ct * 4 + es) * 32 + crow(rg, h)] = q[rg]; }
    __syncthreads();
    const int e = hd * 128 + es * 32 + lr; const float gn = P.dn_norm[l * 128 + es * 32 + lr];
#pragma unroll
    for (int rg = 0; rg < 16; ++rg) { const int r = crow(rg, h); const float tot = (ssq[(ct * 4 + 0) * 32 + r] + ssq[(ct * 4 + 1) * 32 + r]) + (ssq[(ct * 4 + 2) * 32 + r] + ssq[(ct * 4 + 3) * 32 + r]);
        const float rs = __builtin_amdgcn_rsqf(tot * (1.f / 128.f) + NORM_EPS); const size_t idx = (size_t)(m0 + 32 * ct + r) * 512 + e;
        const float zz = __uint_as_float(((unsigned)z[idx]) << 16); brc[idx] = (bf16)(pk2(o[rg] * rs * gn * (zz * fast_sigmoid(zz)), 0.f) & 0xffffu); }
    __syncthreads();
}
__device__ __forceinline__ void final_norm(const Frame& F, const Params& P) {
    const int gw = F.vb * NWAVES + F.wave, NGW = F.G * NWAVES; const float* rowsq = (const float*)(P.ws + WS_ROWSQ);
    f32x4 gn[4];
#pragma unroll
    for (int j = 0; j < 4; ++j) gn[j] = ((const f32x4*)P.final_norm)[F.lane + 64 * j];
    for (int m = gw; m < TT; m += NGW) { float sq = F.lane < 16 ? rowsq[(size_t)m * 16 + F.lane] : 0.f; sq = wave_sum(sq); const float rs = __builtin_amdgcn_rsqf(sq * (1.f / 1024.f) + NORM_EPS);
        f32x4* xr = (f32x4*)(P.out + (size_t)m * DM) + F.lane;
#pragma unroll
        for (int j = 0; j < 4; ++j) xr[64 * j] = xr[64 * j] * rs * gn[j]; }
}

#define RLX_AGENT __ATOMIC_RELAXED, __HIP_MEMORY_SCOPE_AGENT
#define XB_TMO      128
#define XB_XCNT(j)  (256  + 64 * (j))
#define XB_XSUB(j)  (1280 + 64 * (j))
#define XB_XGEN(j)  (2304 + 64 * (j))
#define XB_TOP      3328
#define XB_TOPGEN   3392
#define XCD_BAR_WORDS 3456
#define XB_SPIN_CAP (1u << 18)

__device__ __forceinline__ unsigned xb_ld(unsigned* p)              { return __hip_atomic_load(p, __ATOMIC_RELAXED, __HIP_MEMORY_SCOPE_AGENT); }
__device__ __forceinline__ unsigned xb_add(unsigned* p, unsigned v) { return __hip_atomic_fetch_add(p, v, __ATOMIC_RELAXED, __HIP_MEMORY_SCOPE_AGENT); }
__device__ __forceinline__ unsigned xb_xcc_id() { return (unsigned)__builtin_amdgcn_s_getreg((3 << 11) | 20) & 0xFu; }
#define XB_SPIN(cond, bar) do { unsigned _sp = 0; while (cond) { __builtin_amdgcn_s_sleep(1); \
    if ((++_sp & 255u) == 0u) { if (xb_ld(&(bar)[XB_TMO])) break; if (_sp > XB_SPIN_CAP) { atomicAdd(&(bar)[XB_TMO], 1u); break; } } } } while (0)

struct XcdBarrier {
    unsigned* bar; unsigned x;
    volatile LAS unsigned* st;
};

__device__ __forceinline__ XcdBarrier xcd_barrier_post(unsigned* bar, volatile LAS unsigned* st) {
    XcdBarrier b; b.bar = bar; b.x = xb_xcc_id(); b.st = st;
    if (threadIdx.x == 0) (void)xb_add(&bar[XB_XCNT(b.x)], 1u);
    return b;
}
__device__ __forceinline__ void xcd_barrier_complete(unsigned* bar, unsigned x, unsigned& nloc, unsigned& nx) {
    const unsigned G = gridDim.x * gridDim.y * gridDim.z;
    unsigned sum, cnt, mine, sp = 0u;
    for (;;) {
        sum = 0u; cnt = 0u; mine = 0u;
#pragma unroll
        for (unsigned j = 0; j < 16; ++j) { const unsigned c = xb_ld(&bar[XB_XCNT(j)]); sum += c; cnt += (c > 0u) ? 1u : 0u; mine = (j == x) ? c : mine; }
        if (sum == G) break;
        __builtin_amdgcn_s_sleep(1);
        if ((++sp & 255u) == 0u) { if (xb_ld(&bar[XB_TMO])) break; if (sp > XB_SPIN_CAP) { atomicAdd(&bar[XB_TMO], 1u); break; } }
    }
    nloc = mine > 0u ? mine : 1u; nx = cnt > 0u ? cnt : 1u;
}

__device__ __forceinline__ void xcd_barrier(const XcdBarrier& b) {
    asm volatile("s_waitcnt vmcnt(0)" ::: "memory");
    __syncthreads();
    if (threadIdx.x == 0) {
        unsigned* bar = b.bar;
        __builtin_amdgcn_s_waitcnt(0);
        unsigned nloc = b.st[0], nx = b.st[1];
        if (nloc == 0u) { xcd_barrier_complete(bar, b.x, nloc, nx); b.st[0] = nloc; b.st[1] = nx; }
        const unsigned old = xb_add(&bar[XB_XSUB(b.x)], 1u);
        const unsigned gen = old / nloc;
        if (old + 1u == (gen + 1u) * nloc) {
            __builtin_amdgcn_fence(__ATOMIC_RELEASE, "agent");
            asm volatile("s_waitcnt vmcnt(0)" ::: "memory");
            const unsigned og = xb_add(&bar[XB_TOP], 1u);
            const unsigned tg = og / nx;
            if (og + 1u == (tg + 1u) * nx) xb_add(&bar[XB_TOPGEN], 1u);
            else XB_SPIN(xb_ld(&bar[XB_TOPGEN]) == tg, bar);
            __builtin_amdgcn_fence(__ATOMIC_ACQUIRE, "agent");
            xb_add(&bar[XB_XGEN(b.x)], 1u);
            asm volatile("s_waitcnt vmcnt(0)" ::: "memory");
        } else {
            XB_SPIN(xb_ld(&bar[XB_XGEN(b.x)]) == gen, bar);
            __builtin_amdgcn_fence(__ATOMIC_ACQUIRE, "agent");
            asm volatile("s_waitcnt vmcnt(0)" ::: "memory");
        }
    }
    __syncthreads();
}

constexpr int PH_PER_LAYER = 9, N_PHASES = DEPTH * PH_PER_LAYER + 1;
__device__ __forceinline__ void run_phase(const Frame& F0, const Params& P0, int ph, int sub = 0) {
    Frame F = F0; Params P = P0; asm volatile("" : "+v"(F.tid)); F.lane = F.tid & 63; F.wave = __builtin_amdgcn_readfirstlane(F.tid >> 6); asm volatile("" : "+s"(F.G), "+s"(F.vb)); int bid = (int)blockIdx.x; asm volatile("" : "+s"(bid));
    { size_t zoff = 0; asm volatile("" : "+s"(zoff)); P.ws = P0.ws + zoff; }
    const int l = ph / PH_PER_LAYER, k = ph % PH_PER_LAYER;
    unsigned char* ws = P.ws; const float* rowsq = (const float*)(ws + WS_ROWSQ); const LAS float* lrs = (const LAS float*)(F.lds + pg8::LRS_OFF);
    if (ph == N_PHASES - 1) { final_norm(F, P); return; }
#ifdef ONLY_K
    if (k != ONLY_K) return;
#endif
    switch (k) {
    case 0: p0_attn_weights(F, P, l); if (l == 0) p0_input(F, P); break;
    case 1: {
        pg8::Gemm g{(const pg8::bf16_t*)(ws + WS_XB), (const pg8::bf16_t*)(ws + WS_WIN), TT, NMIXP, DM}; pg8::StaticOrder S; S.init(TT, NMIXP, F.G, bid);
        pg8::EpiProj E{(pg8::bf16_t*)(ws + WS_UV), (pg8::bf16_t*)(ws + WS_QKVB), (pg8::bf16_t*)(ws + WS_QKVC), (pg8::bf16_t*)(ws + WS_Z), lrs, (float*)(ws + WS_BA)};
        pg8::prep_rstd(F.lds, S, rowsq);
        pg8::gemm_phase<pg8::EpiProj, pg8::StaticOrder, true, true>(F.lds, g, S, E); } break;
    case 2: for (int t = F.vb; t < 512; t += F.G) dn_pre_pair(F, P, l, t); break;
    case 3: { const int sb = bid; if (sb < 8) { if (!(sub & 2)) dn_scan(F, P, sb, (sub & 16) != 0); }
              else if (!(sub & 1)) { const int nb = F.G - 8; for (int t = sb - 8; t < 768; t += nb) { if (t < 256) { if (!(sub & 4)) swa_task(F, P, l, t); } else if (!(sub & 8)) sgu_task(F, P, l, t - 256); } } } break;
    case 4: for (int t = F.vb; t < 1024; t += F.G) dn_out_task(F, P, l, t); p0_ffn_weights(F, P, l); break;
    case 5: {
#pragma unroll 1
        for (int n = 0; n < 3; ++n) {
            { pg8::Gemm g{(const pg8::bf16_t*)(ws + WS_XB), (const pg8::bf16_t*)(ws + WS_WG) + (size_t)n * 1024 * 1024, TT, DM, DM}; pg8::StaticOrder S; S.init(TT, DM, F.G, bid);
              pg8::EpiSig E{(pg8::bf16_t*)(ws + WS_UV), lrs}; if (n == 0) pg8::prep_rstd(F.lds, S, rowsq); pg8::gemm_phase<pg8::EpiSig, pg8::StaticOrder, true, true>(F.lds, g, S, E); }
            __syncthreads();
            { pg8::Gemm g{(const pg8::bf16_t*)(ws + WS_BR) + (size_t)n * TT * 512, (const pg8::bf16_t*)(ws + WS_WBR) + (size_t)n * 1024 * 512, TT, DM, 512}; pg8::StaticOrder S; S.init(TT, DM, F.G, bid);
              if (n == 0) { pg8::EpiMerge<false> E{(const pg8::bf16_t*)(ws + WS_UV), (pg8::bf16_t*)(ws + WS_DN)}; pg8::gemm_phase<pg8::EpiMerge<false>, pg8::StaticOrder, true, true>(F.lds, g, S, E); }
              else { pg8::EpiMerge<true> E{(const pg8::bf16_t*)(ws + WS_UV), (pg8::bf16_t*)(ws + WS_DN)}; pg8::gemm_phase<pg8::EpiMerge<true>, pg8::StaticOrder, true, true>(F.lds, g, S, E); } }
            __syncthreads();
        } } break;
    case 6: { pg8::Gemm g{(const pg8::bf16_t*)(ws + WS_DN), (const pg8::bf16_t*)(ws + WS_WOUT), TT, DM, DM}; pg8::StaticOrder S; S.init(TT, DM, F.G, bid);
        pg8::EpiResid<false> E{(pg8::bf16_t*)(ws + WS_XB), (float*)(ws + WS_ROWSQ), nullptr}; pg8::gemm_phase<pg8::EpiResid<false>, pg8::StaticOrder, true, true>(F.lds, g, S, E); } break;
    case 7: { pg8::Gemm g{(const pg8::bf16_t*)(ws + WS_XB), (const pg8::bf16_t*)(ws + WS_WGU), TT, 2 * DFF, DM}; pg8::StaticOrder S; S.init(TT, 2 * DFF, F.G, bid);
        pg8::EpiGU E{(pg8::bf16_t*)(ws + WS_HID), lrs}; pg8::prep_rstd(F.lds, S, rowsq); pg8::gemm_phase<pg8::EpiGU, pg8::StaticOrder, true, true>(F.lds, g, S, E); } break;
    case 8: { pg8::Gemm g{(const pg8::bf16_t*)(ws + WS_HID), (const pg8::bf16_t*)(ws + WS_WDN), TT, DM, DFF}; pg8::StaticOrder S; S.init(TT, DM, F.G, bid);
        if (l < DEPTH - 1) { pg8::EpiResid<false> E{(pg8::bf16_t*)(ws + WS_XB), (float*)(ws + WS_ROWSQ), nullptr}; pg8::gemm_phase<pg8::EpiResid<false>, pg8::StaticOrder, true, true>(F.lds, g, S, E); }
        else { pg8::EpiResid<true> E{(pg8::bf16_t*)(ws + WS_XB), (float*)(ws + WS_ROWSQ), P.out}; pg8::gemm_phase<pg8::EpiResid<true>, pg8::StaticOrder, true, true>(F.lds, g, S, E); } } break;
    }
}

__global__ void __launch_bounds__(NTHR, 2) hgpm_fwd(Params P) {
    extern __shared__ __attribute__((aligned(16))) unsigned char lds_raw[];
    Frame F; F.lds = (LAS unsigned char*)lds_raw; F.tid = threadIdx.x; F.lane = F.tid & 63; F.wave = __builtin_amdgcn_readfirstlane(F.tid >> 6);
    F.G = gridDim.x; { const int bx = blockIdx.x; F.vb = (F.G % 8 == 0) ? (bx % 8) * (F.G / 8) + bx / 8 : bx; }
#if USE_CG_SYNC
    cg::grid_group grid = cg::this_grid();
#define GRID_SYNC() grid.sync()
#else
    volatile LAS unsigned* misc = (volatile LAS unsigned*)(F.lds + MISC_OFF);
    if (F.tid < 64) misc[F.tid] = 0u;
    __syncthreads();
    const XcdBarrier bar = xcd_barrier_post((unsigned*)(P.ws + WS_CTL) + 1024, misc + 8);
#define GRID_SYNC() xcd_barrier(bar)
#endif
    for (int ph = P.ph_lo; ph < P.ph_hi; ++ph) {
        run_phase(F, P, ph);
#ifdef DUPK
#ifndef DUPSUB
#define DUPSUB 0
#endif
        if (ph % PH_PER_LAYER == DUPK && ph != N_PHASES - 1 && (DUPK != 6 || ph < PH_PER_LAYER)) { GRID_SYNC(); run_phase(F, P, ph, DUPSUB); }
        if (DUPK == 23 && ph % PH_PER_LAYER == 3) { GRID_SYNC(); run_phase(F, P, ph - 1, 0); GRID_SYNC(); run_phase(F, P, ph, 0); }
#endif
        if (ph + 1 < P.ph_hi) GRID_SYNC();
    }
}

#ifndef N_LAUNCH_MODE
#define N_LAUNCH_MODE 0
#endif
extern "C" void kernel_launch(void* const* d_in, const int* in_sizes, int n_in, void* d_out, int out_size, void* d_ws, size_t ws_size, hipStream_t stream) {
    static int grid = 0;
    if (grid == 0) {
        if (n_in != 19 || in_sizes[0] != TT * DM || out_size != TT * DM || ws_size < WS_END) { fprintf(stderr, "kernel_launch: unexpected shapes (n_in %d, in0 %d, out %d, ws %zu)\n", n_in, n_in > 0 ? in_sizes[0] : -1, out_size, ws_size); grid = -1; return; }
        int dev = 0, cus = 0, per_cu = 0;
        if (hipGetDevice(&dev) != hipSuccess || hipDeviceGetAttribute(&cus, hipDeviceAttributeMultiprocessorCount, dev) != hipSuccess) { grid = -1; return; }
        if (hipFuncSetAttribute((const void*)hgpm_fwd, hipFuncAttributeMaxDynamicSharedMemorySize, LDS_BYTES) != hipSuccess) { fprintf(stderr, "kernel_launch: hipFuncSetAttribute failed\n"); grid = -1; return; }
        if (hipOccupancyMaxActiveBlocksPerMultiprocessor(&per_cu, (const void*)hgpm_fwd, NTHR, LDS_BYTES) != hipSuccess || per_cu < 1) { fprintf(stderr, "kernel_launch: occupancy query says %d blocks per CU\n", per_cu); per_cu = 1; }
        (void)hipGetLastError();
        grid = cus;
    }
    if (grid < 0) return;
    Params p{};
    p.x = (const float*)d_in[0]; p.pos = (const int*)d_in[1]; p.attn_norm = (const float*)d_in[2]; p.w_in = (const float*)d_in[3]; p.sgu_ln_g = (const float*)d_in[4]; p.sgu_ln_b = (const float*)d_in[5];
    p.sgu_w = (const float*)d_in[6]; p.sgu_b = (const float*)d_in[7]; p.sinks = (const float*)d_in[8]; p.conv_w = (const float*)d_in[9]; p.a_log = (const float*)d_in[10]; p.dt_bias = (const float*)d_in[11];
    p.dn_norm = (const float*)d_in[12]; p.w_branch = (const float*)d_in[13]; p.w_out = (const float*)d_in[14]; p.ffn_norm = (const float*)d_in[15]; p.w_gate_up = (const float*)d_in[16]; p.w_down = (const float*)d_in[17];
    p.final_norm = (const float*)d_in[18]; p.out = (float*)d_out; p.ws = (unsigned char*)d_ws;
#if N_LAUNCH_MODE == 0
    p.ph_lo = 0; p.ph_hi = N_PHASES;
#if USE_CG_SYNC
    void* args[] = {&p};
    hipError_t e = hipLaunchCooperativeKernel((const void*)hgpm_fwd, dim3(grid), dim3(NTHR), args, LDS_BYTES, stream);
    if (e != hipSuccess) fprintf(stderr, "kernel_launch: cooperative launch failed: %s (grid %d)\n", hipGetErrorString(e), grid);
#else
    if (hipMemsetAsync((char*)d_ws + WS_CTL, 0, CTL_ZERO_BYTES, stream) != hipSuccess) { fprintf(stderr, "kernel_launch: hipMemsetAsync failed\n"); return; }
    hipLaunchKernelGGL(hgpm_fwd, dim3(grid), dim3(NTHR), LDS_BYTES, stream, p);
#endif
#else
    for (int ph = 0; ph < N_PHASES; ++ph) { p.ph_lo = ph; p.ph_hi = ph + 1; hipLaunchKernelGGL(hgpm_fwd, dim3(grid), dim3(NTHR), LDS_BYTES, stream, p); }
#endif
}
```

```cpp
#include <hip/hip_runtime.h>
#include <hip/hip_cooperative_groups.h>
#include <cstdio>
#include <cstdint>
namespace cg = cooperative_groups;
namespace pg8 {
#define PG8_LAS __attribute__((address_space(3)))
typedef unsigned short bf16_t;
typedef short bf16x8 __attribute__((ext_vector_type(8)));
typedef float f32x4 __attribute__((ext_vector_type(4)));
typedef unsigned u32x4 __attribute__((ext_vector_type(4)));
constexpr int BM = 256, BK = 64, HALF = 128, HTB = HALF * BK * 2  , STAGE_BYTES = 8 * HTB, NXCD = 8, WGM = 8;

__host__ __device__ __forceinline__ int lds_byte(int r, int c) { const int st = (r >> 4) * 2 + (c >> 5), rr = r & 15, cc = c & 31, ob = rr * 64 + cc * 2; return st * 1024 + (ob ^ (((ob >> 9) & 1) << 5)); }
__host__ __device__ __forceinline__ void stage_rc(int b, int& R, int& C) { const int st = b / 1024, sb = b % 1024, swz = sb ^ (((sb >> 9) & 1) << 5); R = (st >> 1) * 16 + swz / 64; C = (st & 1) * 32 + (swz % 64) / 2; }
__host__ __device__ __forceinline__ int perm32(int rho) { const int n = rho >> 4, i = rho & 15; return 8 * (i >> 2) + 4 * n + (i & 3); }

struct Unit { int pm, pn, idx, pa; };
struct Gemm { const bf16_t* A; const bf16_t* Bt; int M, N, K; };

struct StaticOrder {
    int nM, nN, nwg, G, c;
    __host__ __device__ __forceinline__ void init(int M, int N, int G_, int c_) { nM = M / BM; nN = N / BM; nwg = nM * nN; G = G_; c = c_; }
    __host__ __device__ __forceinline__ bool next(int i, Unit& u) const {
        const long L = (long)i * G + c; if (L >= nwg) return false;
        int wgid = (int)L; { const int q = nwg / NXCD, r = nwg % NXCD, xcd = wgid % NXCD, off = wgid / NXCD; wgid = (xcd < r ? xcd * (q + 1) : r * (q + 1) + (xcd - r) * q) + off; }
        const int nig = WGM * nN, gid = wgid / nig, fm = gid * WGM, gsz = (nM - fm) < WGM ? (nM - fm) : WGM;
        u.pm = fm + ((wgid % nig) % gsz); u.pn = (wgid % nig) / gsz; u.idx = i; u.pa = u.pm; return true;
    }
    __device__ __forceinline__ void a_ready(const Unit&) const {}
    __device__ __forceinline__ void done(const Unit&) const {}
};

typedef float f32x2 __attribute__((ext_vector_type(2)));
typedef __bf16 bf16v2 __attribute__((ext_vector_type(2)));
typedef unsigned u32x2 __attribute__((ext_vector_type(2)));
__device__ __forceinline__ unsigned pk2(float lo, float hi) { f32x2 v = {lo, hi}; bf16v2 r = __builtin_convertvector(v, bf16v2); return __builtin_bit_cast(unsigned, r); }
__device__ __forceinline__ float bflo(unsigned w) { return __uint_as_float(w << 16); }
__device__ __forceinline__ float bfhi(unsigned w) { return __uint_as_float(w & 0xffff0000u); }
__device__ __forceinline__ float fast_sigmoid(float x) { return __builtin_amdgcn_rcpf(1.0f + __expf(-x)); }
__device__ __forceinline__ float gelu_tanh(float x) { const float u = 1.5957691216f * (x + 0.044715f * x * x * x); return x * fast_sigmoid(u); }
constexpr float NORM_EPS = 1e-6f;
__device__ __forceinline__ float row_rstd(const float* rowsq, int row) {
    const f32x4* p = (const f32x4*)(rowsq + (size_t)row * 16); const f32x4 a = p[0], b = p[1], c = p[2], d = p[3];
    const float s = ((a.x + a.y) + (a.z + a.w)) + ((b.x + b.y) + (b.z + b.w)) + ((c.x + c.y) + (c.z + c.w)) + ((d.x + d.y) + (d.z + d.w));
    return __builtin_amdgcn_rsqf(s * (1.0f / 1024.0f) + NORM_EPS);
}
constexpr int LRS_OFF = STAGE_BYTES, LRS_MAX_UNITS = 8;
template <class Sched> __device__ __forceinline__ void prep_rstd(PG8_LAS unsigned char* lds, const Sched& S, const float* rowsq) {
    PG8_LAS float* t = (PG8_LAS float*)(lds + LRS_OFF); Unit u;
#pragma unroll 1
    for (int i = 0; i < LRS_MAX_UNITS; ++i) { if (!S.next(i, u)) break; if (threadIdx.x < 256) t[i * 256 + threadIdx.x] = row_rstd(rowsq, u.pm * BM + threadIdx.x); asm volatile("" ::: "memory"); }
    __syncthreads();
}
struct EpiProj {
    static constexpr bool PERM = true, AFTER_DRAIN = false;
    bf16_t *uv, *qkvb, *qkvc, *z; const PG8_LAS float* lrs; float* ba;
    __device__ __forceinline__ void operator()(const f32x4 (&acc)[2][2][4][2], const Unit& u, int wr, int wc, int fr, int fq) const {
        const int pn = u.pn; bf16_t* base; int ldc, colt; bool act = false;
        if (pn == 15) {
            if (wc == 0 && fq == 0) {
#pragma unroll
                for (int ai = 0; ai < 2; ++ai)
#pragma unroll
                    for (int m = 0; m < 4; ++m) { const int rl = wr * 64 + fr + ai * HALF + m * 16; const float rs = lrs[u.idx * 256 + rl]; float* bp = ba + (size_t)(u.pm * BM + rl) * 8;
                        *(f32x4*)bp = acc[ai][0][m][0] * rs; *(f32x4*)(bp + 4) = acc[ai][0][m][1] * rs; } }
            return; }
        if (pn < 4) { base = uv; ldc = 1024; colt = pn * 256; act = true; }
        else if (pn < 7) { base = qkvb; ldc = 768; colt = (pn - 4) * 256; }
        else if (pn < 13) { base = qkvc; ldc = 1536; colt = (pn - 7) * 256; }
        else { base = z; ldc = 512; colt = (pn - 13) * 256; }
        const int row0 = u.pm * BM + wr * 64 + fr, col0 = colt + wc * 32 + 8 * fq;
#pragma unroll
        for (int ai = 0; ai < 2; ++ai)
#pragma unroll
            for (int m = 0; m < 4; ++m) { const int row = row0 + ai * HALF + m * 16; const float rs = lrs[u.idx * 256 + (row - u.pm * BM)]; bf16_t* rowp = base + (size_t)row * ldc + col0;
#pragma unroll
                for (int bj = 0; bj < 2; ++bj) { f32x4 v0 = acc[ai][bj][m][0] * rs, v1 = acc[ai][bj][m][1] * rs;
                    if (act) {
#pragma unroll
                        for (int j = 0; j < 4; ++j) { v0[j] = gelu_tanh(v0[j]); v1[j] = gelu_tanh(v1[j]); } }
                    u32x4 w; w.x = pk2(v0[0], v0[1]); w.y = pk2(v0[2], v0[3]); w.z = pk2(v1[0], v1[1]); w.w = pk2(v1[2], v1[3]);
                    *(u32x4*)(rowp + bj * HALF) = w; } }
    }
};
struct TripleOrder {
    StaticOrder base; bool stackA;
    __device__ __forceinline__ void init(int M, int G_, int c_, bool stackA_) { base.init(M, 1024, G_, c_); stackA = stackA_; }
    __device__ __forceinline__ bool next(int i, Unit& u) const { Unit t; if (i >= 3 || !base.next(0, t)) return false; u.pm = t.pm; u.pn = 4 * i + t.pn; u.idx = 0; u.pa = stackA ? 64 * i + t.pm : t.pm; return true; }
    __device__ __forceinline__ void a_ready(const Unit&) const {}
    __device__ __forceinline__ void done(const Unit&) const {}
};
struct EpiY {
    static constexpr bool PERM = true, AFTER_DRAIN = false;
    bf16_t* y0; long d1, d2;
    __device__ __forceinline__ void operator()(const f32x4 (&acc)[2][2][4][2], const Unit& u, int wr, int wc, int fr, int fq) const {
        const int n = u.pn >> 2; bf16_t* y = y0 + (n ? d1 + (long)(n - 1) * d2 : 0l);
        const int row0 = u.pm * BM + wr * 64 + fr, col0 = (u.pn & 3) * BM + wc * 32 + 8 * fq;
#pragma unroll
        for (int ai = 0; ai < 2; ++ai)
#pragma unroll
            for (int m = 0; m < 4; ++m) { bf16_t* rowp = y + (size_t)(row0 + ai * HALF + m * 16) * 1024 + col0;
#pragma unroll
                for (int bj = 0; bj < 2; ++bj) { const f32x4 v0 = acc[ai][bj][m][0], v1 = acc[ai][bj][m][1];
                    u32x4 w; w.x = pk2(v0[0], v0[1]); w.y = pk2(v0[2], v0[3]); w.z = pk2(v1[0], v1[1]); w.w = pk2(v1[2], v1[3]); *(u32x4*)(rowp + bj * HALF) = w; } }
    }
};
struct EpiGateMerge {
    static constexpr bool PERM = true, AFTER_DRAIN = false;
    const bf16_t* y0; long d1, d2; bf16_t* mg; const PG8_LAS float* lrs;
    __device__ __forceinline__ void operator()(const f32x4 (&acc)[2][2][4][2], const Unit& u, int wr, int wc, int fr, int fq) const {
        const int n = u.pn >> 2; const bf16_t* y = y0 + (n ? d1 + (long)(n - 1) * d2 : 0l);
        const int rl0 = wr * 64 + fr, row0 = u.pm * BM + rl0, col0 = (u.pn & 3) * BM + wc * 32 + 8 * fq;
#pragma unroll
        for (int ai = 0; ai < 2; ++ai)
#pragma unroll
          for (int m0 = 0; m0 < 4; m0 += 2) { u32x4 yv[2][2], ov[2][2];
#pragma unroll
            for (int mm = 0; mm < 2; ++mm)
#pragma unroll
                for (int bj = 0; bj < 2; ++bj) { const size_t off = (size_t)(row0 + ai * HALF + (m0 + mm) * 16) * 1024 + col0 + bj * HALF; yv[mm][bj] = *(const u32x4*)(y + off); if (n > 0) ov[mm][bj] = *(const u32x4*)(mg + off); else ov[mm][bj] = (u32x4){0u, 0u, 0u, 0u}; }
            __builtin_amdgcn_sched_barrier(0);
#pragma unroll
            for (int mm = 0; mm < 2; ++mm) { const int m = m0 + mm; const float rs = lrs[u.idx * 256 + rl0 + ai * HALF + m * 16];
#pragma unroll
                for (int bj = 0; bj < 2; ++bj) { const size_t off = (size_t)(row0 + ai * HALF + m * 16) * 1024 + col0 + bj * HALF; const u32x4 yy = yv[mm][bj], o = ov[mm][bj];
                    f32x4 v0 = acc[ai][bj][m][0] * rs, v1 = acc[ai][bj][m][1] * rs;
#pragma unroll
                    for (int j = 0; j < 4; ++j) { v0[j] = fast_sigmoid(v0[j]); v1[j] = fast_sigmoid(v1[j]); }
                    v0[0] = v0[0] * bflo(yy.x) + bflo(o.x); v0[1] = v0[1] * bfhi(yy.x) + bfhi(o.x); v0[2] = v0[2] * bflo(yy.y) + bflo(o.y); v0[3] = v0[3] * bfhi(yy.y) + bfhi(o.y);
                    v1[0] = v1[0] * bflo(yy.z) + bflo(o.z); v1[1] = v1[1] * bfhi(yy.z) + bfhi(o.z); v1[2] = v1[2] * bflo(yy.w) + bflo(o.w); v1[3] = v1[3] * bfhi(yy.w) + bfhi(o.w);
                    u32x4 w; w.x = pk2(v0[0], v0[1]); w.y = pk2(v0[2], v0[3]); w.z = pk2(v1[0], v1[1]); w.w = pk2(v1[2], v1[3]); *(u32x4*)(mg + off) = w; } }
            __builtin_amdgcn_sched_barrier(0); }
    }
};
template <bool F32OUT> struct EpiResid {
    static constexpr bool PERM = true, AFTER_DRAIN = false;
    bf16_t* xb; float* rowsq; float* xout;
    __device__ __forceinline__ void operator()(const f32x4 (&acc)[2][2][4][2], const Unit& u, int wr, int wc, int fr, int fq) const {
        const int row0 = u.pm * BM + wr * 64 + fr, col0 = u.pn * BM + wc * 32 + 8 * fq;
#pragma unroll
        for (int ai = 0; ai < 2; ++ai) { u32x4 xv[4][2];
#pragma unroll
            for (int m = 0; m < 4; ++m)
#pragma unroll
                for (int bj = 0; bj < 2; ++bj) xv[m][bj] = *(const u32x4*)(xb + (size_t)(row0 + ai * HALF + m * 16) * 1024 + col0 + bj * HALF);
            __builtin_amdgcn_sched_barrier(0);
#pragma unroll
            for (int m = 0; m < 4; ++m) { const int row = row0 + ai * HALF + m * 16; const size_t off = (size_t)row * 1024 + col0; float ss = 0.f;
#pragma unroll
                for (int bj = 0; bj < 2; ++bj) { const u32x4 xo = xv[m][bj];
                    f32x4 v0 = acc[ai][bj][m][0], v1 = acc[ai][bj][m][1];
                    v0[0] += bflo(xo.x); v0[1] += bfhi(xo.x); v0[2] += bflo(xo.y); v0[3] += bfhi(xo.y); v1[0] += bflo(xo.z); v1[1] += bfhi(xo.z); v1[2] += bflo(xo.w); v1[3] += bfhi(xo.w);
                    if (F32OUT) { *(f32x4*)(xout + off + bj * HALF) = v0; *(f32x4*)(xout + off + bj * HALF + 4) = v1; }
                    else { u32x4 w; w.x = pk2(v0[0], v0[1]); w.y = pk2(v0[2], v0[3]); w.z = pk2(v1[0], v1[1]); w.w = pk2(v1[2], v1[3]); *(u32x4*)(xb + off + bj * HALF) = w; }
                    ss += ((v0[0] * v0[0] + v0[1] * v0[1]) + (v0[2] * v0[2] + v0[3] * v0[3])) + ((v1[0] * v1[0] + v1[1] * v1[1]) + (v1[2] * v1[2] + v1[3] * v1[3])); }
                ss += __shfl_xor(ss, 16); ss += __shfl_xor(ss, 32);
                if (fq == 0) rowsq[(size_t)row * 16 + u.pn * 4 + wc] = ss; }
            __builtin_amdgcn_sched_barrier(0); }
    }
};
struct EpiGU {
    static constexpr bool PERM = true, AFTER_DRAIN = false;
    bf16_t* hid; const PG8_LAS float* lrs;
    __device__ __forceinline__ void operator()(const f32x4 (&acc)[2][2][4][2], const Unit& u, int wr, int wc, int fr, int fq) const {
        const int row0 = u.pm * BM + wr * 64 + fr, col0 = u.pn * HALF + wc * 32 + 8 * fq;
#pragma unroll
        for (int ai = 0; ai < 2; ++ai)
#pragma unroll
            for (int m = 0; m < 4; ++m) { const int row = row0 + ai * HALF + m * 16; const float rs = lrs[u.idx * 256 + (row - u.pm * BM)];
                float o[8];
#pragma unroll
                for (int n = 0; n < 2; ++n)
#pragma unroll
                    for (int j = 0; j < 4; ++j) { const float g = acc[ai][0][m][n][j] * rs, up = acc[ai][1][m][n][j] * rs; o[n * 4 + j] = g * fast_sigmoid(g) * up; }
                u32x4 w; w.x = pk2(o[0], o[1]); w.y = pk2(o[2], o[3]); w.z = pk2(o[4], o[5]); w.w = pk2(o[6], o[7]);
                *(u32x4*)(hid + (size_t)row * 2816 + col0) = w; }
    }
};

template <class Epi, class Sched, bool ALIGN_EPI = false, bool SP2 = false>
__device__ __forceinline__ void gemm_phase(PG8_LAS unsigned char* lds, const Gemm g, const Sched& S, const Epi& E) {
    int tid_ = threadIdx.x; asm volatile("" : "+v"(tid_));
    const int tid = tid_, wid = __builtin_amdgcn_readfirstlane(tid >> 6), lane = tid & 63, wr = wid >> 2, wc = wid & 3, fr = lane & 15, fq = lane >> 4;
    const int K = g.K, nt = K / BK;
    unsigned voffA[2], voffB[2];
#pragma unroll
    for (int i = 0; i < 2; ++i) { int R, C; stage_rc(tid * 16 + i * 8192, R, C); const int Rb = Epi::PERM ? ((R & ~31) + perm32(R & 31)) : R;
        voffA[i] = (unsigned)(R * K + C) * 2u; voffB[i] = (unsigned)(Rb * K + C) * 2u; }
    const size_t kstep = (size_t)(BK * 2);
    const size_t hstep = (size_t)HALF * K * 2;
    const size_t tstep = 2 * hstep;
    const unsigned ldsw = (unsigned)wid * 1024u;
    const int aoff = lds_byte(wr * 64 + fr, fq * 8), boff = lds_byte(wc * 32 + fr, fq * 8);
#define PG8_SA(b, h) (((b) * 2 + (h)) * HTB)
#define PG8_SB(b, h) ((4 + (b) * 2 + (h)) * HTB)
#define PG8_STAGE(bufoff, gbase, voff) do { _Pragma("unroll") for (int _i = 0; _i < 2; ++_i) \
        __builtin_amdgcn_global_load_lds((const unsigned*)((const char*)(gbase) + (voff)[_i]), (PG8_LAS unsigned*)(lds + (bufoff) + ldsw + _i * 8192), 16, 0, 0); } while (0)
#define PG8_LDA(dst, b, h) do { _Pragma("unroll") for (int m = 0; m < 4; ++m) _Pragma("unroll") for (int k = 0; k < 2; ++k) dst[m][k] = *(const PG8_LAS bf16x8*)(lds + PG8_SA(b, h) + aoff + m * 2048 + k * 1024); } while (0)
#define PG8_LDB(dst, b, h) do { _Pragma("unroll") for (int n = 0; n < 2; ++n) _Pragma("unroll") for (int k = 0; k < 2; ++k) dst[n][k] = *(const PG8_LAS bf16x8*)(lds + PG8_SB(b, h) + boff + n * 2048 + k * 1024); } while (0)
#define PG8_MMA(ai, bj, At, Bt) do { __builtin_amdgcn_s_setprio(1); _Pragma("unroll") for (int m = 0; m < 4; ++m) _Pragma("unroll") for (int n = 0; n < 2; ++n) _Pragma("unroll") for (int k = 0; k < 2; ++k) \
        acc[ai][bj][m][n] = __builtin_amdgcn_mfma_f32_16x16x32_bf16(Bt[n][k], At[m][k], acc[ai][bj][m][n], 0, 0, 0); __builtin_amdgcn_s_setprio(0); } while (0)
#define PG8_WAIT_V(n) asm volatile("s_waitcnt vmcnt(" #n ")" ::: "memory")
#define PG8_WAIT_L(n) asm volatile("s_waitcnt lgkmcnt(" #n ")" ::: "memory")
#define PG8_BAR __builtin_amdgcn_s_barrier()
#define PG8_SCHED __builtin_amdgcn_sched_barrier(0)
    Unit cur, nxt; int ui = 0;
    if (!S.next(0, cur)) return;
    f32x4 acc[2][2][4][2];
#pragma unroll
    for (int a = 0; a < 2; ++a)
#pragma unroll
        for (int b = 0; b < 2; ++b)
#pragma unroll
            for (int m = 0; m < 4; ++m)
#pragma unroll
                for (int n = 0; n < 2; ++n) acc[a][b][m][n] = (f32x4){0.f, 0.f, 0.f, 0.f};
    bf16x8 At[4][2], B0[2][2], B1[2][2];
    const char* cA = (const char*)g.A + (size_t)cur.pa * tstep; const char* cB = (const char*)g.Bt + (size_t)cur.pn * tstep;
    S.a_ready(cur);
    if constexpr (SP2) {
        PG8_STAGE(PG8_SB(0, 0), cB, voffB); PG8_STAGE(PG8_SB(0, 1), cB + hstep, voffB); PG8_STAGE(PG8_SA(0, 0), cA, voffA); PG8_STAGE(PG8_SA(0, 1), cA + hstep, voffA);
        if (wr == 1) PG8_BAR;
        PG8_WAIT_V(2); PG8_BAR;
        PG8_STAGE(PG8_SB(1, 0), cB + kstep, voffB); PG8_STAGE(PG8_SA(1, 0), cA + kstep, voffA); PG8_STAGE(PG8_SB(1, 1), cB + hstep + kstep, voffB);
        PG8_WAIT_V(6); PG8_BAR;
    } else {
        PG8_STAGE(PG8_SB(0, 0), cB, voffB); PG8_STAGE(PG8_SA(0, 0), cA, voffA); PG8_STAGE(PG8_SB(0, 1), cB + hstep, voffB); PG8_STAGE(PG8_SA(0, 1), cA + hstep, voffA);
        if (wr == 1) PG8_BAR;
        PG8_WAIT_V(4); PG8_BAR;
        PG8_STAGE(PG8_SB(1, 0), cB + kstep, voffB); PG8_STAGE(PG8_SA(1, 0), cA + kstep, voffA); PG8_STAGE(PG8_SB(1, 1), cB + hstep + kstep, voffB);
        PG8_WAIT_V(6); PG8_BAR;
    }
    for (;;) {
        const bool has_next = S.next(ui + 1, nxt);
        const char* nA = has_next ? (const char*)g.A + (size_t)nxt.pa * tstep : cA; const char* nB = has_next ? (const char*)g.Bt + (size_t)nxt.pn * tstep : cB;
        for (int t = 0; t < nt; t += 2) {
            const bool last = (t == nt - 2);
            const char* a1 = cA + (size_t)(t + 1) * kstep;
            const char* a2 = last ? nA : cA + (size_t)(t + 2) * kstep; const char* b2 = last ? nB : cB + (size_t)(t + 2) * kstep;
            const char* a3 = a2 + kstep; const char* b3 = b2 + kstep;
            if (last && has_next) S.a_ready(nxt);
            if constexpr (SP2) {
            PG8_LDB(B0, 0, 0); PG8_LDB(B1, 0, 1); PG8_SCHED; PG8_LDA(At, 0, 0); PG8_STAGE(PG8_SA(1, 1), a1 + hstep, voffA);
            PG8_WAIT_V(8); PG8_WAIT_L(0); PG8_BAR; PG8_MMA(0, 0, At, B0); PG8_MMA(0, 1, At, B1); PG8_BAR; PG8_SCHED;
            PG8_LDA(At, 0, 1); PG8_STAGE(PG8_SB(0, 0), b2, voffB); PG8_STAGE(PG8_SB(0, 1), b2 + hstep, voffB); PG8_STAGE(PG8_SA(0, 0), a2, voffA);
            PG8_WAIT_V(8); PG8_WAIT_L(0); PG8_BAR; PG8_MMA(1, 0, At, B0); PG8_MMA(1, 1, At, B1); PG8_BAR; PG8_SCHED;
            PG8_LDB(B0, 1, 0); PG8_LDB(B1, 1, 1); PG8_SCHED; PG8_LDA(At, 1, 0); PG8_STAGE(PG8_SA(0, 1), a2 + hstep, voffA);
            PG8_WAIT_V(8); PG8_WAIT_L(0); PG8_BAR; PG8_MMA(0, 0, At, B0); PG8_MMA(0, 1, At, B1); PG8_BAR; PG8_SCHED;
            PG8_LDA(At, 1, 1); PG8_STAGE(PG8_SB(1, 0), b3, voffB); PG8_STAGE(PG8_SB(1, 1), b3 + hstep, voffB); PG8_STAGE(PG8_SA(1, 0), a3, voffA);
            PG8_WAIT_V(8); PG8_WAIT_L(0); PG8_BAR; PG8_MMA(1, 0, At, B0); PG8_MMA(1, 1, At, B1); PG8_BAR; PG8_SCHED;
            } else {
            PG8_LDB(B0, 0, 0); PG8_SCHED; PG8_LDA(At, 0, 0); PG8_STAGE(PG8_SA(1, 1), a1 + hstep, voffA);
            PG8_WAIT_L(8); PG8_BAR; PG8_WAIT_L(0); PG8_MMA(0, 0, At, B0); PG8_BAR; PG8_SCHED;
            PG8_LDB(B1, 0, 1); PG8_STAGE(PG8_SB(0, 0), b2, voffB);
            PG8_BAR; PG8_WAIT_L(0); PG8_MMA(0, 1, At, B1); PG8_BAR;
            PG8_LDA(At, 0, 1); PG8_STAGE(PG8_SA(0, 0), a2, voffA);
            PG8_BAR; PG8_WAIT_L(0); PG8_MMA(1, 0, At, B0); PG8_BAR; PG8_SCHED;
            PG8_STAGE(PG8_SB(0, 1), b2 + hstep, voffB);
            PG8_WAIT_V(6); PG8_BAR; PG8_MMA(1, 1, At, B1); PG8_BAR;
            PG8_LDB(B0, 1, 0); PG8_SCHED; PG8_LDA(At, 1, 0); PG8_STAGE(PG8_SA(0, 1), a2 + hstep, voffA);
            PG8_WAIT_L(8); PG8_BAR; PG8_WAIT_L(0); PG8_MMA(0, 0, At, B0); PG8_BAR; PG8_SCHED;
            PG8_LDB(B1, 1, 1); PG8_STAGE(PG8_SB(1, 0), b3, voffB);
            PG8_BAR; PG8_WAIT_L(0); PG8_MMA(0, 1, At, B1); PG8_BAR;
            PG8_LDA(At, 1, 1); PG8_STAGE(PG8_SA(1, 0), a3, voffA);
            PG8_BAR; PG8_WAIT_L(0); PG8_MMA(1, 0, At, B0); PG8_BAR; PG8_SCHED;
            PG8_STAGE(PG8_SB(1, 1), b3 + hstep, voffB);
            PG8_WAIT_V(6); PG8_BAR; PG8_MMA(1, 1, At, B1); PG8_BAR;
            }
        }
        if constexpr (ALIGN_EPI) { if (wr == 0) PG8_BAR; }
        if constexpr (!Epi::AFTER_DRAIN) { E(acc, cur, wr, wc, fr, fq); S.done(cur); }
        if (!has_next) break;
#pragma unroll
        for (int a = 0; a < 2; ++a)
#pragma unroll
            for (int b = 0; b < 2; ++b)
#pragma unroll
                for (int m = 0; m < 4; ++m)
#pragma unroll
                    for (int n = 0; n < 2; ++n) acc[a][b][m][n] = (f32x4){0.f, 0.f, 0.f, 0.f};
        cur = nxt; cA = nA; cB = nB; ++ui;
        if constexpr (ALIGN_EPI) { if (wr == 1) PG8_BAR; }
    }
    PG8_WAIT_V(0);
    if constexpr (!ALIGN_EPI) { if (wr == 0) PG8_BAR; }
    PG8_BAR;
    if constexpr (Epi::AFTER_DRAIN) { E.fused(acc, cur, wr, wc, fr, fq, lds, wid, lane); S.done(cur); }
#undef PG8_SA
#undef PG8_SB
#undef PG8_STAGE
#undef PG8_LDA
#undef PG8_LDB
#undef PG8_MMA
#undef PG8_WAIT_V
#undef PG8_WAIT_L
#undef PG8_BAR
#undef PG8_SCHED
}
}

#ifndef USE_CG_SYNC
#define USE_CG_SYNC 0
#endif
constexpr int NWAVES = 8, NTHR = 512;
constexpr int TT = 16384, SEQ = 8192, DM = 1024, DEPTH = 2, INC = 6920, DFF = 2816;
constexpr int C_QKVC = 1792, C_BETA = 3840, C_GATE = 3848;
constexpr int NMIX = 3840, NMIXP = 4096;
constexpr size_t MiB = 1u << 20, KiB = 1u << 10;
constexpr size_t WS_CTL = 0, CTL_ZERO_BYTES = 64 * KiB;
constexpr size_t WS_ROWSQ = 1 * MiB;
constexpr size_t WS_BA = 2 * MiB;
constexpr size_t WS_CD = 2 * MiB + 512 * KiB;
constexpr size_t WS_WBA = WS_CD + 64 * KiB;
constexpr size_t WS_SGUW = 2 * MiB + 768 * KiB;
constexpr size_t WS_WIN = 3 * MiB;
constexpr size_t WS_WG = WS_WIN + 4096 * 1024 * 2;
constexpr size_t WS_WBR = WS_WG + 3072 * 1024 * 2;
constexpr size_t WS_WOUT = WS_WBR + 3 * 1024 * 512 * 2;
constexpr size_t WS_XB = 22 * MiB;
constexpr size_t WS_UV = 54 * MiB;
constexpr size_t WS_QKVB = 86 * MiB;
constexpr size_t WS_WGU = WS_QKVB;
constexpr size_t WS_WDN = WS_QKVB + 5632 * 1024 * 2;
constexpr size_t WS_QKVC = 110 * MiB;
constexpr size_t WS_BR = WS_QKVC;
constexpr size_t WS_Z = 158 * MiB;
constexpr size_t WS_DN = 174 * MiB;
constexpr size_t WS_MG = 158 * MiB, WS_Y1 = 190 * MiB, WS_Y2 = 222 * MiB;
constexpr size_t WS_HID = 110 * MiB;
constexpr size_t WS_END = 254 * MiB;
static_assert(WS_WOUT + 1024 * 1024 * 2 <= WS_XB && WS_WDN + 1024 * 2816 * 2 <= WS_QKVC && WS_HID + (size_t)TT * DFF * 2 <= WS_END && WS_DN + 1024 * 72 * KiB <= WS_END && WS_Y2 + 32 * MiB <= WS_END, "ws map");
constexpr int DN_TASK_BYTES = 73728, DN_OFF_W = 0, DN_OFF_QD = 16384, DN_OFF_AT = 32768, DN_OFF_KD = 40960, DN_OFF_U = 57344;
constexpr int LDS_BYTES = 163840, MISC_OFF = LDS_BYTES - 256;

#define LAS __attribute__((address_space(3)))
typedef unsigned short bf16;
typedef float f32x4 __attribute__((ext_vector_type(4)));
typedef float f32x16 __attribute__((ext_vector_type(16)));
typedef short bf16x8 __attribute__((ext_vector_type(8)));
typedef unsigned u32x4 __attribute__((ext_vector_type(4)));
typedef unsigned u32x2 __attribute__((ext_vector_type(2)));
using pg8::pk2; using pg8::bflo; using pg8::bfhi; using pg8::fast_sigmoid; using pg8::NORM_EPS;
#define MFMA32(a, b, c) __builtin_amdgcn_mfma_f32_32x32x16_bf16((a), (b), (c), 0, 0, 0)
__device__ __forceinline__ int crow(int reg, int h) { return (reg & 3) + 8 * (reg >> 2) + 4 * h; }
__device__ __forceinline__ bf16x8 pack_step(const f32x16& x, int s) {
    u32x4 p; p.x = pk2(x[8 * s], x[8 * s + 1]); p.y = pk2(x[8 * s + 2], x[8 * s + 3]); p.z = pk2(x[8 * s + 4], x[8 * s + 5]); p.w = pk2(x[8 * s + 6], x[8 * s + 7]);
    return __builtin_bit_cast(bf16x8, p);
}
__device__ __forceinline__ float wave_sum(float v) {
#pragma unroll
    for (int o = 1; o < 64; o <<= 1) v += __shfl_xor(v, o);
    return v;
}
__device__ __forceinline__ f32x16 zero16() { f32x16 z; for (int i = 0; i < 16; ++i) z[i] = 0.f; return z; }

struct Params {
    const float* x; const int* pos; const float* attn_norm; const float* w_in; const float* sgu_ln_g; const float* sgu_ln_b; const float* sgu_w; const float* sgu_b;
    const float* sinks; const float* conv_w; const float* a_log; const float* dt_bias; const float* dn_norm; const float* w_branch; const float* w_out; const float* ffn_norm;
    const float* w_gate_up; const float* w_down; const float* final_norm;
    float* out; unsigned char* ws; int ph_lo, ph_hi;
};
struct Frame { LAS unsigned char* lds; int tid, lane, wave, vb, G; };

constexpr int TR_SCR = 64 * 68 * 4;
template <int MAP> __device__ __forceinline__ void transpose_item(const float* W, int ldw, int ncol0, int K, int N, const float* kscale, bf16* WT, LAS float* scr, int item, int lane) {
    const int nblk = N / 64, kb = item / nblk, nb = item % nblk, k0 = 64 * kb, n0 = 64 * nb, r4 = lane >> 4, c4 = lane & 15;
    f32x4 v[16];
#pragma unroll
    for (int i = 0; i < 16; ++i) v[i] = *(const f32x4*)(W + (size_t)(k0 + 4 * i + r4) * ldw + ncol0 + n0 + 4 * c4);
    if (kscale) {
#pragma unroll
        for (int i = 0; i < 16; ++i) v[i] = v[i] * kscale[k0 + 4 * i + r4]; }
#pragma unroll
    for (int i = 0; i < 16; ++i) { const int r = 4 * i + r4; *(LAS f32x4*)(scr + r * 68 + ((4 * c4 + 4 * (r >> 3)) & 63)) = v[i]; }
    asm volatile("s_waitcnt lgkmcnt(0)" ::: "memory");
    const int kc = lane & 7, nn = lane >> 3;
#pragma unroll
    for (int j = 0; j < 8; ++j) { const int n = nn + 8 * j; const LAS float* sp = scr + (8 * kc) * 68 + ((n + 4 * kc) & 63);
        u32x4 o; o.x = pk2(sp[0 * 68], sp[1 * 68]); o.y = pk2(sp[2 * 68], sp[3 * 68]); o.z = pk2(sp[4 * 68], sp[5 * 68]); o.w = pk2(sp[6 * 68], sp[7 * 68]);
        const int gn = n0 + n; int dr = gn;
        if (MAP == 1) { const int f = gn < DFF ? gn : gn - DFF; dr = (f >> 7) * 256 + (gn < DFF ? 0 : 128) + (f & 127); }
        *(u32x4*)(WT + (size_t)dr * K + k0 + 8 * kc) = o; }
    asm volatile("s_waitcnt lgkmcnt(0)" ::: "memory");
}
__device__ __forceinline__ void p0_attn_weights(const Frame& F, const Params& P, int l) {
    LAS float* scr = (LAS float*)(F.lds + F.wave * TR_SCR);
    const int gw = F.vb * NWAVES + F.wave, NGW = F.G * NWAVES;
    const float* win = P.w_in + (size_t)l * DM * INC; const float* an = P.attn_norm + l * DM;
    constexpr int I_MIX = 16 * (NMIX / 64), I_G = 16 * (3072 / 64), I_BR = 8 * 16, I_O = 16 * 16, NIT = I_MIX + I_G + 3 * I_BR + I_O;
#pragma unroll 1
    for (int it = gw; it < NIT; it += NGW) {
        int r = it;
        if (r < I_MIX) { transpose_item<0>(win, INC, 0, DM, NMIX, an, (bf16*)(P.ws + WS_WIN), scr, r, F.lane); continue; } r -= I_MIX;
        if (r < I_G) { transpose_item<0>(win, INC, C_GATE, DM, 3072, an, (bf16*)(P.ws + WS_WG), scr, r, F.lane); continue; } r -= I_G;
        if (r < 3 * I_BR) { const int n = r / I_BR; transpose_item<0>(P.w_branch + ((size_t)l * 3 + n) * 512 * 1024, 1024, 0, 512, 1024, nullptr, (bf16*)(P.ws + WS_WBR) + (size_t)n * 1024 * 512, scr, r % I_BR, F.lane); continue; } r -= 3 * I_BR;
        transpose_item<0>(P.w_out + (size_t)l * DM * DM, DM, 0, DM, DM, nullptr, (bf16*)(P.ws + WS_WOUT), scr, r, F.lane);
    }
    bf16* wpad = (bf16*)(P.ws + WS_WIN) + (size_t)NMIX * DM;
    const int gi = F.vb * NTHR + F.tid;
    if (F.vb < 16) { const int c = gi >> 10, k = gi & 1023; wpad[gi] = (bf16)(pk2(win[(size_t)k * INC + C_BETA + c] * an[k], 0.f) & 0xffffu); }
    if (F.vb < 62) { unsigned zz = 0u; asm volatile("" : "+v"(zz)); ((u32x4*)(wpad + 8 * DM))[gi] = (u32x4){zz, zz, zz, zz}; }
    if (F.vb < 64) { bf16* sw = (bf16*)(P.ws + WS_SGUW); const float* sgw = P.sgu_w + (size_t)l * 4 * 128 * 128;
        const int e = 2 * gi, sx = e & 127, t = (e >> 7) & 127; const float a = sx <= t ? sgw[e] : 0.f, bq = (sx + 1) <= t ? sgw[e + 1] : 0.f; ((unsigned*)sw)[gi] = pk2(a, bq); }
}
__device__ __forceinline__ void p0_ffn_weights(const Frame& F, const Params& P, int l) {
    LAS float* scr = (LAS float*)(F.lds + F.wave * TR_SCR);
    const int gw = F.vb * NWAVES + F.wave, NGW = F.G * NWAVES;
    constexpr int I_GU = 16 * (2 * DFF / 64), I_DN = (DFF / 64) * 16, NIT = I_GU + I_DN;
#pragma unroll 1
    for (int it = gw; it < NIT; it += NGW) {
        if (it < I_GU) transpose_item<1>(P.w_gate_up + (size_t)l * DM * 2 * DFF, 2 * DFF, 0, DM, 2 * DFF, P.ffn_norm + l * DM, (bf16*)(P.ws + WS_WGU), scr, it, F.lane);
        else transpose_item<0>(P.w_down + (size_t)l * DFF * DM, DM, 0, DFF, DM, nullptr, (bf16*)(P.ws + WS_WDN), scr, it - I_GU, F.lane);
    }
}
__device__ __forceinline__ void p0_input(const Frame& F, const Params& P) {
    const int gw = F.vb * NWAVES + F.wave, NGW = F.G * NWAVES;
    bf16* xb = (bf16*)(P.ws + WS_XB); float* rowsq = (float*)(P.ws + WS_ROWSQ);
    for (int m = gw; m < TT; m += NGW) {
        const f32x4* xr = (const f32x4*)(P.x + (size_t)m * DM) + F.lane; float s = 0.f;
        unsigned long long* o8 = (unsigned long long*)(xb + (size_t)m * DM) + F.lane;
#pragma unroll
        for (int j = 0; j < 4; ++j) { const f32x4 v = xr[64 * j]; s += (v.x * v.x + v.y * v.y) + (v.z * v.z + v.w * v.w); o8[64 * j] = (unsigned long long)pk2(v.x, v.y) | ((unsigned long long)pk2(v.z, v.w) << 32); }
        s = wave_sum(s);
        if (F.lane < 16) rowsq[(size_t)m * 16 + F.lane] = F.lane == 0 ? s : 0.f;
    }
}
__device__ __forceinline__ void sgu_task(const Frame& F, const Params& P, int l, int task) {
    const int g = task & 3, cb = task >> 2, m0 = cb * 128;
    const bf16* uv = (const bf16*)(P.ws + WS_UV); bf16* bra = (bf16*)(P.ws + WS_BR);
    LAS bf16* vnT = (LAS bf16*)F.lds;
    const int r = F.tid >> 2, qq = F.tid & 3;
    { const bf16* vrow = uv + (size_t)(m0 + r) * 1024 + 512 + qq * 128; float s = 0.f, s2 = 0.f;
#pragma unroll
      for (int j = 0; j < 16; ++j) { const u32x4 w = *(const u32x4*)(vrow + 8 * j); const float a0 = bflo(w.x), a1 = bfhi(w.x), a2 = bflo(w.y), a3 = bfhi(w.y), a4 = bflo(w.z), a5 = bfhi(w.z), a6 = bflo(w.w), a7 = bfhi(w.w);
          s += ((a0 + a1) + (a2 + a3)) + ((a4 + a5) + (a6 + a7)); s2 += ((a0 * a0 + a1 * a1) + (a2 * a2 + a3 * a3)) + ((a4 * a4 + a5 * a5) + (a6 * a6 + a7 * a7)); }
      s += __shfl_xor(s, 1); s += __shfl_xor(s, 2); s2 += __shfl_xor(s2, 1); s2 += __shfl_xor(s2, 2);
      const float mean = s * (1.f / 512.f); float var = s2 * (1.f / 512.f) - mean * mean; var = var > 0.f ? var : 0.f; const float rstd = __builtin_amdgcn_rsqf(var + NORM_EPS);
      const bf16* vg = uv + (size_t)(m0 + r) * 1024 + 512 + g * 128 + qq * 32; const float* lg = P.sgu_ln_g + l * 512 + g * 128 + qq * 32; const float* lb = P.sgu_ln_b + l * 512 + g * 128 + qq * 32;
#pragma unroll
      for (int j = 0; j < 4; ++j) { const u32x4 w = *(const u32x4*)(vg + 8 * j); const float a[8] = {bflo(w.x), bfhi(w.x), bflo(w.y), bfhi(w.y), bflo(w.z), bfhi(w.z), bflo(w.w), bfhi(w.w)};
#pragma unroll
          for (int i = 0; i < 8; ++i) { const int c = qq * 32 + 8 * j + i; const float y = (a[i] - mean) * rstd * lg[8 * j + i] + lb[8 * j + i]; vnT[c * 136 + r] = (bf16)(pk2(y, 0.f) & 0xffffu); } }
    }
    __syncthreads();
    const int lr = F.lane & 31, h = F.lane >> 5, ct = F.wave >> 1;
    const bf16* sw = (const bf16*)(P.ws + WS_SGUW) + (size_t)g * 128 * 128;
#pragma unroll
    for (int t2 = 0; t2 < 2; ++t2) { const int tt = 2 * (F.wave & 1) + t2; f32x16 acc = zero16();
        for (int ks = 0; ks < 2 * (tt + 1); ++ks) {
            const bf16x8 a = *(const LAS bf16x8*)(vnT + (32 * ct + lr) * 136 + 16 * ks + 8 * h);
            const bf16x8 b = *(const bf16x8*)(sw + (size_t)(32 * tt + lr) * 128 + 16 * ks + 8 * h);
            acc = MFMA32(a, b, acc); }
        const int t = 32 * tt + lr; const float bias = P.sgu_b[l * 512 + g * 128 + t];
#pragma unroll
        for (int gq = 0; gq < 4; ++gq) { const int c0 = 32 * ct + 8 * gq + 4 * h; const u32x2 uu = *(const u32x2*)(uv + (size_t)(m0 + t) * 1024 + g * 128 + c0);
            u32x2 o; o.x = pk2(bflo(uu.x) * (acc[4 * gq] + bias), bfhi(uu.x) * (acc[4 * gq + 1] + bias)); o.y = pk2(bflo(uu.y) * (acc[4 * gq + 2] + bias), bfhi(uu.y) * (acc[4 * gq + 3] + bias));
            *(u32x2*)(bra + (size_t)(m0 + t) * 512 + g * 128 + c0) = o; } }
    __syncthreads();
}

__device__ __forceinline__ void swa_task(const Frame& F, const Params& P, int l, int task) {
    const int kvh = task & 1, cb = task >> 1, nq = cb & 63, m0 = cb * 128;
    const bf16* qkvb = (const bf16*)(P.ws + WS_QKVB); bf16* brb = (bf16*)(P.ws + WS_BR) + (size_t)TT * 512;
    LAS bf16* Qs = (LAS bf16*)F.lds;
    LAS bf16* Ks = (LAS bf16*)(F.lds + 73728);
    LAS bf16* VT = (LAS bf16*)(F.lds + 110592);
    for (int i = F.tid; i < 4096; i += NTHR) { const int g = i >> 10, r = (i >> 3) & 127, c8 = i & 7; if (c8 < 2) continue;
        const u32x4 w = *(const u32x4*)(qkvb + (size_t)(m0 + r) * 768 + (kvh * 4 + g) * 64 + c8 * 8);
        u32x4 o; o.x = pk2(bflo(w.x) * 0.125f, bfhi(w.x) * 0.125f); o.y = pk2(bflo(w.y) * 0.125f, bfhi(w.y) * 0.125f); o.z = pk2(bflo(w.z) * 0.125f, bfhi(w.z) * 0.125f); o.w = pk2(bflo(w.w) * 0.125f, bfhi(w.w) * 0.125f);
        *(LAS u32x4*)(Qs + (g * 128 + r) * 72 + c8 * 8) = o; }
    const float invf[8] = {1.0f, 0.19392274474868576f, 0.03760603093086393f, 0.007292664737217109f, 0.001414213562373095f, 0.0002742481756762073f, 5.318295896944988e-05f, 1.031338537721246e-05f};
    { const int g = F.tid >> 7, r = F.tid & 127; const float pos = (float)P.pos[m0 + r];
      const bf16* src = qkvb + (size_t)(m0 + r) * 768 + (kvh * 4 + g) * 64; const u32x4 w1 = *(const u32x4*)src, w2 = *(const u32x4*)(src + 8);
      const float x1[8] = {bflo(w1.x), bfhi(w1.x), bflo(w1.y), bfhi(w1.y), bflo(w1.z), bfhi(w1.z), bflo(w1.w), bfhi(w1.w)}, x2[8] = {bflo(w2.x), bfhi(w2.x), bflo(w2.y), bfhi(w2.y), bflo(w2.z), bfhi(w2.z), bflo(w2.w), bfhi(w2.w)};
      float o1[8], o2[8];
#pragma unroll
      for (int i = 0; i < 8; ++i) { float sn, cs; sincosf(pos * invf[i], &sn, &cs); o1[i] = (x1[i] * cs - x2[i] * sn) * 0.125f; o2[i] = (x2[i] * cs + x1[i] * sn) * 0.125f; }
      u32x4 a, b; a.x = pk2(o1[0], o1[1]); a.y = pk2(o1[2], o1[3]); a.z = pk2(o1[4], o1[5]); a.w = pk2(o1[6], o1[7]); b.x = pk2(o2[0], o2[1]); b.y = pk2(o2[2], o2[3]); b.z = pk2(o2[4], o2[5]); b.w = pk2(o2[6], o2[7]);
      *(LAS u32x4*)(Qs + (g * 128 + r) * 72) = a; *(LAS u32x4*)(Qs + (g * 128 + r) * 72 + 8) = b; }
    for (int i = F.tid; i < 2048; i += NTHR) { const int s = i >> 3, c8 = i & 7; const bool ok = nq > 0 || s >= 128; const size_t row = (size_t)(m0 - 128 + s);
        u32x4 kw = {0u, 0u, 0u, 0u}, vw = {0u, 0u, 0u, 0u};
        if (ok) { if (c8 >= 2) kw = *(const u32x4*)(qkvb + row * 768 + 512 + kvh * 64 + c8 * 8); vw = *(const u32x4*)(qkvb + row * 768 + 640 + kvh * 64 + c8 * 8); }
        if (c8 >= 2) *(LAS u32x4*)(Ks + s * 72 + c8 * 8) = kw;
        const int p = (s & ~12) | ((s & 4) << 1) | ((s & 8) >> 1); const unsigned vv[4] = {vw.x, vw.y, vw.z, vw.w};
#pragma unroll
        for (int j = 0; j < 4; ++j) { VT[(c8 * 8 + 2 * j) * 264 + p] = (bf16)(vv[j] & 0xffffu); VT[(c8 * 8 + 2 * j + 1) * 264 + p] = (bf16)(vv[j] >> 16); } }
    if (F.tid < 256) { const int s = F.tid; const bool ok = nq > 0 || s >= 128; u32x4 a = {0u, 0u, 0u, 0u}, b = {0u, 0u, 0u, 0u};
        if (ok) { const size_t row = (size_t)(m0 - 128 + s); const float pos = (float)P.pos[row]; const bf16* src = qkvb + row * 768 + 512 + kvh * 64; const u32x4 w1 = *(const u32x4*)src, w2 = *(const u32x4*)(src + 8);
            const float x1[8] = {bflo(w1.x), bfhi(w1.x), bflo(w1.y), bfhi(w1.y), bflo(w1.z), bfhi(w1.z), bflo(w1.w), bfhi(w1.w)}, x2[8] = {bflo(w2.x), bfhi(w2.x), bflo(w2.y), bfhi(w2.y), bflo(w2.z), bfhi(w2.z), bflo(w2.w), bfhi(w2.w)};
            float o1[8], o2[8];
#pragma unroll
            for (int i = 0; i < 8; ++i) { float sn, cs; sincosf(pos * invf[i], &sn, &cs); o1[i] = x1[i] * cs - x2[i] * sn; o2[i] = x2[i] * cs + x1[i] * sn; }
            a.x = pk2(o1[0], o1[1]); a.y = pk2(o1[2], o1[3]); a.z = pk2(o1[4], o1[5]); a.w = pk2(o1[6], o1[7]); b.x = pk2(o2[0], o2[1]); b.y = pk2(o2[2], o2[3]); b.z = pk2(o2[4], o2[5]); b.w = pk2(o2[6], o2[7]); }
        *(LAS u32x4*)(Ks + s * 72) = a; *(LAS u32x4*)(Ks + s * 72 + 8) = b; }
    __syncthreads();
    const int lr = F.lane & 31, h = F.lane >> 5, g = F.wave >> 1, qh = F.wave & 1;
    const float sink = P.sinks[l * 8 + kvh * 4 + g];
#pragma unroll 1
    for (int q2 = 0; q2 < 2; ++q2) { const int qt = 2 * qh + q2, q0 = 32 * qt, qi = q0 + lr;
        bf16x8 bq[4];
#pragma unroll
        for (int ks = 0; ks < 4; ++ks) bq[ks] = *(const LAS bf16x8*)(Qs + (g * 128 + q0 + lr) * 72 + 16 * ks + 8 * h);
        f32x16 sc[5];
#pragma unroll
        for (int k5 = 0; k5 < 5; ++k5) { sc[k5] = zero16();
#pragma unroll
            for (int ks = 0; ks < 4; ++ks) { const bf16x8 a = *(const LAS bf16x8*)(Ks + (32 * (qt + k5) + lr) * 72 + 16 * ks + 8 * h); sc[k5] = MFMA32(a, bq[ks], sc[k5]); } }
        float mx = sink;
#pragma unroll
        for (int k5 = 0; k5 < 5; ++k5)
#pragma unroll
            for (int rg = 0; rg < 16; ++rg) { const int sj = 32 * (qt + k5) + crow(rg, h); const bool ok = sj >= qi + 1 && sj <= qi + 128 && (nq > 0 || sj >= 128);
                const float v = ok ? sc[k5][rg] : -INFINITY; sc[k5][rg] = v; mx = fmaxf(mx, v); }
        mx = fmaxf(mx, __shfl_xor(mx, 32));
        float sum = 0.f;
#pragma unroll
        for (int k5 = 0; k5 < 5; ++k5)
#pragma unroll
            for (int rg = 0; rg < 16; ++rg) { const float p = __expf(sc[k5][rg] - mx); sc[k5][rg] = p; sum += p; }
        sum += __shfl_xor(sum, 32); sum += __expf(sink - mx);
        const float inv = 1.0f / sum;
        f32x16 o[2] = {zero16(), zero16()};
#pragma unroll
        for (int k5 = 0; k5 < 5; ++k5)
#pragma unroll
            for (int s2 = 0; s2 < 2; ++s2) { const bf16x8 pb = pack_step(sc[k5], s2);
#pragma unroll
                for (int dt = 0; dt < 2; ++dt) { const bf16x8 a = *(const LAS bf16x8*)(VT + (32 * dt + lr) * 264 + 32 * (qt + k5) + 16 * s2 + 8 * h); o[dt] = MFMA32(a, pb, o[dt]); } }
        bf16* orow = brb + (size_t)(m0 + qi) * 512 + (kvh * 4 + g) * 64;
#pragma unroll
        for (int dt = 0; dt < 2; ++dt)
#pragma unroll
            for (int gq = 0; gq < 4; ++gq) { u32x2 w; w.x = pk2(o[dt][4 * gq] * inv, o[dt][4 * gq + 1] * inv); w.y = pk2(o[dt][4 * gq + 2] * inv, o[dt][4 * gq + 3] * inv);
                *(u32x2*)(orow + 32 * dt + 8 * gq + 4 * h) = w; }
    }
    __syncthreads();
}

#define MFMA16F(a, b, c) __builtin_amdgcn_mfma_f32_16x16x4f32((a), (b), (c), 0, 0, 0)
constexpr int DP_HALF = 81920, DP_QS = 0, DP_KS = 17408, DP_LM = 0, DP_TF = 17408, DP_KT = 34816, DP_VT = 53248, DP_TAB = 71680;
__device__ __forceinline__ f32x4 blk_mm(const LAS float* X, const LAS float* Y, f32x4 c, int lane) {
    const int q = lane & 15, g = lane >> 4;
#pragma unroll
    for (int s = 0; s < 4; ++s) c = MFMA16F(X[q * 68 + 4 * s + g], Y[(4 * s + g) * 68 + q], c);
    return c;
}
__device__ __forceinline__ f32x4 blk_mm_acc(const LAS float* Z, const f32x4 p, int lane) {
    const int q = lane & 15, g = lane >> 4; f32x4 c = {0.f, 0.f, 0.f, 0.f};
#pragma unroll
    for (int s = 0; s < 4; ++s) c = MFMA16F(Z[q * 68 + 4 * g + s], p[s], c);
    return c;
}
__device__ __forceinline__ void blk_store_neg(LAS float* T, const f32x4 qv, int lane) {
    const int q = lane & 15, g = lane >> 4;
#pragma unroll
    for (int r = 0; r < 4; ++r) T[(4 * g + r) * 68 + q] = -qv[r];
}
__device__ __forceinline__ void dn_pre_pair(const Frame& F, const Params& P, int l, int pair) {
    const int half = F.wave >> 2, hw = F.wave & 3, ht = F.tid & 255, task = pair * 2 + half;
    const int hd = task & 3, cbn = task >> 2, b = cbn >> 7, n = cbn & 127, m0 = cbn * 64;
    const bf16* qkvc = (const bf16*)(P.ws + WS_QKVC); const float* ba = (const float*)(P.ws + WS_BA);
    unsigned char* outb = P.ws + WS_DN + (size_t)task * DN_TASK_BYTES;
    LAS unsigned char* L0 = F.lds + half * DP_HALF;
    LAS bf16* qs = (LAS bf16*)(L0 + DP_QS);
    LAS bf16* ks = (LAS bf16*)(L0 + DP_KS);
    LAS float* Lm = (LAS float*)(L0 + DP_LM);
    LAS float* Tf = (LAS float*)(L0 + DP_TF);
    LAS bf16* kT = (LAS bf16*)(L0 + DP_KT);
    LAS bf16* vT = (LAS bf16*)(L0 + DP_VT);
    LAS float* tgc = (LAS float*)(L0 + DP_TAB);
    LAS float *tbeta = tgc + 64, *ted = tgc + 128, *tsb = tgc + 192;
    const int lr = F.lane & 31, h = F.lane >> 5;
    float beta_l, gc_l, gl;
    { const int row = m0 + F.lane; beta_l = fast_sigmoid(ba[(size_t)row * 8 + hd]); const float xa = ba[(size_t)row * 8 + 4 + hd] + P.dt_bias[l * 4 + hd];
      const float sp = fmaxf(xa, 0.f) + __logf(1.0f + __expf(-fabsf(xa))); float x = -__expf(P.a_log[l * 4 + hd]) * sp;
#pragma unroll
      for (int o = 1; o < 64; o <<= 1) { const float y = __shfl_up(x, o); if (F.lane >= o) x += y; }
      gc_l = x; gl = __shfl(x, 63);
      if (hw == 0) { tgc[F.lane] = x; tbeta[F.lane] = beta_l; ted[F.lane] = __expf(gl - x); tsb[F.lane] = beta_l * __expf(x); if (F.lane == 0) ((float*)(P.ws + WS_CD))[task] = __expf(gl); } }
    { const int seg = ht & 7, tq = ht >> 3, t0 = 2 * tq, c0 = seg * 16;
      const float be0 = __shfl(beta_l, t0), be1 = __shfl(beta_l, t0 + 1), eg0 = __expf(__shfl(gc_l, t0)), eg1 = __expf(__shfl(gc_l, t0 + 1));
#pragma unroll
      for (int part = 0; part < 3; ++part) { const int col0 = part * 512 + hd * 128 + c0;
          float a0[16], a1[16];
#pragma unroll
          for (int i = 0; i < 16; ++i) { a0[i] = 0.f; a1[i] = 0.f; }
          const f32x4* cw = (const f32x4*)(P.conv_w + (size_t)l * 4 * 1536 + col0);
#pragma unroll
          for (int j = 0; j < 5; ++j) { const int sr = n * 64 + t0 - 3 + j;
              u32x4 w1 = {0u, 0u, 0u, 0u}, w2 = {0u, 0u, 0u, 0u};
              if (sr >= 0) { const bf16* src = qkvc + (size_t)(b * SEQ + sr) * 1536 + col0; w1 = *(const u32x4*)src; w2 = *(const u32x4*)(src + 8); }
              const float xv[16] = {bflo(w1.x), bfhi(w1.x), bflo(w1.y), bfhi(w1.y), bflo(w1.z), bfhi(w1.z), bflo(w1.w), bfhi(w1.w), bflo(w2.x), bfhi(w2.x), bflo(w2.y), bfhi(w2.y), bflo(w2.z), bfhi(w2.z), bflo(w2.w), bfhi(w2.w)};
#pragma unroll
              for (int q = 0; q < 4; ++q) {
                  if (j < 4) { const f32x4 w = cw[j * 384 + q];
#pragma unroll
                      for (int e = 0; e < 4; ++e) a0[4 * q + e] += xv[4 * q + e] * w[e]; }
                  if (j >= 1) { const f32x4 w = cw[(j - 1) * 384 + q];
#pragma unroll
                      for (int e = 0; e < 4; ++e) a1[4 * q + e] += xv[4 * q + e] * w[e]; } } }
          float s0 = 0.f, s1 = 0.f;
#pragma unroll
          for (int i = 0; i < 16; ++i) { a0[i] = a0[i] * fast_sigmoid(a0[i]); a1[i] = a1[i] * fast_sigmoid(a1[i]); s0 += a0[i] * a0[i]; s1 += a1[i] * a1[i]; }
          if (part < 2) { s0 += __shfl_xor(s0, 1); s0 += __shfl_xor(s0, 2); s0 += __shfl_xor(s0, 4); s1 += __shfl_xor(s1, 1); s1 += __shfl_xor(s1, 2); s1 += __shfl_xor(s1, 4);
              const float sc = part == 0 ? 0.08838834764831845f : 1.0f, r0 = __builtin_amdgcn_rsqf(s0 + NORM_EPS) * sc, r1 = __builtin_amdgcn_rsqf(s1 + NORM_EPS) * sc;
#pragma unroll
              for (int i = 0; i < 16; ++i) { a0[i] *= r0; a1[i] *= r1; } }
          else {
#pragma unroll
              for (int i = 0; i < 16; ++i) { a0[i] *= be0; a1[i] *= be1; } }
          if (part < 2) { LAS bf16* d0 = (part == 0 ? qs : ks) + t0 * 136 + c0;
              *(LAS u32x4*)d0 = (u32x4){pk2(a0[0], a0[1]), pk2(a0[2], a0[3]), pk2(a0[4], a0[5]), pk2(a0[6], a0[7])}; *(LAS u32x4*)(d0 + 8) = (u32x4){pk2(a0[8], a0[9]), pk2(a0[10], a0[11]), pk2(a0[12], a0[13]), pk2(a0[14], a0[15])};
              *(LAS u32x4*)(d0 + 136) = (u32x4){pk2(a1[0], a1[1]), pk2(a1[2], a1[3]), pk2(a1[4], a1[5]), pk2(a1[6], a1[7])}; *(LAS u32x4*)(d0 + 144) = (u32x4){pk2(a1[8], a1[9]), pk2(a1[10], a1[11]), pk2(a1[12], a1[13]), pk2(a1[14], a1[15])}; }
          if (part == 0) {
#pragma unroll
              for (int rr = 0; rr < 2; ++rr) { const float* a = rr ? a1 : a0; const float e = rr ? eg1 : eg0; const int t = t0 + rr;
#pragma unroll
                  for (int hh = 0; hh < 2; ++hh) { u32x4 o; o.x = pk2(a[4 * hh] * e, a[4 * hh + 1] * e); o.y = pk2(a[4 * hh + 2] * e, a[4 * hh + 3] * e); o.z = pk2(a[8 + 4 * hh] * e, a[9 + 4 * hh] * e); o.w = pk2(a[10 + 4 * hh] * e, a[11 + 4 * hh] * e);
                      *(u32x4*)(outb + DN_OFF_QD + (((t >> 5) * 8 + seg) * 64 + (t & 31) + 32 * hh) * 16) = o; } } }
          else { LAS bf16* dT = part == 1 ? kT : vT;
#pragma unroll
              for (int i = 0; i < 16; ++i) *(LAS unsigned*)(dT + (c0 + i) * 72 + t0) = pk2(a0[i], a1[i]); }
      }
    }
    __syncthreads();
    f32x16 accG = zero16(), accA = zero16(); const int i2 = hw >> 1, j2 = hw & 1;
    if (j2 <= i2) {
#pragma unroll
        for (int s = 0; s < 8; ++s) { const bf16x8 a = *(const LAS bf16x8*)(ks + (32 * i2 + lr) * 136 + 16 * s + 8 * h), bb = *(const LAS bf16x8*)(ks + (32 * j2 + lr) * 136 + 16 * s + 8 * h); accG = MFMA32(a, bb, accG); } }
    if (i2 <= j2) {
#pragma unroll
        for (int s = 0; s < 8; ++s) { const bf16x8 a = *(const LAS bf16x8*)(ks + (32 * i2 + lr) * 136 + 16 * s + 8 * h), bb = *(const LAS bf16x8*)(qs + (32 * j2 + lr) * 136 + 16 * s + 8 * h); accA = MFMA32(a, bb, accA); } }
    __syncthreads();
    { const int j = 32 * j2 + lr; const float gj = tgc[j];
#pragma unroll
      for (int rg = 0; rg < 16; ++rg) { const int i = 32 * i2 + crow(rg, h); Lm[i * 68 + j] = i > j ? tbeta[i] * accG[rg] * __expf(tgc[i] - gj) : 0.f; }
      const int c = 32 * j2 + lr; const float gcc = tgc[c];
#pragma unroll
      for (int rg = 0; rg < 16; ++rg) { const int jp = 32 * i2 + crow(rg, h); accA[rg] = jp <= c ? accA[rg] * __expf(gcc - tgc[jp]) : 0.f; }
#pragma unroll
      for (int s = 0; s < 2; ++s) *(bf16x8*)(outb + DN_OFF_AT + ((j2 * 4 + 2 * i2 + s) * 64 + F.lane) * 16) = pack_step(accA, s); }
    __syncthreads();
    { const LAS float* Ld = Lm + (16 * hw) * 68 + 16 * hw; LAS float* Td = Tf + (16 * hw) * 68 + 16 * hw; const int c = F.lane & 15; float t[16];
#pragma unroll
      for (int ii = 0; ii < 16; ++ii) { float a = (ii == c) ? 1.f : 0.f;
#pragma unroll
          for (int j4 = 0; j4 < ii; j4 += 4) { const f32x4 lv = *(const LAS f32x4*)(Ld + ii * 68 + j4); a -= lv.x * t[j4]; if (j4 + 1 < ii) a -= lv.y * t[j4 + 1]; if (j4 + 2 < ii) a -= lv.z * t[j4 + 2]; if (j4 + 3 < ii) a -= lv.w * t[j4 + 3]; }
          t[ii] = a; }
      if (F.lane < 16) {
#pragma unroll
          for (int ii = 0; ii < 16; ++ii) Td[ii * 68 + c] = t[ii]; }
      else {
          const int zc = F.lane - 16;
#pragma unroll
          for (int ii = 0; ii < 16; ++ii) { const int col = 16 * hw + 16 + zc; if (col < 64) Tf[(16 * hw + ii) * 68 + col] = 0.f; } } }
    __syncthreads();
    if (hw < 3) { const int i = hw + 1, j = hw; f32x4 p = {0.f, 0.f, 0.f, 0.f};
        p = blk_mm(Lm + (16 * i) * 68 + 16 * j, Tf + (16 * j) * 68 + 16 * j, p, F.lane);
        blk_store_neg(Tf + (16 * i) * 68 + 16 * j, blk_mm_acc(Tf + (16 * i) * 68 + 16 * i, p, F.lane), F.lane); }
    __syncthreads();
    if (hw < 2) { const int i = hw + 2, j = hw; f32x4 p = {0.f, 0.f, 0.f, 0.f};
        p = blk_mm(Lm + (16 * i) * 68 + 16 * j, Tf + (16 * j) * 68 + 16 * j, p, F.lane);
        p = blk_mm(Lm + (16 * i) * 68 + 16 * (j + 1), Tf + (16 * (j + 1)) * 68 + 16 * j, p, F.lane);
        blk_store_neg(Tf + (16 * i) * 68 + 16 * j, blk_mm_acc(Tf + (16 * i) * 68 + 16 * i, p, F.lane), F.lane); }
    __syncthreads();
    if (hw == 0) { f32x4 p = {0.f, 0.f, 0.f, 0.f};
        p = blk_mm(Lm + 48 * 68, Tf, p, F.lane); p = blk_mm(Lm + 48 * 68 + 16, Tf + 16 * 68, p, F.lane); p = blk_mm(Lm + 48 * 68 + 32, Tf + 32 * 68, p, F.lane);
        blk_store_neg(Tf + 48 * 68, blk_mm_acc(Tf + 48 * 68 + 48, p, F.lane), F.lane); }
    __syncthreads();
#define DP_TFRAG(row_, s_) ({ const LAS f32x4* tp_ = (const LAS f32x4*)(Tf + (row_) * 68 + 16 * (s_) + 8 * h); const f32x4 x0_ = tp_[0], x1_ = tp_[1]; \
        u32x4 tw_; tw_.x = pk2(x0_.x, x0_.y); tw_.y = pk2(x0_.z, x0_.w); tw_.z = pk2(x1_.x, x1_.y); tw_.w = pk2(x1_.z, x1_.w); __builtin_bit_cast(bf16x8, tw_); })
#pragma unroll
    for (int it = 0; it < 2; ++it) { const int et = hw; f32x16 acc = zero16();
#pragma unroll
        for (int s = 0; s < 4; ++s) { const bf16x8 a = DP_TFRAG(32 * it + lr, s), bb = *(const LAS bf16x8*)(vT + (32 * et + lr) * 72 + 16 * s + 8 * h); acc = MFMA32(a, bb, acc); }
        u32x4 o0, o1; o0.x = pk2(acc[0], acc[1]); o0.y = pk2(acc[2], acc[3]); o0.z = pk2(acc[4], acc[5]); o0.w = pk2(acc[6], acc[7]); o1.x = pk2(acc[8], acc[9]); o1.y = pk2(acc[10], acc[11]); o1.z = pk2(acc[12], acc[13]); o1.w = pk2(acc[14], acc[15]);
        unsigned char* up = outb + DN_OFF_U + ((et * 2 + it) * 64 + F.lane) * 32; *(u32x4*)up = o0; *(u32x4*)(up + 16) = o1; }
#pragma unroll
    for (int it = 0; it < 2; ++it) { const int dt = hw; f32x16 acc = zero16();
#pragma unroll
        for (int s = 0; s < 4; ++s) { const u32x4 kw = *(const LAS u32x4*)(kT + (32 * dt + lr) * 72 + 16 * s + 8 * h); const f32x4 e0 = *(const LAS f32x4*)(tsb + 16 * s + 8 * h), e1 = *(const LAS f32x4*)(tsb + 16 * s + 8 * h + 4);
            u32x4 aw; aw.x = pk2(bflo(kw.x) * e0.x, bfhi(kw.x) * e0.y); aw.y = pk2(bflo(kw.y) * e0.z, bfhi(kw.y) * e0.w); aw.z = pk2(bflo(kw.z) * e1.x, bfhi(kw.z) * e1.y); aw.w = pk2(bflo(kw.w) * e1.z, bfhi(kw.w) * e1.w);
            const bf16x8 bb = DP_TFRAG(32 * it + lr, s); acc = MFMA32(__builtin_bit_cast(bf16x8, aw), bb, acc); }
#pragma unroll
        for (int s = 0; s < 2; ++s) *(bf16x8*)(outb + DN_OFF_W + ((it * 8 + 2 * dt + s) * 64 + F.lane) * 16) = pack_step(acc, s); }
#undef DP_TFRAG
#pragma unroll
    for (int s = 0; s < 4; ++s) { const int dt = hw, d = 32 * dt + lr;
        const u32x2 lo = *(const LAS u32x2*)(kT + d * 72 + 16 * s + 4 * h), hi = *(const LAS u32x2*)(kT + d * 72 + 16 * s + 8 + 4 * h);
        const f32x4 e0 = *(const LAS f32x4*)(ted + 16 * s + 4 * h), e1 = *(const LAS f32x4*)(ted + 16 * s + 8 + 4 * h);
        u32x4 o; o.x = pk2(bflo(lo.x) * e0.x, bfhi(lo.x) * e0.y); o.y = pk2(bflo(lo.y) * e0.z, bfhi(lo.y) * e0.w); o.z = pk2(bflo(hi.x) * e1.x, bfhi(hi.x) * e1.y); o.w = pk2(bflo(hi.y) * e1.z, bfhi(hi.y) * e1.w);
        *(u32x4*)(outb + DN_OFF_KD + ((dt * 4 + s) * 64 + F.lane) * 16) = o; }
    __syncthreads();
}
constexpr int SC_BUF = 49152;
#define SC_BARRIER() do { asm volatile("s_waitcnt lgkmcnt(0)" ::: "memory"); __builtin_amdgcn_s_barrier(); asm volatile("" ::: "memory"); } while (0)
__device__ __forceinline__ void dn_scan(const Frame& F, const Params& P, int bh, bool nostore = false) {
    const int b = bh >> 2, hd = bh & 3; const int es = F.wave;
    unsigned char* dn = P.ws + WS_DN; const float* cdv = (const float*)(P.ws + WS_CD);
#define task_of(n_) ((((b) * 128 + (n_)) << 2) | (hd))
#define SC_SRC(n_, i_) ((const u32x4*)(dn + (size_t)task_of(n_) * DN_TASK_BYTES + ((i_) < 4 ? 0 : ((i_) < 8 ? DN_OFF_KD - 16384 : DN_OFF_U - 32768))) + t4 + 256 * (i_))
    if (F.wave >= 4) {
        const int t4 = F.tid - 256; u32x4 R0[12], R1[12], R2[12]; LAS float* cdl = (LAS float*)(F.lds + 2 * SC_BUF);
        float C0 = cdv[task_of(1)], C1 = cdv[task_of(2)], C2 = cdv[task_of(3)];
        if (t4 == 0) cdl[0] = cdv[task_of(0)];
        { LAS u32x4* dst = (LAS u32x4*)F.lds;
#pragma unroll
          for (int i = 0; i < 12; ++i) R0[i] = *SC_SRC(0, i);
#pragma unroll
          for (int i = 0; i < 12; ++i) dst[t4 + 256 * i] = R0[i]; }
#pragma unroll
        for (int i = 0; i < 12; ++i) { R0[i] = *SC_SRC(1, i); R1[i] = *SC_SRC(2, i); R2[i] = *SC_SRC(3, i); }
        SC_BARRIER();
#define SC_LSTEP(R, C, n_) if ((n_) < 128) { if ((n_) + 1 < 128) { LAS u32x4* dst = (LAS u32x4*)(F.lds + (((n_) + 1) & 1) * SC_BUF); \
            _Pragma("unroll") for (int i = 0; i < 12; ++i) dst[t4 + 256 * i] = R[i]; if (t4 == 0) cdl[((n_) + 1) & 1] = C; } \
            if ((n_) + 4 < 128) { _Pragma("unroll") for (int i = 0; i < 12; ++i) R[i] = *SC_SRC((n_) + 4, i); C = cdv[task_of((n_) + 4)]; } \
            SC_BARRIER(); }
#pragma unroll
        for (int n = 0; n < 129; n += 3) { SC_LSTEP(R0, C0, n) SC_LSTEP(R1, C1, n + 1) SC_LSTEP(R2, C2, n + 2) }
#undef SC_LSTEP
    } else {
        f32x16 S[4] = {zero16(), zero16(), zero16(), zero16()};
        const LAS float* cdl = (const LAS float*)(F.lds + 2 * SC_BUF);
        SC_BARRIER();
#pragma unroll 1
        for (int n = 0; n < 128; ++n) {
            const LAS unsigned char* cur = F.lds + (n & 1) * SC_BUF; unsigned char* tb = dn + (size_t)task_of(n) * DN_TASK_BYTES;
            const float cd = cdl[n & 1];
            bf16x8 Sb[8], A[16];
#pragma unroll
            for (int i = 0; i < 16; ++i) A[i] = *(const LAS bf16x8*)(cur + (i * 64 + F.lane) * 16);
#pragma unroll
            for (int dt = 0; dt < 4; ++dt) { Sb[2 * dt] = pack_step(S[dt], 0); Sb[2 * dt + 1] = pack_step(S[dt], 1); }
            { unsigned char* hp = tb + (es < 2 ? 0 : DN_OFF_KD) + ((es & 1) * 8 * 64 + F.lane) * 16;
              if (!nostore) {
#pragma unroll
              for (int s = 0; s < 8; ++s) *(bf16x8*)(hp + s * 1024) = Sb[s]; } }
            __builtin_amdgcn_sched_barrier(0);
            f32x16 Pw[2] = {zero16(), zero16()};
#pragma unroll
            for (int s = 0; s < 8; ++s) { Pw[0] = MFMA32(A[s], Sb[s], Pw[0]); Pw[1] = MFMA32(A[8 + s], Sb[s], Pw[1]); }
            __builtin_amdgcn_sched_barrier(0);
            u32x4 uu[4];
#pragma unroll
            for (int i = 0; i < 4; ++i) uu[i] = *(const LAS u32x4*)(cur + 32768 + ((es * 2 + (i >> 1)) * 64 + F.lane) * 32 + (i & 1) * 16);
#pragma unroll
            for (int i = 0; i < 16; ++i) A[i] = *(const LAS bf16x8*)(cur + 16384 + (i * 64 + F.lane) * 16);
            __builtin_amdgcn_sched_barrier(0);
            bf16x8 Vb[4];
#pragma unroll
            for (int ct = 0; ct < 2; ++ct) { const unsigned uw[8] = {uu[2 * ct].x, uu[2 * ct].y, uu[2 * ct].z, uu[2 * ct].w, uu[2 * ct + 1].x, uu[2 * ct + 1].y, uu[2 * ct + 1].z, uu[2 * ct + 1].w}; f32x16 v;
#pragma unroll
                for (int p = 0; p < 8; ++p) { v[2 * p] = bflo(uw[p]) - Pw[ct][2 * p]; v[2 * p + 1] = bfhi(uw[p]) - Pw[ct][2 * p + 1]; }
                Vb[2 * ct] = pack_step(v, 0); Vb[2 * ct + 1] = pack_step(v, 1); }
            { unsigned char* vp = tb + DN_OFF_U + (es * 4 * 64 + F.lane) * 16;
              if (!nostore) {
#pragma unroll
              for (int s = 0; s < 4; ++s) *(bf16x8*)(vp + s * 1024) = Vb[s]; } }
#pragma unroll
            for (int dt = 0; dt < 4; ++dt) S[dt] = S[dt] * cd;
            __builtin_amdgcn_sched_barrier(0);
#pragma unroll
            for (int s = 0; s < 4; ++s)
#pragma unroll
                for (int dt = 0; dt < 4; ++dt) S[dt] = MFMA32(A[dt * 4 + s], Vb[s], S[dt]);
            SC_BARRIER();
        }
    }
#undef SC_SRC
#undef task_of
}
__device__ __forceinline__ void dn_out_task(const Frame& F, const Params& P, int l, int task) {
    const int hd = task & 3, cbn = task >> 2, m0 = cbn * 64; const int lr = F.lane & 31, h = F.lane >> 5, ct = F.wave >> 2, es = F.wave & 3;
    const unsigned char* tb = P.ws + WS_DN + (size_t)task * DN_TASK_BYTES; bf16* brc = (bf16*)(P.ws + WS_BR) + (size_t)2 * TT * 512; const bf16* z = (const bf16*)(P.ws + WS_Z);
    LAS float* ssq = (LAS float*)F.lds;
    f32x16 o = zero16();
    { const unsigned char* hp = tb + (es < 2 ? 0 : DN_OFF_KD) + ((es & 1) * 8 * 64 + F.lane) * 16;
#pragma unroll
      for (int s = 0; s < 8; ++s) { const bf16x8 a = *(const bf16x8*)(tb + DN_OFF_QD + ((ct * 8 + s) * 64 + F.lane) * 16), bb = *(const bf16x8*)(hp + s * 1024); o = MFMA32(a, bb, o); }
      const unsigned char* vp = tb + DN_OFF_U + (es * 4 * 64 + F.lane) * 16;
#pragma unroll
      for (int s = 0; s < 4; ++s) { const bf16x8 a = *(const bf16x8*)(tb + DN_OFF_AT + ((ct * 4 + s) * 64 + F.lane) * 16), bb = *(const bf16x8*)(vp + s * 1024); o = MFMA32(a, bb, o); } }
    float q[16];
#pragma unroll
    for (int rg = 0; rg < 16; ++rg) { float v = o[rg] * o[rg]; v += __shfl_xor(v, 1); v += __shfl_xor(v, 2); v += __shfl_xor(v, 4); v += __shfl_xor(v, 8); v += __shfl_xor(v, 16); q[rg] = v; }
    if (lr == 0) {
#pragma unroll
        for (int rg = 0; rg < 16; ++rg) ssq[(ct * 4 + es) * 32 + crow(rg, h)] = q[rg]; }
    __syncthreads();
    const int e = hd * 128 + es * 32 + lr; const float gn = P.dn_norm[l * 128 + es * 32 + lr];
#pragma unroll
    for (int rg = 0; rg < 16; ++rg) { const int r = crow(rg, h); const float tot = (ssq[(ct * 4 + 0) * 32 + r] + ssq[(ct * 4 + 1) * 32 + r]) + (ssq[(ct * 4 + 2) * 32 + r] + ssq[(ct * 4 + 3) * 32 + r]);
        const float rs = __builtin_amdgcn_rsqf(tot * (1.f / 128.f) + NORM_EPS); const size_t idx = (size_t)(m0 + 32 * ct + r) * 512 + e;
        const float zz = __uint_as_float(((unsigned)z[idx]) << 16); brc[idx] = (bf16)(pk2(o[rg] * rs * gn * (zz * fast_sigmoid(zz)), 0.f) & 0xffffu); }
    __syncthreads();
}
__device__ __forceinline__ void final_norm(const Frame& F, const Params& P) {
    const int gw = F.vb * NWAVES + F.wave, NGW = F.G * NWAVES; const float* rowsq = (const float*)(P.ws + WS_ROWSQ);
    f32x4 gn[4];
#pragma unroll
    for (int j = 0; j < 4; ++j) gn[j] = ((const f32x4*)P.final_norm)[F.lane + 64 * j];
    for (int m = gw; m < TT; m += NGW) { float sq = F.lane < 16 ? rowsq[(size_t)m * 16 + F.lane] : 0.f; sq = wave_sum(sq); const float rs = __builtin_amdgcn_rsqf(sq * (1.f / 1024.f) + NORM_EPS);
        f32x4* xr = (f32x4*)(P.out + (size_t)m * DM) + F.lane;
#pragma unroll
        for (int j = 0; j < 4; ++j) xr[64 * j] = xr[64 * j] * rs * gn[j]; }
}

#define RLX_AGENT __ATOMIC_RELAXED, __HIP_MEMORY_SCOPE_AGENT
#define XB_TMO      128
#define XB_XCNT(j)  (256  + 64 * (j))
#define XB_XSUB(j)  (1280 + 64 * (j))
#define XB_XGEN(j)  (2304 + 64 * (j))
#define XB_TOP      3328
#define XB_TOPGEN   3392
#define XCD_BAR_WORDS 3456
#define XB_SPIN_CAP (1u << 18)

__device__ __forceinline__ unsigned xb_ld(unsigned* p)              { return __hip_atomic_load(p, __ATOMIC_RELAXED, __HIP_MEMORY_SCOPE_AGENT); }
__device__ __forceinline__ unsigned xb_add(unsigned* p, unsigned v) { return __hip_atomic_fetch_add(p, v, __ATOMIC_RELAXED, __HIP_MEMORY_SCOPE_AGENT); }
__device__ __forceinline__ unsigned xb_xcc_id() { return (unsigned)__builtin_amdgcn_s_getreg((3 << 11) | 20) & 0xFu; }
#define XB_SPIN(cond, bar) do { unsigned _sp = 0; while (cond) { __builtin_amdgcn_s_sleep(1); \
    if ((++_sp & 255u) == 0u) { if (xb_ld(&(bar)[XB_TMO])) break; if (_sp > XB_SPIN_CAP) { atomicAdd(&(bar)[XB_TMO], 1u); break; } } } } while (0)

struct XcdBarrier {
    unsigned* bar; unsigned x;
    volatile LAS unsigned* st;
};

__device__ __forceinline__ XcdBarrier xcd_barrier_post(unsigned* bar, volatile LAS unsigned* st) {
    XcdBarrier b; b.bar = bar; b.x = xb_xcc_id(); b.st = st;
    if (threadIdx.x == 0) (void)xb_add(&bar[XB_XCNT(b.x)], 1u);
    return b;
}
__device__ __forceinline__ void xcd_barrier_complete(unsigned* bar, unsigned x, unsigned& nloc, unsigned& nx) {
    const unsigned G = gridDim.x * gridDim.y * gridDim.z;
    unsigned sum, cnt, mine, sp = 0u;
    for (;;) {
        sum = 0u; cnt = 0u; mine = 0u;
#pragma unroll
        for (unsigned j = 0; j < 16; ++j) { const unsigned c = xb_ld(&bar[XB_XCNT(j)]); sum += c; cnt += (c > 0u) ? 1u : 0u; mine = (j == x) ? c : mine; }
        if (sum == G) break;
        __builtin_amdgcn_s_sleep(1);
        if ((++sp & 255u) == 0u) { if (xb_ld(&bar[XB_TMO])) break; if (sp > XB_SPIN_CAP) { atomicAdd(&bar[XB_TMO], 1u); break; } }
    }
    nloc = mine > 0u ? mine : 1u; nx = cnt > 0u ? cnt : 1u;
}

__device__ __forceinline__ void xcd_barrier(const XcdBarrier& b) {
    asm volatile("s_waitcnt vmcnt(0)" ::: "memory");
    __syncthreads();
    if (threadIdx.x == 0) {
        unsigned* bar = b.bar;
        __builtin_amdgcn_s_waitcnt(0);
        unsigned nloc = b.st[0], nx = b.st[1];
        if (nloc == 0u) { xcd_barrier_complete(bar, b.x, nloc, nx); b.st[0] = nloc; b.st[1] = nx; }
        const unsigned old = xb_add(&bar[XB_XSUB(b.x)], 1u);
        const unsigned gen = old / nloc;
        if (old + 1u == (gen + 1u) * nloc) {
            __builtin_amdgcn_fence(__ATOMIC_RELEASE, "agent");
            asm volatile("s_waitcnt vmcnt(0)" ::: "memory");
            const unsigned og = xb_add(&bar[XB_TOP], 1u);
            const unsigned tg = og / nx;
            if (og + 1u == (tg + 1u) * nx) xb_add(&bar[XB_TOPGEN], 1u);
            else XB_SPIN(xb_ld(&bar[XB_TOPGEN]) == tg, bar);
            __builtin_amdgcn_fence(__ATOMIC_ACQUIRE, "agent");
            xb_add(&bar[XB_XGEN(b.x)], 1u);
            asm volatile("s_waitcnt vmcnt(0)" ::: "memory");
        } else {
            XB_SPIN(xb_ld(&bar[XB_XGEN(b.x)]) == gen, bar);
            __builtin_amdgcn_fence(__ATOMIC_ACQUIRE, "agent");
            asm volatile("s_waitcnt vmcnt(0)" ::: "memory");
        }
    }
    __syncthreads();
}

constexpr int PH_PER_LAYER = 9, N_PHASES = DEPTH * PH_PER_LAYER + 1;
__device__ __forceinline__ void run_phase(const Frame& F0, const Params& P0, int ph, int sub = 0) {
    Frame F = F0; Params P = P0; asm volatile("" : "+v"(F.tid)); F.lane = F.tid & 63; F.wave = __builtin_amdgcn_readfirstlane(F.tid >> 6); asm volatile("" : "+s"(F.G), "+s"(F.vb)); int bid = (int)blockIdx.x; asm volatile("" : "+s"(bid));
    { size_t zoff = 0; asm volatile("" : "+s"(zoff)); P.ws = P0.ws + zoff; }
    const int l = ph / PH_PER_LAYER, k = ph % PH_PER_LAYER;
    unsigned char* ws = P.ws; const float* rowsq = (const float*)(ws + WS_ROWSQ); const LAS float* lrs = (const LAS float*)(F.lds + pg8::LRS_OFF);
    if (ph == N_PHASES - 1) { final_norm(F, P); return; }
#ifdef ONLY_K
    if (k != ONLY_K) return;
#endif
    switch (k) {
    case 0: p0_attn_weights(F, P, l); if (l == 0) p0_input(F, P); break;
    case 1: {
        pg8::Gemm g{(const pg8::bf16_t*)(ws + WS_XB), (const pg8::bf16_t*)(ws + WS_WIN), TT, NMIXP, DM}; pg8::StaticOrder S; S.init(TT, NMIXP, F.G, bid);
        pg8::EpiProj E{(pg8::bf16_t*)(ws + WS_UV), (pg8::bf16_t*)(ws + WS_QKVB), (pg8::bf16_t*)(ws + WS_QKVC), (pg8::bf16_t*)(ws + WS_Z), lrs, (float*)(ws + WS_BA)};
        pg8::prep_rstd(F.lds, S, rowsq);
        pg8::gemm_phase<pg8::EpiProj, pg8::StaticOrder, true, true>(F.lds, g, S, E); } break;
    case 2: for (int t = F.vb; t < 512; t += F.G) dn_pre_pair(F, P, l, t); break;
    case 3: { const int sb = bid; if (sb < 8) { if (!(sub & 2)) dn_scan(F, P, sb, (sub & 16) != 0); }
              else if (!(sub & 1)) { const int nb = F.G - 8; for (int t = sb - 8; t < 768; t += nb) { if (t < 256) { if (!(sub & 4)) swa_task(F, P, l, t); } else if (!(sub & 8)) sgu_task(F, P, l, t - 256); } } } break;
    case 4: for (int t = F.vb; t < 1024; t += F.G) dn_out_task(F, P, l, t); p0_ffn_weights(F, P, l); break;
    case 5: {
        pg8::bf16_t* y0 = (pg8::bf16_t*)(ws + WS_UV); const long yd1 = (long)(WS_Y1 - WS_UV) / 2, yd2 = (long)(WS_Y2 - WS_Y1) / 2; pg8::bf16_t* mg = (pg8::bf16_t*)(ws + WS_MG);
        { pg8::Gemm g{(const pg8::bf16_t*)(ws + WS_BR), (const pg8::bf16_t*)(ws + WS_WBR), 3 * TT, 3072, 512}; pg8::TripleOrder S; S.init(TT, F.G, bid, true);
          pg8::EpiY E{y0, yd1, yd2}; pg8::gemm_phase<pg8::EpiY, pg8::TripleOrder, true, true>(F.lds, g, S, E); }
        __syncthreads();
        if (!(sub & 32)) { pg8::Gemm g{(const pg8::bf16_t*)(ws + WS_XB), (const pg8::bf16_t*)(ws + WS_WG), TT, 3072, DM}; pg8::TripleOrder S; S.init(TT, F.G, bid, false);
          pg8::EpiGateMerge E{y0, yd1, yd2, mg, lrs}; pg8::prep_rstd(F.lds, S.base, rowsq); pg8::gemm_phase<pg8::EpiGateMerge, pg8::TripleOrder, true, true>(F.lds, g, S, E); }
        } break;
    case 6: { pg8::Gemm g{(const pg8::bf16_t*)(ws + WS_MG), (const pg8::bf16_t*)(ws + WS_WOUT), TT, DM, DM}; pg8::StaticOrder S; S.init(TT, DM, F.G, bid);
        pg8::EpiResid<false> E{(pg8::bf16_t*)(ws + WS_XB), (float*)(ws + WS_ROWSQ), nullptr}; pg8::gemm_phase<pg8::EpiResid<false>, pg8::StaticOrder, true, true>(F.lds, g, S, E); } break;
    case 7: { pg8::Gemm g{(const pg8::bf16_t*)(ws + WS_XB), (const pg8::bf16_t*)(ws + WS_WGU), TT, 2 * DFF, DM}; pg8::StaticOrder S; S.init(TT, 2 * DFF, F.G, bid);
        pg8::EpiGU E{(pg8::bf16_t*)(ws + WS_HID), lrs}; pg8::prep_rstd(F.lds, S, rowsq); pg8::gemm_phase<pg8::EpiGU, pg8::StaticOrder, true, true>(F.lds, g, S, E); } break;
    case 8: { pg8::Gemm g{(const pg8::bf16_t*)(ws + WS_HID), (const pg8::bf16_t*)(ws + WS_WDN), TT, DM, DFF}; pg8::StaticOrder S; S.init(TT, DM, F.G, bid);
        if (l < DEPTH - 1) { pg8::EpiResid<false> E{(pg8::bf16_t*)(ws + WS_XB), (float*)(ws + WS_ROWSQ), nullptr}; pg8::gemm_phase<pg8::EpiResid<false>, pg8::StaticOrder, true, true>(F.lds, g, S, E); }
        else { pg8::EpiResid<true> E{(pg8::bf16_t*)(ws + WS_XB), (float*)(ws + WS_ROWSQ), P.out}; pg8::gemm_phase<pg8::EpiResid<true>, pg8::StaticOrder, true, true>(F.lds, g, S, E); } } break;
    }
}

__global__ void __launch_bounds__(NTHR, 2) hgpm_fwd(Params P) {
    extern __shared__ __attribute__((aligned(16))) unsigned char lds_raw[];
    Frame F; F.lds = (LAS unsigned char*)lds_raw; F.tid = threadIdx.x; F.lane = F.tid & 63; F.wave = __builtin_amdgcn_readfirstlane(F.tid >> 6);
    F.G = gridDim.x; { const int bx = blockIdx.x; F.vb = (F.G % 8 == 0) ? (bx % 8) * (F.G / 8) + bx / 8 : bx; }
#if USE_CG_SYNC
    cg::grid_group grid = cg::this_grid();
#define GRID_SYNC() grid.sync()
#else
    volatile LAS unsigned* misc = (volatile LAS unsigned*)(F.lds + MISC_OFF);
    if (F.tid < 64) misc[F.tid] = 0u;
    __syncthreads();
    const XcdBarrier bar = xcd_barrier_post((unsigned*)(P.ws + WS_CTL) + 1024, misc + 8);
#define GRID_SYNC() xcd_barrier(bar)
#endif
    for (int ph = P.ph_lo; ph < P.ph_hi; ++ph) {
        run_phase(F, P, ph);
#ifdef DUPK
#ifndef DUPSUB
#define DUPSUB 0
#endif
        if (ph % PH_PER_LAYER == DUPK && ph != N_PHASES - 1 && (DUPK != 6 || ph < PH_PER_LAYER)) { GRID_SYNC(); run_phase(F, P, ph, DUPSUB); }
        if (DUPK == 23 && ph % PH_PER_LAYER == 3) { GRID_SYNC(); run_phase(F, P, ph - 1, 0); GRID_SYNC(); run_phase(F, P, ph, 0); }
#endif
        if (ph + 1 < P.ph_hi) GRID_SYNC();
    }
}

#ifndef N_LAUNCH_MODE
#define N_LAUNCH_MODE 0
#endif
extern "C" void kernel_launch(void* const* d_in, const int* in_sizes, int n_in, void* d_out, int out_size, void* d_ws, size_t ws_size, hipStream_t stream) {
    static int grid = 0;
    if (grid == 0) {
        if (n_in != 19 || in_sizes[0] != TT * DM || out_size != TT * DM || ws_size < WS_END) { fprintf(stderr, "kernel_launch: unexpected shapes (n_in %d, in0 %d, out %d, ws %zu)\n", n_in, n_in > 0 ? in_sizes[0] : -1, out_size, ws_size); grid = -1; return; }
        int dev = 0, cus = 0, per_cu = 0;
        if (hipGetDevice(&dev) != hipSuccess || hipDeviceGetAttribute(&cus, hipDeviceAttributeMultiprocessorCount, dev) != hipSuccess) { grid = -1; return; }
        if (hipFuncSetAttribute((const void*)hgpm_fwd, hipFuncAttributeMaxDynamicSharedMemorySize, LDS_BYTES) != hipSuccess) { fprintf(stderr, "kernel_launch: hipFuncSetAttribute failed\n"); grid = -1; return; }
        if (hipOccupancyMaxActiveBlocksPerMultiprocessor(&per_cu, (const void*)hgpm_fwd, NTHR, LDS_BYTES) != hipSuccess || per_cu < 1) { fprintf(stderr, "kernel_launch: occupancy query says %d blocks per CU\n", per_cu); per_cu = 1; }
        (void)hipGetLastError();
        grid = cus;
    }
    if (grid < 0) return;
    Params p{};
    p.x = (const float*)d_in[0]; p.pos = (const int*)d_in[1]; p.attn_norm = (const float*)d_in[2]; p.w_in = (const float*)d_in[3]; p.sgu_ln_g = (const float*)d_in[4]; p.sgu_ln_b = (const float*)d_in[5];
    p.sgu_w = (const float*)d_in[6]; p.sgu_b = (const float*)d_in[7]; p.sinks = (const float*)d_in[8]; p.conv_w = (const float*)d_in[9]; p.a_log = (const float*)d_in[10]; p.dt_bias = (const float*)d_in[11];
    p.dn_norm = (const float*)d_in[12]; p.w_branch = (const float*)d_in[13]; p.w_out = (const float*)d_in[14]; p.ffn_norm = (const float*)d_in[15]; p.w_gate_up = (const float*)d_in[16]; p.w_down = (const float*)d_in[17];
    p.final_norm = (const float*)d_in[18]; p.out = (float*)d_out; p.ws = (unsigned char*)d_ws;
#if N_LAUNCH_MODE == 0
    p.ph_lo = 0; p.ph_hi = N_PHASES;
#if USE_CG_SYNC
    void* args[] = {&p};
    hipError_t e = hipLaunchCooperativeKernel((const void*)hgpm_fwd, dim3(grid), dim3(NTHR), args, LDS_BYTES, stream);
    if (e != hipSuccess) fprintf(stderr, "kernel_launch: cooperative launch failed: %s (grid %d)\n", hipGetErrorString(e), grid);
#else
    if (hipMemsetAsync((char*)d_ws + WS_CTL, 0, CTL_ZERO_BYTES, stream) != hipSuccess) { fprintf(stderr, "kernel_launch: hipMemsetAsync failed\n"); return; }
    hipLaunchKernelGGL(hgpm_fwd, dim3(grid), dim3(NTHR), LDS_BYTES, stream, p);
#endif
#else
    for (int ph = 0; ph < N_PHASES; ++ph) { p.ph_lo = ph; p.ph_hi = ph + 1; hipLaunchKernelGGL(hgpm_fwd, dim3(grid), dim3(NTHR), LDS_BYTES, stream, p); }
#endif
}
```
